# Optimizing an MI355X kernel written in HIP

```python
import jax, jax.numpy as jnp
from jax import lax
import numpy as np

D_MODEL = 2048
BATCH = 4
SEQ = 2048
DEPTH = 1
DEC_BATCH = 128
DEC_SEQ = 8
PAST_LEN = 16384
PAGE_SIZE = 128

CHUNK = 128
A_WIDTH = 1024
A_GROUPS = 4
A_GROUP_DIM = A_WIDTH // A_GROUPS
B_WIDTH = 1024
CONV_W = 3
N_MEM = 256
X_HEADS = 4
X_HEAD_DIM = D_MODEL // X_HEADS
D_FF = 4 * D_MODEL
EPS = 1e-6
IN_WIDTHS = (A_WIDTH, A_WIDTH, B_WIDTH, B_WIDTH, B_WIDTH, D_MODEL, D_MODEL)
IN_WIDTH = sum(IN_WIDTHS)
IN_SPLITS = tuple(int(s) for s in np.cumsum(IN_WIDTHS)[:-1])

kernel_name = "gated_chunkmlp_shortconv_memxattn_step"


def rmsnorm(x, g):
    xf = x.astype(jnp.float32)
    r = lax.rsqrt(jnp.mean(xf * xf, axis=-1, keepdims=True) + EPS)
    return (xf * r).astype(x.dtype) * g


def layernorm(x, g, b):
    xf = x.astype(jnp.float32)
    mu = jnp.mean(xf, axis=-1, keepdims=True)
    var = jnp.mean(jnp.square(xf - mu), axis=-1, keepdims=True)
    return ((xf - mu) * lax.rsqrt(var + EPS)).astype(x.dtype) * g + b


def chunk_spatial_gate(u, v, w_s, b_s):
    n, t, _ = v.shape
    L = CHUNK if t % CHUNK == 0 else t
    nc = t // L
    mask = jnp.tril(jnp.ones((L, L), dtype=bool))
    ws = jnp.where(mask, w_s[:, :L, :L], 0).astype(v.dtype)
    vc = v.reshape(n, nc, L, A_GROUPS, A_GROUP_DIM)
    z = jnp.einsum("gts,bcsgd->bctgd", ws, vc) + b_s[:, :L].T[None, None, :, :, None]
    return u * z.reshape(n, t, A_WIDTH)


def causal_dwconv(p, prev, w):
    t = p.shape[1]
    xp = jnp.concatenate([prev, p], axis=1)
    y = sum(w[k] * xp[:, k:k + t] for k in range(CONV_W))
    return y, xp[:, t:]


def mem_kv(mem, g_mem, w_k, w_v):
    n = mem.shape[0]
    mn = rmsnorm(mem, g_mem)
    k = (mn @ w_k).reshape(n, N_MEM, X_HEADS, X_HEAD_DIM)
    v = (mn @ w_v).reshape(n, N_MEM, X_HEADS, X_HEAD_DIM)
    return k, v


def cross_attn(hn, k, v, w_q, w_xo):
    n, t, _ = hn.shape
    q = (hn @ w_q).reshape(n, t, X_HEADS, X_HEAD_DIM)
    s = jnp.einsum("bthd,bmhd->bhtm", q, k).astype(jnp.float32) * (X_HEAD_DIM ** -0.5)
    p = jax.nn.softmax(s, axis=-1).astype(v.dtype)
    o = jnp.einsum("bhtm,bmhd->bthd", p, v).reshape(n, t, D_MODEL)
    return o @ w_xo


def layer(x, conv_prev, k_mem, v_mem, norm_mix_g, w_in, ln_v_g, ln_v_b, w_spatial, b_spatial,
          conv_w, w_branch_a, w_branch_b, w_mix_out, norm_x_g, w_q, w_x_out, norm_mlp_g, w_up, w_down):
    xn = rmsnorm(x, norm_mix_g)
    u, v, bg, cg, xin, ga, gb = jnp.split(xn @ w_in, IN_SPLITS, axis=-1)
    v = layernorm(v, ln_v_g, ln_v_b)
    y_a = chunk_spatial_gate(u, v, w_spatial, b_spatial)
    conv, conv_state = causal_dwconv(cg * xin, conv_prev, conv_w)
    y_b = bg * conv
    merged = jax.nn.sigmoid(ga) * (y_a @ w_branch_a) + jax.nn.sigmoid(gb) * (y_b @ w_branch_b)
    h = x + merged @ w_mix_out
    h = h + cross_attn(rmsnorm(h, norm_x_g), k_mem, v_mem, w_q, w_x_out)
    h = h + jnp.square(jax.nn.relu(rmsnorm(h, norm_mlp_g) @ w_up)) @ w_down
    return h, v, conv_state


def setup_inputs(seed: int = 0) -> dict:
    key = jax.random.key(seed)
    ks = jax.random.split(key, 32)
    f32 = jnp.float32

    def nrm(k, shape, scale=1.0):
        return jax.random.normal(k, shape, f32) * scale

    def gain(k, shape):
        return 1.0 + 0.1 * jax.random.normal(k, shape, f32)

    return {
        "x_prompt": nrm(ks[0], (BATCH, SEQ, D_MODEL)),
        "x_sample": nrm(ks[1], (DEC_BATCH, DEC_SEQ, D_MODEL)),
        "state_conv": nrm(ks[2], (DEPTH, DEC_BATCH, CONV_W - 1, B_WIDTH)),
        "cache_mem_k": nrm(ks[3], (DEPTH, DEC_BATCH, N_MEM, X_HEADS, X_HEAD_DIM)),
        "cache_mem_v": nrm(ks[4], (DEPTH, DEC_BATCH, N_MEM, X_HEADS, X_HEAD_DIM)),
        "mem_prompt": nrm(ks[5], (BATCH, N_MEM, D_MODEL)),
        "norm_mix_g": gain(ks[6], (DEPTH, D_MODEL)),
        "w_in": nrm(ks[7], (DEPTH, D_MODEL, IN_WIDTH), D_MODEL ** -0.5),
        "ln_v_g": gain(ks[8], (DEPTH, A_WIDTH)),
        "ln_v_b": nrm(ks[9], (DEPTH, A_WIDTH), 0.02),
        "w_spatial": nrm(ks[10], (DEPTH, A_GROUPS, CHUNK, CHUNK), CHUNK ** -0.5),
        "b_spatial": gain(ks[11], (DEPTH, A_GROUPS, CHUNK)),
        "conv_w": nrm(ks[12], (DEPTH, CONV_W, B_WIDTH), CONV_W ** -0.5),
        "w_branch_a": nrm(ks[13], (DEPTH, A_WIDTH, D_MODEL), A_WIDTH ** -0.5),
        "w_branch_b": nrm(ks[14], (DEPTH, B_WIDTH, D_MODEL), B_WIDTH ** -0.5),
        "w_mix_out": nrm(ks[15], (DEPTH, D_MODEL, D_MODEL), D_MODEL ** -0.5),
        "norm_x_g": gain(ks[16], (DEPTH, D_MODEL)),
        "norm_mem_g": gain(ks[17], (DEPTH, D_MODEL)),
        "w_q": nrm(ks[18], (DEPTH, D_MODEL, D_MODEL), D_MODEL ** -0.5),
        "w_k": nrm(ks[19], (DEPTH, D_MODEL, D_MODEL), D_MODEL ** -0.5),
        "w_v": nrm(ks[20], (DEPTH, D_MODEL, D_MODEL), D_MODEL ** -0.5),
        "w_x_out": nrm(ks[21], (DEPTH, D_MODEL, D_MODEL), D_MODEL ** -0.5),
        "norm_mlp_g": gain(ks[22], (DEPTH, D_MODEL)),
        "w_up": nrm(ks[23], (DEPTH, D_MODEL, D_FF), D_MODEL ** -0.5),
        "w_down": nrm(ks[24], (DEPTH, D_FF, D_MODEL), D_FF ** -0.5),
        "norm_final_g": gain(ks[25], (D_MODEL,)),
    }


def reference(x_prompt, x_sample, state_conv, cache_mem_k, cache_mem_v, mem_prompt,
              norm_mix_g, w_in, ln_v_g, ln_v_b, w_spatial, b_spatial, conv_w,
              w_branch_a, w_branch_b, w_mix_out, norm_x_g, norm_mem_g, w_q, w_k, w_v,
              w_x_out, norm_mlp_g, w_up, w_down, norm_final_g):
    hp, hs = x_prompt, x_sample
    mem_k_list, mem_v_list, conv_p_list, conv_s_list, chunk_v_list = [], [], [], [], []
    for l in range(DEPTH):
        lp = (norm_mix_g[l], w_in[l], ln_v_g[l], ln_v_b[l], w_spatial[l], b_spatial[l], conv_w[l],
              w_branch_a[l], w_branch_b[l], w_mix_out[l], norm_x_g[l], w_q[l], w_x_out[l],
              norm_mlp_g[l], w_up[l], w_down[l])
        k_p, v_p = mem_kv(mem_prompt, norm_mem_g[l], w_k[l], w_v[l])
        zero_prev = jnp.zeros((hp.shape[0], CONV_W - 1, B_WIDTH), hp.dtype)
        hp, _, conv_p = layer(hp, zero_prev, k_p, v_p, *lp)
        hs, v_s, conv_s = layer(hs, state_conv[l], cache_mem_k[l], cache_mem_v[l], *lp)
        mem_k_list.append(k_p)
        mem_v_list.append(v_p)
        conv_p_list.append(conv_p)
        conv_s_list.append(conv_s)
        chunk_v_list.append(v_s)
    y_prompt = rmsnorm(hp, norm_final_g)
    y_sample = rmsnorm(hs, norm_final_g)
    mem_k_prompt = jnp.stack(mem_k_list, axis=0)
    mem_v_prompt = jnp.stack(mem_v_list, axis=0)
    conv_prompt = jnp.stack(conv_p_list, axis=0)
    conv_sample = jnp.stack(conv_s_list, axis=0)
    chunk_v_sample = jnp.stack(chunk_v_list, axis=0)
    return (y_prompt, y_sample, mem_k_prompt, mem_v_prompt, conv_prompt, conv_sample, chunk_v_sample)
```

```cpp
#include <hip/hip_runtime.h>
#include <hip/hip_cooperative_groups.h>
#include <cstdio>
#include <cstdint>
namespace cg = cooperative_groups;

#define LAS __attribute__((address_space(3)))
typedef unsigned short bf16_t;
typedef short bf16x8 __attribute__((ext_vector_type(8)));
typedef float f32x4 __attribute__((ext_vector_type(4)));
typedef float f32x2 __attribute__((ext_vector_type(2)));
typedef unsigned u32x4 __attribute__((ext_vector_type(4)));
typedef unsigned u32x2 __attribute__((ext_vector_type(2)));

constexpr int DM = 2048, MP = 8192, MS = 1024, MT = MP + MS  ;
constexpr int NIN = 9216, FF = 8192, NMEM = 256, XH = 4, XD = 512;
constexpr int C_U = 0, C_V = 1024, C_BG = 2048, C_CG = 3072, C_XIN = 4096, C_GA = 5120, C_GB = 7168;
constexpr float EPS = 1e-6f;
constexpr size_t O_Y = 0, O_MK = 18874368, O_MV = 20971520, O_CP = 23068672, O_CS = 23076864, O_CV = 23339008;
constexpr size_t MiB = 1u << 20;
constexpr size_t WS_CTL = 0, CTL_BYTES = 1 * MiB;
constexpr size_t WS_WIN = 2 * MiB;
constexpr size_t WS_WA = 54 * MiB, WS_WB = 58 * MiB;
constexpr size_t WS_WMIX = 62 * MiB, WS_WQ = 70 * MiB, WS_WXO = 78 * MiB;
constexpr size_t WS_WUP = 86 * MiB;
constexpr size_t WS_WDN = 118 * MiB;
constexpr size_t WS_WSP = 150 * MiB;
constexpr size_t WS_XN = 152 * MiB;
constexpr size_t WS_P1 = 192 * MiB;
constexpr size_t WS_UP = 192 * MiB;
constexpr size_t WS_VT = 354 * MiB;
constexpr size_t WS_YA = 370 * MiB, WS_YB = 388 * MiB;
constexpr size_t WS_TMP = 406 * MiB;
constexpr size_t WS_H3 = 406 * MiB;
constexpr size_t WS_MRG = 478 * MiB;
constexpr size_t WS_H1 = 514 * MiB;
constexpr size_t WS_Q = 586 * MiB;
constexpr size_t WS_KP = 622 * MiB;
constexpr size_t WS_VPT = 626 * MiB;
constexpr size_t WS_PS = 630 * MiB;
constexpr size_t WS_O = 646 * MiB;
constexpr size_t WS_H2 = 682 * MiB;
constexpr size_t WS_END = 754 * MiB;

constexpr int LDS_BYTES = 147456;
constexpr int NWAVES = 8;

__device__ __forceinline__ unsigned cvt_pk_bf16(float lo, float hi) { unsigned r; asm volatile("v_cvt_pk_bf16_f32 %0, %1, %2" : "=v"(r) : "v"(lo), "v"(hi)); return r; }
__device__ __forceinline__ float bf_lo(unsigned u) { return __uint_as_float(u << 16); }
__device__ __forceinline__ float bf_hi(unsigned u) { return __uint_as_float(u & 0xffff0000u); }
__device__ __forceinline__ float bf1(bf16_t h) { return __uint_as_float(((unsigned)h) << 16); }
__device__ __forceinline__ bf16x8 pack8(f32x4 a, f32x4 b) {
    u32x4 w; w.x = cvt_pk_bf16(a.x, a.y); w.y = cvt_pk_bf16(a.z, a.w); w.z = cvt_pk_bf16(b.x, b.y); w.w = cvt_pk_bf16(b.z, b.w);
    return __builtin_bit_cast(bf16x8, w);
}
__device__ __forceinline__ void unpack8(u32x4 w, float (&f)[8]) {
    f[0] = bf_lo(w.x); f[1] = bf_hi(w.x); f[2] = bf_lo(w.y); f[3] = bf_hi(w.y); f[4] = bf_lo(w.z); f[5] = bf_hi(w.z); f[6] = bf_lo(w.w); f[7] = bf_hi(w.w);
}
__device__ __forceinline__ float wave_sum(float v) {
#pragma unroll
    for (int o = 1; o < 64; o <<= 1) v += __shfl_xor(v, o);
    return v;
}
__device__ __forceinline__ float sigmoidf_(float x) { return __builtin_amdgcn_rcpf(1.0f + __expf(-x)); }
#define LDS_WAIT() asm volatile("s_waitcnt lgkmcnt(0)" ::: "memory")

namespace pg8 {
constexpr int BM = 256, BK = 64, HALF = 128, HTB = HALF * BK * 2, STAGE_BYTES = 8 * HTB, NXCD = 8, WGM = 8;
__host__ __device__ __forceinline__ int lds_byte(int r, int c) { const int st = (r >> 4) * 2 + (c >> 5), rr = r & 15, cc = c & 31, ob = rr * 64 + cc * 2; return st * 1024 + (ob ^ (((ob >> 9) & 1) << 5)); }
__host__ __device__ __forceinline__ void stage_rc(int b, int& R, int& C) { const int st = b / 1024, sb = b % 1024, swz = sb ^ (((sb >> 9) & 1) << 5); R = (st >> 1) * 16 + swz / 64; C = (st & 1) * 32 + (swz % 64) / 2; }
__host__ __device__ __forceinline__ int perm32(int rho) { const int n = rho >> 4, i = rho & 15; return 8 * (i >> 2) + 4 * n + (i & 3); }

struct Unit { const char* A; const char* B; int orow, ocol, aux; };

__device__ __forceinline__ void rect_order(int L, int nM, int nN, int& pm, int& pn) {
    const int nwg = nM * nN; int wgid = L;
    { const int q = nwg / NXCD, r = nwg % NXCD, xcd = wgid % NXCD, off = wgid / NXCD; wgid = (xcd < r ? xcd * (q + 1) : r * (q + 1) + (xcd - r) * q) + off; }
    const int nig = WGM * nN, gid = wgid / nig, fm = gid * WGM, gsz = (nM - fm) < WGM ? (nM - fm) : WGM;
    pm = fm + ((wgid % nig) % gsz); pn = (wgid % nig) / gsz;
}

template <class Epi, class Sched, bool ALIGN_EPI>
__device__ __forceinline__ void gemm_phase(LAS unsigned char* lds, const int lda, const int ldb, const int K, const Sched& S, const Epi& E) {
    int tid_ = threadIdx.x; asm volatile("" : "+v"(tid_));
    const int tid = tid_, wid = __builtin_amdgcn_readfirstlane(tid >> 6), lane = tid & 63, wr = wid >> 2, wc = wid & 3, fr = lane & 15, fq = lane >> 4;
    int nt_ = K / BK; asm volatile("" : "+s"(nt_)); const int nt = nt_;
    unsigned voffA[2], voffB[2];
#pragma unroll
    for (int i = 0; i < 2; ++i) { int R, C; stage_rc(tid * 16 + i * 8192, R, C); const int Rb = Epi::PERM ? ((R & ~31) + perm32(R & 31)) : R;
        voffA[i] = (unsigned)(R * lda + C) * 2u; voffB[i] = (unsigned)(Rb * ldb + C) * 2u; }
    const size_t kstep = (size_t)(BK * 2);
    const size_t hstepA = (size_t)HALF * lda * 2, hstepB = (size_t)HALF * ldb * 2;
    const unsigned ldsw = (unsigned)wid * 1024u;
    const int aoff = lds_byte(wr * 64 + fr, fq * 8), boff = lds_byte(wc * 32 + fr, fq * 8);
#define PG8_SA(b, h) (((b) * 2 + (h)) * HTB)
#define PG8_SB(b, h) ((4 + (b) * 2 + (h)) * HTB)
#define PG8_STAGE(bufoff, gbase, voff) do { _Pragma("unroll") for (int _i = 0; _i < 2; ++_i) \
        __builtin_amdgcn_global_load_lds((const unsigned*)((const char*)(gbase) + (voff)[_i]), (LAS unsigned*)(lds + (bufoff) + ldsw + _i * 8192), 16, 0, 0); } while (0)
#define PG8_LDA(dst, b, h) do { _Pragma("unroll") for (int m = 0; m < 4; ++m) _Pragma("unroll") for (int k = 0; k < 2; ++k) dst[m][k] = *(const LAS bf16x8*)(lds + PG8_SA(b, h) + aoff + m * 2048 + k * 1024); } while (0)
#define PG8_LDB(dst, b, h) do { _Pragma("unroll") for (int n = 0; n < 2; ++n) _Pragma("unroll") for (int k = 0; k < 2; ++k) dst[n][k] = *(const LAS bf16x8*)(lds + PG8_SB(b, h) + boff + n * 2048 + k * 1024); } while (0)
#define PG8_MMA(ai, bj, At, Bt) do { __builtin_amdgcn_s_setprio(1); _Pragma("unroll") for (int m = 0; m < 4; ++m) _Pragma("unroll") for (int n = 0; n < 2; ++n) _Pragma("unroll") for (int k = 0; k < 2; ++k) \
        acc[ai][bj][m][n] = __builtin_amdgcn_mfma_f32_16x16x32_bf16(Bt[n][k], At[m][k], acc[ai][bj][m][n], 0, 0, 0); __builtin_amdgcn_s_setprio(0); } while (0)
#define PG8_WAIT_V(n) asm volatile("s_waitcnt vmcnt(" #n ")" ::: "memory")
#define PG8_WAIT_L(n) asm volatile("s_waitcnt lgkmcnt(" #n ")" ::: "memory")
#define PG8_BAR __builtin_amdgcn_s_barrier()
#define PG8_SCHED __builtin_amdgcn_sched_barrier(0)
    Unit cur, nxt; int ui = 0;
    if (!S.next(0, cur)) return;
    f32x4 acc[2][2][4][2];
#pragma unroll
    for (int a = 0; a < 2; ++a)
#pragma unroll
        for (int b = 0; b < 2; ++b)
#pragma unroll
            for (int m = 0; m < 4; ++m)
#pragma unroll
                for (int n = 0; n < 2; ++n) acc[a][b][m][n] = (f32x4){0.f, 0.f, 0.f, 0.f};
    bf16x8 At[4][2], B0[2][2], B1[2][2];
    const char* cA = cur.A; const char* cB = cur.B;
    PG8_STAGE(PG8_SB(0, 0), cB, voffB); PG8_STAGE(PG8_SB(0, 1), cB + hstepB, voffB); PG8_STAGE(PG8_SA(0, 0), cA, voffA); PG8_STAGE(PG8_SA(0, 1), cA + hstepA, voffA);
    if (wr == 1) PG8_BAR;
    PG8_WAIT_V(2); PG8_BAR;
    PG8_STAGE(PG8_SB(1, 0), cB + kstep, voffB); PG8_STAGE(PG8_SA(1, 0), cA + kstep, voffA); PG8_STAGE(PG8_SB(1, 1), cB + hstepB + kstep, voffB);
    PG8_WAIT_V(6); PG8_BAR;
    for (;;) {
        const bool has_next = S.next(ui + 1, nxt);
        const char* nA = has_next ? nxt.A : cA; const char* nB = has_next ? nxt.B : cB;
        for (int t = 0; t < nt; t += 2) {
            const bool last = (t == nt - 2);
            const char* a1 = cA + (size_t)(t + 1) * kstep;
            const char* a2 = last ? nA : cA + (size_t)(t + 2) * kstep; const char* b2 = last ? nB : cB + (size_t)(t + 2) * kstep;
            const char* a3 = a2 + kstep; const char* b3 = b2 + kstep;
            PG8_LDB(B0, 0, 0); PG8_LDB(B1, 0, 1); PG8_SCHED; PG8_LDA(At, 0, 0); PG8_STAGE(PG8_SA(1, 1), a1 + hstepA, voffA);
            PG8_WAIT_V(8); PG8_WAIT_L(0); PG8_BAR; PG8_MMA(0, 0, At, B0); PG8_MMA(0, 1, At, B1); PG8_BAR; PG8_SCHED;
            PG8_LDA(At, 0, 1); PG8_STAGE(PG8_SB(0, 0), b2, voffB); PG8_STAGE(PG8_SB(0, 1), b2 + hstepB, voffB); PG8_STAGE(PG8_SA(0, 0), a2, voffA);
            PG8_WAIT_V(8); PG8_WAIT_L(0); PG8_BAR; PG8_MMA(1, 0, At, B0); PG8_MMA(1, 1, At, B1); PG8_BAR; PG8_SCHED;
            PG8_LDB(B0, 1, 0); PG8_LDB(B1, 1, 1); PG8_SCHED; PG8_LDA(At, 1, 0); PG8_STAGE(PG8_SA(0, 1), a2 + hstepA, voffA);
            PG8_WAIT_V(8); PG8_WAIT_L(0); PG8_BAR; PG8_MMA(0, 0, At, B0); PG8_MMA(0, 1, At, B1); PG8_BAR; PG8_SCHED;
            PG8_LDA(At, 1, 1); PG8_STAGE(PG8_SB(1, 0), b3, voffB); PG8_STAGE(PG8_SB(1, 1), b3 + hstepB, voffB); PG8_STAGE(PG8_SA(1, 0), a3, voffA);
            PG8_WAIT_V(8); PG8_WAIT_L(0); PG8_BAR; PG8_MMA(1, 0, At, B0); PG8_MMA(1, 1, At, B1); PG8_BAR; PG8_SCHED;
        }
        if constexpr (ALIGN_EPI) { if (wr == 0) PG8_BAR; }
        if constexpr (!Epi::AFTER_DRAIN) { E(acc, cur, wr, wc, fr, fq); }
        if (!has_next) break;
#pragma unroll
        for (int a = 0; a < 2; ++a)
#pragma unroll
            for (int b = 0; b < 2; ++b)
#pragma unroll
                for (int m = 0; m < 4; ++m)
#pragma unroll
                    for (int n = 0; n < 2; ++n) acc[a][b][m][n] = (f32x4){0.f, 0.f, 0.f, 0.f};
        cur = nxt; cA = nA; cB = nB; ++ui;
        if constexpr (ALIGN_EPI) { if (wr == 1) PG8_BAR; }
    }
    PG8_WAIT_V(0);
    if constexpr (!ALIGN_EPI) { if (wr == 0) PG8_BAR; }
    PG8_BAR;
    if constexpr (Epi::AFTER_DRAIN) { E.fused(acc, cur, wr, wc, fr, fq, lds, wid, lane); }
#undef PG8_SA
#undef PG8_SB
#undef PG8_STAGE
#undef PG8_LDA
#undef PG8_LDB
#undef PG8_MMA
#undef PG8_WAIT_V
#undef PG8_WAIT_L
#undef PG8_BAR
#undef PG8_SCHED
}

struct SchedRect {
    const char* A; const char* B; size_t atile, btile; int nM, nN, G, c;
    __device__ __forceinline__ bool next(int i, Unit& u) const {
        const int L = i * G + c; if (L >= nM * nN) return false;
        int pm, pn; rect_order(L, nM, nN, pm, pn);
        u.A = A + (size_t)pm * atile; u.B = B + (size_t)pn * btile; u.orow = pm * BM; u.ocol = pn * BM; u.aux = 0; return true;
    }
};
struct SchedIn {
    const char* A; const char* B; int G, c;
    __device__ __forceinline__ bool next(int i, Unit& u) const {
        const int L = i * G + c; if (L >= 1296 + 64) return false;
        int pm, pn;
        if (L < 1296) { rect_order(L, 36, 36, pm, pn); u.orow = pm * BM; u.ocol = pn * BM; u.aux = 0; }
        else { const int l = L - 1296; pm = 36 + (l & 3); pn = 36 + (l >> 2); u.orow = (pm - 36) * BM; u.ocol = (pn - 36) * BM; u.aux = 1; }
        u.A = A + (size_t)pm * (BM * DM * 2); u.B = B + (size_t)pn * (BM * DM * 2); return true;
    }
};
struct SchedSp {
    const char* WSP; const char* VT; int G, c;
    __device__ __forceinline__ bool next(int i, Unit& u) const {
        const int L = i * G + c; if (L >= 256) return false;
        const int chunk = L >> 2, p = (L >> 1) & 1, gi = L & 1, g = 2 * p + gi;
        u.A = WSP + (size_t)p * (256 * 128 * 2); u.B = VT + ((size_t)chunk * 1024 + g * 256) * 128 * 2; u.orow = chunk * 128; u.ocol = g * 256; u.aux = gi; return true;
    }
};
struct SchedS {
    const char* Q; const char* KP; int G, c;
    __device__ __forceinline__ bool next(int i, Unit& u) const {
        const int L = i * G + c; if (L >= 128 || i > 0) return false;
        const int b = L >> 5, h = (L >> 3) & 3, p = L & 7;
        u.A = Q + ((size_t)(b * 2048 + p * 256) * DM + h * XD) * 2; u.B = KP + ((size_t)(b * 256) * DM + h * XD) * 2;
        u.orow = (b * 4 + h) * 2048 + p * 256; u.ocol = 0; u.aux = 0; return true;
    }
};
struct SchedO {
    const char* PS; const char* VPT; int G, c;
    __device__ __forceinline__ bool next(int i, Unit& u) const {
        const int L = i * G + c; if (L >= 256) return false;
        const int b = L >> 6, h = (L >> 4) & 3, p = (L >> 1) & 7, pn = L & 1;
        u.A = PS + ((size_t)((b * 4 + h) * 2048 + p * 256) * 256) * 2; u.B = VPT + ((size_t)(b * 2048 + h * XD + pn * 256) * 256) * 2;
        u.orow = b * 2048 + p * 256; u.ocol = h * XD + pn * 256; u.aux = 0; return true;
    }
};

#define EPI_ROWS_BEGIN _Pragma("unroll") for (int ai = 0; ai < 2; ++ai) _Pragma("unroll") for (int m = 0; m < 4; ++m) { const int rl = ai * HALF + wr * 64 + m * 16 + fr;
#define EPI_ROWS_END }

struct EpiIn {
    static constexpr bool PERM = true, AFTER_DRAIN = false;
    bf16_t* P1; float* memk; float* memv; bf16_t* KP; bf16_t* VPT;
    __device__ __forceinline__ void operator()(const f32x4 (&acc)[2][2][4][2], const Unit& u, int wr, int wc, int fr, int fq) const {
        const int cl0 = wc * 32 + 8 * fq;
        if (u.aux == 0) {
            EPI_ROWS_BEGIN
                bf16_t* rowp = P1 + (size_t)(u.orow + rl) * NIN + u.ocol + cl0;
#pragma unroll
                for (int bj = 0; bj < 2; ++bj) { const f32x4 v0 = acc[ai][bj][m][0], v1 = acc[ai][bj][m][1];
                    u32x4 w; w.x = cvt_pk_bf16(v0[0], v0[1]); w.y = cvt_pk_bf16(v0[2], v0[3]); w.z = cvt_pk_bf16(v1[0], v1[1]); w.w = cvt_pk_bf16(v1[2], v1[3]);
                    *(u32x4*)(rowp + bj * HALF) = w; }
            EPI_ROWS_END
        } else {
            const bool isV = u.ocol >= DM; const int cb = u.ocol - (isV ? DM : 0) + cl0;
            float* fo = isV ? memv : memk;
            EPI_ROWS_BEGIN
                const int row = u.orow + rl;
#pragma unroll
                for (int bj = 0; bj < 2; ++bj) { const f32x4 v0 = acc[ai][bj][m][0], v1 = acc[ai][bj][m][1]; const int col = cb + bj * HALF;
                    *(f32x4*)(fo + (size_t)row * DM + col) = v0; *(f32x4*)(fo + (size_t)row * DM + col + 4) = v1;
                    u32x4 w; w.x = cvt_pk_bf16(v0[0], v0[1]); w.y = cvt_pk_bf16(v0[2], v0[3]); w.z = cvt_pk_bf16(v1[0], v1[1]); w.w = cvt_pk_bf16(v1[2], v1[3]);
                    if (!isV) { *(u32x4*)(KP + (size_t)row * DM + col) = w; }
                    else { bf16_t* vp = VPT + ((size_t)(row >> 8) * DM + col) * 256 + (row & 255);
                        vp[0 * 256] = (bf16_t)(w.x & 0xffff); vp[1 * 256] = (bf16_t)(w.x >> 16); vp[2 * 256] = (bf16_t)(w.y & 0xffff); vp[3 * 256] = (bf16_t)(w.y >> 16);
                        vp[4 * 256] = (bf16_t)(w.z & 0xffff); vp[5 * 256] = (bf16_t)(w.z >> 16); vp[6 * 256] = (bf16_t)(w.w & 0xffff); vp[7 * 256] = (bf16_t)(w.w >> 16); } }
            EPI_ROWS_END
        }
    }
};
struct EpiSp {
    static constexpr bool PERM = true, AFTER_DRAIN = false;
    const bf16_t* P1; const float* bsp; bf16_t* YA;
    __device__ __forceinline__ void operator()(const f32x4 (&acc)[2][2][4][2], const Unit& u, int wr, int wc, int fr, int fq) const {
        const int g = u.ocol >> 8, cl0 = wc * 32 + 8 * fq;
#pragma unroll
        for (int ai = 0; ai < 2; ++ai) if (ai == u.aux) {
#pragma unroll
            for (int m = 0; m < 4; ++m) { const int t = wr * 64 + m * 16 + fr; const int row = u.orow + t; const float bs = bsp[g * 128 + t];
#pragma unroll
                for (int bj = 0; bj < 2; ++bj) { const int col = u.ocol + bj * HALF + cl0;
                    const u32x4 uw = *(const u32x4*)(P1 + (size_t)row * NIN + C_U + col); float uf[8]; unpack8(uw, uf);
                    const f32x4 v0 = acc[ai][bj][m][0], v1 = acc[ai][bj][m][1];
                    u32x4 w; w.x = cvt_pk_bf16(uf[0] * (v0[0] + bs), uf[1] * (v0[1] + bs)); w.y = cvt_pk_bf16(uf[2] * (v0[2] + bs), uf[3] * (v0[3] + bs));
                    w.z = cvt_pk_bf16(uf[4] * (v1[0] + bs), uf[5] * (v1[1] + bs)); w.w = cvt_pk_bf16(uf[6] * (v1[2] + bs), uf[7] * (v1[3] + bs));
                    *(u32x4*)(YA + (size_t)row * 1024 + col) = w; } }
        }
    }
};
struct EpiGA {
    static constexpr bool PERM = false, AFTER_DRAIN = false;
    const bf16_t* P1; float* TMP;
    __device__ __forceinline__ void operator()(const f32x4 (&acc)[2][2][4][2], const Unit& u, int wr, int wc, int fr, int fq) const {
        EPI_ROWS_BEGIN
            const int row = u.orow + rl;
#pragma unroll
            for (int bj = 0; bj < 2; ++bj)
#pragma unroll
                for (int n = 0; n < 2; ++n) { const int col = u.ocol + bj * HALF + wc * 32 + 16 * n + 4 * fq;
                    const u32x2 gw = *(const u32x2*)(P1 + (size_t)row * NIN + C_GA + col); const f32x4 v = acc[ai][bj][m][n];
                    f32x4 o; o[0] = sigmoidf_(bf_lo(gw.x)) * v[0]; o[1] = sigmoidf_(bf_hi(gw.x)) * v[1]; o[2] = sigmoidf_(bf_lo(gw.y)) * v[2]; o[3] = sigmoidf_(bf_hi(gw.y)) * v[3];
                    *(f32x4*)(TMP + (size_t)row * DM + col) = o; }
        EPI_ROWS_END
    }
};
struct EpiGB {
    static constexpr bool PERM = true, AFTER_DRAIN = false;
    const bf16_t* P1; const float* TMP; bf16_t* MRG;
    __device__ __forceinline__ void operator()(const f32x4 (&acc)[2][2][4][2], const Unit& u, int wr, int wc, int fr, int fq) const {
        const int cl0 = wc * 32 + 8 * fq;
        EPI_ROWS_BEGIN
            const int row = u.orow + rl;
#pragma unroll
            for (int bj = 0; bj < 2; ++bj) { const int col = u.ocol + bj * HALF + cl0;
                const u32x4 gw = *(const u32x4*)(P1 + (size_t)row * NIN + C_GB + col); float gf[8]; unpack8(gw, gf);
                const f32x4 t0 = *(const f32x4*)(TMP + (size_t)row * DM + col), t1 = *(const f32x4*)(TMP + (size_t)row * DM + col + 4);
                const f32x4 v0 = acc[ai][bj][m][0], v1 = acc[ai][bj][m][1];
                u32x4 w; w.x = cvt_pk_bf16(t0[0] + sigmoidf_(gf[0]) * v0[0], t0[1] + sigmoidf_(gf[1]) * v0[1]); w.y = cvt_pk_bf16(t0[2] + sigmoidf_(gf[2]) * v0[2], t0[3] + sigmoidf_(gf[3]) * v0[3]);
                w.z = cvt_pk_bf16(t1[0] + sigmoidf_(gf[4]) * v1[0], t1[1] + sigmoidf_(gf[5]) * v1[1]); w.w = cvt_pk_bf16(t1[2] + sigmoidf_(gf[6]) * v1[2], t1[3] + sigmoidf_(gf[7]) * v1[3]);
                *(u32x4*)(MRG + (size_t)row * DM + col) = w; }
        EPI_ROWS_END
    }
};
struct EpiRes {
    static constexpr bool PERM = false, AFTER_DRAIN = false;
    const float* resA; const float* resB; int split; float* out;
    __device__ __forceinline__ void operator()(const f32x4 (&acc)[2][2][4][2], const Unit& u, int wr, int wc, int fr, int fq) const {
        const float* rbase = (u.orow < split) ? resA + (size_t)u.orow * DM : resB + (size_t)(u.orow - split) * DM;
        float* obase = out + (size_t)u.orow * DM;
        EPI_ROWS_BEGIN
#pragma unroll
            for (int bj = 0; bj < 2; ++bj)
#pragma unroll
                for (int n = 0; n < 2; ++n) { const size_t off = (size_t)rl * DM + u.ocol + bj * HALF + wc * 32 + 16 * n + 4 * fq;
                    const f32x4 r = *(const f32x4*)(rbase + off); *(f32x4*)(obase + off) = r + acc[ai][bj][m][n]; }
        EPI_ROWS_END
    }
};
template <int MODE  > struct EpiBf {
    static constexpr bool PERM = true, AFTER_DRAIN = false;
    bf16_t* O; int ldc; float scale;
    __device__ __forceinline__ void operator()(const f32x4 (&acc)[2][2][4][2], const Unit& u, int wr, int wc, int fr, int fq) const {
        const int cl0 = wc * 32 + 8 * fq;
        EPI_ROWS_BEGIN
            bf16_t* rowp = O + (size_t)(u.orow + rl) * ldc + u.ocol + cl0;
#pragma unroll
            for (int bj = 0; bj < 2; ++bj) { f32x4 v0 = acc[ai][bj][m][0], v1 = acc[ai][bj][m][1];
                if (MODE == 0) { v0 = v0 * scale; v1 = v1 * scale; }
                else {
#pragma unroll
                    for (int e = 0; e < 4; ++e) { const float a = fmaxf(v0[e], 0.f), b = fmaxf(v1[e], 0.f); v0[e] = a * a; v1[e] = b * b; } }
                u32x4 w; w.x = cvt_pk_bf16(v0[0], v0[1]); w.y = cvt_pk_bf16(v0[2], v0[3]); w.z = cvt_pk_bf16(v1[0], v1[1]); w.w = cvt_pk_bf16(v1[2], v1[3]);
                *(u32x4*)(rowp + bj * HALF) = w; }
        EPI_ROWS_END
    }
};
struct EpiSoftmax {
    static constexpr bool PERM = true, AFTER_DRAIN = true;
    bf16_t* PS;
    __device__ __forceinline__ void fused(f32x4 (&acc)[2][2][4][2], const Unit& u, int wr, int wc, int fr, int fq, LAS unsigned char* lds, int wid, int lane) const {
        LAS f32x2* X = (LAS f32x2*)lds;
        float mxl[2][4];
        EPI_ROWS_BEGIN
            float mx = -3.0e38f;
#pragma unroll
            for (int bj = 0; bj < 2; ++bj)
#pragma unroll
                for (int n = 0; n < 2; ++n) { const f32x4 v = acc[ai][bj][m][n]; mx = fmaxf(mx, fmaxf(fmaxf(v[0], v[1]), fmaxf(v[2], v[3]))); }
            mx = fmaxf(mx, __shfl_xor(mx, 16)); mx = fmaxf(mx, __shfl_xor(mx, 32));
            float s = 0.f;
#pragma unroll
            for (int bj = 0; bj < 2; ++bj)
#pragma unroll
                for (int n = 0; n < 2; ++n) { f32x4 v = acc[ai][bj][m][n];
#pragma unroll
                    for (int e = 0; e < 4; ++e) { v[e] = __expf(v[e] - mx); s += v[e]; }
                    acc[ai][bj][m][n] = v; }
            s += __shfl_xor(s, 16); s += __shfl_xor(s, 32);
            mxl[ai][m] = mx;
            if (fq == 0) X[rl * 4 + wc] = (f32x2){mx, s};
        EPI_ROWS_END
        LDS_WAIT(); __builtin_amdgcn_s_barrier(); asm volatile("" ::: "memory");
        const int cl0 = wc * 32 + 8 * fq;
        EPI_ROWS_BEGIN
            const f32x2 a = X[rl * 4 + 0], b = X[rl * 4 + 1], c = X[rl * 4 + 2], d = X[rl * 4 + 3];
            const float M = fmaxf(fmaxf(a.x, b.x), fmaxf(c.x, d.x));
            const float L = a.y * __expf(a.x - M) + b.y * __expf(b.x - M) + c.y * __expf(c.x - M) + d.y * __expf(d.x - M);
            const float f = __expf(mxl[ai][m] - M) / L;
            bf16_t* rowp = PS + (size_t)(u.orow + rl) * 256 + cl0;
#pragma unroll
            for (int bj = 0; bj < 2; ++bj) { const f32x4 v0 = acc[ai][bj][m][0] * f, v1 = acc[ai][bj][m][1] * f;
                u32x4 w; w.x = cvt_pk_bf16(v0[0], v0[1]); w.y = cvt_pk_bf16(v0[2], v0[3]); w.z = cvt_pk_bf16(v1[0], v1[1]); w.w = cvt_pk_bf16(v1[2], v1[3]);
                *(u32x4*)(rowp + bj * HALF) = w; }
        EPI_ROWS_END
        LDS_WAIT(); __builtin_amdgcn_s_barrier(); asm volatile("" ::: "memory");
    }
};
}

struct Args { const float* in[26]; float* out; unsigned char* ws; };

struct Frame {
    LAS unsigned char* lds;
    int tid, lane, wave, G, bx;
    float* out; unsigned char* ws;
};
typedef const float* cfp_t;
__device__ __forceinline__ const float* karg_in(int i) {
    asm volatile("" : "+s"(i));
    const __attribute__((address_space(4))) cfp_t* ka = (const __attribute__((address_space(4))) cfp_t*)__builtin_amdgcn_kernarg_segment_ptr();
    return ka[i];
}
#define IN(i) karg_in(i)
#define WSP(T, off) ((T*)(F.ws + (off)))

__device__ __forceinline__ void p0_transpose_item(const float* W, int K, int N, bf16_t* WT, int row_off, LAS float* scr, int item, int lane) {
    const int nblk = N / 32, kb = item / nblk, nb = item % nblk, k0 = 64 * kb, n0 = 32 * nb;
#pragma unroll 8
    for (int i = 0; i < 32; ++i) { const int kk = 2 * i + (lane >> 5); scr[kk * 33 + (lane & 31)] = W[(size_t)(k0 + kk) * N + n0 + (lane & 31)]; }
    LDS_WAIT(); asm volatile("" ::: "memory");
    const int c = lane & 7;
#pragma unroll
    for (int j = 0; j < 4; ++j) { const int n = (lane >> 3) + 8 * j; const LAS float* s = scr + (8 * c) * 33 + n;
        u32x4 o; o.x = cvt_pk_bf16(s[0 * 33], s[1 * 33]); o.y = cvt_pk_bf16(s[2 * 33], s[3 * 33]); o.z = cvt_pk_bf16(s[4 * 33], s[5 * 33]); o.w = cvt_pk_bf16(s[6 * 33], s[7 * 33]);
        *(u32x4*)(WT + (size_t)(row_off + n0 + n) * K + k0 + 8 * c) = o; }
    LDS_WAIT(); asm volatile("" ::: "memory");
}
template <bool OUT_F32> __device__ __forceinline__ void rms_row(const float* xrow, const float* g, void* orow, int lane) {
    const f32x4* xr = (const f32x4*)xrow + lane; f32x4 v[8]; float ss = 0.f;
#pragma unroll
    for (int j = 0; j < 8; ++j) { v[j] = xr[64 * j]; ss += (v[j].x * v[j].x + v[j].y * v[j].y) + (v[j].z * v[j].z + v[j].w * v[j].w); }
    const float r = rsqrtf(wave_sum(ss) * (1.f / DM) + EPS);
    const f32x4* gr = (const f32x4*)g + lane;
#pragma unroll
    for (int j = 0; j < 8; ++j) { const f32x4 gg = gr[64 * j]; const f32x4 o = v[j] * r * gg;
        if (OUT_F32) ((f32x4*)orow)[lane + 64 * j] = o;
        else { u32x2 w; w.x = cvt_pk_bf16(o.x, o.y); w.y = cvt_pk_bf16(o.z, o.w); ((u32x2*)orow)[lane + 64 * j] = w; } }
}

__device__ __forceinline__ void phase_prologue(Frame& F) {
    LAS float* scr = (LAS float*)(F.lds + F.wave * 16384);
    const int gw = F.bx * NWAVES + F.wave, NGW = F.G * NWAVES;
    constexpr int I_IN = 32 * 288, I_SQ = 32 * 64, I_BR = 16 * 64, I_UP = 32 * 256, I_DN = 128 * 64;
    constexpr int NITEMS = I_IN + 5 * I_SQ + 2 * I_BR + I_UP + I_DN;
    bf16_t* WIN = WSP(bf16_t, WS_WIN);
    for (int it = gw; it < NITEMS; it += NGW) {
        int r = it;
        if (r < I_IN) { p0_transpose_item(IN(7), DM, NIN, WIN, 0, scr, r, F.lane); continue; } r -= I_IN;
        if (r < I_SQ) { p0_transpose_item(IN(19), DM, DM, WIN, NIN, scr, r, F.lane); continue; } r -= I_SQ;
        if (r < I_SQ) { p0_transpose_item(IN(20), DM, DM, WIN, NIN + DM, scr, r, F.lane); continue; } r -= I_SQ;
        if (r < I_SQ) { p0_transpose_item(IN(15), DM, DM, WSP(bf16_t, WS_WMIX), 0, scr, r, F.lane); continue; } r -= I_SQ;
        if (r < I_SQ) { p0_transpose_item(IN(18), DM, DM, WSP(bf16_t, WS_WQ), 0, scr, r, F.lane); continue; } r -= I_SQ;
        if (r < I_SQ) { p0_transpose_item(IN(21), DM, DM, WSP(bf16_t, WS_WXO), 0, scr, r, F.lane); continue; } r -= I_SQ;
        if (r < I_BR) { p0_transpose_item(IN(13), 1024, DM, WSP(bf16_t, WS_WA), 0, scr, r, F.lane); continue; } r -= I_BR;
        if (r < I_BR) { p0_transpose_item(IN(14), 1024, DM, WSP(bf16_t, WS_WB), 0, scr, r, F.lane); continue; } r -= I_BR;
        if (r < I_UP) { p0_transpose_item(IN(23), DM, FF, WSP(bf16_t, WS_WUP), 0, scr, r, F.lane); continue; } r -= I_UP;
        p0_transpose_item(IN(24), FF, DM, WSP(bf16_t, WS_WDN), 0, scr, r, F.lane);
    }
    bf16_t* XN = WSP(bf16_t, WS_XN);
    for (int m = gw; m < MT + 1024; m += NGW) {
        const float* src = m < MP ? IN(0) + (size_t)m * DM : (m < MT ? IN(1) + (size_t)(m - MP) * DM : IN(5) + (size_t)(m - MT) * DM);
        rms_row<false>(src, m < MT ? IN(6) : IN(17), XN + (size_t)m * DM, F.lane);
    }
    bf16_t* WS = WSP(bf16_t, WS_WSP);
    for (int i = F.bx * 512 + F.tid; i < 4 * 128 * 128; i += F.G * 512) { const int t = (i >> 7) & 127, s = i & 127; const float w = (s <= t) ? IN(10)[i] : 0.f; WS[i] = (bf16_t)(cvt_pk_bf16(w, 0.f) & 0xffff); }
}

__device__ __forceinline__ void phase_mixprep(Frame& F) {
    const bf16_t* P1 = WSP(bf16_t, WS_P1);
    {
        bf16_t* YB = WSP(bf16_t, WS_YB); const float* cw = IN(12); const float* st = IN(2);
        for (int it = F.bx * 512 + F.tid; it < MT * 128; it += F.G * 512) {
            const int row = it >> 7, c0 = (it & 127) * 8;
            const bf16_t* pr = P1 + (size_t)row * NIN;
            float cg[8], xi[8], p0[8], p1[8], p2[8], bg[8];
            unpack8(*(const u32x4*)(pr + C_CG + c0), cg); unpack8(*(const u32x4*)(pr + C_XIN + c0), xi); unpack8(*(const u32x4*)(pr + C_BG + c0), bg);
#pragma unroll
            for (int e = 0; e < 8; ++e) p0[e] = cg[e] * xi[e];
            int pos, b; const bool prompt = row < MP;
            if (prompt) { pos = row & 2047; b = row >> 11; } else { pos = (row - MP) & 7; b = (row - MP) >> 3; }
            if (pos >= 1) { unpack8(*(const u32x4*)(pr - NIN + C_CG + c0), cg); unpack8(*(const u32x4*)(pr - NIN + C_XIN + c0), xi);
#pragma unroll
                for (int e = 0; e < 8; ++e) p1[e] = cg[e] * xi[e]; }
            else if (prompt) {
#pragma unroll
                for (int e = 0; e < 8; ++e) p1[e] = 0.f; }
            else { const f32x4 a = *(const f32x4*)(st + ((size_t)b * 2 + 1) * 1024 + c0), c = *(const f32x4*)(st + ((size_t)b * 2 + 1) * 1024 + c0 + 4);
                p1[0] = a.x; p1[1] = a.y; p1[2] = a.z; p1[3] = a.w; p1[4] = c.x; p1[5] = c.y; p1[6] = c.z; p1[7] = c.w; }
            if (pos >= 2) { unpack8(*(const u32x4*)(pr - 2 * NIN + C_CG + c0), cg); unpack8(*(const u32x4*)(pr - 2 * NIN + C_XIN + c0), xi);
#pragma unroll
                for (int e = 0; e < 8; ++e) p2[e] = cg[e] * xi[e]; }
            else if (prompt) {
#pragma unroll
                for (int e = 0; e < 8; ++e) p2[e] = 0.f; }
            else { const int sr = (pos == 1) ? 1 : 0; const f32x4 a = *(const f32x4*)(st + ((size_t)b * 2 + sr) * 1024 + c0), c = *(const f32x4*)(st + ((size_t)b * 2 + sr) * 1024 + c0 + 4);
                p2[0] = a.x; p2[1] = a.y; p2[2] = a.z; p2[3] = a.w; p2[4] = c.x; p2[5] = c.y; p2[6] = c.z; p2[7] = c.w; }
            float y[8];
#pragma unroll
            for (int e = 0; e < 8; ++e) y[e] = bg[e] * (cw[c0 + e] * p2[e] + cw[1024 + c0 + e] * p1[e] + cw[2048 + c0 + e] * p0[e]);
            u32x4 w; w.x = cvt_pk_bf16(y[0], y[1]); w.y = cvt_pk_bf16(y[2], y[3]); w.z = cvt_pk_bf16(y[4], y[5]); w.w = cvt_pk_bf16(y[6], y[7]);
            *(u32x4*)(YB + (size_t)row * 1024 + c0) = w;
            const int tail = prompt ? 2046 : 6;
            if (pos >= tail) { float* o = F.out + (prompt ? O_CP : O_CS) + ((size_t)b * 2 + (pos - tail)) * 1024 + c0;
                *(f32x4*)o = (f32x4){p0[0], p0[1], p0[2], p0[3]}; *(f32x4*)(o + 4) = (f32x4){p0[4], p0[5], p0[6], p0[7]}; }
        }
    }
    {
        const float* lg = IN(8); const float* lb = IN(9); const float* wsp = IN(10); const float* bsp = IN(11);
        bf16_t* YA = WSP(bf16_t, WS_YA);
        const int gw = F.bx * NWAVES + F.wave, NGW = F.G * NWAVES;
        for (int sq = gw; sq < 128; sq += NGW) {
            const int row0 = MP + sq * 8;
            float mu[8], rs[8];
#pragma unroll
            for (int t = 0; t < 8; ++t) {
                const bf16_t* pr = P1 + (size_t)(row0 + t) * NIN + C_V + 8 * F.lane;
                float a[8], b[8]; unpack8(*(const u32x4*)pr, a); unpack8(*(const u32x4*)(pr + 512), b);
                float s = 0.f;
#pragma unroll
                for (int e = 0; e < 8; ++e) s += a[e] + b[e];
                const float mean = wave_sum(s) * (1.f / 1024.f); float q = 0.f;
#pragma unroll
                for (int e = 0; e < 8; ++e) { const float da = a[e] - mean, db = b[e] - mean; q += da * da + db * db; }
                mu[t] = mean; rs[t] = rsqrtf(wave_sum(q) * (1.f / 1024.f) + EPS);
                asm volatile("" ::: "memory");
            }
#pragma unroll
            for (int j = 0; j < 2; ++j) {
                const int c0 = 8 * F.lane + 512 * j, g = c0 >> 8;
                float gg[8], bb[8];
                { const f32x4 a = *(const f32x4*)(lg + c0), b = *(const f32x4*)(lg + c0 + 4), c = *(const f32x4*)(lb + c0), d = *(const f32x4*)(lb + c0 + 4);
                  gg[0] = a.x; gg[1] = a.y; gg[2] = a.z; gg[3] = a.w; gg[4] = b.x; gg[5] = b.y; gg[6] = b.z; gg[7] = b.w;
                  bb[0] = c.x; bb[1] = c.y; bb[2] = c.z; bb[3] = c.w; bb[4] = d.x; bb[5] = d.y; bb[6] = d.z; bb[7] = d.w; }
                float vl[8][8];
#pragma unroll
                for (int t = 0; t < 8; ++t) {
                    float a[8]; unpack8(*(const u32x4*)(P1 + (size_t)(row0 + t) * NIN + C_V + c0), a);
#pragma unroll
                    for (int e = 0; e < 8; ++e) vl[t][e] = (a[e] - mu[t]) * rs[t] * gg[e] + bb[e];
                    float* o = F.out + O_CV + (size_t)(sq * 8 + t) * 1024 + c0;
                    *(f32x4*)o = (f32x4){vl[t][0], vl[t][1], vl[t][2], vl[t][3]}; *(f32x4*)(o + 4) = (f32x4){vl[t][4], vl[t][5], vl[t][6], vl[t][7]};
                }
#pragma unroll
                for (int t = 0; t < 8; ++t) {
                    float z[8]; const float bs = bsp[g * 128 + t];
#pragma unroll
                    for (int e = 0; e < 8; ++e) z[e] = bs;
#pragma unroll
                    for (int s = 0; s < 8; ++s) if (s <= t) { const float w = wsp[(size_t)g * 16384 + t * 128 + s];
#pragma unroll
                        for (int e = 0; e < 8; ++e) z[e] += w * vl[s][e]; }
                    float uf[8]; unpack8(*(const u32x4*)(P1 + (size_t)(row0 + t) * NIN + C_U + c0), uf);
                    u32x4 w; w.x = cvt_pk_bf16(uf[0] * z[0], uf[1] * z[1]); w.y = cvt_pk_bf16(uf[2] * z[2], uf[3] * z[3]); w.z = cvt_pk_bf16(uf[4] * z[4], uf[5] * z[5]); w.w = cvt_pk_bf16(uf[6] * z[6], uf[7] * z[7]);
                    *(u32x4*)(YA + (size_t)(row0 + t) * 1024 + c0) = w;
                }
            }
        }
    }
    {
        const float* lg = IN(8); const float* lb = IN(9);
        bf16_t* VT = WSP(bf16_t, WS_VT);
        LAS bf16_t* T = (LAS bf16_t*)F.lds;
        for (int un = F.bx; un < 256; un += F.G) {
            const int chunk = un >> 2, g = un & 3;
            const bool mine = ((F.lane >> 5) == (g & 1));
            const int cm = 256 * g + 8 * (F.lane & 31);
            float gg[8], bb[8];
            { const f32x4 a = *(const f32x4*)(lg + cm), b = *(const f32x4*)(lg + cm + 4), c = *(const f32x4*)(lb + cm), d = *(const f32x4*)(lb + cm + 4);
              gg[0] = a.x; gg[1] = a.y; gg[2] = a.z; gg[3] = a.w; gg[4] = b.x; gg[5] = b.y; gg[6] = b.z; gg[7] = b.w;
              bb[0] = c.x; bb[1] = c.y; bb[2] = c.z; bb[3] = c.w; bb[4] = d.x; bb[5] = d.y; bb[6] = d.z; bb[7] = d.w; }
            for (int rr = 0; rr < 16; ++rr) {
                const int s = F.wave * 16 + rr;
                const bf16_t* pr = P1 + (size_t)(chunk * 128 + s) * NIN + C_V + 8 * F.lane;
                float a[8], b[8]; unpack8(*(const u32x4*)pr, a); unpack8(*(const u32x4*)(pr + 512), b);
                float sm = 0.f;
#pragma unroll
                for (int e = 0; e < 8; ++e) sm += a[e] + b[e];
                const float mean = wave_sum(sm) * (1.f / 1024.f); float q = 0.f;
#pragma unroll
                for (int e = 0; e < 8; ++e) { const float da = a[e] - mean, db = b[e] - mean; q += da * da + db * db; }
                const float rstd = rsqrtf(wave_sum(q) * (1.f / 1024.f) + EPS);
                if (mine) {
                    float y[8];
#pragma unroll
                    for (int e = 0; e < 8; ++e) { const float x = (g >> 1) ? b[e] : a[e]; y[e] = (x - mean) * rstd * gg[e] + bb[e]; }
                    u32x4 w; w.x = cvt_pk_bf16(y[0], y[1]); w.y = cvt_pk_bf16(y[2], y[3]); w.z = cvt_pk_bf16(y[4], y[5]); w.w = cvt_pk_bf16(y[6], y[7]);
                    *(LAS u32x4*)(T + s * 264 + 8 * (F.lane & 31)) = w;
                }
            }
            __syncthreads();
#pragma unroll 2
            for (int itn = 0; itn < 8; ++itn) {
                const int idx = itn * 512 + F.tid, c = idx >> 4, sb = idx & 15;
                unsigned short h[8];
#pragma unroll
                for (int i = 0; i < 8; ++i) h[i] = T[(8 * sb + i) * 264 + c];
                u32x4 w; w.x = (unsigned)h[0] | ((unsigned)h[1] << 16); w.y = (unsigned)h[2] | ((unsigned)h[3] << 16); w.z = (unsigned)h[4] | ((unsigned)h[5] << 16); w.w = (unsigned)h[6] | ((unsigned)h[7] << 16);
                *(u32x4*)(VT + ((size_t)chunk * 1024 + g * 256 + c) * 128 + 8 * sb) = w;
            }
            __syncthreads();
        }
    }
}

__device__ __forceinline__ void sample_attn_unit(Frame& F, int unit) {
    const int b = unit >> 2, h = unit & 3, lane = F.lane, wave = F.wave, r16 = lane & 15, kq = lane >> 4;
    const float* Kb = IN(3) + ((size_t)b * NMEM * XH + h) * XD;
    const float* Vb = IN(4) + ((size_t)b * NMEM * XH + h) * XD;
    const bf16_t* Qb = WSP(bf16_t, WS_Q) + (size_t)(MP + b * 8) * DM + h * XD;
    LAS bf16_t* sP = (LAS bf16_t*)F.lds;
    LAS float* sSt = (LAS float*)(F.lds + 16 * 528);
    f32x4 s0 = {0.f, 0.f, 0.f, 0.f}, s1 = {0.f, 0.f, 0.f, 0.f};
    const float* k0p = Kb + (size_t)(32 * wave + r16) * (XH * XD) + kq * 8;
    const float* k1p = k0p + (size_t)16 * (XH * XD);
    const bf16_t* qp = Qb + (size_t)(r16 & 7) * DM + kq * 8;
#pragma unroll 4
    for (int ds = 0; ds < 16; ++ds) {
        const f32x4 a0 = *(const f32x4*)(k0p + ds * 32), a1 = *(const f32x4*)(k0p + ds * 32 + 4);
        const f32x4 c0 = *(const f32x4*)(k1p + ds * 32), c1 = *(const f32x4*)(k1p + ds * 32 + 4);
        u32x4 qw = *(const u32x4*)(qp + ds * 32); if (r16 >= 8) qw = (u32x4){0u, 0u, 0u, 0u};
        const bf16x8 qf = __builtin_bit_cast(bf16x8, qw);
        s0 = __builtin_amdgcn_mfma_f32_16x16x32_bf16(pack8(a0, a1), qf, s0, 0, 0, 0);
        s1 = __builtin_amdgcn_mfma_f32_16x16x32_bf16(pack8(c0, c1), qf, s1, 0, 0, 0);
    }
    float mx = fmaxf(fmaxf(fmaxf(s0[0], s0[1]), fmaxf(s0[2], s0[3])), fmaxf(fmaxf(s1[0], s1[1]), fmaxf(s1[2], s1[3])));
    mx = fmaxf(mx, __shfl_xor(mx, 16)); mx = fmaxf(mx, __shfl_xor(mx, 32));
    float sm = 0.f;
#pragma unroll
    for (int j = 0; j < 4; ++j) { s0[j] = __expf(s0[j] - mx); s1[j] = __expf(s1[j] - mx); sm += s0[j] + s1[j]; }
    sm += __shfl_xor(sm, 16); sm += __shfl_xor(sm, 32);
    if (kq == 0) { sSt[(wave * 16 + r16) * 2] = mx; sSt[(wave * 16 + r16) * 2 + 1] = sm; }
    __syncthreads();
    float M = -3.0e38f;
#pragma unroll
    for (int w2 = 0; w2 < 8; ++w2) M = fmaxf(M, sSt[(w2 * 16 + r16) * 2]);
    float L = 0.f;
#pragma unroll
    for (int w2 = 0; w2 < 8; ++w2) L += sSt[(w2 * 16 + r16) * 2 + 1] * __expf(sSt[(w2 * 16 + r16) * 2] - M);
    const float f = __expf(mx - M) / L;
    { u32x2 w; w.x = cvt_pk_bf16(s0[0] * f, s0[1] * f); w.y = cvt_pk_bf16(s0[2] * f, s0[3] * f); *(LAS u32x2*)(sP + r16 * 264 + 32 * wave + 4 * kq) = w;
      w.x = cvt_pk_bf16(s1[0] * f, s1[1] * f); w.y = cvt_pk_bf16(s1[2] * f, s1[3] * f); *(LAS u32x2*)(sP + r16 * 264 + 32 * wave + 16 + 4 * kq) = w; }
    __syncthreads();
    f32x4 o[4];
#pragma unroll
    for (int c = 0; c < 4; ++c) o[c] = (f32x4){0.f, 0.f, 0.f, 0.f};
    const float* vp = Vb + (size_t)(kq * 8) * (XH * XD) + 64 * wave + 4 * r16;
#pragma unroll 2
    for (int ms = 0; ms < 8; ++ms) {
        const bf16x8 pf = *(const LAS bf16x8*)(sP + r16 * 264 + ms * 32 + kq * 8);
        f32x4 x[8];
#pragma unroll
        for (int j = 0; j < 8; ++j) x[j] = *(const f32x4*)(vp + (size_t)(ms * 32 + j) * (XH * XD));
#pragma unroll
        for (int c = 0; c < 4; ++c) {
            const bf16x8 a = pack8((f32x4){x[0][c], x[1][c], x[2][c], x[3][c]}, (f32x4){x[4][c], x[5][c], x[6][c], x[7][c]});
            o[c] = __builtin_amdgcn_mfma_f32_16x16x32_bf16(a, pf, o[c], 0, 0, 0);
        }
    }
    if (r16 < 8) {
        bf16_t* op = WSP(bf16_t, WS_O) + (size_t)(MP + b * 8 + r16) * DM + h * XD + 64 * wave + 16 * kq;
        u32x4 w0, w1;
        w0.x = cvt_pk_bf16(o[0][0], o[1][0]); w0.y = cvt_pk_bf16(o[2][0], o[3][0]); w0.z = cvt_pk_bf16(o[0][1], o[1][1]); w0.w = cvt_pk_bf16(o[2][1], o[3][1]);
        w1.x = cvt_pk_bf16(o[0][2], o[1][2]); w1.y = cvt_pk_bf16(o[2][2], o[3][2]); w1.z = cvt_pk_bf16(o[0][3], o[1][3]); w1.w = cvt_pk_bf16(o[2][3], o[3][3]);
        *(u32x4*)op = w0; *(u32x4*)(op + 8) = w1;
    }
    __syncthreads();
}

template <bool OUT_F32> __device__ __forceinline__ void phase_rms(Frame& F, const float* src, const float* g, void* dst) {
    const int gw = F.bx * NWAVES + F.wave, NGW = F.G * NWAVES;
    for (int m = gw; m < MT; m += NGW) rms_row<OUT_F32>(src + (size_t)m * DM, g, OUT_F32 ? (void*)((float*)dst + (size_t)m * DM) : (void*)((bf16_t*)dst + (size_t)m * DM), F.lane);
}

__global__ void __launch_bounds__(NWAVES * 64, 2) fwd_megakernel(Args args) {
    extern __shared__ __attribute__((aligned(16))) unsigned char lds_raw[];
    cg::grid_group grid = cg::this_grid();
    Frame F;
    F.lds = (LAS unsigned char*)lds_raw;
    F.tid = threadIdx.x; F.lane = F.tid & 63; F.wave = __builtin_amdgcn_readfirstlane(F.tid >> 6);
    F.G = gridDim.x; F.bx = blockIdx.x;
    F.out = args.out; F.ws = args.ws;
#define SEAM() do { grid.sync(); int t_ = threadIdx.x; asm volatile("" : "+v"(t_)); F.tid = t_; F.lane = t_ & 63; } while (0)
#ifndef PHASE_MASK
#define PHASE_MASK 0xffffffffu
#endif
#define PH(k) ((PHASE_MASK >> (k)) & 1u)
    using namespace pg8;
    const char* XN = (const char*)(F.ws + WS_XN);

    if (PH(0)) phase_prologue(F);
    SEAM();
    if (PH(1)) {
        SchedIn S{XN, (const char*)(F.ws + WS_WIN), F.G, F.bx};
        EpiIn E{WSP(bf16_t, WS_P1), F.out + O_MK, F.out + O_MV, WSP(bf16_t, WS_KP), WSP(bf16_t, WS_VPT)};
        gemm_phase<EpiIn, SchedIn, true>(F.lds, DM, DM, DM, S, E);
    }
    SEAM();
    if (PH(2)) phase_mixprep(F);
    SEAM();
    if (PH(3)) {
        SchedSp S{(const char*)(F.ws + WS_WSP), (const char*)(F.ws + WS_VT), F.G, F.bx};
        EpiSp E{WSP(bf16_t, WS_P1), IN(11), WSP(bf16_t, WS_YA)};
        gemm_phase<EpiSp, SchedSp, true>(F.lds, 128, 128, 128, S, E);
    }
    SEAM();
    if (PH(4)) {
        SchedRect S{(const char*)(F.ws + WS_YA), (const char*)(F.ws + WS_WA), (size_t)BM * 1024 * 2, (size_t)BM * 1024 * 2, 36, 8, F.G, F.bx};
        EpiGA E{WSP(bf16_t, WS_P1), WSP(float, WS_TMP)};
        gemm_phase<EpiGA, SchedRect, true>(F.lds, 1024, 1024, 1024, S, E);
    }
    SEAM();
    if (PH(5)) {
        SchedRect S{(const char*)(F.ws + WS_YB), (const char*)(F.ws + WS_WB), (size_t)BM * 1024 * 2, (size_t)BM * 1024 * 2, 36, 8, F.G, F.bx};
        EpiGB E{WSP(bf16_t, WS_P1), WSP(float, WS_TMP), WSP(bf16_t, WS_MRG)};
        gemm_phase<EpiGB, SchedRect, true>(F.lds, 1024, 1024, 1024, S, E);
    }
    SEAM();
    if (PH(6)) {
        SchedRect S{(const char*)(F.ws + WS_MRG), (const char*)(F.ws + WS_WMIX), (size_t)BM * DM * 2, (size_t)BM * DM * 2, 36, 8, F.G, F.bx};
        EpiRes E{IN(0), IN(1), MP, WSP(float, WS_H1)};
        gemm_phase<EpiRes, SchedRect, true>(F.lds, DM, DM, DM, S, E);
    }
    SEAM();
    phase_rms<false>(F, WSP(float, WS_H1), IN(16), WSP(bf16_t, WS_XN));
    SEAM();
    if (PH(7)) {
        SchedRect S{XN, (const char*)(F.ws + WS_WQ), (size_t)BM * DM * 2, (size_t)BM * DM * 2, 36, 8, F.G, F.bx};
        EpiBf<0> E{WSP(bf16_t, WS_Q), DM, 0.04419417382415922f};
        gemm_phase<EpiBf<0>, SchedRect, true>(F.lds, DM, DM, DM, S, E);
    }
    SEAM();
    if (PH(8)) {
        SchedS S{(const char*)(F.ws + WS_Q), (const char*)(F.ws + WS_KP), F.G, F.bx};
        EpiSoftmax E{WSP(bf16_t, WS_PS)};
        gemm_phase<EpiSoftmax, SchedS, false>(F.lds, DM, DM, XD, S, E);
        __syncthreads();
        for (int un = F.bx; un < 512; un += F.G) sample_attn_unit(F, un);
    }
    SEAM();
    if (PH(9)) {
        SchedO S{(const char*)(F.ws + WS_PS), (const char*)(F.ws + WS_VPT), F.G, F.bx};
        EpiBf<0> E{WSP(bf16_t, WS_O), DM, 1.0f};
        gemm_phase<EpiBf<0>, SchedO, true>(F.lds, 256, 256, 256, S, E);
    }
    SEAM();
    if (PH(10)) {
        SchedRect S{(const char*)(F.ws + WS_O), (const char*)(F.ws + WS_WXO), (size_t)BM * DM * 2, (size_t)BM * DM * 2, 36, 8, F.G, F.bx};
        EpiRes E{WSP(float, WS_H1), WSP(float, WS_H1), 1 << 30, WSP(float, WS_H2)};
        gemm_phase<EpiRes, SchedRect, true>(F.lds, DM, DM, DM, S, E);
    }
    SEAM();
    phase_rms<false>(F, WSP(float, WS_H2), IN(22), WSP(bf16_t, WS_XN));
    SEAM();
    if (PH(11)) {
        SchedRect S{XN, (const char*)(F.ws + WS_WUP), (size_t)BM * DM * 2, (size_t)BM * DM * 2, 36, 32, F.G, F.bx};
        EpiBf<1> E{WSP(bf16_t, WS_UP), FF, 1.0f};
        gemm_phase<EpiBf<1>, SchedRect, true>(F.lds, DM, DM, DM, S, E);
    }
    SEAM();
    if (PH(12)) {
        SchedRect S{(const char*)(F.ws + WS_UP), (const char*)(F.ws + WS_WDN), (size_t)BM * FF * 2, (size_t)BM * FF * 2, 36, 8, F.G, F.bx};
        EpiRes E{WSP(float, WS_H2), WSP(float, WS_H2), 1 << 30, WSP(float, WS_H3)};
        gemm_phase<EpiRes, SchedRect, true>(F.lds, FF, FF, FF, S, E);
    }
    SEAM();
    phase_rms<true>(F, WSP(float, WS_H3), IN(25), F.out + O_Y);
}

extern "C" void kernel_launch(void* const* d_in, const int* in_sizes, int n_in, void* d_out, int out_size, void* d_ws, size_t ws_size, hipStream_t stream) {
    static int grid = 0;
    if (grid == 0) {
        if (n_in != 26 || ws_size < WS_END) { fprintf(stderr, "kernel_launch: unexpected n_in %d / ws_size %zu\n", n_in, ws_size); grid = -1; return; }
        int dev = 0, cus = 0, per_cu = 0;
        hipGetDevice(&dev);
        hipDeviceGetAttribute(&cus, hipDeviceAttributeMultiprocessorCount, dev);
        if (hipFuncSetAttribute((const void*)fwd_megakernel, hipFuncAttributeMaxDynamicSharedMemorySize, LDS_BYTES) != hipSuccess) { fprintf(stderr, "kernel_launch: hipFuncSetAttribute failed\n"); grid = -1; return; }
        if (hipOccupancyMaxActiveBlocksPerMultiprocessor(&per_cu, (const void*)fwd_megakernel, NWAVES * 64, LDS_BYTES) != hipSuccess || per_cu < 1) { fprintf(stderr, "kernel_launch: occupancy query says %d\n", per_cu); per_cu = 1; }
        (void)hipGetLastError();
        grid = cus;
        if (grid < 128) { fprintf(stderr, "kernel_launch: needs >= 128 CUs\n"); grid = -1; return; }
    }
    if (grid < 0) return;
    Args a{};
    for (int i = 0; i < 26; ++i) a.in[i] = (const float*)d_in[i];
    a.out = (float*)d_out; a.ws = (unsigned char*)d_ws;
    void* kargs[] = {&a};
    hipError_t e = hipLaunchCooperativeKernel((const void*)fwd_megakernel, dim3(grid), dim3(NWAVES * 64), kargs, LDS_BYTES, stream);
    if (e != hipSuccess) fprintf(stderr, "kernel_launch: cooperative launch failed: %s (grid %d)\n", hipGetErrorString(e), grid);
}
```

```cpp
#include <hip/hip_runtime.h>
#include <hip/hip_cooperative_groups.h>
#include <cstdio>
#include <cstdint>
namespace cg = cooperative_groups;

#define LAS __attribute__((address_space(3)))
typedef unsigned short bf16_t;
typedef short bf16x8 __attribute__((ext_vector_type(8)));
typedef float f32x4 __attribute__((ext_vector_type(4)));
typedef float f32x2 __attribute__((ext_vector_type(2)));
typedef unsigned u32x4 __attribute__((ext_vector_type(4)));
typedef unsigned u32x2 __attribute__((ext_vector_type(2)));

constexpr int DM = 2048, MP = 8192, MS = 1024, MT = MP + MS  ;
constexpr int NIN = 9216, FF = 8192, NMEM = 256, XH = 4, XD = 512;
constexpr int C_U = 0, C_V = 1024, C_BG = 2048, C_CG = 3072, C_XIN = 4096, C_GA = 5120, C_GB = 7168;
constexpr float EPS = 1e-6f;
constexpr size_t O_Y = 0, O_MK = 18874368, O_MV = 20971520, O_CP = 23068672, O_CS = 23076864, O_CV = 23339008;
constexpr size_t MiB = 1u << 20;
constexpr size_t WS_CTL = 0, CTL_BYTES = 1 * MiB;
constexpr size_t WS_WIN = 2 * MiB;
constexpr size_t WS_WA = 54 * MiB, WS_WB = 58 * MiB;
constexpr size_t WS_WMIX = 62 * MiB, WS_WQ = 70 * MiB, WS_WXO = 78 * MiB;
constexpr size_t WS_WUP = 86 * MiB;
constexpr size_t WS_WDN = 118 * MiB;
constexpr size_t WS_WSP = 150 * MiB;
constexpr size_t WS_XN = 152 * MiB;
constexpr size_t WS_P1 = 192 * MiB;
constexpr size_t WS_UP = 192 * MiB;
constexpr size_t WS_VT = 354 * MiB;
constexpr size_t WS_YA = 370 * MiB, WS_YB = 388 * MiB;
constexpr size_t WS_TMP = 406 * MiB;
constexpr size_t WS_H3 = 406 * MiB;
constexpr size_t WS_MRG = 478 * MiB;
constexpr size_t WS_H1 = 514 * MiB;
constexpr size_t WS_Q = 586 * MiB;
constexpr size_t WS_KP = 622 * MiB;
constexpr size_t WS_VPT = 626 * MiB;
constexpr size_t WS_PS = 630 * MiB;
constexpr size_t WS_O = 646 * MiB;
constexpr size_t WS_H2 = 682 * MiB;
constexpr size_t WS_END = 754 * MiB;

constexpr int LDS_BYTES = 147456;
constexpr int NWAVES = 8;

__device__ __forceinline__ unsigned cvt_pk_bf16(float lo, float hi) { unsigned r; asm volatile("v_cvt_pk_bf16_f32 %0, %1, %2" : "=v"(r) : "v"(lo), "v"(hi)); return r; }
__device__ __forceinline__ float bf_lo(unsigned u) { return __uint_as_float(u << 16); }
__device__ __forceinline__ float bf_hi(unsigned u) { return __uint_as_float(u & 0xffff0000u); }
__device__ __forceinline__ float bf1(bf16_t h) { return __uint_as_float(((unsigned)h) << 16); }
__device__ __forceinline__ bf16x8 pack8(f32x4 a, f32x4 b) {
    u32x4 w; w.x = cvt_pk_bf16(a.x, a.y); w.y = cvt_pk_bf16(a.z, a.w); w.z = cvt_pk_bf16(b.x, b.y); w.w = cvt_pk_bf16(b.z, b.w);
    return __builtin_bit_cast(bf16x8, w);
}
__device__ __forceinline__ void unpack8(u32x4 w, float (&f)[8]) {
    f[0] = bf_lo(w.x); f[1] = bf_hi(w.x); f[2] = bf_lo(w.y); f[3] = bf_hi(w.y); f[4] = bf_lo(w.z); f[5] = bf_hi(w.z); f[6] = bf_lo(w.w); f[7] = bf_hi(w.w);
}
__device__ __forceinline__ float wave_sum(float v) {
#pragma unroll
    for (int o = 1; o < 64; o <<= 1) v += __shfl_xor(v, o);
    return v;
}
__device__ __forceinline__ float sigmoidf_(float x) { return __builtin_amdgcn_rcpf(1.0f + __expf(-x)); }
#define LDS_WAIT() asm volatile("s_waitcnt lgkmcnt(0)" ::: "memory")

namespace pg8 {
constexpr int BM = 256, BK = 64, HALF = 128, HTB = HALF * BK * 2, STAGE_BYTES = 8 * HTB, NXCD = 8, WGM = 8;
__host__ __device__ __forceinline__ int lds_byte(int r, int c) { const int st = (r >> 4) * 2 + (c >> 5), rr = r & 15, cc = c & 31, ob = rr * 64 + cc * 2; return st * 1024 + (ob ^ (((ob >> 9) & 1) << 5)); }
__host__ __device__ __forceinline__ void stage_rc(int b, int& R, int& C) { const int st = b / 1024, sb = b % 1024, swz = sb ^ (((sb >> 9) & 1) << 5); R = (st >> 1) * 16 + swz / 64; C = (st & 1) * 32 + (swz % 64) / 2; }
__host__ __device__ __forceinline__ int perm32(int rho) { const int n = rho >> 4, i = rho & 15; return 8 * (i >> 2) + 4 * n + (i & 3); }

struct Unit { const char* A; const char* B; int orow, ocol, aux; };

__device__ __forceinline__ void rect_order(int L, int nM, int nN, int& pm, int& pn) {
    const int nwg = nM * nN; int wgid = L;
    { const int q = nwg / NXCD, r = nwg % NXCD, xcd = wgid % NXCD, off = wgid / NXCD; wgid = (xcd < r ? xcd * (q + 1) : r * (q + 1) + (xcd - r) * q) + off; }
    const int nig = WGM * nN, gid = wgid / nig, fm = gid * WGM, gsz = (nM - fm) < WGM ? (nM - fm) : WGM;
    pm = fm + ((wgid % nig) % gsz); pn = (wgid % nig) / gsz;
}

template <class Epi, class Sched, bool ALIGN_EPI>
__device__ __forceinline__ void gemm_phase(LAS unsigned char* lds, const int lda, const int ldb, const int K, const Sched& S, const Epi& E) {
    int tid_ = threadIdx.x; asm volatile("" : "+v"(tid_));
    const int tid = tid_, wid = __builtin_amdgcn_readfirstlane(tid >> 6), lane = tid & 63, wr = wid >> 2, wc = wid & 3, fr = lane & 15, fq = lane >> 4;
    int nt_ = K / BK; asm volatile("" : "+s"(nt_)); const int nt = nt_;
    unsigned voffA[2], voffB[2];
#pragma unroll
    for (int i = 0; i < 2; ++i) { int R, C; stage_rc(tid * 16 + i * 8192, R, C); const int Rb = Epi::PERM ? ((R & ~31) + perm32(R & 31)) : R;
        voffA[i] = (unsigned)(R * lda + C) * 2u; voffB[i] = (unsigned)(Rb * ldb + C) * 2u; }
    const size_t kstep = (size_t)(BK * 2);
    const size_t hstepA = (size_t)HALF * lda * 2, hstepB = (size_t)HALF * ldb * 2;
    const unsigned ldsw = (unsigned)wid * 1024u;
    const int aoff = lds_byte(wr * 64 + fr, fq * 8), boff = lds_byte(wc * 32 + fr, fq * 8);
#define PG8_SA(b, h) (((b) * 2 + (h)) * HTB)
#define PG8_SB(b, h) ((4 + (b) * 2 + (h)) * HTB)
#define PG8_STAGE(bufoff, gbase, voff) do { _Pragma("unroll") for (int _i = 0; _i < 2; ++_i) \
        __builtin_amdgcn_global_load_lds((const unsigned*)((const char*)(gbase) + (voff)[_i]), (LAS unsigned*)(lds + (bufoff) + ldsw + _i * 8192), 16, 0, 0); } while (0)
#define PG8_LDA(dst, b, h) do { _Pragma("unroll") for (int m = 0; m < 4; ++m) _Pragma("unroll") for (int k = 0; k < 2; ++k) dst[m][k] = *(const LAS bf16x8*)(lds + PG8_SA(b, h) + aoff + m * 2048 + k * 1024); } while (0)
#define PG8_LDB(dst, b, h) do { _Pragma("unroll") for (int n = 0; n < 2; ++n) _Pragma("unroll") for (int k = 0; k < 2; ++k) dst[n][k] = *(const LAS bf16x8*)(lds + PG8_SB(b, h) + boff + n * 2048 + k * 1024); } while (0)
#define PG8_MMA(ai, bj, At, Bt) do { __builtin_amdgcn_s_setprio(1); _Pragma("unroll") for (int m = 0; m < 4; ++m) _Pragma("unroll") for (int n = 0; n < 2; ++n) _Pragma("unroll") for (int k = 0; k < 2; ++k) \
        acc[ai][bj][m][n] = __builtin_amdgcn_mfma_f32_16x16x32_bf16(Bt[n][k], At[m][k], acc[ai][bj][m][n], 0, 0, 0); __builtin_amdgcn_s_setprio(0); } while (0)
#define PG8_WAIT_V(n) asm volatile("s_waitcnt vmcnt(" #n ")" ::: "memory")
#define PG8_WAIT_L(n) asm volatile("s_waitcnt lgkmcnt(" #n ")" ::: "memory")
#define PG8_BAR __builtin_amdgcn_s_barrier()
#define PG8_SCHED __builtin_amdgcn_sched_barrier(0)
    Unit cur, nxt; int ui = 0;
    if (!S.next(0, cur)) return;
    f32x4 acc[2][2][4][2];
#pragma unroll
    for (int a = 0; a < 2; ++a)
#pragma unroll
        for (int b = 0; b < 2; ++b)
#pragma unroll
            for (int m = 0; m < 4; ++m)
#pragma unroll
                for (int n = 0; n < 2; ++n) acc[a][b][m][n] = (f32x4){0.f, 0.f, 0.f, 0.f};
    bf16x8 At[4][2], B0[2][2], B1[2][2];
    const char* cA = cur.A; const char* cB = cur.B;
    PG8_STAGE(PG8_SB(0, 0), cB, voffB); PG8_STAGE(PG8_SB(0, 1), cB + hstepB, voffB); PG8_STAGE(PG8_SA(0, 0), cA, voffA); PG8_STAGE(PG8_SA(0, 1), cA + hstepA, voffA);
    if (wr == 1) PG8_BAR;
    PG8_WAIT_V(2); PG8_BAR;
    PG8_STAGE(PG8_SB(1, 0), cB + kstep, voffB); PG8_STAGE(PG8_SA(1, 0), cA + kstep, voffA); PG8_STAGE(PG8_SB(1, 1), cB + hstepB + kstep, voffB);
    PG8_WAIT_V(6); PG8_BAR;
    for (;;) {
        const bool has_next = S.next(ui + 1, nxt);
        const char* nA = has_next ? nxt.A : cA; const char* nB = has_next ? nxt.B : cB;
        for (int t = 0; t < nt; t += 2) {
            const bool last = (t == nt - 2);
            const char* a1 = cA + (size_t)(t + 1) * kstep;
            const char* a2 = last ? nA : cA + (size_t)(t + 2) * kstep; const char* b2 = last ? nB : cB + (size_t)(t + 2) * kstep;
            const char* a3 = a2 + kstep; const char* b3 = b2 + kstep;
            PG8_LDB(B0, 0, 0); PG8_LDB(B1, 0, 1); PG8_SCHED; PG8_LDA(At, 0, 0); PG8_STAGE(PG8_SA(1, 1), a1 + hstepA, voffA);
            PG8_WAIT_V(8); PG8_WAIT_L(0); PG8_BAR; PG8_MMA(0, 0, At, B0); PG8_MMA(0, 1, At, B1); PG8_BAR; PG8_SCHED;
            PG8_LDA(At, 0, 1); PG8_STAGE(PG8_SB(0, 0), b2, voffB); PG8_STAGE(PG8_SB(0, 1), b2 + hstepB, voffB); PG8_STAGE(PG8_SA(0, 0), a2, voffA);
            PG8_WAIT_V(8); PG8_WAIT_L(0); PG8_BAR; PG8_MMA(1, 0, At, B0); PG8_MMA(1, 1, At, B1); PG8_BAR; PG8_SCHED;
            PG8_LDB(B0, 1, 0); PG8_LDB(B1, 1, 1); PG8_SCHED; PG8_LDA(At, 1, 0); PG8_STAGE(PG8_SA(0, 1), a2 + hstepA, voffA);
            PG8_WAIT_V(8); PG8_WAIT_L(0); PG8_BAR; PG8_MMA(0, 0, At, B0); PG8_MMA(0, 1, At, B1); PG8_BAR; PG8_SCHED;
            PG8_LDA(At, 1, 1); PG8_STAGE(PG8_SB(1, 0), b3, voffB); PG8_STAGE(PG8_SB(1, 1), b3 + hstepB, voffB); PG8_STAGE(PG8_SA(1, 0), a3, voffA);
            PG8_WAIT_V(8); PG8_WAIT_L(0); PG8_BAR; PG8_MMA(1, 0, At, B0); PG8_MMA(1, 1, At, B1); PG8_BAR; PG8_SCHED;
        }
        if constexpr (ALIGN_EPI) { if (wr == 0) PG8_BAR; }
        if constexpr (!Epi::AFTER_DRAIN) { E(acc, cur, wr, wc, fr, fq); }
        if (!has_next) break;
#pragma unroll
        for (int a = 0; a < 2; ++a)
#pragma unroll
            for (int b = 0; b < 2; ++b)
#pragma unroll
                for (int m = 0; m < 4; ++m)
#pragma unroll
                    for (int n = 0; n < 2; ++n) acc[a][b][m][n] = (f32x4){0.f, 0.f, 0.f, 0.f};
        cur = nxt; cA = nA; cB = nB; ++ui;
        if constexpr (ALIGN_EPI) { if (wr == 1) PG8_BAR; }
    }
    PG8_WAIT_V(0);
    if constexpr (!ALIGN_EPI) { if (wr == 0) PG8_BAR; }
    PG8_BAR;
    if constexpr (Epi::AFTER_DRAIN) { E.fused(acc, cur, wr, wc, fr, fq, lds, wid, lane); }
#undef PG8_SA
#undef PG8_SB
#undef PG8_STAGE
#undef PG8_LDA
#undef PG8_LDB
#undef PG8_MMA
#undef PG8_WAIT_V
#undef PG8_WAIT_L
#undef PG8_BAR
#undef PG8_SCHED
}

struct SchedRect {
    const char* A; const char* B; size_t atile, btile; int nM, nN, G, c;
    __device__ __forceinline__ bool next(int i, Unit& u) const {
        const int L = i * G + c; if (L >= nM * nN) return false;
        int pm, pn; rect_order(L, nM, nN, pm, pn);
        u.A = A + (size_t)pm * atile; u.B = B + (size_t)pn * btile; u.orow = pm * BM; u.ocol = pn * BM; u.aux = 0; return true;
    }
};
struct SchedIn {
    const char* A; const char* B; int G, c;
    __device__ __forceinline__ bool next(int i, Unit& u) const {
        const int L = i * G + c; if (L >= 1296 + 64) return false;
        int pm, pn;
        if (L < 1296) { rect_order(L, 36, 36, pm, pn); u.orow = pm * BM; u.ocol = pn * BM; u.aux = 0; }
        else { const int l = L - 1296; pm = 36 + (l & 3); pn = 36 + (l >> 2); u.orow = (pm - 36) * BM; u.ocol = (pn - 36) * BM; u.aux = 1; }
        u.A = A + (size_t)pm * (BM * DM * 2); u.B = B + (size_t)pn * (BM * DM * 2); return true;
    }
};
struct SchedSp {
    const char* WSP; const char* VT; int G, c;
    __device__ __forceinline__ bool next(int i, Unit& u) const {
        const int L = i * G + c; if (L >= 256) return false;
        const int chunk = L >> 2, p = (L >> 1) & 1, gi = L & 1, g = 2 * p + gi;
        u.A = WSP + (size_t)p * (256 * 128 * 2); u.B = VT + ((size_t)chunk * 1024 + g * 256) * 128 * 2; u.orow = chunk * 128; u.ocol = g * 256; u.aux = gi; return true;
    }
};
struct SchedS {
    const char* Q; const char* KP; int G, c;
    __device__ __forceinline__ bool next(int i, Unit& u) const {
        const int L = i * G + c; if (L >= 128 || i > 0) return false;
        const int b = L >> 5, h = (L >> 3) & 3, p = L & 7;
        u.A = Q + ((size_t)(b * 2048 + p * 256) * DM + h * XD) * 2; u.B = KP + ((size_t)(b * 256) * DM + h * XD) * 2;
        u.orow = (b * 4 + h) * 2048 + p * 256; u.ocol = 0; u.aux = 0; return true;
    }
};
struct SchedO {
    const char* PS; const char* VPT; int G, c;
    __device__ __forceinline__ bool next(int i, Unit& u) const {
        const int L = i * G + c; if (L >= 256) return false;
        const int b = L >> 6, h = (L >> 4) & 3, p = (L >> 1) & 7, pn = L & 1;
        u.A = PS + ((size_t)((b * 4 + h) * 2048 + p * 256) * 256) * 2; u.B = VPT + ((size_t)(b * 2048 + h * XD + pn * 256) * 256) * 2;
        u.orow = b * 2048 + p * 256; u.ocol = h * XD + pn * 256; u.aux = 0; return true;
    }
};

#define EPI_ROWS_BEGIN _Pragma("unroll") for (int ai = 0; ai < 2; ++ai) _Pragma("unroll") for (int m = 0; m < 4; ++m) { const int rl = ai * HALF + wr * 64 + m * 16 + fr;
#define EPI_ROWS_END }

struct EpiIn {
    static constexpr bool PERM = true, AFTER_DRAIN = false;
    bf16_t* P1; float* memk; float* memv; bf16_t* KP; bf16_t* VPT;
    __device__ __forceinline__ void operator()(const f32x4 (&acc)[2][2][4][2], const Unit& u, int wr, int wc, int fr, int fq) const {
        const int cl0 = wc * 32 + 8 * fq;
        if (u.aux == 0) {
            EPI_ROWS_BEGIN
                bf16_t* rowp = P1 + (size_t)(u.orow + rl) * NIN + u.ocol + cl0;
#pragma unroll
                for (int bj = 0; bj < 2; ++bj) { const f32x4 v0 = acc[ai][bj][m][0], v1 = acc[ai][bj][m][1];
                    u32x4 w; w.x = cvt_pk_bf16(v0[0], v0[1]); w.y = cvt_pk_bf16(v0[2], v0[3]); w.z = cvt_pk_bf16(v1[0], v1[1]); w.w = cvt_pk_bf16(v1[2], v1[3]);
                    *(u32x4*)(rowp + bj * HALF) = w; }
            EPI_ROWS_END
        } else {
            const bool isV = u.ocol >= DM; const int cb = u.ocol - (isV ? DM : 0) + cl0;
            float* fo = isV ? memv : memk;
            EPI_ROWS_BEGIN
                const int row = u.orow + rl;
#pragma unroll
                for (int bj = 0; bj < 2; ++bj) { const f32x4 v0 = acc[ai][bj][m][0], v1 = acc[ai][bj][m][1]; const int col = cb + bj * HALF;
                    *(f32x4*)(fo + (size_t)row * DM + col) = v0; *(f32x4*)(fo + (size_t)row * DM + col + 4) = v1;
                    u32x4 w; w.x = cvt_pk_bf16(v0[0], v0[1]); w.y = cvt_pk_bf16(v0[2], v0[3]); w.z = cvt_pk_bf16(v1[0], v1[1]); w.w = cvt_pk_bf16(v1[2], v1[3]);
                    if (!isV) { *(u32x4*)(KP + (size_t)row * DM + col) = w; }
                    else { bf16_t* vp = VPT + ((size_t)(row >> 8) * DM + col) * 256 + (row & 255);
                        vp[0 * 256] = (bf16_t)(w.x & 0xffff); vp[1 * 256] = (bf16_t)(w.x >> 16); vp[2 * 256] = (bf16_t)(w.y & 0xffff); vp[3 * 256] = (bf16_t)(w.y >> 16);
                        vp[4 * 256] = (bf16_t)(w.z & 0xffff); vp[5 * 256] = (bf16_t)(w.z >> 16); vp[6 * 256] = (bf16_t)(w.w & 0xffff); vp[7 * 256] = (bf16_t)(w.w >> 16); } }
            EPI_ROWS_END
        }
    }
};
struct EpiSp {
    static constexpr bool PERM = true, AFTER_DRAIN = false;
    const bf16_t* P1; const float* bsp; bf16_t* YA;
    __device__ __forceinline__ void operator()(const f32x4 (&acc)[2][2][4][2], const Unit& u, int wr, int wc, int fr, int fq) const {
        const int g = u.ocol >> 8, cl0 = wc * 32 + 8 * fq;
#pragma unroll
        for (int ai = 0; ai < 2; ++ai) if (ai == u.aux) {
#pragma unroll
            for (int m = 0; m < 4; ++m) { const int t = wr * 64 + m * 16 + fr; const int row = u.orow + t; const float bs = bsp[g * 128 + t];
#pragma unroll
                for (int bj = 0; bj < 2; ++bj) { const int col = u.ocol + bj * HALF + cl0;
                    const u32x4 uw = *(const u32x4*)(P1 + (size_t)row * NIN + C_U + col); float uf[8]; unpack8(uw, uf);
                    const f32x4 v0 = acc[ai][bj][m][0], v1 = acc[ai][bj][m][1];
                    u32x4 w; w.x = cvt_pk_bf16(uf[0] * (v0[0] + bs), uf[1] * (v0[1] + bs)); w.y = cvt_pk_bf16(uf[2] * (v0[2] + bs), uf[3] * (v0[3] + bs));
                    w.z = cvt_pk_bf16(uf[4] * (v1[0] + bs), uf[5] * (v1[1] + bs)); w.w = cvt_pk_bf16(uf[6] * (v1[2] + bs), uf[7] * (v1[3] + bs));
                    *(u32x4*)(YA + (size_t)row * 1024 + col) = w; } }
        }
    }
};
struct EpiGA {
    static constexpr bool PERM = false, AFTER_DRAIN = false;
    const bf16_t* P1; float* TMP;
    __device__ __forceinline__ void operator()(const f32x4 (&acc)[2][2][4][2], const Unit& u, int wr, int wc, int fr, int fq) const {
        EPI_ROWS_BEGIN
            const int row = u.orow + rl;
#pragma unroll
            for (int bj = 0; bj < 2; ++bj)
#pragma unroll
                for (int n = 0; n < 2; ++n) { const int col = u.ocol + bj * HALF + wc * 32 + 16 * n + 4 * fq;
                    const u32x2 gw = *(const u32x2*)(P1 + (size_t)row * NIN + C_GA + col); const f32x4 v = acc[ai][bj][m][n];
                    f32x4 o; o[0] = sigmoidf_(bf_lo(gw.x)) * v[0]; o[1] = sigmoidf_(bf_hi(gw.x)) * v[1]; o[2] = sigmoidf_(bf_lo(gw.y)) * v[2]; o[3] = sigmoidf_(bf_hi(gw.y)) * v[3];
                    *(f32x4*)(TMP + (size_t)row * DM + col) = o; }
        EPI_ROWS_END
    }
};
struct EpiGB {
    static constexpr bool PERM = true, AFTER_DRAIN = false;
    const bf16_t* P1; const float* TMP; bf16_t* MRG;
    __device__ __forceinline__ void operator()(const f32x4 (&acc)[2][2][4][2], const Unit& u, int wr, int wc, int fr, int fq) const {
        const int cl0 = wc * 32 + 8 * fq;
        EPI_ROWS_BEGIN
            const int row = u.orow + rl;
#pragma unroll
            for (int bj = 0; bj < 2; ++bj) { const int col = u.ocol + bj * HALF + cl0;
                const u32x4 gw = *(const u32x4*)(P1 + (size_t)row * NIN + C_GB + col); float gf[8]; unpack8(gw, gf);
                const f32x4 t0 = *(const f32x4*)(TMP + (size_t)row * DM + col), t1 = *(const f32x4*)(TMP + (size_t)row * DM + col + 4);
                const f32x4 v0 = acc[ai][bj][m][0], v1 = acc[ai][bj][m][1];
                u32x4 w; w.x = cvt_pk_bf16(t0[0] + sigmoidf_(gf[0]) * v0[0], t0[1] + sigmoidf_(gf[1]) * v0[1]); w.y = cvt_pk_bf16(t0[2] + sigmoidf_(gf[2]) * v0[2], t0[3] + sigmoidf_(gf[3]) * v0[3]);
                w.z = cvt_pk_bf16(t1[0] + sigmoidf_(gf[4]) * v1[0], t1[1] + sigmoidf_(gf[5]) * v1[1]); w.w = cvt_pk_bf16(t1[2] + sigmoidf_(gf[6]) * v1[2], t1[3] + sigmoidf_(gf[7]) * v1[3]);
                *(u32x4*)(MRG + (size_t)row * DM + col) = w; }
        EPI_ROWS_END
    }
};
struct EpiRes {
    static constexpr bool PERM = false, AFTER_DRAIN = false;
    const float* resA; const float* resB; int split; float* out;
    __device__ __forceinline__ void operator()(const f32x4 (&acc)[2][2][4][2], const Unit& u, int wr, int wc, int fr, int fq) const {
        const float* rbase = (u.orow < split) ? resA + (size_t)u.orow * DM : resB + (size_t)(u.orow - split) * DM;
        float* obase = out + (size_t)u.orow * DM;
        EPI_ROWS_BEGIN
#pragma unroll
            for (int bj = 0; bj < 2; ++bj)
#pragma unroll
                for (int n = 0; n < 2; ++n) { const size_t off = (size_t)rl * DM + u.ocol + bj * HALF + wc * 32 + 16 * n + 4 * fq;
                    const f32x4 r = *(const f32x4*)(rbase + off); *(f32x4*)(obase + off) = r + acc[ai][bj][m][n]; }
        EPI_ROWS_END
    }
};
template <int MODE  > struct EpiBf {
    static constexpr bool PERM = true, AFTER_DRAIN = false;
    bf16_t* O; int ldc; float scale;
    __device__ __forceinline__ void operator()(const f32x4 (&acc)[2][2][4][2], const Unit& u, int wr, int wc, int fr, int fq) const {
        const int cl0 = wc * 32 + 8 * fq;
        EPI_ROWS_BEGIN
            bf16_t* rowp = O + (size_t)(u.orow + rl) * ldc + u.ocol + cl0;
#pragma unroll
            for (int bj = 0; bj < 2; ++bj) { f32x4 v0 = acc[ai][bj][m][0], v1 = acc[ai][bj][m][1];
                if (MODE == 0) { v0 = v0 * scale; v1 = v1 * scale; }
                else {
#pragma unroll
                    for (int e = 0; e < 4; ++e) { const float a = fmaxf(v0[e], 0.f), b = fmaxf(v1[e], 0.f); v0[e] = a * a; v1[e] = b * b; } }
                u32x4 w; w.x = cvt_pk_bf16(v0[0], v0[1]); w.y = cvt_pk_bf16(v0[2], v0[3]); w.z = cvt_pk_bf16(v1[0], v1[1]); w.w = cvt_pk_bf16(v1[2], v1[3]);
                *(u32x4*)(rowp + bj * HALF) = w; }
        EPI_ROWS_END
    }
};
struct EpiSoftmax {
    static constexpr bool PERM = true, AFTER_DRAIN = true;
    bf16_t* PS;
    __device__ __forceinline__ void fused(f32x4 (&acc)[2][2][4][2], const Unit& u, int wr, int wc, int fr, int fq, LAS unsigned char* lds, int wid, int lane) const {
        LAS f32x2* X = (LAS f32x2*)lds;
        float mxl[2][4];
        EPI_ROWS_BEGIN
            float mx = -3.0e38f;
#pragma unroll
            for (int bj = 0; bj < 2; ++bj)
#pragma unroll
                for (int n = 0; n < 2; ++n) { const f32x4 v = acc[ai][bj][m][n]; mx = fmaxf(mx, fmaxf(fmaxf(v[0], v[1]), fmaxf(v[2], v[3]))); }
            mx = fmaxf(mx, __shfl_xor(mx, 16)); mx = fmaxf(mx, __shfl_xor(mx, 32));
            float s = 0.f;
#pragma unroll
            for (int bj = 0; bj < 2; ++bj)
#pragma unroll
                for (int n = 0; n < 2; ++n) { f32x4 v = acc[ai][bj][m][n];
#pragma unroll
                    for (int e = 0; e < 4; ++e) { v[e] = __expf(v[e] - mx); s += v[e]; }
                    acc[ai][bj][m][n] = v; }
            s += __shfl_xor(s, 16); s += __shfl_xor(s, 32);
            mxl[ai][m] = mx;
            if (fq == 0) X[rl * 4 + wc] = (f32x2){mx, s};
        EPI_ROWS_END
        LDS_WAIT(); __builtin_amdgcn_s_barrier(); asm volatile("" ::: "memory");
        const int cl0 = wc * 32 + 8 * fq;
        EPI_ROWS_BEGIN
            const f32x2 a = X[rl * 4 + 0], b = X[rl * 4 + 1], c = X[rl * 4 + 2], d = X[rl * 4 + 3];
            const float M = fmaxf(fmaxf(a.x, b.x), fmaxf(c.x, d.x));
            const float L = a.y * __expf(a.x - M) + b.y * __expf(b.x - M) + c.y * __expf(c.x - M) + d.y * __expf(d.x - M);
            const float f = __expf(mxl[ai][m] - M) / L;
            bf16_t* rowp = PS + (size_t)(u.orow + rl) * 256 + cl0;
#pragma unroll
            for (int bj = 0; bj < 2; ++bj) { const f32x4 v0 = acc[ai][bj][m][0] * f, v1 = acc[ai][bj][m][1] * f;
                u32x4 w; w.x = cvt_pk_bf16(v0[0], v0[1]); w.y = cvt_pk_bf16(v0[2], v0[3]); w.z = cvt_pk_bf16(v1[0], v1[1]); w.w = cvt_pk_bf16(v1[2], v1[3]);
                *(u32x4*)(rowp + bj * HALF) = w; }
        EPI_ROWS_END
        LDS_WAIT(); __builtin_amdgcn_s_barrier(); asm volatile("" ::: "memory");
    }
};
}


#define XB_TMO      128
#define XB_XCNT(j)  (256  + 64 * (j))
#define XB_XSUB(j)  (1280 + 64 * (j))
#define XB_XGEN(j)  (2304 + 64 * (j))
#define XB_TOP      3328
#define XB_TOPGEN   3392
#define XCD_BAR_WORDS 3456
#define XB_SPIN_CAP (1u << 18)
__device__ __forceinline__ unsigned xb_ld(unsigned* p)              { return __hip_atomic_load(p, __ATOMIC_RELAXED, __HIP_MEMORY_SCOPE_AGENT); }
__device__ __forceinline__ unsigned xb_add(unsigned* p, unsigned v) { return __hip_atomic_fetch_add(p, v, __ATOMIC_RELAXED, __HIP_MEMORY_SCOPE_AGENT); }
__device__ __forceinline__ unsigned xb_xcc_id() { return (unsigned)__builtin_amdgcn_s_getreg((3 << 11) | 20) & 0xFu; }
#define XB_SPIN(cond, bar) do { unsigned _sp = 0; while (cond) { __builtin_amdgcn_s_sleep(1); \
    if ((++_sp & 255u) == 0u) { if (xb_ld(&(bar)[XB_TMO])) break; if (_sp > XB_SPIN_CAP) { atomicAdd(&(bar)[XB_TMO], 1u); break; } } } } while (0)
struct XcdBarrier { unsigned* bar; unsigned x; volatile LAS unsigned* st; };
__device__ __forceinline__ XcdBarrier xcd_barrier_post(unsigned* bar, volatile LAS unsigned* st) {
    XcdBarrier b; b.bar = bar; b.x = xb_xcc_id(); b.st = st;
    if (threadIdx.x == 0) (void)xb_add(&bar[XB_XCNT(b.x)], 1u);
    return b;
}
__device__ __forceinline__ void xcd_barrier_complete(unsigned* bar, unsigned x, unsigned& nloc, unsigned& nx) {
    const unsigned G = gridDim.x * gridDim.y * gridDim.z;
    unsigned sum, cnt, mine, sp = 0u;
    for (;;) {
        sum = 0u; cnt = 0u; mine = 0u;
#pragma unroll
        for (unsigned j = 0; j < 16; ++j) { const unsigned c = xb_ld(&bar[XB_XCNT(j)]); sum += c; cnt += (c > 0u) ? 1u : 0u; mine = (j == x) ? c : mine; }
        if (sum == G) break;
        __builtin_amdgcn_s_sleep(1);
        if ((++sp & 255u) == 0u) { if (xb_ld(&bar[XB_TMO])) break; if (sp > XB_SPIN_CAP) { atomicAdd(&bar[XB_TMO], 1u); break; } }
    }
    nloc = mine > 0u ? mine : 1u; nx = cnt > 0u ? cnt : 1u;
}
__device__ __forceinline__ void xcd_barrier(const XcdBarrier& b) {
    asm volatile("s_waitcnt vmcnt(0)" ::: "memory");
    __syncthreads();
    if (threadIdx.x == 0) {
        unsigned* bar = b.bar;
        __builtin_amdgcn_s_waitcnt(0);
        unsigned nloc = b.st[0], nx = b.st[1];
        if (nloc == 0u) { xcd_barrier_complete(bar, b.x, nloc, nx); b.st[0] = nloc; b.st[1] = nx; }
        const unsigned old = xb_add(&bar[XB_XSUB(b.x)], 1u);
        const unsigned gen = old / nloc;
        if (old + 1u == (gen + 1u) * nloc) {
            __builtin_amdgcn_fence(__ATOMIC_RELEASE, "agent");
            asm volatile("s_waitcnt vmcnt(0)" ::: "memory");
            const unsigned og = xb_add(&bar[XB_TOP], 1u);
            const unsigned tg = og / nx;
            if (og + 1u == (tg + 1u) * nx) xb_add(&bar[XB_TOPGEN], 1u);
            else XB_SPIN(xb_ld(&bar[XB_TOPGEN]) == tg, bar);
            __builtin_amdgcn_fence(__ATOMIC_ACQUIRE, "agent");
            xb_add(&bar[XB_XGEN(b.x)], 1u);
            asm volatile("s_waitcnt vmcnt(0)" ::: "memory");
        } else {
            XB_SPIN(xb_ld(&bar[XB_XGEN(b.x)]) == gen, bar);
            __builtin_amdgcn_fence(__ATOMIC_ACQUIRE, "agent");
            asm volatile("s_waitcnt vmcnt(0)" ::: "memory");
        }
    }
    __syncthreads();
}

struct Args { const float* in[26]; float* out; unsigned char* ws; };

struct Frame {
    LAS unsigned char* lds;
    int tid, lane, wave, G, bx;
    float* out; unsigned char* ws;
};
typedef const float* cfp_t;
__device__ __forceinline__ const float* karg_in(int i) {
    asm volatile("" : "+s"(i));
    const __attribute__((address_space(4))) cfp_t* ka = (const __attribute__((address_space(4))) cfp_t*)__builtin_amdgcn_kernarg_segment_ptr();
    return ka[i];
}
#define IN(i) karg_in(i)
#define WSP(T, off) ((T*)(F.ws + (off)))

__device__ __forceinline__ void p0_transpose_item(const float* W, int K, int N, bf16_t* WT, int row_off, LAS float* scr, int item, int lane) {
    const int nblk = N / 32, kb = item / nblk, nb = item % nblk, k0 = 64 * kb, n0 = 32 * nb;
#pragma unroll 8
    for (int i = 0; i < 32; ++i) { const int kk = 2 * i + (lane >> 5); scr[kk * 33 + (lane & 31)] = W[(size_t)(k0 + kk) * N + n0 + (lane & 31)]; }
    LDS_WAIT(); asm volatile("" ::: "memory");
    const int c = lane & 7;
#pragma unroll
    for (int j = 0; j < 4; ++j) { const int n = (lane >> 3) + 8 * j; const LAS float* s = scr + (8 * c) * 33 + n;
        u32x4 o; o.x = cvt_pk_bf16(s[0 * 33], s[1 * 33]); o.y = cvt_pk_bf16(s[2 * 33], s[3 * 33]); o.z = cvt_pk_bf16(s[4 * 33], s[5 * 33]); o.w = cvt_pk_bf16(s[6 * 33], s[7 * 33]);
        *(u32x4*)(WT + (size_t)(row_off + n0 + n) * K + k0 + 8 * c) = o; }
    LDS_WAIT(); asm volatile("" ::: "memory");
}
template <bool OUT_F32> __device__ __forceinline__ void rms_row(const float* xrow, const float* g, void* orow, int lane) {
    const f32x4* xr = (const f32x4*)xrow + lane; f32x4 v[8]; float ss = 0.f;
#pragma unroll
    for (int j = 0; j < 8; ++j) { v[j] = xr[64 * j]; ss += (v[j].x * v[j].x + v[j].y * v[j].y) + (v[j].z * v[j].z + v[j].w * v[j].w); }
    const float r = rsqrtf(wave_sum(ss) * (1.f / DM) + EPS);
    const f32x4* gr = (const f32x4*)g + lane;
#pragma unroll
    for (int j = 0; j < 8; ++j) { const f32x4 gg = gr[64 * j]; const f32x4 o = v[j] * r * gg;
        if (OUT_F32) ((f32x4*)orow)[lane + 64 * j] = o;
        else { u32x2 w; w.x = cvt_pk_bf16(o.x, o.y); w.y = cvt_pk_bf16(o.z, o.w); ((u32x2*)orow)[lane + 64 * j] = w; } }
}

__device__ __forceinline__ void phase_prologue(Frame& F) {
    LAS float* scr = (LAS float*)(F.lds + F.wave * 16384);
    const int gw = F.bx * NWAVES + F.wave, NGW = F.G * NWAVES;
    constexpr int I_IN = 32 * 288, I_SQ = 32 * 64, I_BR = 16 * 64, I_UP = 32 * 256, I_DN = 128 * 64;
    constexpr int NITEMS = I_IN + 5 * I_SQ + 2 * I_BR + I_UP + I_DN;
    bf16_t* WIN = WSP(bf16_t, WS_WIN);
    for (int it = gw; it < NITEMS; it += NGW) {
        int r = it;
        if (r < I_IN) { p0_transpose_item(IN(7), DM, NIN, WIN, 0, scr, r, F.lane); continue; } r -= I_IN;
        if (r < I_SQ) { p0_transpose_item(IN(19), DM, DM, WIN, NIN, scr, r, F.lane); continue; } r -= I_SQ;
        if (r < I_SQ) { p0_transpose_item(IN(20), DM, DM, WIN, NIN + DM, scr, r, F.lane); continue; } r -= I_SQ;
        if (r < I_SQ) { p0_transpose_item(IN(15), DM, DM, WSP(bf16_t, WS_WMIX), 0, scr, r, F.lane); continue; } r -= I_SQ;
        if (r < I_SQ) { p0_transpose_item(IN(18), DM, DM, WSP(bf16_t, WS_WQ), 0, scr, r, F.lane); continue; } r -= I_SQ;
        if (r < I_SQ) { p0_transpose_item(IN(21), DM, DM, WSP(bf16_t, WS_WXO), 0, scr, r, F.lane); continue; } r -= I_SQ;
        if (r < I_BR) { p0_transpose_item(IN(13), 1024, DM, WSP(bf16_t, WS_WA), 0, scr, r, F.lane); continue; } r -= I_BR;
        if (r < I_BR) { p0_transpose_item(IN(14), 1024, DM, WSP(bf16_t, WS_WB), 0, scr, r, F.lane); continue; } r -= I_BR;
        if (r < I_UP) { p0_transpose_item(IN(23), DM, FF, WSP(bf16_t, WS_WUP), 0, scr, r, F.lane); continue; } r -= I_UP;
        p0_transpose_item(IN(24), FF, DM, WSP(bf16_t, WS_WDN), 0, scr, r, F.lane);
    }
    bf16_t* XN = WSP(bf16_t, WS_XN);
    for (int m = gw; m < MT + 1024; m += NGW) {
        const float* src = m < MP ? IN(0) + (size_t)m * DM : (m < MT ? IN(1) + (size_t)(m - MP) * DM : IN(5) + (size_t)(m - MT) * DM);
        rms_row<false>(src, m < MT ? IN(6) : IN(17), XN + (size_t)m * DM, F.lane);
    }
    bf16_t* WS = WSP(bf16_t, WS_WSP);
    for (int i = F.bx * 512 + F.tid; i < 4 * 128 * 128; i += F.G * 512) { const int t = (i >> 7) & 127, s = i & 127; const float w = (s <= t) ? IN(10)[i] : 0.f; WS[i] = (bf16_t)(cvt_pk_bf16(w, 0.f) & 0xffff); }
}

__device__ __forceinline__ void phase_mixprep(Frame& F) {
    const bf16_t* P1 = WSP(bf16_t, WS_P1);
    {
        bf16_t* YB = WSP(bf16_t, WS_YB); const float* cw = IN(12); const float* st = IN(2);
        for (int it = F.bx * 512 + F.tid; it < MT * 128; it += F.G * 512) {
            const int row = it >> 7, c0 = (it & 127) * 8;
            const bf16_t* pr = P1 + (size_t)row * NIN;
            float cg[8], xi[8], p0[8], p1[8], p2[8], bg[8];
            unpack8(*(const u32x4*)(pr + C_CG + c0), cg); unpack8(*(const u32x4*)(pr + C_XIN + c0), xi); unpack8(*(const u32x4*)(pr + C_BG + c0), bg);
#pragma unroll
            for (int e = 0; e < 8; ++e) p0[e] = cg[e] * xi[e];
            int pos, b; const bool prompt = row < MP;
            if (prompt) { pos = row & 2047; b = row >> 11; } else { pos = (row - MP) & 7; b = (row - MP) >> 3; }
            if (pos >= 1) { unpack8(*(const u32x4*)(pr - NIN + C_CG + c0), cg); unpack8(*(const u32x4*)(pr - NIN + C_XIN + c0), xi);
#pragma unroll
                for (int e = 0; e < 8; ++e) p1[e] = cg[e] * xi[e]; }
            else if (prompt) {
#pragma unroll
                for (int e = 0; e < 8; ++e) p1[e] = 0.f; }
            else { const f32x4 a = *(const f32x4*)(st + ((size_t)b * 2 + 1) * 1024 + c0), c = *(const f32x4*)(st + ((size_t)b * 2 + 1) * 1024 + c0 + 4);
                p1[0] = a.x; p1[1] = a.y; p1[2] = a.z; p1[3] = a.w; p1[4] = c.x; p1[5] = c.y; p1[6] = c.z; p1[7] = c.w; }
            if (pos >= 2) { unpack8(*(const u32x4*)(pr - 2 * NIN + C_CG + c0), cg); unpack8(*(const u32x4*)(pr - 2 * NIN + C_XIN + c0), xi);
#pragma unroll
                for (int e = 0; e < 8; ++e) p2[e] = cg[e] * xi[e]; }
            else if (prompt) {
#pragma unroll
                for (int e = 0; e < 8; ++e) p2[e] = 0.f; }
            else { const int sr = (pos == 1) ? 1 : 0; const f32x4 a = *(const f32x4*)(st + ((size_t)b * 2 + sr) * 1024 + c0), c = *(const f32x4*)(st + ((size_t)b * 2 + sr) * 1024 + c0 + 4);
                p2[0] = a.x; p2[1] = a.y; p2[2] = a.z; p2[3] = a.w; p2[4] = c.x; p2[5] = c.y; p2[6] = c.z; p2[7] = c.w; }
            float y[8];
#pragma unroll
            for (int e = 0; e < 8; ++e) y[e] = bg[e] * (cw[c0 + e] * p2[e] + cw[1024 + c0 + e] * p1[e] + cw[2048 + c0 + e] * p0[e]);
            u32x4 w; w.x = cvt_pk_bf16(y[0], y[1]); w.y = cvt_pk_bf16(y[2], y[3]); w.z = cvt_pk_bf16(y[4], y[5]); w.w = cvt_pk_bf16(y[6], y[7]);
            *(u32x4*)(YB + (size_t)row * 1024 + c0) = w;
            const int tail = prompt ? 2046 : 6;
            if (pos >= tail) { float* o = F.out + (prompt ? O_CP : O_CS) + ((size_t)b * 2 + (pos - tail)) * 1024 + c0;
                *(f32x4*)o = (f32x4){p0[0], p0[1], p0[2], p0[3]}; *(f32x4*)(o + 4) = (f32x4){p0[4], p0[5], p0[6], p0[7]}; }
        }
    }
    {
        const float* lg = IN(8); const float* lb = IN(9); const float* wsp = IN(10); const float* bsp = IN(11);
        bf16_t* YA = WSP(bf16_t, WS_YA);
        const int gw = F.bx * NWAVES + F.wave, NGW = F.G * NWAVES;
        for (int sq = gw; sq < 128; sq += NGW) {
            const int row0 = MP + sq * 8;
            float mu[8], rs[8];
#pragma unroll
            for (int t = 0; t < 8; ++t) {
                const bf16_t* pr = P1 + (size_t)(row0 + t) * NIN + C_V + 8 * F.lane;
                float a[8], b[8]; unpack8(*(const u32x4*)pr, a); unpack8(*(const u32x4*)(pr + 512), b);
                float s = 0.f;
#pragma unroll
                for (int e = 0; e < 8; ++e) s += a[e] + b[e];
                const float mean = wave_sum(s) * (1.f / 1024.f); float q = 0.f;
#pragma unroll
                for (int e = 0; e < 8; ++e) { const float da = a[e] - mean, db = b[e] - mean; q += da * da + db * db; }
                mu[t] = mean; rs[t] = rsqrtf(wave_sum(q) * (1.f / 1024.f) + EPS);
                asm volatile("" ::: "memory");
            }
#pragma unroll
            for (int j = 0; j < 2; ++j) {
                const int c0 = 8 * F.lane + 512 * j, g = c0 >> 8;
                float gg[8], bb[8];
                { const f32x4 a = *(const f32x4*)(lg + c0), b = *(const f32x4*)(lg + c0 + 4), c = *(const f32x4*)(lb + c0), d = *(const f32x4*)(lb + c0 + 4);
                  gg[0] = a.x; gg[1] = a.y; gg[2] = a.z; gg[3] = a.w; gg[4] = b.x; gg[5] = b.y; gg[6] = b.z; gg[7] = b.w;
                  bb[0] = c.x; bb[1] = c.y; bb[2] = c.z; bb[3] = c.w; bb[4] = d.x; bb[5] = d.y; bb[6] = d.z; bb[7] = d.w; }
                float vl[8][8];
#pragma unroll
                for (int t = 0; t < 8; ++t) {
                    float a[8]; unpack8(*(const u32x4*)(P1 + (size_t)(row0 + t) * NIN + C_V + c0), a);
#pragma unroll
                    for (int e = 0; e < 8; ++e) vl[t][e] = (a[e] - mu[t]) * rs[t] * gg[e] + bb[e];
                    float* o = F.out + O_CV + (size_t)(sq * 8 + t) * 1024 + c0;
                    *(f32x4*)o = (f32x4){vl[t][0], vl[t][1], vl[t][2], vl[t][3]}; *(f32x4*)(o + 4) = (f32x4){vl[t][4], vl[t][5], vl[t][6], vl[t][7]};
                }
#pragma unroll
                for (int t = 0; t < 8; ++t) {
                    float z[8]; const float bs = bsp[g * 128 + t];
#pragma unroll
                    for (int e = 0; e < 8; ++e) z[e] = bs;
#pragma unroll
                    for (int s = 0; s < 8; ++s) if (s <= t) { const float w = wsp[(size_t)g * 16384 + t * 128 + s];
#pragma unroll
                        for (int e = 0; e < 8; ++e) z[e] += w * vl[s][e]; }
                    float uf[8]; unpack8(*(const u32x4*)(P1 + (size_t)(row0 + t) * NIN + C_U + c0), uf);
                    u32x4 w; w.x = cvt_pk_bf16(uf[0] * z[0], uf[1] * z[1]); w.y = cvt_pk_bf16(uf[2] * z[2], uf[3] * z[3]); w.z = cvt_pk_bf16(uf[4] * z[4], uf[5] * z[5]); w.w = cvt_pk_bf16(uf[6] * z[6], uf[7] * z[7]);
                    *(u32x4*)(YA + (size_t)(row0 + t) * 1024 + c0) = w;
                }
            }
        }
    }
    {
        const float* lg = IN(8); const float* lb = IN(9);
        bf16_t* VT = WSP(bf16_t, WS_VT);
        LAS bf16_t* T = (LAS bf16_t*)F.lds;
        for (int un = F.bx; un < 256; un += F.G) {
            const int chunk = un >> 2, g = un & 3;
            const bool mine = ((F.lane >> 5) == (g & 1));
            const int cm = 256 * g + 8 * (F.lane & 31);
            float gg[8], bb[8];
            { const f32x4 a = *(const f32x4*)(lg + cm), b = *(const f32x4*)(lg + cm + 4), c = *(const f32x4*)(lb + cm), d = *(const f32x4*)(lb + cm + 4);
              gg[0] = a.x; gg[1] = a.y; gg[2] = a.z; gg[3] = a.w; gg[4] = b.x; gg[5] = b.y; gg[6] = b.z; gg[7] = b.w;
              bb[0] = c.x; bb[1] = c.y; bb[2] = c.z; bb[3] = c.w; bb[4] = d.x; bb[5] = d.y; bb[6] = d.z; bb[7] = d.w; }
            for (int rr = 0; rr < 16; ++rr) {
                const int s = F.wave * 16 + rr;
                const bf16_t* pr = P1 + (size_t)(chunk * 128 + s) * NIN + C_V + 8 * F.lane;
                float a[8], b[8]; unpack8(*(const u32x4*)pr, a); unpack8(*(const u32x4*)(pr + 512), b);
                float sm = 0.f;
#pragma unroll
                for (int e = 0; e < 8; ++e) sm += a[e] + b[e];
                const float mean = wave_sum(sm) * (1.f / 1024.f); float q = 0.f;
#pragma unroll
                for (int e = 0; e < 8; ++e) { const float da = a[e] - mean, db = b[e] - mean; q += da * da + db * db; }
                const float rstd = rsqrtf(wave_sum(q) * (1.f / 1024.f) + EPS);
                if (mine) {
                    float y[8];
#pragma unroll
                    for (int e = 0; e < 8; ++e) { const float x = (g >> 1) ? b[e] : a[e]; y[e] = (x - mean) * rstd * gg[e] + bb[e]; }
                    u32x4 w; w.x = cvt_pk_bf16(y[0], y[1]); w.y = cvt_pk_bf16(y[2], y[3]); w.z = cvt_pk_bf16(y[4], y[5]); w.w = cvt_pk_bf16(y[6], y[7]);
                    *(LAS u32x4*)(T + s * 264 + 8 * (F.lane & 31)) = w;
                }
            }
            __syncthreads();
#pragma unroll 2
            for (int itn = 0; itn < 8; ++itn) {
                const int idx = itn * 512 + F.tid, c = idx >> 4, sb = idx & 15;
                unsigned short h[8];
#pragma unroll
                for (int i = 0; i < 8; ++i) h[i] = T[(8 * sb + i) * 264 + c];
                u32x4 w; w.x = (unsigned)h[0] | ((unsigned)h[1] << 16); w.y = (unsigned)h[2] | ((unsigned)h[3] << 16); w.z = (unsigned)h[4] | ((unsigned)h[5] << 16); w.w = (unsigned)h[6] | ((unsigned)h[7] << 16);
                *(u32x4*)(VT + ((size_t)chunk * 1024 + g * 256 + c) * 128 + 8 * sb) = w;
            }
            __syncthreads();
        }
    }
}

__device__ __forceinline__ void sample_attn_unit(Frame& F, int unit) {
    const int b = unit >> 2, h = unit & 3, lane = F.lane, wave = F.wave, r16 = lane & 15, kq = lane >> 4;
    const float* Kb = IN(3) + ((size_t)b * NMEM * XH + h) * XD;
    const float* Vb = IN(4) + ((size_t)b * NMEM * XH + h) * XD;
    const bf16_t* Qb = WSP(bf16_t, WS_Q) + (size_t)(MP + b * 8) * DM + h * XD;
    LAS bf16_t* sP = (LAS bf16_t*)F.lds;
    LAS float* sSt = (LAS float*)(F.lds + 16 * 528);
    f32x4 s0 = {0.f, 0.f, 0.f, 0.f}, s1 = {0.f, 0.f, 0.f, 0.f};
    const float* k0p = Kb + (size_t)(32 * wave + r16) * (XH * XD) + kq * 8;
    const float* k1p = k0p + (size_t)16 * (XH * XD);
    const bf16_t* qp = Qb + (size_t)(r16 & 7) * DM + kq * 8;
#pragma unroll 4
    for (int ds = 0; ds < 16; ++ds) {
        const f32x4 a0 = *(const f32x4*)(k0p + ds * 32), a1 = *(const f32x4*)(k0p + ds * 32 + 4);
        const f32x4 c0 = *(const f32x4*)(k1p + ds * 32), c1 = *(const f32x4*)(k1p + ds * 32 + 4);
        u32x4 qw = *(const u32x4*)(qp + ds * 32); if (r16 >= 8) qw = (u32x4){0u, 0u, 0u, 0u};
        const bf16x8 qf = __builtin_bit_cast(bf16x8, qw);
        s0 = __builtin_amdgcn_mfma_f32_16x16x32_bf16(pack8(a0, a1), qf, s0, 0, 0, 0);
        s1 = __builtin_amdgcn_mfma_f32_16x16x32_bf16(pack8(c0, c1), qf, s1, 0, 0, 0);
    }
    float mx = fmaxf(fmaxf(fmaxf(s0[0], s0[1]), fmaxf(s0[2], s0[3])), fmaxf(fmaxf(s1[0], s1[1]), fmaxf(s1[2], s1[3])));
    mx = fmaxf(mx, __shfl_xor(mx, 16)); mx = fmaxf(mx, __shfl_xor(mx, 32));
    float sm = 0.f;
#pragma unroll
    for (int j = 0; j < 4; ++j) { s0[j] = __expf(s0[j] - mx); s1[j] = __expf(s1[j] - mx); sm += s0[j] + s1[j]; }
    sm += __shfl_xor(sm, 16); sm += __shfl_xor(sm, 32);
    if (kq == 0) { sSt[(wave * 16 + r16) * 2] = mx; sSt[(wave * 16 + r16) * 2 + 1] = sm; }
    __syncthreads();
    float M = -3.0e38f;
#pragma unroll
    for (int w2 = 0; w2 < 8; ++w2) M = fmaxf(M, sSt[(w2 * 16 + r16) * 2]);
    float L = 0.f;
#pragma unroll
    for (int w2 = 0; w2 < 8; ++w2) L += sSt[(w2 * 16 + r16) * 2 + 1] * __expf(sSt[(w2 * 16 + r16) * 2] - M);
    const float f = __expf(mx - M) / L;
    { u32x2 w; w.x = cvt_pk_bf16(s0[0] * f, s0[1] * f); w.y = cvt_pk_bf16(s0[2] * f, s0[3] * f); *(LAS u32x2*)(sP + r16 * 264 + 32 * wave + 4 * kq) = w;
      w.x = cvt_pk_bf16(s1[0] * f, s1[1] * f); w.y = cvt_pk_bf16(s1[2] * f, s1[3] * f); *(LAS u32x2*)(sP + r16 * 264 + 32 * wave + 16 + 4 * kq) = w; }
    __syncthreads();
    f32x4 o[4];
#pragma unroll
    for (int c = 0; c < 4; ++c) o[c] = (f32x4){0.f, 0.f, 0.f, 0.f};
    const float* vp = Vb + (size_t)(kq * 8) * (XH * XD) + 64 * wave + 4 * r16;
#pragma unroll 2
    for (int ms = 0; ms < 8; ++ms) {
        const bf16x8 pf = *(const LAS bf16x8*)(sP + r16 * 264 + ms * 32 + kq * 8);
        f32x4 x[8];
#pragma unroll
        for (int j = 0; j < 8; ++j) x[j] = *(const f32x4*)(vp + (size_t)(ms * 32 + j) * (XH * XD));
#pragma unroll
        for (int c = 0; c < 4; ++c) {
            const bf16x8 a = pack8((f32x4){x[0][c], x[1][c], x[2][c], x[3][c]}, (f32x4){x[4][c], x[5][c], x[6][c], x[7][c]});
            o[c] = __builtin_amdgcn_mfma_f32_16x16x32_bf16(a, pf, o[c], 0, 0, 0);
        }
    }
    if (r16 < 8) {
        bf16_t* op = WSP(bf16_t, WS_O) + (size_t)(MP + b * 8 + r16) * DM + h * XD + 64 * wave + 16 * kq;
        u32x4 w0, w1;
        w0.x = cvt_pk_bf16(o[0][0], o[1][0]); w0.y = cvt_pk_bf16(o[2][0], o[3][0]); w0.z = cvt_pk_bf16(o[0][1], o[1][1]); w0.w = cvt_pk_bf16(o[2][1], o[3][1]);
        w1.x = cvt_pk_bf16(o[0][2], o[1][2]); w1.y = cvt_pk_bf16(o[2][2], o[3][2]); w1.z = cvt_pk_bf16(o[0][3], o[1][3]); w1.w = cvt_pk_bf16(o[2][3], o[3][3]);
        *(u32x4*)op = w0; *(u32x4*)(op + 8) = w1;
    }
    __syncthreads();
}

template <bool OUT_F32> __device__ __forceinline__ void phase_rms(Frame& F, const float* src, const float* g, void* dst) {
    const int gw = F.bx * NWAVES + F.wave, NGW = F.G * NWAVES;
    for (int m = gw; m < MT; m += NGW) rms_row<OUT_F32>(src + (size_t)m * DM, g, OUT_F32 ? (void*)((float*)dst + (size_t)m * DM) : (void*)((bf16_t*)dst + (size_t)m * DM), F.lane);
}

__global__ void __launch_bounds__(NWAVES * 64, 2) fwd_megakernel(Args args) {
    extern __shared__ __attribute__((aligned(16))) unsigned char lds_raw[];
    cg::grid_group grid = cg::this_grid();
    Frame F;
    F.lds = (LAS unsigned char*)lds_raw;
    F.tid = threadIdx.x; F.lane = F.tid & 63; F.wave = __builtin_amdgcn_readfirstlane(F.tid >> 6);
    F.G = gridDim.x; F.bx = blockIdx.x;
    F.out = args.out; F.ws = args.ws;
    volatile LAS unsigned* MISC = (volatile LAS unsigned*)(F.lds + 131072 + 320);
    if (F.tid < 32) MISC[F.tid] = 0u;
    __syncthreads();
    XcdBarrier xbar = xcd_barrier_post((unsigned*)(F.ws + WS_CTL) + 4096, MISC + 8);
#define SEAM0() do { grid.sync(); int t_ = threadIdx.x; asm volatile("" : "+v"(t_)); F.tid = t_; F.lane = t_ & 63; } while (0)
#define SEAM() do { xcd_barrier(xbar); int t_ = threadIdx.x; asm volatile("" : "+v"(t_)); F.tid = t_; F.lane = t_ & 63; } while (0)
#ifndef PHASE_MASK
#define PHASE_MASK 0xffffffffu
#endif
#define PH(k) ((PHASE_MASK >> (k)) & 1u)
    using namespace pg8;
    const char* XN = (const char*)(F.ws + WS_XN);

    if (PH(0)) phase_prologue(F);
    SEAM0();
    if (PH(1)) {
        SchedIn S{XN, (const char*)(F.ws + WS_WIN), F.G, F.bx};
        EpiIn E{WSP(bf16_t, WS_P1), F.out + O_MK, F.out + O_MV, WSP(bf16_t, WS_KP), WSP(bf16_t, WS_VPT)};
        gemm_phase<EpiIn, SchedIn, true>(F.lds, DM, DM, DM, S, E);
    }
    SEAM();
    if (PH(2)) phase_mixprep(F);
    SEAM();
    if (PH(3)) {
        SchedSp S{(const char*)(F.ws + WS_WSP), (const char*)(F.ws + WS_VT), F.G, F.bx};
        EpiSp E{WSP(bf16_t, WS_P1), IN(11), WSP(bf16_t, WS_YA)};
        gemm_phase<EpiSp, SchedSp, true>(F.lds, 128, 128, 128, S, E);
    }
    SEAM();
    if (PH(4)) {
        SchedRect S{(const char*)(F.ws + WS_YA), (const char*)(F.ws + WS_WA), (size_t)BM * 1024 * 2, (size_t)BM * 1024 * 2, 36, 8, F.G, F.bx};
        EpiGA E{WSP(bf16_t, WS_P1), WSP(float, WS_TMP)};
        gemm_phase<EpiGA, SchedRect, true>(F.lds, 1024, 1024, 1024, S, E);
    }
    SEAM();
    if (PH(5)) {
        SchedRect S{(const char*)(F.ws + WS_YB), (const char*)(F.ws + WS_WB), (size_t)BM * 1024 * 2, (size_t)BM * 1024 * 2, 36, 8, F.G, F.bx};
        EpiGB E{WSP(bf16_t, WS_P1), WSP(float, WS_TMP), WSP(bf16_t, WS_MRG)};
        gemm_phase<EpiGB, SchedRect, true>(F.lds, 1024, 1024, 1024, S, E);
    }
    SEAM();
    if (PH(6)) {
        SchedRect S{(const char*)(F.ws + WS_MRG), (const char*)(F.ws + WS_WMIX), (size_t)BM * DM * 2, (size_t)BM * DM * 2, 36, 8, F.G, F.bx};
        EpiRes E{IN(0), IN(1), MP, WSP(float, WS_H1)};
        gemm_phase<EpiRes, SchedRect, true>(F.lds, DM, DM, DM, S, E);
    }
    SEAM();
    phase_rms<false>(F, WSP(float, WS_H1), IN(16), WSP(bf16_t, WS_XN));
    SEAM();
    if (PH(7)) {
        SchedRect S{XN, (const char*)(F.ws + WS_WQ), (size_t)BM * DM * 2, (size_t)BM * DM * 2, 36, 8, F.G, F.bx};
        EpiBf<0> E{WSP(bf16_t, WS_Q), DM, 0.04419417382415922f};
        gemm_phase<EpiBf<0>, SchedRect, true>(F.lds, DM, DM, DM, S, E);
    }
    SEAM();
    if (PH(8)) {
        SchedS S{(const char*)(F.ws + WS_Q), (const char*)(F.ws + WS_KP), F.G, F.bx};
        EpiSoftmax E{WSP(bf16_t, WS_PS)};
        gemm_phase<EpiSoftmax, SchedS, false>(F.lds, DM, DM, XD, S, E);
        __syncthreads();
        for (int un = F.bx; un < 512; un += F.G) sample_attn_unit(F, un);
    }
    SEAM();
    if (PH(9)) {
        SchedO S{(const char*)(F.ws + WS_PS), (const char*)(F.ws + WS_VPT), F.G, F.bx};
        EpiBf<0> E{WSP(bf16_t, WS_O), DM, 1.0f};
        gemm_phase<EpiBf<0>, SchedO, true>(F.lds, 256, 256, 256, S, E);
    }
    SEAM();
    if (PH(10)) {
        SchedRect S{(const char*)(F.ws + WS_O), (const char*)(F.ws + WS_WXO), (size_t)BM * DM * 2, (size_t)BM * DM * 2, 36, 8, F.G, F.bx};
        EpiRes E{WSP(float, WS_H1), WSP(float, WS_H1), 1 << 30, WSP(float, WS_H2)};
        gemm_phase<EpiRes, SchedRect, true>(F.lds, DM, DM, DM, S, E);
    }
    SEAM();
    phase_rms<false>(F, WSP(float, WS_H2), IN(22), WSP(bf16_t, WS_XN));
    SEAM();
    if (PH(11)) {
        SchedRect S{XN, (const char*)(F.ws + WS_WUP), (size_t)BM * DM * 2, (size_t)BM * DM * 2, 36, 32, F.G, F.bx};
        EpiBf<1> E{WSP(bf16_t, WS_UP), FF, 1.0f};
        gemm_phase<EpiBf<1>, SchedRect, true>(F.lds, DM, DM, DM, S, E);
    }
    SEAM();
    if (PH(12)) {
        SchedRect S{(const char*)(F.ws + WS_UP), (const char*)(F.ws + WS_WDN), (size_t)BM * FF * 2, (size_t)BM * FF * 2, 36, 8, F.G, F.bx};
        EpiRes E{WSP(float, WS_H2), WSP(float, WS_H2), 1 << 30, WSP(float, WS_H3)};
        gemm_phase<EpiRes, SchedRect, true>(F.lds, FF, FF, FF, S, E);
    }
    SEAM();
    phase_rms<true>(F, WSP(float, WS_H3), IN(25), F.out + O_Y);
}

extern "C" void kernel_launch(void* const* d_in, const int* in_sizes, int n_in, void* d_out, int out_size, void* d_ws, size_t ws_size, hipStream_t stream) {
    static int grid = 0;
    if (grid == 0) {
        if (n_in != 26 || ws_size < WS_END) { fprintf(stderr, "kernel_launch: unexpected n_in %d / ws_size %zu\n", n_in, ws_size); grid = -1; return; }
        int dev = 0, cus = 0, per_cu = 0;
        hipGetDevice(&dev);
        hipDeviceGetAttribute(&cus, hipDeviceAttributeMultiprocessorCount, dev);
        if (hipFuncSetAttribute((const void*)fwd_megakernel, hipFuncAttributeMaxDynamicSharedMemorySize, LDS_BYTES) != hipSuccess) { fprintf(stderr, "kernel_launch: hipFuncSetAttribute failed\n"); grid = -1; return; }
        if (hipOccupancyMaxActiveBlocksPerMultiprocessor(&per_cu, (const void*)fwd_megakernel, NWAVES * 64, LDS_BYTES) != hipSuccess || per_cu < 1) { fprintf(stderr, "kernel_launch: occupancy query says %d\n", per_cu); per_cu = 1; }
        (void)hipGetLastError();
        grid = cus;
        if (grid < 128) { fprintf(stderr, "kernel_launch: needs >= 128 CUs\n"); grid = -1; return; }
    }
    if (grid < 0) return;
    if (hipMemsetAsync((char*)d_ws + WS_CTL, 0, 65536, stream) != hipSuccess) { fprintf(stderr, "kernel_launch: memset failed\n"); return; }
    Args a{};
    for (int i = 0; i < 26; ++i) a.in[i] = (const float*)d_in[i];
    a.out = (float*)d_out; a.ws = (unsigned char*)d_ws;
    void* kargs[] = {&a};
    hipError_t e = hipLaunchCooperativeKernel((const void*)fwd_megakernel, dim3(grid), dim3(NWAVES * 64), kargs, LDS_BYTES, stream);
    if (e != hipSuccess) fprintf(stderr, "kernel_launch: cooperative launch failed: %s (grid %d)\n", hipGetErrorString(e), grid);
}
```

```cpp
#include <hip/hip_runtime.h>
#include <hip/hip_cooperative_groups.h>
#include <cstdio>
#include <cstdint>
namespace cg = cooperative_groups;

#define LAS __attribute__((address_space(3)))
typedef unsigned short bf16_t;
typedef short bf16x8 __attribute__((ext_vector_type(8)));
typedef float f32x4 __attribute__((ext_vector_type(4)));
typedef float f32x2 __attribute__((ext_vector_type(2)));
typedef unsigned u32x4 __attribute__((ext_vector_type(4)));
typedef unsigned u32x2 __attribute__((ext_vector_type(2)));

constexpr int DM = 2048, MP = 8192, MS = 1024, MT = MP + MS  ;
constexpr int NIN = 9216, FF = 8192, NMEM = 256, XH = 4, XD = 512;
constexpr int C_U = 0, C_V = 1024, C_BG = 2048, C_CG = 3072, C_XIN = 4096, C_GA = 5120, C_GB = 7168;
constexpr float EPS = 1e-6f, QSCALE = 0.04419417382415922f  ;
constexpr size_t O_Y = 0, O_MK = 18874368, O_MV = 20971520, O_CP = 23068672, O_CS = 23076864, O_CV = 23339008;
constexpr size_t MiB = 1u << 20;
constexpr size_t WS_CTL = 0, CTL_BYTES = 1 * MiB;
constexpr size_t WS_WIN = 2 * MiB;
constexpr size_t WS_WA = 54 * MiB, WS_WB = 58 * MiB;
constexpr size_t WS_WMIX = 62 * MiB, WS_WQ = 70 * MiB, WS_WXO = 78 * MiB;
constexpr size_t WS_WUP = 86 * MiB;
constexpr size_t WS_WDN = 118 * MiB;
constexpr size_t WS_WSP = 150 * MiB;
constexpr size_t WS_XN = 152 * MiB;
constexpr size_t WS_P1 = 192 * MiB;
constexpr size_t WS_UP = 192 * MiB;
constexpr size_t WS_VT = 354 * MiB;
constexpr size_t WS_YA = 370 * MiB, WS_YB = 388 * MiB;
constexpr size_t WS_TMP = 406 * MiB;
constexpr size_t WS_PART = 406 * MiB;
constexpr size_t WS_MRG = 478 * MiB;
constexpr size_t WS_H1 = 514 * MiB;
constexpr size_t WS_Q = 586 * MiB;
constexpr size_t WS_KP = 622 * MiB;
constexpr size_t WS_VPT = 626 * MiB;
constexpr size_t WS_PS = 630 * MiB;
constexpr size_t WS_O = 646 * MiB;
constexpr size_t WS_H2 = 682 * MiB;
constexpr size_t WS_END = 754 * MiB;

constexpr int LDS_BYTES = 147456;
constexpr int NWAVES = 8;

__device__ __forceinline__ unsigned cvt_pk_bf16(float lo, float hi) { unsigned r; asm volatile("v_cvt_pk_bf16_f32 %0, %1, %2" : "=v"(r) : "v"(lo), "v"(hi)); return r; }
__device__ __forceinline__ float bf_lo(unsigned u) { return __uint_as_float(u << 16); }
__device__ __forceinline__ float bf_hi(unsigned u) { return __uint_as_float(u & 0xffff0000u); }
__device__ __forceinline__ float bf1(bf16_t h) { return __uint_as_float(((unsigned)h) << 16); }
__device__ __forceinline__ bf16x8 pack8(f32x4 a, f32x4 b) {
    u32x4 w; w.x = cvt_pk_bf16(a.x, a.y); w.y = cvt_pk_bf16(a.z, a.w); w.z = cvt_pk_bf16(b.x, b.y); w.w = cvt_pk_bf16(b.z, b.w);
    return __builtin_bit_cast(bf16x8, w);
}
__device__ __forceinline__ void unpack8(u32x4 w, float (&f)[8]) {
    f[0] = bf_lo(w.x); f[1] = bf_hi(w.x); f[2] = bf_lo(w.y); f[3] = bf_hi(w.y); f[4] = bf_lo(w.z); f[5] = bf_hi(w.z); f[6] = bf_lo(w.w); f[7] = bf_hi(w.w);
}
__device__ __forceinline__ float wave_sum(float v) {
#pragma unroll
    for (int o = 1; o < 64; o <<= 1) v += __shfl_xor(v, o);
    return v;
}
__device__ __forceinline__ float sigmoidf_(float x) { return __builtin_amdgcn_rcpf(1.0f + __expf(-x)); }
#define LDS_WAIT() asm volatile("s_waitcnt lgkmcnt(0)" ::: "memory")

namespace pg8 {
constexpr int BM = 256, BK = 64, HALF = 128, HTB = HALF * BK * 2, STAGE_BYTES = 8 * HTB, NXCD = 8, WGM = 8;
__host__ __device__ __forceinline__ int lds_byte(int r, int c) { const int st = (r >> 4) * 2 + (c >> 5), rr = r & 15, cc = c & 31, ob = rr * 64 + cc * 2; return st * 1024 + (ob ^ (((ob >> 9) & 1) << 5)); }
__host__ __device__ __forceinline__ void stage_rc(int b, int& R, int& C) { const int st = b / 1024, sb = b % 1024, swz = sb ^ (((sb >> 9) & 1) << 5); R = (st >> 1) * 16 + swz / 64; C = (st & 1) * 32 + (swz % 64) / 2; }
__host__ __device__ __forceinline__ int perm32(int rho) { const int n = rho >> 4, i = rho & 15; return 8 * (i >> 2) + 4 * n + (i & 3); }

struct Unit { const char* A; const char* B; int orow, ocol, aux, nkt; };

__device__ __forceinline__ void rect_order(int L, int nM, int nN, int& pm, int& pn) {
    const int nwg = nM * nN; int wgid = L;
    { const int q = nwg / NXCD, r = nwg % NXCD, xcd = wgid % NXCD, off = wgid / NXCD; wgid = (xcd < r ? xcd * (q + 1) : r * (q + 1) + (xcd - r) * q) + off; }
    const int nig = WGM * nN, gid = wgid / nig, fm = gid * WGM, gsz = (nM - fm) < WGM ? (nM - fm) : WGM;
    pm = fm + ((wgid % nig) % gsz); pn = (wgid % nig) / gsz;
}

template <class Epi, class Sched, bool ALIGN_EPI>
__device__ __forceinline__ void gemm_phase(LAS unsigned char* lds, const int lda, const int ldb, const Sched& S, const Epi& E) {
    int tid_ = threadIdx.x; asm volatile("" : "+v"(tid_));
    const int tid = tid_, wid = __builtin_amdgcn_readfirstlane(tid >> 6), lane = tid & 63, wr = wid >> 2, wc = wid & 3, fr = lane & 15, fq = lane >> 4;
    unsigned voffA[2], voffB[2];
#pragma unroll
    for (int i = 0; i < 2; ++i) { int R, C; stage_rc(tid * 16 + i * 8192, R, C); const int Rb = Epi::PERM ? ((R & ~31) + perm32(R & 31)) : R;
        voffA[i] = (unsigned)(R * lda + C) * 2u; voffB[i] = (unsigned)(Rb * ldb + C) * 2u; }
    const size_t kstep = (size_t)(BK * 2);
    const size_t hstepA = (size_t)HALF * lda * 2, hstepB = (size_t)HALF * ldb * 2;
    const unsigned ldsw = (unsigned)wid * 1024u;
    const int aoff = lds_byte(wr * 64 + fr, fq * 8), boff = lds_byte(wc * 32 + fr, fq * 8);
#define PG8_SA(b, h) (((b) * 2 + (h)) * HTB)
#define PG8_SB(b, h) ((4 + (b) * 2 + (h)) * HTB)
#define PG8_STAGE(bufoff, gbase, voff) do { _Pragma("unroll") for (int _i = 0; _i < 2; ++_i) \
        __builtin_amdgcn_global_load_lds((const unsigned*)((const char*)(gbase) + (voff)[_i]), (LAS unsigned*)(lds + (bufoff) + ldsw + _i * 8192), 16, 0, 0); } while (0)
#define PG8_LDA(dst, b, h) do { _Pragma("unroll") for (int m = 0; m < 4; ++m) _Pragma("unroll") for (int k = 0; k < 2; ++k) dst[m][k] = *(const LAS bf16x8*)(lds + PG8_SA(b, h) + aoff + m * 2048 + k * 1024); } while (0)
#define PG8_LDB(dst, b, h) do { _Pragma("unroll") for (int n = 0; n < 2; ++n) _Pragma("unroll") for (int k = 0; k < 2; ++k) dst[n][k] = *(const LAS bf16x8*)(lds + PG8_SB(b, h) + boff + n * 2048 + k * 1024); } while (0)
#define PG8_MMA(ai, bj, At, Bt) do { __builtin_amdgcn_s_setprio(1); _Pragma("unroll") for (int m = 0; m < 4; ++m) _Pragma("unroll") for (int n = 0; n < 2; ++n) _Pragma("unroll") for (int k = 0; k < 2; ++k) \
        acc[ai][bj][m][n] = __builtin_amdgcn_mfma_f32_16x16x32_bf16(Bt[n][k], At[m][k], acc[ai][bj][m][n], 0, 0, 0); __builtin_amdgcn_s_setprio(0); } while (0)
#define PG8_WAIT_V(n) asm volatile("s_waitcnt vmcnt(" #n ")" ::: "memory")
#define PG8_WAIT_L(n) asm volatile("s_waitcnt lgkmcnt(" #n ")" ::: "memory")
#define PG8_BAR __builtin_amdgcn_s_barrier()
#define PG8_SCHED __builtin_amdgcn_sched_barrier(0)
    Unit cur, nxt; int ui = 0;
    if (!S.next(0, cur)) return;
    f32x4 acc[2][2][4][2];
#pragma unroll
    for (int a = 0; a < 2; ++a)
#pragma unroll
        for (int b = 0; b < 2; ++b)
#pragma unroll
            for (int m = 0; m < 4; ++m)
#pragma unroll
                for (int n = 0; n < 2; ++n) acc[a][b][m][n] = (f32x4){0.f, 0.f, 0.f, 0.f};
    bf16x8 At[4][2], B0[2][2], B1[2][2];
    const char* cA = cur.A; const char* cB = cur.B;
    PG8_STAGE(PG8_SB(0, 0), cB, voffB); PG8_STAGE(PG8_SB(0, 1), cB + hstepB, voffB); PG8_STAGE(PG8_SA(0, 0), cA, voffA); PG8_STAGE(PG8_SA(0, 1), cA + hstepA, voffA);
    if (wr == 1) PG8_BAR;
    PG8_WAIT_V(2); PG8_BAR;
    PG8_STAGE(PG8_SB(1, 0), cB + kstep, voffB); PG8_STAGE(PG8_SA(1, 0), cA + kstep, voffA); PG8_STAGE(PG8_SB(1, 1), cB + hstepB + kstep, voffB);
    PG8_WAIT_V(6); PG8_BAR;
    for (;;) {
        const bool has_next = S.next(ui + 1, nxt);
        int nt = cur.nkt; asm volatile("" : "+s"(nt));
        const char* nA = has_next ? nxt.A : cA; const char* nB = has_next ? nxt.B : cB;
        for (int t = 0; t < nt; t += 2) {
            const bool last = (t == nt - 2);
            const char* a1 = cA + (size_t)(t + 1) * kstep;
            const char* a2 = last ? nA : cA + (size_t)(t + 2) * kstep; const char* b2 = last ? nB : cB + (size_t)(t + 2) * kstep;
            const char* a3 = a2 + kstep; const char* b3 = b2 + kstep;
            PG8_LDB(B0, 0, 0); PG8_LDB(B1, 0, 1); PG8_SCHED; PG8_LDA(At, 0, 0); PG8_STAGE(PG8_SA(1, 1), a1 + hstepA, voffA);
            PG8_WAIT_V(8); PG8_WAIT_L(0); PG8_BAR; PG8_MMA(0, 0, At, B0); PG8_MMA(0, 1, At, B1); PG8_BAR; PG8_SCHED;
            PG8_LDA(At, 0, 1); PG8_STAGE(PG8_SB(0, 0), b2, voffB); PG8_STAGE(PG8_SB(0, 1), b2 + hstepB, voffB); PG8_STAGE(PG8_SA(0, 0), a2, voffA);
            PG8_WAIT_V(8); PG8_WAIT_L(0); PG8_BAR; PG8_MMA(1, 0, At, B0); PG8_MMA(1, 1, At, B1); PG8_BAR; PG8_SCHED;
            PG8_LDB(B0, 1, 0); PG8_LDB(B1, 1, 1); PG8_SCHED; PG8_LDA(At, 1, 0); PG8_STAGE(PG8_SA(0, 1), a2 + hstepA, voffA);
            PG8_WAIT_V(8); PG8_WAIT_L(0); PG8_BAR; PG8_MMA(0, 0, At, B0); PG8_MMA(0, 1, At, B1); PG8_BAR; PG8_SCHED;
            PG8_LDA(At, 1, 1); PG8_STAGE(PG8_SB(1, 0), b3, voffB); PG8_STAGE(PG8_SB(1, 1), b3 + hstepB, voffB); PG8_STAGE(PG8_SA(1, 0), a3, voffA);
            PG8_WAIT_V(8); PG8_WAIT_L(0); PG8_BAR; PG8_MMA(1, 0, At, B0); PG8_MMA(1, 1, At, B1); PG8_BAR; PG8_SCHED;
        }
        if constexpr (ALIGN_EPI) { if (wr == 0) PG8_BAR; }
        if constexpr (!Epi::AFTER_DRAIN) { E(acc, cur, wr, wc, fr, fq); }
        if (!has_next) break;
#pragma unroll
        for (int a = 0; a < 2; ++a)
#pragma unroll
            for (int b = 0; b < 2; ++b)
#pragma unroll
                for (int m = 0; m < 4; ++m)
#pragma unroll
                    for (int n = 0; n < 2; ++n) acc[a][b][m][n] = (f32x4){0.f, 0.f, 0.f, 0.f};
        cur = nxt; cA = nA; cB = nB; ++ui;
        if constexpr (ALIGN_EPI) { if (wr == 1) PG8_BAR; }
    }
    PG8_WAIT_V(0);
    if constexpr (!ALIGN_EPI) { if (wr == 0) PG8_BAR; }
    PG8_BAR;
    if constexpr (Epi::AFTER_DRAIN) { E.fused(acc, cur, wr, wc, fr, fq, lds, wid, lane); }
#undef PG8_SA
#undef PG8_SB
#undef PG8_STAGE
#undef PG8_LDA
#undef PG8_LDB
#undef PG8_MMA
#undef PG8_WAIT_V
#undef PG8_WAIT_L
#undef PG8_BAR
#undef PG8_SCHED
}

struct SchedRect {
    const char* A; const char* B; size_t atile, btile; int nM, nN, G, c, NT;
    __device__ __forceinline__ bool next(int i, Unit& u) const {
        const int L = i * G + c; if (L >= nM * nN) return false;
        int pm, pn; rect_order(L, nM, nN, pm, pn);
        u.A = A + (size_t)pm * atile; u.B = B + (size_t)pn * btile; u.orow = pm * BM; u.ocol = pn * BM; u.aux = 0; u.nkt = NT; return true;
    }
};
struct SchedIn {
    const char* A; const char* B; int G, c;
    __device__ __forceinline__ bool next(int i, Unit& u) const {
        const int L = i * G + c; if (L >= 1296 + 64) return false;
        int pm, pn;
        if (L < 1296) { rect_order(L, 36, 36, pm, pn); u.orow = pm * BM; u.ocol = pn * BM; u.aux = 0; }
        else { const int l = L - 1296; pm = 36 + (l & 3); pn = 36 + (l >> 2); u.orow = (pm - 36) * BM; u.ocol = (pn - 36) * BM; u.aux = 1; }
        u.A = A + (size_t)pm * (BM * DM * 2); u.B = B + (size_t)pn * (BM * DM * 2); u.nkt = DM / BK; return true;
    }
};
struct SchedSp {
    const char* WSP; const char* VT; int G, c;
    __device__ __forceinline__ bool next(int i, Unit& u) const {
        const int L = i * G + c; if (L >= 256) return false;
        const int chunk = L >> 2, p = (L >> 1) & 1, gi = L & 1, g = 2 * p + gi;
        u.A = WSP + (size_t)p * (256 * 128 * 2); u.B = VT + ((size_t)chunk * 1024 + g * 256) * 128 * 2; u.orow = chunk * 128; u.ocol = g * 256; u.aux = gi; u.nkt = 2; return true;
    }
};
struct SchedS {
    const char* Q; const char* KP; int G, c;
    __device__ __forceinline__ bool next(int i, Unit& u) const {
        const int L = i * G + c; if (L >= 128 || i > 0) return false;
        const int b = L >> 5, h = (L >> 3) & 3, p = L & 7;
        u.A = Q + ((size_t)(b * 2048 + p * 256) * DM + h * XD) * 2; u.B = KP + ((size_t)(b * 256) * DM + h * XD) * 2;
        u.orow = (b * 4 + h) * 2048 + p * 256; u.ocol = 0; u.aux = 0; u.nkt = XD / BK; return true;
    }
};
struct SchedO {
    const char* PS; const char* VPT; int G, c;
    __device__ __forceinline__ bool next(int i, Unit& u) const {
        const int L = i * G + c; if (L >= 256) return false;
        const int b = L >> 6, h = (L >> 4) & 3, p = (L >> 1) & 7, pn = L & 1;
        u.A = PS + ((size_t)((b * 4 + h) * 2048 + p * 256) * 256) * 2; u.B = VPT + ((size_t)(b * 2048 + h * XD + pn * 256) * 256) * 2;
        u.orow = b * 2048 + p * 256; u.ocol = h * XD + pn * 256; u.aux = 0; u.nkt = 4; return true;
    }
};


struct SchedTail {
    const char* A; const char* B; size_t atile, btile; int NT, G, c; bool tail;
    __device__ __forceinline__ bool next(int i, Unit& u) const {
        if (!tail) { const int L = i * G + c; if (L >= 288) return false; int pm, pn; rect_order(L, 36, 8, pm, pn);
            u.A = A + (size_t)pm * atile; u.B = B + (size_t)pn * btile; u.orow = pm * BM; u.ocol = pn * BM; u.aux = 0; u.nkt = NT; return true; }
        const int vcu = (c & 7) * 32 + (c >> 3);
        if (i == 0) { const int pm = vcu >> 3, pn = vcu & 7; u.A = A + (size_t)pm * atile; u.B = B + (size_t)pn * btile; u.orow = pm * BM; u.ocol = pn * BM; u.aux = 0; u.nkt = NT; return true; }
        if (i == 1) { const int t = vcu >> 3, s = vcu & 7, pm = 32 + (t >> 3), pn = t & 7, nk = NT >> 3;
            u.A = A + (size_t)pm * atile + (size_t)(s * nk) * (BK * 2); u.B = B + (size_t)pn * btile + (size_t)(s * nk) * (BK * 2);
            u.orow = (t >> 3) * BM; u.ocol = pn * BM; u.aux = 1 + s; u.nkt = nk; return true; }
        return false;
    }
};
#define EPI_ROWS_BEGIN _Pragma("unroll") for (int ai = 0; ai < 2; ++ai) _Pragma("unroll") for (int m = 0; m < 4; ++m) { const int rl = ai * HALF + wr * 64 + m * 16 + fr;
#define EPI_ROWS_END }

struct EpiIn {
    static constexpr bool PERM = true, AFTER_DRAIN = false;
    bf16_t* P1; float* memk; float* memv; bf16_t* KP; bf16_t* VPT;
    __device__ __forceinline__ void operator()(const f32x4 (&acc)[2][2][4][2], const Unit& u, int wr, int wc, int fr, int fq) const {
        const int cl0 = wc * 32 + 8 * fq;
        if (u.aux == 0) {
            EPI_ROWS_BEGIN
                bf16_t* rowp = P1 + (size_t)(u.orow + rl) * NIN + u.ocol + cl0;
#pragma unroll
                for (int bj = 0; bj < 2; ++bj) { const f32x4 v0 = acc[ai][bj][m][0], v1 = acc[ai][bj][m][1];
                    u32x4 w; w.x = cvt_pk_bf16(v0[0], v0[1]); w.y = cvt_pk_bf16(v0[2], v0[3]); w.z = cvt_pk_bf16(v1[0], v1[1]); w.w = cvt_pk_bf16(v1[2], v1[3]);
                    *(u32x4*)(rowp + bj * HALF) = w; }
            EPI_ROWS_END
        } else {
            const bool isV = u.ocol >= DM; const int cb = u.ocol - (isV ? DM : 0) + cl0;
            float* fo = isV ? memv : memk;
            EPI_ROWS_BEGIN
                const int row = u.orow + rl;
#pragma unroll
                for (int bj = 0; bj < 2; ++bj) { const f32x4 v0 = acc[ai][bj][m][0], v1 = acc[ai][bj][m][1]; const int col = cb + bj * HALF;
                    *(f32x4*)(fo + (size_t)row * DM + col) = v0; *(f32x4*)(fo + (size_t)row * DM + col + 4) = v1;
                    u32x4 w; w.x = cvt_pk_bf16(v0[0], v0[1]); w.y = cvt_pk_bf16(v0[2], v0[3]); w.z = cvt_pk_bf16(v1[0], v1[1]); w.w = cvt_pk_bf16(v1[2], v1[3]);
                    if (!isV) { *(u32x4*)(KP + (size_t)row * DM + col) = w; }
                    else { bf16_t* vp = VPT + ((size_t)(row >> 8) * DM + col) * 256 + (row & 255);
                        vp[0 * 256] = (bf16_t)(w.x & 0xffff); vp[1 * 256] = (bf16_t)(w.x >> 16); vp[2 * 256] = (bf16_t)(w.y & 0xffff); vp[3 * 256] = (bf16_t)(w.y >> 16);
                        vp[4 * 256] = (bf16_t)(w.z & 0xffff); vp[5 * 256] = (bf16_t)(w.z >> 16); vp[6 * 256] = (bf16_t)(w.w & 0xffff); vp[7 * 256] = (bf16_t)(w.w >> 16); } }
            EPI_ROWS_END
        }
    }
};
struct EpiSp {
    static constexpr bool PERM = true, AFTER_DRAIN = false;
    const bf16_t* P1; const float* bsp; bf16_t* YA;
    __device__ __forceinline__ void operator()(const f32x4 (&acc)[2][2][4][2], const Unit& u, int wr, int wc, int fr, int fq) const {
        const int g = u.ocol >> 8, cl0 = wc * 32 + 8 * fq;
#pragma unroll
        for (int ai = 0; ai < 2; ++ai) if (ai == u.aux) {
#pragma unroll
            for (int m = 0; m < 4; ++m) { const int t = wr * 64 + m * 16 + fr; const int row = u.orow + t; const float bs = bsp[g * 128 + t];
#pragma unroll
                for (int bj = 0; bj < 2; ++bj) { const int col = u.ocol + bj * HALF + cl0;
                    const u32x4 uw = *(const u32x4*)(P1 + (size_t)row * NIN + C_U + col); float uf[8]; unpack8(uw, uf);
                    const f32x4 v0 = acc[ai][bj][m][0], v1 = acc[ai][bj][m][1];
                    u32x4 w; w.x = cvt_pk_bf16(uf[0] * (v0[0] + bs), uf[1] * (v0[1] + bs)); w.y = cvt_pk_bf16(uf[2] * (v0[2] + bs), uf[3] * (v0[3] + bs));
                    w.z = cvt_pk_bf16(uf[4] * (v1[0] + bs), uf[5] * (v1[1] + bs)); w.w = cvt_pk_bf16(uf[6] * (v1[2] + bs), uf[7] * (v1[3] + bs));
                    *(u32x4*)(YA + (size_t)row * 1024 + col) = w; } }
        }
    }
};
struct EpiGA {
    static constexpr bool PERM = false, AFTER_DRAIN = false;
    const bf16_t* P1; float* TMP;
    __device__ __forceinline__ void operator()(const f32x4 (&acc)[2][2][4][2], const Unit& u, int wr, int wc, int fr, int fq) const {
        EPI_ROWS_BEGIN
            const int row = u.orow + rl;
#pragma unroll
            for (int bj = 0; bj < 2; ++bj)
#pragma unroll
                for (int n = 0; n < 2; ++n) { const int col = u.ocol + bj * HALF + wc * 32 + 16 * n + 4 * fq;
                    const u32x2 gw = *(const u32x2*)(P1 + (size_t)row * NIN + C_GA + col); const f32x4 v = acc[ai][bj][m][n];
                    f32x4 o; o[0] = sigmoidf_(bf_lo(gw.x)) * v[0]; o[1] = sigmoidf_(bf_hi(gw.x)) * v[1]; o[2] = sigmoidf_(bf_lo(gw.y)) * v[2]; o[3] = sigmoidf_(bf_hi(gw.y)) * v[3];
                    *(f32x4*)(TMP + (size_t)row * DM + col) = o; }
        EPI_ROWS_END
    }
};
struct EpiGB {
    static constexpr bool PERM = true, AFTER_DRAIN = false;
    const bf16_t* P1; const float* TMP; bf16_t* MRG;
    __device__ __forceinline__ void operator()(const f32x4 (&acc)[2][2][4][2], const Unit& u, int wr, int wc, int fr, int fq) const {
        const int cl0 = wc * 32 + 8 * fq;
        EPI_ROWS_BEGIN
            const int row = u.orow + rl;
#pragma unroll
            for (int bj = 0; bj < 2; ++bj) { const int col = u.ocol + bj * HALF + cl0;
                const u32x4 gw = *(const u32x4*)(P1 + (size_t)row * NIN + C_GB + col); float gf[8]; unpack8(gw, gf);
                const f32x4 t0 = *(const f32x4*)(TMP + (size_t)row * DM + col), t1 = *(const f32x4*)(TMP + (size_t)row * DM + col + 4);
                const f32x4 v0 = acc[ai][bj][m][0], v1 = acc[ai][bj][m][1];
                u32x4 w; w.x = cvt_pk_bf16(t0[0] + sigmoidf_(gf[0]) * v0[0], t0[1] + sigmoidf_(gf[1]) * v0[1]); w.y = cvt_pk_bf16(t0[2] + sigmoidf_(gf[2]) * v0[2], t0[3] + sigmoidf_(gf[3]) * v0[3]);
                w.z = cvt_pk_bf16(t1[0] + sigmoidf_(gf[4]) * v1[0], t1[1] + sigmoidf_(gf[5]) * v1[1]); w.w = cvt_pk_bf16(t1[2] + sigmoidf_(gf[6]) * v1[2], t1[3] + sigmoidf_(gf[7]) * v1[3]);
                *(u32x4*)(MRG + (size_t)row * DM + col) = w; }
        EPI_ROWS_END
    }
};
struct EpiRes {
    static constexpr bool PERM = false, AFTER_DRAIN = false;
    const float* resA; const float* resB; int split; float* out;
    __device__ __forceinline__ void operator()(const f32x4 (&acc)[2][2][4][2], const Unit& u, int wr, int wc, int fr, int fq) const {
        const float* rbase = (u.orow < split) ? resA + (size_t)u.orow * DM : resB + (size_t)(u.orow - split) * DM;
        float* obase = out + (size_t)u.orow * DM;
        EPI_ROWS_BEGIN
#pragma unroll
            for (int bj = 0; bj < 2; ++bj)
#pragma unroll
                for (int n = 0; n < 2; ++n) { const size_t off = (size_t)rl * DM + u.ocol + bj * HALF + wc * 32 + 16 * n + 4 * fq;
                    const f32x4 r = *(const f32x4*)(rbase + off); *(f32x4*)(obase + off) = r + acc[ai][bj][m][n]; }
        EPI_ROWS_END
    }
};
template <int MODE  > struct EpiBf {
    static constexpr bool PERM = true, AFTER_DRAIN = false;
    bf16_t* O; int ldc; float scale;
    __device__ __forceinline__ void operator()(const f32x4 (&acc)[2][2][4][2], const Unit& u, int wr, int wc, int fr, int fq) const {
        const int cl0 = wc * 32 + 8 * fq;
        EPI_ROWS_BEGIN
            bf16_t* rowp = O + (size_t)(u.orow + rl) * ldc + u.ocol + cl0;
#pragma unroll
            for (int bj = 0; bj < 2; ++bj) { f32x4 v0 = acc[ai][bj][m][0], v1 = acc[ai][bj][m][1];
                if (MODE == 0) { v0 = v0 * scale; v1 = v1 * scale; }
                else {
#pragma unroll
                    for (int e = 0; e < 4; ++e) { const float a = fmaxf(v0[e], 0.f), b = fmaxf(v1[e], 0.f); v0[e] = a * a; v1[e] = b * b; } }
                u32x4 w; w.x = cvt_pk_bf16(v0[0], v0[1]); w.y = cvt_pk_bf16(v0[2], v0[3]); w.z = cvt_pk_bf16(v1[0], v1[1]); w.w = cvt_pk_bf16(v1[2], v1[3]);
                *(u32x4*)(rowp + bj * HALF) = w; }
        EPI_ROWS_END
    }
};
struct EpiSoftmax {
    static constexpr bool PERM = true, AFTER_DRAIN = true;
    bf16_t* PS;
    __device__ __forceinline__ void fused(f32x4 (&acc)[2][2][4][2], const Unit& u, int wr, int wc, int fr, int fq, LAS unsigned char* lds, int wid, int lane) const {
        LAS f32x2* X = (LAS f32x2*)lds;
        float mxl[2][4];
        EPI_ROWS_BEGIN
            float mx = -3.0e38f;
#pragma unroll
            for (int bj = 0; bj < 2; ++bj)
#pragma unroll
                for (int n = 0; n < 2; ++n) { const f32x4 v = acc[ai][bj][m][n]; mx = fmaxf(mx, fmaxf(fmaxf(v[0], v[1]), fmaxf(v[2], v[3]))); }
            mx = fmaxf(mx, __shfl_xor(mx, 16)); mx = fmaxf(mx, __shfl_xor(mx, 32));
            float s = 0.f;
#pragma unroll
            for (int bj = 0; bj < 2; ++bj)
#pragma unroll
                for (int n = 0; n < 2; ++n) { f32x4 v = acc[ai][bj][m][n];
#pragma unroll
                    for (int e = 0; e < 4; ++e) { v[e] = __expf(v[e] - mx); s += v[e]; }
                    acc[ai][bj][m][n] = v; }
            s += __shfl_xor(s, 16); s += __shfl_xor(s, 32);
            mxl[ai][m] = mx;
            if (fq == 0) X[rl * 4 + wc] = (f32x2){mx, s};
        EPI_ROWS_END
        LDS_WAIT(); __builtin_amdgcn_s_barrier(); asm volatile("" ::: "memory");
        const int cl0 = wc * 32 + 8 * fq;
        EPI_ROWS_BEGIN
            const f32x2 a = X[rl * 4 + 0], b = X[rl * 4 + 1], c = X[rl * 4 + 2], d = X[rl * 4 + 3];
            const float M = fmaxf(fmaxf(a.x, b.x), fmaxf(c.x, d.x));
            const float L = a.y * __expf(a.x - M) + b.y * __expf(b.x - M) + c.y * __expf(c.x - M) + d.y * __expf(d.x - M);
            const float f = __expf(mxl[ai][m] - M) / L;
            bf16_t* rowp = PS + (size_t)(u.orow + rl) * 256 + cl0;
#pragma unroll
            for (int bj = 0; bj < 2; ++bj) { const f32x4 v0 = acc[ai][bj][m][0] * f, v1 = acc[ai][bj][m][1] * f;
                u32x4 w; w.x = cvt_pk_bf16(v0[0], v0[1]); w.y = cvt_pk_bf16(v0[2], v0[3]); w.z = cvt_pk_bf16(v1[0], v1[1]); w.w = cvt_pk_bf16(v1[2], v1[3]);
                *(u32x4*)(rowp + bj * HALF) = w; }
        EPI_ROWS_END
        LDS_WAIT(); __builtin_amdgcn_s_barrier(); asm volatile("" ::: "memory");
    }
};

template <class Base> struct EpiTail {
    static constexpr bool PERM = Base::PERM, AFTER_DRAIN = false;
    Base base; float* part;
    __device__ __forceinline__ void operator()(const f32x4 (&acc)[2][2][4][2], const Unit& u, int wr, int wc, int fr, int fq) const {
        if (u.aux == 0) { base(acc, u, wr, wc, fr, fq); return; }
        float* pb = part + (size_t)(u.aux - 1) * (MS * DM) + (size_t)u.orow * DM + u.ocol;
        EPI_ROWS_BEGIN
#pragma unroll
            for (int bj = 0; bj < 2; ++bj)
#pragma unroll
                for (int n = 0; n < 2; ++n) { const int col = PERM ? (bj * HALF + wc * 32 + 8 * fq + 4 * n) : (bj * HALF + wc * 32 + 16 * n + 4 * fq);
                    *(f32x4*)(pb + (size_t)rl * DM + col) = acc[ai][bj][m][n]; }
        EPI_ROWS_END
    }
};
}


#define XB_TMO      128
#define XB_XCNT(j)  (256  + 64 * (j))
#define XB_XSUB(j)  (1280 + 64 * (j))
#define XB_XGEN(j)  (2304 + 64 * (j))
#define XB_TOP      3328
#define XB_TOPGEN   3392
#define XCD_BAR_WORDS 3456
#define XB_SPIN_CAP (1u << 18)
__device__ __forceinline__ unsigned xb_ld(unsigned* p)              { return __hip_atomic_load(p, __ATOMIC_RELAXED, __HIP_MEMORY_SCOPE_AGENT); }
__device__ __forceinline__ unsigned xb_add(unsigned* p, unsigned v) { return __hip_atomic_fetch_add(p, v, __ATOMIC_RELAXED, __HIP_MEMORY_SCOPE_AGENT); }
__device__ __forceinline__ unsigned xb_xcc_id() { return (unsigned)__builtin_amdgcn_s_getreg((3 << 11) | 20) & 0xFu; }
#define XB_SPIN(cond, bar) do { unsigned _sp = 0; while (cond) { __builtin_amdgcn_s_sleep(1); \
    if ((++_sp & 255u) == 0u) { if (xb_ld(&(bar)[XB_TMO])) break; if (_sp > XB_SPIN_CAP) { atomicAdd(&(bar)[XB_TMO], 1u); break; } } } } while (0)
struct XcdBarrier { unsigned* bar; unsigned x; volatile LAS unsigned* st; };
__device__ __forceinline__ XcdBarrier xcd_barrier_post(unsigned* bar, volatile LAS unsigned* st) {
    XcdBarrier b; b.bar = bar; b.x = xb_xcc_id(); b.st = st;
    if (threadIdx.x == 0) (void)xb_add(&bar[XB_XCNT(b.x)], 1u);
    return b;
}
__device__ __forceinline__ void xcd_barrier_complete(unsigned* bar, unsigned x, unsigned& nloc, unsigned& nx) {
    const unsigned G = gridDim.x * gridDim.y * gridDim.z;
    unsigned sum, cnt, mine, sp = 0u;
    for (;;) {
        sum = 0u; cnt = 0u; mine = 0u;
#pragma unroll
        for (unsigned j = 0; j < 16; ++j) { const unsigned c = xb_ld(&bar[XB_XCNT(j)]); sum += c; cnt += (c > 0u) ? 1u : 0u; mine = (j == x) ? c : mine; }
        if (sum == G) break;
        __builtin_amdgcn_s_sleep(1);
        if ((++sp & 255u) == 0u) { if (xb_ld(&bar[XB_TMO])) break; if (sp > XB_SPIN_CAP) { atomicAdd(&bar[XB_TMO], 1u); break; } }
    }
    nloc = mine > 0u ? mine : 1u; nx = cnt > 0u ? cnt : 1u;
}
__device__ __forceinline__ void xcd_barrier(const XcdBarrier& b) {
    asm volatile("s_waitcnt vmcnt(0)" ::: "memory");
    __syncthreads();
    if (threadIdx.x == 0) {
        unsigned* bar = b.bar;
        __builtin_amdgcn_s_waitcnt(0);
        unsigned nloc = b.st[0], nx = b.st[1];
        if (nloc == 0u) { xcd_barrier_complete(bar, b.x, nloc, nx); b.st[0] = nloc; b.st[1] = nx; }
        const unsigned old = xb_add(&bar[XB_XSUB(b.x)], 1u);
        const unsigned gen = old / nloc;
        if (old + 1u == (gen + 1u) * nloc) {
            __builtin_amdgcn_fence(__ATOMIC_RELEASE, "agent");
            asm volatile("s_waitcnt vmcnt(0)" ::: "memory");
            const unsigned og = xb_add(&bar[XB_TOP], 1u);
            const unsigned tg = og / nx;
            if (og + 1u == (tg + 1u) * nx) xb_add(&bar[XB_TOPGEN], 1u);
            else XB_SPIN(xb_ld(&bar[XB_TOPGEN]) == tg, bar);
            __builtin_amdgcn_fence(__ATOMIC_ACQUIRE, "agent");
            xb_add(&bar[XB_XGEN(b.x)], 1u);
            asm volatile("s_waitcnt vmcnt(0)" ::: "memory");
        } else {
            XB_SPIN(xb_ld(&bar[XB_XGEN(b.x)]) == gen, bar);
            __builtin_amdgcn_fence(__ATOMIC_ACQUIRE, "agent");
            asm volatile("s_waitcnt vmcnt(0)" ::: "memory");
        }
    }
    __syncthreads();
}

struct Args { const float* in[26]; float* out; unsigned char* ws; };

struct Frame {
    LAS unsigned char* lds;
    int tid, lane, wave, G, bx;
    float* out; unsigned char* ws;
};
typedef const float* cfp_t;
__device__ __forceinline__ const float* karg_in(int i) {
    asm volatile("" : "+s"(i));
    const __attribute__((address_space(4))) cfp_t* ka = (const __attribute__((address_space(4))) cfp_t*)__builtin_amdgcn_kernarg_segment_ptr();
    return ka[i];
}
#define IN(i) karg_in(i)
#define WSP(T, off) ((T*)(F.ws + (off)))

__device__ __forceinline__ void p0_transpose_item(const float* W, int K, int N, bf16_t* WT, int row_off, LAS float* scr, int item, int lane) {
    const int nblk = N / 32, kb = item / nblk, nb = item % nblk, k0 = 64 * kb, n0 = 32 * nb;
#pragma unroll 8
    for (int i = 0; i < 32; ++i) { const int kk = 2 * i + (lane >> 5); scr[kk * 33 + (lane & 31)] = W[(size_t)(k0 + kk) * N + n0 + (lane & 31)]; }
    LDS_WAIT(); asm volatile("" ::: "memory");
    const int c = lane & 7;
#pragma unroll
    for (int j = 0; j < 4; ++j) { const int n = (lane >> 3) + 8 * j; const LAS float* s = scr + (8 * c) * 33 + n;
        u32x4 o; o.x = cvt_pk_bf16(s[0 * 33], s[1 * 33]); o.y = cvt_pk_bf16(s[2 * 33], s[3 * 33]); o.z = cvt_pk_bf16(s[4 * 33], s[5 * 33]); o.w = cvt_pk_bf16(s[6 * 33], s[7 * 33]);
        *(u32x4*)(WT + (size_t)(row_off + n0 + n) * K + k0 + 8 * c) = o; }
    LDS_WAIT(); asm volatile("" ::: "memory");
}
template <bool OUT_F32> __device__ __forceinline__ void rms_row(const float* xrow, const float* g, void* orow, int lane) {
    const f32x4* xr = (const f32x4*)xrow + lane; f32x4 v[8]; float ss = 0.f;
#pragma unroll
    for (int j = 0; j < 8; ++j) { v[j] = xr[64 * j]; ss += (v[j].x * v[j].x + v[j].y * v[j].y) + (v[j].z * v[j].z + v[j].w * v[j].w); }
    const float r = rsqrtf(wave_sum(ss) * (1.f / DM) + EPS);
    const f32x4* gr = (const f32x4*)g + lane;
#pragma unroll
    for (int j = 0; j < 8; ++j) { const f32x4 gg = gr[64 * j]; const f32x4 o = v[j] * r * gg;
        if (OUT_F32) ((f32x4*)orow)[lane + 64 * j] = o;
        else { u32x2 w; w.x = cvt_pk_bf16(o.x, o.y); w.y = cvt_pk_bf16(o.z, o.w); ((u32x2*)orow)[lane + 64 * j] = w; } }
}

__device__ __forceinline__ void phase_prologue(Frame& F) {
    LAS float* scr = (LAS float*)(F.lds + F.wave * 16384);
    const int gw = F.bx * NWAVES + F.wave, NGW = F.G * NWAVES;
    constexpr int I_IN = 32 * 288, I_SQ = 32 * 64, I_BR = 16 * 64, I_UP = 32 * 256, I_DN = 128 * 64;
    constexpr int NITEMS = I_IN + 5 * I_SQ + 2 * I_BR + I_UP + I_DN;
    bf16_t* WIN = WSP(bf16_t, WS_WIN);
    for (int it = gw; it < NITEMS; it += NGW) {
        int r = it;
        if (r < I_IN) { p0_transpose_item(IN(7), DM, NIN, WIN, 0, scr, r, F.lane); continue; } r -= I_IN;
        if (r < I_SQ) { p0_transpose_item(IN(19), DM, DM, WIN, NIN, scr, r, F.lane); continue; } r -= I_SQ;
        if (r < I_SQ) { p0_transpose_item(IN(20), DM, DM, WIN, NIN + DM, scr, r, F.lane); continue; } r -= I_SQ;
        if (r < I_SQ) { p0_transpose_item(IN(15), DM, DM, WSP(bf16_t, WS_WMIX), 0, scr, r, F.lane); continue; } r -= I_SQ;
        if (r < I_SQ) { p0_transpose_item(IN(18), DM, DM, WSP(bf16_t, WS_WQ), 0, scr, r, F.lane); continue; } r -= I_SQ;
        if (r < I_SQ) { p0_transpose_item(IN(21), DM, DM, WSP(bf16_t, WS_WXO), 0, scr, r, F.lane); continue; } r -= I_SQ;
        if (r < I_BR) { p0_transpose_item(IN(13), 1024, DM, WSP(bf16_t, WS_WA), 0, scr, r, F.lane); continue; } r -= I_BR;
        if (r < I_BR) { p0_transpose_item(IN(14), 1024, DM, WSP(bf16_t, WS_WB), 0, scr, r, F.lane); continue; } r -= I_BR;
        if (r < I_UP) { p0_transpose_item(IN(23), DM, FF, WSP(bf16_t, WS_WUP), 0, scr, r, F.lane); continue; } r -= I_UP;
        p0_transpose_item(IN(24), FF, DM, WSP(bf16_t, WS_WDN), 0, scr, r, F.lane);
    }
    bf16_t* XN = WSP(bf16_t, WS_XN);
    for (int m = gw; m < MT + 1024; m += NGW) {
        const float* src = m < MP ? IN(0) + (size_t)m * DM : (m < MT ? IN(1) + (size_t)(m - MP) * DM : IN(5) + (size_t)(m - MT) * DM);
        rms_row<false>(src, m < MT ? IN(6) : IN(17), XN + (size_t)m * DM, F.lane);
    }
    bf16_t* WS = WSP(bf16_t, WS_WSP);
    for (int i = F.bx * 512 + F.tid; i < 4 * 128 * 128; i += F.G * 512) { const int t = (i >> 7) & 127, s = i & 127; const float w = (s <= t) ? IN(10)[i] : 0.f; WS[i] = (bf16_t)(cvt_pk_bf16(w, 0.f) & 0xffff); }
}

__device__ __forceinline__ void phase_mixprep(Frame& F) {
    const bf16_t* P1 = WSP(bf16_t, WS_P1);
    {
        bf16_t* YB = WSP(bf16_t, WS_YB); const float* cw = IN(12); const float* st = IN(2);
        for (int it = F.bx * 512 + F.tid; it < MT * 128; it += F.G * 512) {
            const int row = it >> 7, c0 = (it & 127) * 8;
            const bf16_t* pr = P1 + (size_t)row * NIN;
            float cg[8], xi[8], p0[8], p1[8], p2[8], bg[8];
            unpack8(*(const u32x4*)(pr + C_CG + c0), cg); unpack8(*(const u32x4*)(pr + C_XIN + c0), xi); unpack8(*(const u32x4*)(pr + C_BG + c0), bg);
#pragma unroll
            for (int e = 0; e < 8; ++e) p0[e] = cg[e] * xi[e];
            int pos, b; const bool prompt = row < MP;
            if (prompt) { pos = row & 2047; b = row >> 11; } else { pos = (row - MP) & 7; b = (row - MP) >> 3; }
            if (pos >= 1) { unpack8(*(const u32x4*)(pr - NIN + C_CG + c0), cg); unpack8(*(const u32x4*)(pr - NIN + C_XIN + c0), xi);
#pragma unroll
                for (int e = 0; e < 8; ++e) p1[e] = cg[e] * xi[e]; }
            else if (prompt) {
#pragma unroll
                for (int e = 0; e < 8; ++e) p1[e] = 0.f; }
            else { const f32x4 a = *(const f32x4*)(st + ((size_t)b * 2 + 1) * 1024 + c0), c = *(const f32x4*)(st + ((size_t)b * 2 + 1) * 1024 + c0 + 4);
                p1[0] = a.x; p1[1] = a.y; p1[2] = a.z; p1[3] = a.w; p1[4] = c.x; p1[5] = c.y; p1[6] = c.z; p1[7] = c.w; }
            if (pos >= 2) { unpack8(*(const u32x4*)(pr - 2 * NIN + C_CG + c0), cg); unpack8(*(const u32x4*)(pr - 2 * NIN + C_XIN + c0), xi);
#pragma unroll
                for (int e = 0; e < 8; ++e) p2[e] = cg[e] * xi[e]; }
            else if (prompt) {
#pragma unroll
                for (int e = 0; e < 8; ++e) p2[e] = 0.f; }
            else { const int sr = (pos == 1) ? 1 : 0; const f32x4 a = *(const f32x4*)(st + ((size_t)b * 2 + sr) * 1024 + c0), c = *(const f32x4*)(st + ((size_t)b * 2 + sr) * 1024 + c0 + 4);
                p2[0] = a.x; p2[1] = a.y; p2[2] = a.z; p2[3] = a.w; p2[4] = c.x; p2[5] = c.y; p2[6] = c.z; p2[7] = c.w; }
            float y[8];
#pragma unroll
            for (int e = 0; e < 8; ++e) y[e] = bg[e] * (cw[c0 + e] * p2[e] + cw[1024 + c0 + e] * p1[e] + cw[2048 + c0 + e] * p0[e]);
            u32x4 w; w.x = cvt_pk_bf16(y[0], y[1]); w.y = cvt_pk_bf16(y[2], y[3]); w.z = cvt_pk_bf16(y[4], y[5]); w.w = cvt_pk_bf16(y[6], y[7]);
            *(u32x4*)(YB + (size_t)row * 1024 + c0) = w;
            const int tail = prompt ? 2046 : 6;
            if (pos >= tail) { float* o = F.out + (prompt ? O_CP : O_CS) + ((size_t)b * 2 + (pos - tail)) * 1024 + c0;
                *(f32x4*)o = (f32x4){p0[0], p0[1], p0[2], p0[3]}; *(f32x4*)(o + 4) = (f32x4){p0[4], p0[5], p0[6], p0[7]}; }
        }
    }
    {
        const float* lg = IN(8); const float* lb = IN(9); const float* wsp = IN(10); const float* bsp = IN(11);
        bf16_t* YA = WSP(bf16_t, WS_YA);
        const int gw = F.bx * NWAVES + F.wave, NGW = F.G * NWAVES;
        for (int sq = gw; sq < 128; sq += NGW) {
            const int row0 = MP + sq * 8;
            float mu[8], rs[8];
#pragma unroll
            for (int t = 0; t < 8; ++t) {
                const bf16_t* pr = P1 + (size_t)(row0 + t) * NIN + C_V + 8 * F.lane;
                float a[8], b[8]; unpack8(*(const u32x4*)pr, a); unpack8(*(const u32x4*)(pr + 512), b);
                float s = 0.f;
#pragma unroll
                for (int e = 0; e < 8; ++e) s += a[e] + b[e];
                const float mean = wave_sum(s) * (1.f / 1024.f); float q = 0.f;
#pragma unroll
                for (int e = 0; e < 8; ++e) { const float da = a[e] - mean, db = b[e] - mean; q += da * da + db * db; }
                mu[t] = mean; rs[t] = rsqrtf(wave_sum(q) * (1.f / 1024.f) + EPS);
                asm volatile("" ::: "memory");
            }
#pragma unroll
            for (int j = 0; j < 2; ++j) {
                const int c0 = 8 * F.lane + 512 * j, g = c0 >> 8;
                float gg[8], bb[8];
                { const f32x4 a = *(const f32x4*)(lg + c0), b = *(const f32x4*)(lg + c0 + 4), c = *(const f32x4*)(lb + c0), d = *(const f32x4*)(lb + c0 + 4);
                  gg[0] = a.x; gg[1] = a.y; gg[2] = a.z; gg[3] = a.w; gg[4] = b.x; gg[5] = b.y; gg[6] = b.z; gg[7] = b.w;
                  bb[0] = c.x; bb[1] = c.y; bb[2] = c.z; bb[3] = c.w; bb[4] = d.x; bb[5] = d.y; bb[6] = d.z; bb[7] = d.w; }
                float vl[8][8];
#pragma unroll
                for (int t = 0; t < 8; ++t) {
                    float a[8]; unpack8(*(const u32x4*)(P1 + (size_t)(row0 + t) * NIN + C_V + c0), a);
#pragma unroll
                    for (int e = 0; e < 8; ++e) vl[t][e] = (a[e] - mu[t]) * rs[t] * gg[e] + bb[e];
                    float* o = F.out + O_CV + (size_t)(sq * 8 + t) * 1024 + c0;
                    *(f32x4*)o = (f32x4){vl[t][0], vl[t][1], vl[t][2], vl[t][3]}; *(f32x4*)(o + 4) = (f32x4){vl[t][4], vl[t][5], vl[t][6], vl[t][7]};
                }
#pragma unroll
                for (int t = 0; t < 8; ++t) {
                    float z[8]; const float bs = bsp[g * 128 + t];
#pragma unroll
                    for (int e = 0; e < 8; ++e) z[e] = bs;
#pragma unroll
                    for (int s = 0; s < 8; ++s) if (s <= t) { const float w = wsp[(size_t)g * 16384 + t * 128 + s];
#pragma unroll
                        for (int e = 0; e < 8; ++e) z[e] += w * vl[s][e]; }
                    float uf[8]; unpack8(*(const u32x4*)(P1 + (size_t)(row0 + t) * NIN + C_U + c0), uf);
                    u32x4 w; w.x = cvt_pk_bf16(uf[0] * z[0], uf[1] * z[1]); w.y = cvt_pk_bf16(uf[2] * z[2], uf[3] * z[3]); w.z = cvt_pk_bf16(uf[4] * z[4], uf[5] * z[5]); w.w = cvt_pk_bf16(uf[6] * z[6], uf[7] * z[7]);
                    *(u32x4*)(YA + (size_t)(row0 + t) * 1024 + c0) = w;
                }
            }
        }
    }
    {
        const float* lg = IN(8); const float* lb = IN(9);
        bf16_t* VT = WSP(bf16_t, WS_VT);
        LAS bf16_t* T = (LAS bf16_t*)F.lds;
        for (int un = F.bx; un < 256; un += F.G) {
            const int chunk = un >> 2, g = un & 3;
            const bool mine = ((F.lane >> 5) == (g & 1));
            const int cm = 256 * g + 8 * (F.lane & 31);
            float gg[8], bb[8];
            { const f32x4 a = *(const f32x4*)(lg + cm), b = *(const f32x4*)(lg + cm + 4), c = *(const f32x4*)(lb + cm), d = *(const f32x4*)(lb + cm + 4);
              gg[0] = a.x; gg[1] = a.y; gg[2] = a.z; gg[3] = a.w; gg[4] = b.x; gg[5] = b.y; gg[6] = b.z; gg[7] = b.w;
              bb[0] = c.x; bb[1] = c.y; bb[2] = c.z; bb[3] = c.w; bb[4] = d.x; bb[5] = d.y; bb[6] = d.z; bb[7] = d.w; }
            for (int rr = 0; rr < 16; ++rr) {
                const int s = F.wave * 16 + rr;
                const bf16_t* pr = P1 + (size_t)(chunk * 128 + s) * NIN + C_V + 8 * F.lane;
                float a[8], b[8]; unpack8(*(const u32x4*)pr, a); unpack8(*(const u32x4*)(pr + 512), b);
                float sm = 0.f;
#pragma unroll
                for (int e = 0; e < 8; ++e) sm += a[e] + b[e];
                const float mean = wave_sum(sm) * (1.f / 1024.f); float q = 0.f;
#pragma unroll
                for (int e = 0; e < 8; ++e) { const float da = a[e] - mean, db = b[e] - mean; q += da * da + db * db; }
                const float rstd = rsqrtf(wave_sum(q) * (1.f / 1024.f) + EPS);
                if (mine) {
                    float y[8];
#pragma unroll
                    for (int e = 0; e < 8; ++e) { const float x = (g >> 1) ? b[e] : a[e]; y[e] = (x - mean) * rstd * gg[e] + bb[e]; }
                    u32x4 w; w.x = cvt_pk_bf16(y[0], y[1]); w.y = cvt_pk_bf16(y[2], y[3]); w.z = cvt_pk_bf16(y[4], y[5]); w.w = cvt_pk_bf16(y[6], y[7]);
                    *(LAS u32x4*)(T + s * 264 + 8 * (F.lane & 31)) = w;
                }
            }
            __syncthreads();
#pragma unroll 2
            for (int itn = 0; itn < 8; ++itn) {
                const int idx = itn * 512 + F.tid, c = idx >> 4, sb = idx & 15;
                unsigned short h[8];
#pragma unroll
                for (int i = 0; i < 8; ++i) h[i] = T[(8 * sb + i) * 264 + c];
                u32x4 w; w.x = (unsigned)h[0] | ((unsigned)h[1] << 16); w.y = (unsigned)h[2] | ((unsigned)h[3] << 16); w.z = (unsigned)h[4] | ((unsigned)h[5] << 16); w.w = (unsigned)h[6] | ((unsigned)h[7] << 16);
                *(u32x4*)(VT + ((size_t)chunk * 1024 + g * 256 + c) * 128 + 8 * sb) = w;
            }
            __syncthreads();
        }
    }
}

__device__ __forceinline__ void sample_attn_unit(Frame& F, int unit, bool tail) {
    const int b = unit >> 2, h = unit & 3, lane = F.lane, wave = F.wave, r16 = lane & 15, kq = lane >> 4;
    const float* Kb = IN(3) + ((size_t)b * NMEM * XH + h) * XD;
    const float* Vb = IN(4) + ((size_t)b * NMEM * XH + h) * XD;
    const bf16_t* Qb = WSP(bf16_t, WS_Q) + (size_t)(MP + b * 8) * DM + h * XD;
    LAS bf16_t* sP = (LAS bf16_t*)F.lds;
    LAS float* sSt = (LAS float*)(F.lds + 16 * 528);
    LAS bf16_t* sQ = (LAS bf16_t*)(F.lds + 9472);
    if (tail) {
        const int t = F.tid >> 6, d0 = (F.tid & 63) * 8;
        const float* pp = WSP(float, WS_PART) + (size_t)(b * 8 + t) * DM + h * XD + d0;
        f32x4 a0 = {0.f, 0.f, 0.f, 0.f}, a1 = {0.f, 0.f, 0.f, 0.f};
#pragma unroll
        for (int s = 0; s < 8; ++s) { a0 = a0 + *(const f32x4*)(pp + (size_t)s * (MS * DM)); a1 = a1 + *(const f32x4*)(pp + (size_t)s * (MS * DM) + 4); }
        a0 = a0 * QSCALE; a1 = a1 * QSCALE;
        *(LAS bf16x8*)(sQ + t * 520 + d0) = pack8(a0, a1);
        __syncthreads();
    }
    f32x4 s0 = {0.f, 0.f, 0.f, 0.f}, s1 = {0.f, 0.f, 0.f, 0.f};
    const float* k0p = Kb + (size_t)(32 * wave + r16) * (XH * XD) + kq * 8;
    const float* k1p = k0p + (size_t)16 * (XH * XD);
    const bf16_t* qp = Qb + (size_t)(r16 & 7) * DM + kq * 8;
#pragma unroll 4
    for (int ds = 0; ds < 16; ++ds) {
        const f32x4 a0 = *(const f32x4*)(k0p + ds * 32), a1 = *(const f32x4*)(k0p + ds * 32 + 4);
        const f32x4 c0 = *(const f32x4*)(k1p + ds * 32), c1 = *(const f32x4*)(k1p + ds * 32 + 4);
        u32x4 qw = tail ? *(const LAS u32x4*)(sQ + (r16 & 7) * 520 + kq * 8 + ds * 32) : *(const u32x4*)(qp + ds * 32); if (r16 >= 8) qw = (u32x4){0u, 0u, 0u, 0u};
        const bf16x8 qf = __builtin_bit_cast(bf16x8, qw);
        s0 = __builtin_amdgcn_mfma_f32_16x16x32_bf16(pack8(a0, a1), qf, s0, 0, 0, 0);
        s1 = __builtin_amdgcn_mfma_f32_16x16x32_bf16(pack8(c0, c1), qf, s1, 0, 0, 0);
    }
    float mx = fmaxf(fmaxf(fmaxf(s0[0], s0[1]), fmaxf(s0[2], s0[3])), fmaxf(fmaxf(s1[0], s1[1]), fmaxf(s1[2], s1[3])));
    mx = fmaxf(mx, __shfl_xor(mx, 16)); mx = fmaxf(mx, __shfl_xor(mx, 32));
    float sm = 0.f;
#pragma unroll
    for (int j = 0; j < 4; ++j) { s0[j] = __expf(s0[j] - mx); s1[j] = __expf(s1[j] - mx); sm += s0[j] + s1[j]; }
    sm += __shfl_xor(sm, 16); sm += __shfl_xor(sm, 32);
    if (kq == 0) { sSt[(wave * 16 + r16) * 2] = mx; sSt[(wave * 16 + r16) * 2 + 1] = sm; }
    __syncthreads();
    float M = -3.0e38f;
#pragma unroll
    for (int w2 = 0; w2 < 8; ++w2) M = fmaxf(M, sSt[(w2 * 16 + r16) * 2]);
    float L = 0.f;
#pragma unroll
    for (int w2 = 0; w2 < 8; ++w2) L += sSt[(w2 * 16 + r16) * 2 + 1] * __expf(sSt[(w2 * 16 + r16) * 2] - M);
    const float f = __expf(mx - M) / L;
    { u32x2 w; w.x = cvt_pk_bf16(s0[0] * f, s0[1] * f); w.y = cvt_pk_bf16(s0[2] * f, s0[3] * f); *(LAS u32x2*)(sP + r16 * 264 + 32 * wave + 4 * kq) = w;
      w.x = cvt_pk_bf16(s1[0] * f, s1[1] * f); w.y = cvt_pk_bf16(s1[2] * f, s1[3] * f); *(LAS u32x2*)(sP + r16 * 264 + 32 * wave + 16 + 4 * kq) = w; }
    __syncthreads();
    f32x4 o[4];
#pragma unroll
    for (int c = 0; c < 4; ++c) o[c] = (f32x4){0.f, 0.f, 0.f, 0.f};
    const float* vp = Vb + (size_t)(kq * 8) * (XH * XD) + 64 * wave + 4 * r16;
#pragma unroll 2
    for (int ms = 0; ms < 8; ++ms) {
        const bf16x8 pf = *(const LAS bf16x8*)(sP + r16 * 264 + ms * 32 + kq * 8);
        f32x4 x[8];
#pragma unroll
        for (int j = 0; j < 8; ++j) x[j] = *(const f32x4*)(vp + (size_t)(ms * 32 + j) * (XH * XD));
#pragma unroll
        for (int c = 0; c < 4; ++c) {
            const bf16x8 a = pack8((f32x4){x[0][c], x[1][c], x[2][c], x[3][c]}, (f32x4){x[4][c], x[5][c], x[6][c], x[7][c]});
            o[c] = __builtin_amdgcn_mfma_f32_16x16x32_bf16(a, pf, o[c], 0, 0, 0);
        }
    }
    if (r16 < 8) {
        bf16_t* op = WSP(bf16_t, WS_O) + (size_t)(MP + b * 8 + r16) * DM + h * XD + 64 * wave + 16 * kq;
        u32x4 w0, w1;
        w0.x = cvt_pk_bf16(o[0][0], o[1][0]); w0.y = cvt_pk_bf16(o[2][0], o[3][0]); w0.z = cvt_pk_bf16(o[0][1], o[1][1]); w0.w = cvt_pk_bf16(o[2][1], o[3][1]);
        w1.x = cvt_pk_bf16(o[0][2], o[1][2]); w1.y = cvt_pk_bf16(o[2][2], o[3][2]); w1.z = cvt_pk_bf16(o[0][3], o[1][3]); w1.w = cvt_pk_bf16(o[2][3], o[3][3]);
        *(u32x4*)op = w0; *(u32x4*)(op + 8) = w1;
    }
    __syncthreads();
}

template <bool OUT_F32> __device__ __forceinline__ void phase_rms(Frame& F, const float* src, const float* g, void* dst, const float* part, const float* sbase, float* hout) {
    const int gw = F.bx * NWAVES + F.wave, NGW = F.G * NWAVES, lane = F.lane;
    for (int m = gw; m < MT; m += NGW) {
        void* orow = OUT_F32 ? (void*)((float*)dst + (size_t)m * DM) : (void*)((bf16_t*)dst + (size_t)m * DM);
        if (m < MP || part == nullptr) { rms_row<OUT_F32>(src + (size_t)m * DM, g, orow, lane); continue; }
        const int ms = m - MP;
        const f32x4* xr = (const f32x4*)(sbase + (size_t)ms * DM) + lane; f32x4 v[8]; float ss = 0.f;
#pragma unroll
        for (int j = 0; j < 8; ++j) v[j] = xr[64 * j];
#pragma unroll
        for (int s = 0; s < 8; ++s) { const f32x4* pr = (const f32x4*)(part + (size_t)s * (MS * DM) + (size_t)ms * DM) + lane;
#pragma unroll
            for (int j = 0; j < 8; ++j) v[j] = v[j] + pr[64 * j]; }
#pragma unroll
        for (int j = 0; j < 8; ++j) { ss += (v[j].x * v[j].x + v[j].y * v[j].y) + (v[j].z * v[j].z + v[j].w * v[j].w); if (hout) ((f32x4*)(hout + (size_t)ms * DM))[lane + 64 * j] = v[j]; }
        const float r = rsqrtf(wave_sum(ss) * (1.f / DM) + EPS);
        const f32x4* gr = (const f32x4*)g + lane;
#pragma unroll
        for (int j = 0; j < 8; ++j) { const f32x4 gg = gr[64 * j]; const f32x4 o = v[j] * r * gg;
            if (OUT_F32) ((f32x4*)orow)[lane + 64 * j] = o;
            else { u32x2 w; w.x = cvt_pk_bf16(o.x, o.y); w.y = cvt_pk_bf16(o.z, o.w); ((u32x2*)orow)[lane + 64 * j] = w; } }
    }
}

__global__ void __launch_bounds__(NWAVES * 64, 2) fwd_megakernel(Args args) {
    extern __shared__ __attribute__((aligned(16))) unsigned char lds_raw[];
    cg::grid_group grid = cg::this_grid();
    Frame F;
    F.lds = (LAS unsigned char*)lds_raw;
    F.tid = threadIdx.x; F.lane = F.tid & 63; F.wave = __builtin_amdgcn_readfirstlane(F.tid >> 6);
    F.G = gridDim.x; F.bx = blockIdx.x;
    F.out = args.out; F.ws = args.ws;
    volatile LAS unsigned* MISC = (volatile LAS unsigned*)(F.lds + 131072 + 320);
    if (F.tid < 32) MISC[F.tid] = 0u;
    __syncthreads();
    XcdBarrier xbar = xcd_barrier_post((unsigned*)(F.ws + WS_CTL) + 4096, MISC + 8);
#define SEAM0() do { grid.sync(); int t_ = threadIdx.x; asm volatile("" : "+v"(t_)); F.tid = t_; F.lane = t_ & 63; } while (0)
#define SEAM() do { xcd_barrier(xbar); int t_ = threadIdx.x; asm volatile("" : "+v"(t_)); F.tid = t_; F.lane = t_ & 63; } while (0)
#ifndef PHASE_MASK
#define PHASE_MASK 0xffffffffu
#endif
#define PH(k) ((PHASE_MASK >> (k)) & 1u)
    using namespace pg8;
    const char* XN = (const char*)(F.ws + WS_XN);
    const bool tail = (F.G == 256);

    if (PH(0)) phase_prologue(F);
    SEAM0();
    if (PH(1)) {
        SchedIn S{XN, (const char*)(F.ws + WS_WIN), F.G, F.bx};
        EpiIn E{WSP(bf16_t, WS_P1), F.out + O_MK, F.out + O_MV, WSP(bf16_t, WS_KP), WSP(bf16_t, WS_VPT)};
        gemm_phase<EpiIn, SchedIn, true>(F.lds, DM, DM, S, E);
    }
    SEAM();
    if (PH(2)) phase_mixprep(F);
    SEAM();
    if (PH(3)) {
        SchedSp S{(const char*)(F.ws + WS_WSP), (const char*)(F.ws + WS_VT), F.G, F.bx};
        EpiSp E{WSP(bf16_t, WS_P1), IN(11), WSP(bf16_t, WS_YA)};
        gemm_phase<EpiSp, SchedSp, true>(F.lds, 128, 128, S, E);
    }
    SEAM();
    if (PH(4)) {
        SchedRect S{(const char*)(F.ws + WS_YA), (const char*)(F.ws + WS_WA), (size_t)BM * 1024 * 2, (size_t)BM * 1024 * 2, 36, 8, F.G, F.bx, 16};
        EpiGA E{WSP(bf16_t, WS_P1), WSP(float, WS_TMP)};
        gemm_phase<EpiGA, SchedRect, true>(F.lds, 1024, 1024, S, E);
    }
    SEAM();
    if (PH(5)) {
        SchedRect S{(const char*)(F.ws + WS_YB), (const char*)(F.ws + WS_WB), (size_t)BM * 1024 * 2, (size_t)BM * 1024 * 2, 36, 8, F.G, F.bx, 16};
        EpiGB E{WSP(bf16_t, WS_P1), WSP(float, WS_TMP), WSP(bf16_t, WS_MRG)};
        gemm_phase<EpiGB, SchedRect, true>(F.lds, 1024, 1024, S, E);
    }
    SEAM();
    if (PH(6)) {
        SchedTail S{(const char*)(F.ws + WS_MRG), (const char*)(F.ws + WS_WMIX), (size_t)BM * DM * 2, (size_t)BM * DM * 2, 32, F.G, F.bx, tail};
        EpiTail<EpiRes> E{{IN(0), IN(1), MP, WSP(float, WS_H1)}, WSP(float, WS_PART)};
        gemm_phase<EpiTail<EpiRes>, SchedTail, true>(F.lds, DM, DM, S, E);
    }
    SEAM();
    phase_rms<false>(F, WSP(float, WS_H1), IN(16), WSP(bf16_t, WS_XN), tail ? WSP(float, WS_PART) : nullptr, IN(1), WSP(float, WS_H1) + (size_t)MP * DM);
    SEAM();
    if (PH(7)) {
        SchedTail S{XN, (const char*)(F.ws + WS_WQ), (size_t)BM * DM * 2, (size_t)BM * DM * 2, 32, F.G, F.bx, tail};
        EpiTail<EpiBf<0>> E{{WSP(bf16_t, WS_Q), DM, QSCALE}, WSP(float, WS_PART)};
        gemm_phase<EpiTail<EpiBf<0>>, SchedTail, true>(F.lds, DM, DM, S, E);
    }
    SEAM();
    if (PH(8)) {
        SchedS S{(const char*)(F.ws + WS_Q), (const char*)(F.ws + WS_KP), F.G, F.bx};
        EpiSoftmax E{WSP(bf16_t, WS_PS)};
        gemm_phase<EpiSoftmax, SchedS, false>(F.lds, DM, DM, S, E);
        __syncthreads();
        for (int un = F.bx; un < 512; un += F.G) sample_attn_unit(F, un, tail);
    }
    SEAM();
    if (PH(9)) {
        SchedO S{(const char*)(F.ws + WS_PS), (const char*)(F.ws + WS_VPT), F.G, F.bx};
        EpiBf<0> E{WSP(bf16_t, WS_O), DM, 1.0f};
        gemm_phase<EpiBf<0>, SchedO, true>(F.lds, 256, 256, S, E);
    }
    SEAM();
    if (PH(10)) {
        SchedTail S{(const char*)(F.ws + WS_O), (const char*)(F.ws + WS_WXO), (size_t)BM * DM * 2, (size_t)BM * DM * 2, 32, F.G, F.bx, tail};
        EpiTail<EpiRes> E{{WSP(float, WS_H1), WSP(float, WS_H1), 1 << 30, WSP(float, WS_H2)}, WSP(float, WS_PART)};
        gemm_phase<EpiTail<EpiRes>, SchedTail, true>(F.lds, DM, DM, S, E);
    }
    SEAM();
    phase_rms<false>(F, WSP(float, WS_H2), IN(22), WSP(bf16_t, WS_XN), tail ? WSP(float, WS_PART) : nullptr, WSP(float, WS_H1) + (size_t)MP * DM, WSP(float, WS_H2) + (size_t)MP * DM);
    SEAM();
    if (PH(11)) {
        SchedRect S{XN, (const char*)(F.ws + WS_WUP), (size_t)BM * DM * 2, (size_t)BM * DM * 2, 36, 32, F.G, F.bx, 32};
        EpiBf<1> E{WSP(bf16_t, WS_UP), FF, 1.0f};
        gemm_phase<EpiBf<1>, SchedRect, true>(F.lds, DM, DM, S, E);
    }
    SEAM();
    if (PH(12)) {
        SchedTail S{(const char*)(F.ws + WS_UP), (const char*)(F.ws + WS_WDN), (size_t)BM * FF * 2, (size_t)BM * FF * 2, 128, F.G, F.bx, tail};
        EpiTail<EpiRes> E{{WSP(float, WS_H2), WSP(float, WS_H2), 1 << 30, WSP(float, WS_H2)}, WSP(float, WS_PART)};
        gemm_phase<EpiTail<EpiRes>, SchedTail, true>(F.lds, FF, FF, S, E);
    }
    SEAM();
    phase_rms<true>(F, WSP(float, WS_H2), IN(25), F.out + O_Y, tail ? WSP(float, WS_PART) : nullptr, WSP(float, WS_H2) + (size_t)MP * DM, nullptr);
}

extern "C" void kernel_launch(void* const* d_in, const int* in_sizes, int n_in, void* d_out, int out_size, void* d_ws, size_t ws_size, hipStream_t stream) {
    static int grid = 0;
    if (grid == 0) {
        if (n_in != 26 || ws_size < WS_END) { fprintf(stderr, "kernel_launch: unexpected n_in %d / ws_size %zu\n", n_in, ws_size); grid = -1; return; }
        int dev = 0, cus = 0, per_cu = 0;
        hipGetDevice(&dev);
        hipDeviceGetAttribute(&cus, hipDeviceAttributeMultiprocessorCount, dev);
        if (hipFuncSetAttribute((const void*)fwd_megakernel, hipFuncAttributeMaxDynamicSharedMemorySize, LDS_BYTES) != hipSuccess) { fprintf(stderr, "kernel_launch: hipFuncSetAttribute failed\n"); grid = -1; return; }
        if (hipOccupancyMaxActiveBlocksPerMultiprocessor(&per_cu, (const void*)fwd_megakernel, NWAVES * 64, LDS_BYTES) != hipSuccess || per_cu < 1) { fprintf(stderr, "kernel_launch: occupancy query says %d\n", per_cu); per_cu = 1; }
        (void)hipGetLastError();
        grid = cus;
        if (grid < 128) { fprintf(stderr, "kernel_launch: needs >= 128 CUs\n"); grid = -1; return; }
    }
    if (grid < 0) return;
    if (hipMemsetAsync((char*)d_ws + WS_CTL, 0, 65536, stream) != hipSuccess) { fprintf(stderr, "kernel_launch: memset failed\n"); return; }
    Args a{};
    for (int i = 0; i < 26; ++i) a.in[i] = (const float*)d_in[i];
    a.out = (float*)d_out; a.ws = (unsigned char*)d_ws;
    void* kargs[] = {&a};
    hipError_t e = hipLaunchCooperativeKernel((const void*)fwd_megakernel, dim3(grid), dim3(NWAVES * 64), kargs, LDS_BYTES, stream);
    if (e != hipSuccess) fprintf(stderr, "kernel_launch: cooperative launch failed: %s (grid %d)\n", hipGetErrorString(e), grid);
}
```

```cpp
#include <hip/hip_runtime.h>
#include <hip/hip_cooperative_groups.h>
#include <cstdio>
#include <cstdint>
namespace cg = cooperative_groups;

#define LAS __attribute__((address_space(3)))
typedef unsigned short bf16_t;
typedef short bf16x8 __attribute__((ext_vector_type(8)));
typedef float f32x4 __attribute__((ext_vector_type(4)));
typedef float f32x2 __attribute__((ext_vector_type(2)));
typedef unsigned u32x4 __attribute__((ext_vector_type(4)));
typedef unsigned u32x2 __attribute__((ext_vector_type(2)));

constexpr int DM = 2048, MP = 8192, MS = 1024, MT = MP + MS  ;
constexpr int NIN = 9216, FF = 8192, NMEM = 256, XH = 4, XD = 512;
constexpr int C_U = 0, C_V = 1024, C_BG = 2048, C_CG = 3072, C_XIN = 4096, C_GA = 5120, C_GB = 7168;
constexpr float EPS = 1e-6f, QSCALE = 0.04419417382415922f  ;
constexpr size_t O_Y = 0, O_MK = 18874368, O_MV = 20971520, O_CP = 23068672, O_CS = 23076864, O_CV = 23339008;
constexpr size_t MiB = 1u << 20;
constexpr size_t WS_CTL = 0, CTL_BYTES = 1 * MiB;
constexpr size_t WS_WIN = 2 * MiB;
constexpr size_t WS_WA = 54 * MiB, WS_WB = 58 * MiB;
constexpr size_t WS_WMIX = 62 * MiB, WS_WQ = 70 * MiB, WS_WXO = 78 * MiB;
constexpr size_t WS_WUP = 86 * MiB;
constexpr size_t WS_WDN = 118 * MiB;
constexpr size_t WS_WSP = 150 * MiB;
constexpr size_t WS_XN = 152 * MiB;
constexpr size_t WS_P1 = 192 * MiB;
constexpr size_t WS_UP = 192 * MiB;
constexpr size_t WS_VT = 354 * MiB;
constexpr size_t WS_YA = 370 * MiB, WS_YB = 388 * MiB;
constexpr size_t WS_TMP = 406 * MiB;
constexpr size_t WS_PART = 406 * MiB;
constexpr size_t WS_MRG = 478 * MiB;
constexpr size_t WS_H1 = 514 * MiB;
constexpr size_t WS_Q = 586 * MiB;
constexpr size_t WS_KP = 622 * MiB;
constexpr size_t WS_VPT = 626 * MiB;
constexpr size_t WS_PS = 630 * MiB;
constexpr size_t WS_O = 646 * MiB;
constexpr size_t WS_H2 = 682 * MiB;
constexpr size_t WS_END = 754 * MiB;

constexpr int LDS_BYTES = 147456;
constexpr int NWAVES = 8;

__device__ __forceinline__ unsigned cvt_pk_bf16(float lo, float hi) { unsigned r; asm volatile("v_cvt_pk_bf16_f32 %0, %1, %2" : "=v"(r) : "v"(lo), "v"(hi)); return r; }
__device__ __forceinline__ float bf_lo(unsigned u) { return __uint_as_float(u << 16); }
__device__ __forceinline__ float bf_hi(unsigned u) { return __uint_as_float(u & 0xffff0000u); }
__device__ __forceinline__ float bf1(bf16_t h) { return __uint_as_float(((unsigned)h) << 16); }
__device__ __forceinline__ bf16x8 pack8(f32x4 a, f32x4 b) {
    u32x4 w; w.x = cvt_pk_bf16(a.x, a.y); w.y = cvt_pk_bf16(a.z, a.w); w.z = cvt_pk_bf16(b.x, b.y); w.w = cvt_pk_bf16(b.z, b.w);
    return __builtin_bit_cast(bf16x8, w);
}
__device__ __forceinline__ void unpack8(u32x4 w, float (&f)[8]) {
    f[0] = bf_lo(w.x); f[1] = bf_hi(w.x); f[2] = bf_lo(w.y); f[3] = bf_hi(w.y); f[4] = bf_lo(w.z); f[5] = bf_hi(w.z); f[6] = bf_lo(w.w); f[7] = bf_hi(w.w);
}
__device__ __forceinline__ float wave_sum(float v) {
#pragma unroll
    for (int o = 1; o < 64; o <<= 1) v += __shfl_xor(v, o);
    return v;
}
__device__ __forceinline__ float sigmoidf_(float x) { return __builtin_amdgcn_rcpf(1.0f + __expf(-x)); }
#define LDS_WAIT() asm volatile("s_waitcnt lgkmcnt(0)" ::: "memory")

namespace pg8 {
constexpr int BM = 256, BK = 64, HALF = 128, HTB = HALF * BK * 2, STAGE_BYTES = 8 * HTB, NXCD = 8, WGM = 8;
__host__ __device__ __forceinline__ int lds_byte(int r, int c) { const int st = (r >> 4) * 2 + (c >> 5), rr = r & 15, cc = c & 31, ob = rr * 64 + cc * 2; return st * 1024 + (ob ^ (((ob >> 9) & 1) << 5)); }
__host__ __device__ __forceinline__ void stage_rc(int b, int& R, int& C) { const int st = b / 1024, sb = b % 1024, swz = sb ^ (((sb >> 9) & 1) << 5); R = (st >> 1) * 16 + swz / 64; C = (st & 1) * 32 + (swz % 64) / 2; }
__host__ __device__ __forceinline__ int perm32(int rho) { const int n = rho >> 4, i = rho & 15; return 8 * (i >> 2) + 4 * n + (i & 3); }

struct Unit { const char* A; const char* B; int orow, ocol, aux, nkt; };

__device__ __forceinline__ void rect_order(int L, int nM, int nN, int& pm, int& pn) {
    const int nwg = nM * nN; int wgid = L;
    { const int q = nwg / NXCD, r = nwg % NXCD, xcd = wgid % NXCD, off = wgid / NXCD; wgid = (xcd < r ? xcd * (q + 1) : r * (q + 1) + (xcd - r) * q) + off; }
    const int nig = WGM * nN, gid = wgid / nig, fm = gid * WGM, gsz = (nM - fm) < WGM ? (nM - fm) : WGM;
    pm = fm + ((wgid % nig) % gsz); pn = (wgid % nig) / gsz;
}

template <class Epi, class Sched, bool ALIGN_EPI>
__device__ __forceinline__ void gemm_phase(LAS unsigned char* lds, const int lda, const int ldb, const Sched& S, const Epi& E) {
    int tid_ = threadIdx.x; asm volatile("" : "+v"(tid_));
    const int tid = tid_, wid = __builtin_amdgcn_readfirstlane(tid >> 6), lane = tid & 63, wr = wid >> 2, wc = wid & 3, fr = lane & 15, fq = lane >> 4;
    unsigned voffA[2], voffB[2];
#pragma unroll
    for (int i = 0; i < 2; ++i) { int R, C; stage_rc(tid * 16 + i * 8192, R, C); const int Rb = Epi::PERM ? ((R & ~31) + perm32(R & 31)) : R;
        voffA[i] = (unsigned)(R * lda + C) * 2u; voffB[i] = (unsigned)(Rb * ldb + C) * 2u; }
    const size_t kstep = (size_t)(BK * 2);
    const size_t hstepA = (size_t)HALF * lda * 2, hstepB = (size_t)HALF * ldb * 2;
    const unsigned ldsw = (unsigned)wid * 1024u;
    const int aoff = lds_byte(wr * 64 + fr, fq * 8), boff = lds_byte(wc * 32 + fr, fq * 8);
#define PG8_SA(b, h) (((b) * 2 + (h)) * HTB)
#define PG8_SB(b, h) ((4 + (b) * 2 + (h)) * HTB)
#define PG8_STAGE(bufoff, gbase, voff) do { _Pragma("unroll") for (int _i = 0; _i < 2; ++_i) \
        __builtin_amdgcn_global_load_lds((const unsigned*)((const char*)(gbase) + (voff)[_i]), (LAS unsigned*)(lds + (bufoff) + ldsw + _i * 8192), 16, 0, 0); } while (0)
#define PG8_LDA(dst, b, h) do { _Pragma("unroll") for (int m = 0; m < 4; ++m) _Pragma("unroll") for (int k = 0; k < 2; ++k) dst[m][k] = *(const LAS bf16x8*)(lds + PG8_SA(b, h) + aoff + m * 2048 + k * 1024); } while (0)
#define PG8_LDB(dst, b, h) do { _Pragma("unroll") for (int n = 0; n < 2; ++n) _Pragma("unroll") for (int k = 0; k < 2; ++k) dst[n][k] = *(const LAS bf16x8*)(lds + PG8_SB(b, h) + boff + n * 2048 + k * 1024); } while (0)
#define PG8_MMA(ai, bj, At, Bt) do { __builtin_amdgcn_s_setprio(1); _Pragma("unroll") for (int m = 0; m < 4; ++m) _Pragma("unroll") for (int n = 0; n < 2; ++n) _Pragma("unroll") for (int k = 0; k < 2; ++k) \
        acc[ai][bj][m][n] = __builtin_amdgcn_mfma_f32_16x16x32_bf16(Bt[n][k], At[m][k], acc[ai][bj][m][n], 0, 0, 0); __builtin_amdgcn_s_setprio(0); } while (0)
#define PG8_WAIT_V(n) asm volatile("s_waitcnt vmcnt(" #n ")" ::: "memory")
#define PG8_WAIT_L(n) asm volatile("s_waitcnt lgkmcnt(" #n ")" ::: "memory")
#define PG8_BAR __builtin_amdgcn_s_barrier()
#define PG8_SCHED __builtin_amdgcn_sched_barrier(0)
    Unit cur, nxt; int ui = 0;
    if (!S.next(0, cur)) return;
    f32x4 acc[2][2][4][2];
#pragma unroll
    for (int a = 0; a < 2; ++a)
#pragma unroll
        for (int b = 0; b < 2; ++b)
#pragma unroll
            for (int m = 0; m < 4; ++m)
#pragma unroll
                for (int n = 0; n < 2; ++n) acc[a][b][m][n] = (f32x4){0.f, 0.f, 0.f, 0.f};
    bf16x8 At[4][2], B0[2][2], B1[2][2];
    const char* cA = cur.A; const char* cB = cur.B;
    PG8_STAGE(PG8_SB(0, 0), cB, voffB); PG8_STAGE(PG8_SB(0, 1), cB + hstepB, voffB); PG8_STAGE(PG8_SA(0, 0), cA, voffA); PG8_STAGE(PG8_SA(0, 1), cA + hstepA, voffA);
    if (wr == 1) PG8_BAR;
    PG8_WAIT_V(2); PG8_BAR;
    PG8_STAGE(PG8_SB(1, 0), cB + kstep, voffB); PG8_STAGE(PG8_SA(1, 0), cA + kstep, voffA); PG8_STAGE(PG8_SB(1, 1), cB + hstepB + kstep, voffB);
    PG8_WAIT_V(6); PG8_BAR;
    for (;;) {
        const bool has_next = S.next(ui + 1, nxt);
        int nt = cur.nkt; asm volatile("" : "+s"(nt));
        const char* nA = has_next ? nxt.A : cA; const char* nB = has_next ? nxt.B : cB;
        for (int t = 0; t < nt; t += 2) {
            const bool last = (t == nt - 2);
            const char* a1 = cA + (size_t)(t + 1) * kstep;
            const char* a2 = last ? nA : cA + (size_t)(t + 2) * kstep; const char* b2 = last ? nB : cB + (size_t)(t + 2) * kstep;
            const char* a3 = a2 + kstep; const char* b3 = b2 + kstep;
            if constexpr (Epi::MIDK) { if (t == (nt >> 1)) E.mid(acc, cur, wr, wc, fr, fq); }
            PG8_LDB(B0, 0, 0); PG8_LDB(B1, 0, 1); PG8_SCHED; PG8_LDA(At, 0, 0); PG8_STAGE(PG8_SA(1, 1), a1 + hstepA, voffA);
            PG8_WAIT_V(8); PG8_WAIT_L(0); PG8_BAR; PG8_MMA(0, 0, At, B0); PG8_MMA(0, 1, At, B1); PG8_BAR; PG8_SCHED;
            PG8_LDA(At, 0, 1); PG8_STAGE(PG8_SB(0, 0), b2, voffB); PG8_STAGE(PG8_SB(0, 1), b2 + hstepB, voffB); PG8_STAGE(PG8_SA(0, 0), a2, voffA);
            PG8_WAIT_V(8); PG8_WAIT_L(0); PG8_BAR; PG8_MMA(1, 0, At, B0); PG8_MMA(1, 1, At, B1); PG8_BAR; PG8_SCHED;
            PG8_LDB(B0, 1, 0); PG8_LDB(B1, 1, 1); PG8_SCHED; PG8_LDA(At, 1, 0); PG8_STAGE(PG8_SA(0, 1), a2 + hstepA, voffA);
            PG8_WAIT_V(8); PG8_WAIT_L(0); PG8_BAR; PG8_MMA(0, 0, At, B0); PG8_MMA(0, 1, At, B1); PG8_BAR; PG8_SCHED;
            PG8_LDA(At, 1, 1); PG8_STAGE(PG8_SB(1, 0), b3, voffB); PG8_STAGE(PG8_SB(1, 1), b3 + hstepB, voffB); PG8_STAGE(PG8_SA(1, 0), a3, voffA);
            PG8_WAIT_V(8); PG8_WAIT_L(0); PG8_BAR; PG8_MMA(1, 0, At, B0); PG8_MMA(1, 1, At, B1); PG8_BAR; PG8_SCHED;
        }
        if constexpr (ALIGN_EPI) { if (wr == 0) PG8_BAR; }
        if constexpr (!Epi::AFTER_DRAIN) { E(acc, cur, wr, wc, fr, fq); }
        if (!has_next) break;
#pragma unroll
        for (int a = 0; a < 2; ++a)
#pragma unroll
            for (int b = 0; b < 2; ++b)
#pragma unroll
                for (int m = 0; m < 4; ++m)
#pragma unroll
                    for (int n = 0; n < 2; ++n) acc[a][b][m][n] = (f32x4){0.f, 0.f, 0.f, 0.f};
        cur = nxt; cA = nA; cB = nB; ++ui;
        if constexpr (ALIGN_EPI) { if (wr == 1) PG8_BAR; }
    }
    PG8_WAIT_V(0);
    if constexpr (!ALIGN_EPI) { if (wr == 0) PG8_BAR; }
    PG8_BAR;
    if constexpr (Epi::AFTER_DRAIN) { E.fused(acc, cur, wr, wc, fr, fq, lds, wid, lane); }
#undef PG8_SA
#undef PG8_SB
#undef PG8_STAGE
#undef PG8_LDA
#undef PG8_LDB
#undef PG8_MMA
#undef PG8_WAIT_V
#undef PG8_WAIT_L
#undef PG8_BAR
#undef PG8_SCHED
}

struct SchedRect {
    const char* A; const char* B; size_t atile, btile; int nM, nN, G, c, NT;
    __device__ __forceinline__ bool next(int i, Unit& u) const {
        const int L = i * G + c; if (L >= nM * nN) return false;
        int pm, pn; rect_order(L, nM, nN, pm, pn);
        u.A = A + (size_t)pm * atile; u.B = B + (size_t)pn * btile; u.orow = pm * BM; u.ocol = pn * BM; u.aux = 0; u.nkt = NT; return true;
    }
};
struct SchedIn {
    const char* A; const char* B; int G, c;
    __device__ __forceinline__ bool next(int i, Unit& u) const {
        const int L = i * G + c; if (L >= 1296 + 64) return false;
        int pm, pn;
        if (L < 1296) { rect_order(L, 36, 36, pm, pn); u.orow = pm * BM; u.ocol = pn * BM; u.aux = 0; }
        else { const int l = L - 1296; pm = 36 + (l & 3); pn = 36 + (l >> 2); u.orow = (pm - 36) * BM; u.ocol = (pn - 36) * BM; u.aux = 1; }
        u.A = A + (size_t)pm * (BM * DM * 2); u.B = B + (size_t)pn * (BM * DM * 2); u.nkt = DM / BK; return true;
    }
};
struct SchedSp {
    const char* WSP; const char* VT; int G, c;
    __device__ __forceinline__ bool next(int i, Unit& u) const {
        const int L = i * G + c; if (L >= 256) return false;
        const int chunk = L >> 2, p = (L >> 1) & 1, gi = L & 1, g = 2 * p + gi;
        u.A = WSP + (size_t)p * (256 * 128 * 2); u.B = VT + ((size_t)chunk * 1024 + g * 256) * 128 * 2; u.orow = chunk * 128; u.ocol = g * 256; u.aux = gi; u.nkt = 2; return true;
    }
};
struct SchedS {
    const char* Q; const char* KP; int G, c;
    __device__ __forceinline__ bool next(int i, Unit& u) const {
        const int L = i * G + c; if (L >= 128 || i > 0) return false;
        const int b = L >> 5, h = (L >> 3) & 3, p = L & 7;
        u.A = Q + ((size_t)(b * 2048 + p * 256) * DM + h * XD) * 2; u.B = KP + ((size_t)(b * 256) * DM + h * XD) * 2;
        u.orow = (b * 4 + h) * 2048 + p * 256; u.ocol = 0; u.aux = 0; u.nkt = XD / BK; return true;
    }
};
struct SchedO {
    const char* PS; const char* VPT; int G, c;
    __device__ __forceinline__ bool next(int i, Unit& u) const {
        const int L = i * G + c; if (L >= 256) return false;
        const int b = L >> 6, h = (L >> 4) & 3, p = (L >> 1) & 7, pn = L & 1;
        u.A = PS + ((size_t)((b * 4 + h) * 2048 + p * 256) * 256) * 2; u.B = VPT + ((size_t)(b * 2048 + h * XD + pn * 256) * 256) * 2;
        u.orow = b * 2048 + p * 256; u.ocol = h * XD + pn * 256; u.aux = 0; u.nkt = 4; return true;
    }
};


struct SchedTail {
    const char* A; const char* B; size_t atile, btile; int NT, G, c; bool tail;
    __device__ __forceinline__ bool next(int i, Unit& u) const {
        if (!tail) { const int L = i * G + c; if (L >= 288) return false; int pm, pn; rect_order(L, 36, 8, pm, pn);
            u.A = A + (size_t)pm * atile; u.B = B + (size_t)pn * btile; u.orow = pm * BM; u.ocol = pn * BM; u.aux = 0; u.nkt = NT; return true; }
        const int vcu = (c & 7) * 32 + (c >> 3);
        if (i == 0) { const int pm = vcu >> 3, pn = vcu & 7; u.A = A + (size_t)pm * atile; u.B = B + (size_t)pn * btile; u.orow = pm * BM; u.ocol = pn * BM; u.aux = 0; u.nkt = NT; return true; }
        if (i == 1) { const int t = vcu >> 3, s = vcu & 7, pm = 32 + (t >> 3), pn = t & 7, nk = NT >> 3;
            u.A = A + (size_t)pm * atile + (size_t)(s * nk) * (BK * 2); u.B = B + (size_t)pn * btile + (size_t)(s * nk) * (BK * 2);
            u.orow = (t >> 3) * BM; u.ocol = pn * BM; u.aux = 1 + s; u.nkt = nk; return true; }
        return false;
    }
};
#define EPI_ROWS_BEGIN _Pragma("unroll") for (int ai = 0; ai < 2; ++ai) _Pragma("unroll") for (int m = 0; m < 4; ++m) { const int rl = ai * HALF + wr * 64 + m * 16 + fr;
#define EPI_ROWS_END }

struct EpiIn {
    static constexpr bool PERM = true, AFTER_DRAIN = false, MIDK = false;
    bf16_t* P1; float* memk; float* memv; bf16_t* KP; bf16_t* VPT;
    __device__ __forceinline__ void operator()(const f32x4 (&acc)[2][2][4][2], const Unit& u, int wr, int wc, int fr, int fq) const {
        const int cl0 = wc * 32 + 8 * fq;
        if (u.aux == 0) {
            const bool gate = u.ocol >= C_GA;
            EPI_ROWS_BEGIN
                bf16_t* rowp = P1 + (size_t)(u.orow + rl) * NIN + u.ocol + cl0;
#pragma unroll
                for (int bj = 0; bj < 2; ++bj) { f32x4 v0 = acc[ai][bj][m][0], v1 = acc[ai][bj][m][1];
                    if (gate) {
                        const f32x4 g0 = acc[ai][1][m][0], g1 = acc[ai][1][m][1];
#pragma unroll
                        for (int e = 0; e < 4; ++e) { const float sb0 = sigmoidf_(g0[e]), sb1 = sigmoidf_(g1[e]);
                            if (bj == 0) { v0[e] = sigmoidf_(v0[e]) * __builtin_amdgcn_rcpf(fmaxf(sb0, 1e-30f)); v1[e] = sigmoidf_(v1[e]) * __builtin_amdgcn_rcpf(fmaxf(sb1, 1e-30f)); }
                            else { v0[e] = fmaxf(sb0, 1e-30f); v1[e] = fmaxf(sb1, 1e-30f); } } }
                    u32x4 w; w.x = cvt_pk_bf16(v0[0], v0[1]); w.y = cvt_pk_bf16(v0[2], v0[3]); w.z = cvt_pk_bf16(v1[0], v1[1]); w.w = cvt_pk_bf16(v1[2], v1[3]);
                    *(u32x4*)(rowp + bj * HALF) = w; }
            EPI_ROWS_END
        } else {
            const bool isV = u.ocol >= DM; const int cb = u.ocol - (isV ? DM : 0) + cl0;
            float* fo = isV ? memv : memk;
            EPI_ROWS_BEGIN
                const int row = u.orow + rl;
#pragma unroll
                for (int bj = 0; bj < 2; ++bj) { const f32x4 v0 = acc[ai][bj][m][0], v1 = acc[ai][bj][m][1]; const int col = cb + bj * HALF;
                    *(f32x4*)(fo + (size_t)row * DM + col) = v0; *(f32x4*)(fo + (size_t)row * DM + col + 4) = v1;
                    u32x4 w; w.x = cvt_pk_bf16(v0[0], v0[1]); w.y = cvt_pk_bf16(v0[2], v0[3]); w.z = cvt_pk_bf16(v1[0], v1[1]); w.w = cvt_pk_bf16(v1[2], v1[3]);
                    if (!isV) { *(u32x4*)(KP + (size_t)row * DM + col) = w; }
                    else { bf16_t* vp = VPT + ((size_t)(row >> 8) * DM + col) * 256 + (row & 255);
                        vp[0 * 256] = (bf16_t)(w.x & 0xffff); vp[1 * 256] = (bf16_t)(w.x >> 16); vp[2 * 256] = (bf16_t)(w.y & 0xffff); vp[3 * 256] = (bf16_t)(w.y >> 16);
                        vp[4 * 256] = (bf16_t)(w.z & 0xffff); vp[5 * 256] = (bf16_t)(w.z >> 16); vp[6 * 256] = (bf16_t)(w.w & 0xffff); vp[7 * 256] = (bf16_t)(w.w >> 16); } }
            EPI_ROWS_END
        }
    }
};
struct EpiSp {
    static constexpr bool PERM = true, AFTER_DRAIN = false, MIDK = false;
    const bf16_t* P1; const float* bsp; bf16_t* YA;
    __device__ __forceinline__ void operator()(const f32x4 (&acc)[2][2][4][2], const Unit& u, int wr, int wc, int fr, int fq) const {
        const int g = u.ocol >> 8, cl0 = wc * 32 + 8 * fq;
#pragma unroll
        for (int ai = 0; ai < 2; ++ai) if (ai == u.aux) {
#pragma unroll
            for (int m = 0; m < 4; ++m) { const int t = wr * 64 + m * 16 + fr; const int row = u.orow + t; const float bs = bsp[g * 128 + t];
#pragma unroll
                for (int bj = 0; bj < 2; ++bj) { const int col = u.ocol + bj * HALF + cl0;
                    const u32x4 uw = *(const u32x4*)(P1 + (size_t)row * NIN + C_U + col); float uf[8]; unpack8(uw, uf);
                    const f32x4 v0 = acc[ai][bj][m][0], v1 = acc[ai][bj][m][1];
                    u32x4 w; w.x = cvt_pk_bf16(uf[0] * (v0[0] + bs), uf[1] * (v0[1] + bs)); w.y = cvt_pk_bf16(uf[2] * (v0[2] + bs), uf[3] * (v0[3] + bs));
                    w.z = cvt_pk_bf16(uf[4] * (v1[0] + bs), uf[5] * (v1[1] + bs)); w.w = cvt_pk_bf16(uf[6] * (v1[2] + bs), uf[7] * (v1[3] + bs));
                    *(u32x4*)(YA + (size_t)row * DM + col) = w; } }
        }
    }
};
struct EpiMerged {
    static constexpr bool PERM = true, AFTER_DRAIN = false, MIDK = true;
    const bf16_t* P1; bf16_t* MRG;
    __device__ __forceinline__ void mid(f32x4 (&acc)[2][2][4][2], const Unit& u, int wr, int wc, int fr, int fq) const {
        asm volatile("" : "+v"(fr), "+v"(fq));
        const bf16_t* pb = P1 + (size_t)(u.orow + wr * 64 + fr) * NIN + C_GA + (u.ocol >> 7) * 256 + wc * 32 + 8 * fq;
#pragma unroll
        for (int ai = 0; ai < 2; ++ai) {
            u32x4 r[4][2];
#pragma unroll
            for (int m = 0; m < 4; ++m)
#pragma unroll
                for (int bj = 0; bj < 2; ++bj) r[m][bj] = *(const u32x4*)(pb + (size_t)(ai * HALF + m * 16) * NIN + bj * 256);
#pragma unroll
            for (int m = 0; m < 4; ++m)
#pragma unroll
                for (int bj = 0; bj < 2; ++bj) { float f[8]; unpack8(r[m][bj], f);
#pragma unroll
                    for (int e = 0; e < 4; ++e) { acc[ai][bj][m][0][e] *= f[e]; acc[ai][bj][m][1][e] *= f[4 + e]; } }
            asm volatile("" ::: "memory");
        }
    }
    __device__ __forceinline__ void operator()(const f32x4 (&acc)[2][2][4][2], const Unit& u, int wr, int wc, int fr, int fq) const {
        const int cl0 = wc * 32 + 8 * fq;
        const bf16_t* pb = P1 + (size_t)(u.orow + wr * 64 + fr) * NIN + C_GA + (u.ocol >> 7) * 256 + 128 + cl0;
        EPI_ROWS_BEGIN
            const int row = u.orow + rl;
#pragma unroll
            for (int bj = 0; bj < 2; ++bj) { const int col = u.ocol + bj * HALF + cl0;
                float sb[8]; unpack8(*(const u32x4*)(pb + (size_t)(ai * HALF + m * 16) * NIN + bj * 256), sb);
                const f32x4 v0 = acc[ai][bj][m][0], v1 = acc[ai][bj][m][1];
                u32x4 w; w.x = cvt_pk_bf16(v0[0] * sb[0], v0[1] * sb[1]); w.y = cvt_pk_bf16(v0[2] * sb[2], v0[3] * sb[3]); w.z = cvt_pk_bf16(v1[0] * sb[4], v1[1] * sb[5]); w.w = cvt_pk_bf16(v1[2] * sb[6], v1[3] * sb[7]);
                *(u32x4*)(MRG + (size_t)row * DM + col) = w; }
        EPI_ROWS_END
    }
};
struct EpiRes {
    static constexpr bool PERM = false, AFTER_DRAIN = false, MIDK = false;
    const float* resA; const float* resB; int split; float* out;
    __device__ __forceinline__ void operator()(const f32x4 (&acc)[2][2][4][2], const Unit& u, int wr, int wc, int fr, int fq) const {
        const float* rbase = (u.orow < split) ? resA + (size_t)u.orow * DM : resB + (size_t)(u.orow - split) * DM;
        float* obase = out + (size_t)u.orow * DM;
        EPI_ROWS_BEGIN
#pragma unroll
            for (int bj = 0; bj < 2; ++bj)
#pragma unroll
                for (int n = 0; n < 2; ++n) { const size_t off = (size_t)rl * DM + u.ocol + bj * HALF + wc * 32 + 16 * n + 4 * fq;
                    const f32x4 r = *(const f32x4*)(rbase + off); *(f32x4*)(obase + off) = r + acc[ai][bj][m][n]; }
        EPI_ROWS_END
    }
};
template <int MODE  > struct EpiBf {
    static constexpr bool PERM = true, AFTER_DRAIN = false, MIDK = false;
    bf16_t* O; int ldc; float scale;
    __device__ __forceinline__ void operator()(const f32x4 (&acc)[2][2][4][2], const Unit& u, int wr, int wc, int fr, int fq) const {
        const int cl0 = wc * 32 + 8 * fq;
        EPI_ROWS_BEGIN
            bf16_t* rowp = O + (size_t)(u.orow + rl) * ldc + u.ocol + cl0;
#pragma unroll
            for (int bj = 0; bj < 2; ++bj) { f32x4 v0 = acc[ai][bj][m][0], v1 = acc[ai][bj][m][1];
                if (MODE == 0) { v0 = v0 * scale; v1 = v1 * scale; }
                else {
#pragma unroll
                    for (int e = 0; e < 4; ++e) { const float a = fmaxf(v0[e], 0.f), b = fmaxf(v1[e], 0.f); v0[e] = a * a; v1[e] = b * b; } }
                u32x4 w; w.x = cvt_pk_bf16(v0[0], v0[1]); w.y = cvt_pk_bf16(v0[2], v0[3]); w.z = cvt_pk_bf16(v1[0], v1[1]); w.w = cvt_pk_bf16(v1[2], v1[3]);
                *(u32x4*)(rowp + bj * HALF) = w; }
        EPI_ROWS_END
    }
};
struct EpiSoftmax {
    static constexpr bool PERM = true, AFTER_DRAIN = true, MIDK = false;
    bf16_t* PS;
    __device__ __forceinline__ void fused(f32x4 (&acc)[2][2][4][2], const Unit& u, int wr, int wc, int fr, int fq, LAS unsigned char* lds, int wid, int lane) const {
        LAS f32x2* X = (LAS f32x2*)lds;
        float mxl[2][4];
        EPI_ROWS_BEGIN
            float mx = -3.0e38f;
#pragma unroll
            for (int bj = 0; bj < 2; ++bj)
#pragma unroll
                for (int n = 0; n < 2; ++n) { const f32x4 v = acc[ai][bj][m][n]; mx = fmaxf(mx, fmaxf(fmaxf(v[0], v[1]), fmaxf(v[2], v[3]))); }
            mx = fmaxf(mx, __shfl_xor(mx, 16)); mx = fmaxf(mx, __shfl_xor(mx, 32));
            float s = 0.f;
#pragma unroll
            for (int bj = 0; bj < 2; ++bj)
#pragma unroll
                for (int n = 0; n < 2; ++n) { f32x4 v = acc[ai][bj][m][n];
#pragma unroll
                    for (int e = 0; e < 4; ++e) { v[e] = __expf(v[e] - mx); s += v[e]; }
                    acc[ai][bj][m][n] = v; }
            s += __shfl_xor(s, 16); s += __shfl_xor(s, 32);
            mxl[ai][m] = mx;
            if (fq == 0) X[rl * 4 + wc] = (f32x2){mx, s};
        EPI_ROWS_END
        LDS_WAIT(); __builtin_amdgcn_s_barrier(); asm volatile("" ::: "memory");
        const int cl0 = wc * 32 + 8 * fq;
        EPI_ROWS_BEGIN
            const f32x2 a = X[rl * 4 + 0], b = X[rl * 4 + 1], c = X[rl * 4 + 2], d = X[rl * 4 + 3];
            const float M = fmaxf(fmaxf(a.x, b.x), fmaxf(c.x, d.x));
            const float L = a.y * __expf(a.x - M) + b.y * __expf(b.x - M) + c.y * __expf(c.x - M) + d.y * __expf(d.x - M);
            const float f = __expf(mxl[ai][m] - M) / L;
            bf16_t* rowp = PS + (size_t)(u.orow + rl) * 256 + cl0;
#pragma unroll
            for (int bj = 0; bj < 2; ++bj) { const f32x4 v0 = acc[ai][bj][m][0] * f, v1 = acc[ai][bj][m][1] * f;
                u32x4 w; w.x = cvt_pk_bf16(v0[0], v0[1]); w.y = cvt_pk_bf16(v0[2], v0[3]); w.z = cvt_pk_bf16(v1[0], v1[1]); w.w = cvt_pk_bf16(v1[2], v1[3]);
                *(u32x4*)(rowp + bj * HALF) = w; }
        EPI_ROWS_END
        LDS_WAIT(); __builtin_amdgcn_s_barrier(); asm volatile("" ::: "memory");
    }
};

template <class Base> struct EpiTail {
    static constexpr bool PERM = Base::PERM, AFTER_DRAIN = false, MIDK = false;
    Base base; float* part;
    __device__ __forceinline__ void operator()(const f32x4 (&acc)[2][2][4][2], const Unit& u, int wr, int wc, int fr, int fq) const {
        if (u.aux == 0) { base(acc, u, wr, wc, fr, fq); return; }
        float* pb = part + (size_t)(u.aux - 1) * (MS * DM) + (size_t)u.orow * DM + u.ocol;
        EPI_ROWS_BEGIN
#pragma unroll
            for (int bj = 0; bj < 2; ++bj)
#pragma unroll
                for (int n = 0; n < 2; ++n) { const int col = PERM ? (bj * HALF + wc * 32 + 8 * fq + 4 * n) : (bj * HALF + wc * 32 + 16 * n + 4 * fq);
                    *(f32x4*)(pb + (size_t)rl * DM + col) = acc[ai][bj][m][n]; }
        EPI_ROWS_END
    }
};
}


#define XB_TMO      128
#define XB_XCNT(j)  (256  + 64 * (j))
#define XB_XSUB(j)  (1280 + 64 * (j))
#define XB_XGEN(j)  (2304 + 64 * (j))
#define XB_TOP      3328
#define XB_TOPGEN   3392
#define XCD_BAR_WORDS 3456
#define XB_SPIN_CAP (1u << 18)
__device__ __forceinline__ unsigned xb_ld(unsigned* p)              { return __hip_atomic_load(p, __ATOMIC_RELAXED, __HIP_MEMORY_SCOPE_AGENT); }
__device__ __forceinline__ unsigned xb_add(unsigned* p, unsigned v) { return __hip_atomic_fetch_add(p, v, __ATOMIC_RELAXED, __HIP_MEMORY_SCOPE_AGENT); }
__device__ __forceinline__ unsigned xb_xcc_id() { return (unsigned)__builtin_amdgcn_s_getreg((3 << 11) | 20) & 0xFu; }
#define XB_SPIN(cond, bar) do { unsigned _sp = 0; while (cond) { __builtin_amdgcn_s_sleep(1); \
    if ((++_sp & 255u) == 0u) { if (xb_ld(&(bar)[XB_TMO])) break; if (_sp > XB_SPIN_CAP) { atomicAdd(&(bar)[XB_TMO], 1u); break; } } } } while (0)
struct XcdBarrier { unsigned* bar; unsigned x; volatile LAS unsigned* st; };
__device__ __forceinline__ XcdBarrier xcd_barrier_post(unsigned* bar, volatile LAS unsigned* st) {
    XcdBarrier b; b.bar = bar; b.x = xb_xcc_id(); b.st = st;
    if (threadIdx.x == 0) (void)xb_add(&bar[XB_XCNT(b.x)], 1u);
    return b;
}
__device__ __forceinline__ void xcd_barrier_complete(unsigned* bar, unsigned x, unsigned& nloc, unsigned& nx) {
    const unsigned G = gridDim.x * gridDim.y * gridDim.z;
    unsigned sum, cnt, mine, sp = 0u;
    for (;;) {
        sum = 0u; cnt = 0u; mine = 0u;
#pragma unroll
        for (unsigned j = 0; j < 16; ++j) { const unsigned c = xb_ld(&bar[XB_XCNT(j)]); sum += c; cnt += (c > 0u) ? 1u : 0u; mine = (j == x) ? c : mine; }
        if (sum == G) break;
        __builtin_amdgcn_s_sleep(1);
        if ((++sp & 255u) == 0u) { if (xb_ld(&bar[XB_TMO])) break; if (sp > XB_SPIN_CAP) { atomicAdd(&bar[XB_TMO], 1u); break; } }
    }
    nloc = mine > 0u ? mine : 1u; nx = cnt > 0u ? cnt : 1u;
}
__device__ __forceinline__ void xcd_barrier(const XcdBarrier& b) {
    asm volatile("s_waitcnt vmcnt(0)" ::: "memory");
    __syncthreads();
    if (threadIdx.x == 0) {
        unsigned* bar = b.bar;
        __builtin_amdgcn_s_waitcnt(0);
        unsigned nloc = b.st[0], nx = b.st[1];
        if (nloc == 0u) { xcd_barrier_complete(bar, b.x, nloc, nx); b.st[0] = nloc; b.st[1] = nx; }
        const unsigned old = xb_add(&bar[XB_XSUB(b.x)], 1u);
        const unsigned gen = old / nloc;
        if (old + 1u == (gen + 1u) * nloc) {
            __builtin_amdgcn_fence(__ATOMIC_RELEASE, "agent");
            asm volatile("s_waitcnt vmcnt(0)" ::: "memory");
            const unsigned og = xb_add(&bar[XB_TOP], 1u);
            const unsigned tg = og / nx;
            if (og + 1u == (tg + 1u) * nx) xb_add(&bar[XB_TOPGEN], 1u);
            else XB_SPIN(xb_ld(&bar[XB_TOPGEN]) == tg, bar);
            __builtin_amdgcn_fence(__ATOMIC_ACQUIRE, "agent");
            xb_add(&bar[XB_XGEN(b.x)], 1u);
            asm volatile("s_waitcnt vmcnt(0)" ::: "memory");
        } else {
            XB_SPIN(xb_ld(&bar[XB_XGEN(b.x)]) == gen, bar);
            __builtin_amdgcn_fence(__ATOMIC_ACQUIRE, "agent");
            asm volatile("s_waitcnt vmcnt(0)" ::: "memory");
        }
    }
    __syncthreads();
}

struct Args { const float* in[26]; float* out; unsigned char* ws; };

struct Frame {
    LAS unsigned char* lds;
    int tid, lane, wave, G, bx;
    float* out; unsigned char* ws;
};
typedef const float* cfp_t;
__device__ __forceinline__ const float* karg_in(int i) {
    asm volatile("" : "+s"(i));
    const __attribute__((address_space(4))) cfp_t* ka = (const __attribute__((address_space(4))) cfp_t*)__builtin_amdgcn_kernarg_segment_ptr();
    return ka[i];
}
#define IN(i) karg_in(i)
#define WSP(T, off) ((T*)(F.ws + (off)))

__device__ __forceinline__ void p0_transpose_item(const float* W, int K, int N, bf16_t* WT, int row_off, LAS float* scr, int item, int lane, int ldk, int koff) {
    const int nblk = N / 32, kb = item / nblk, nb = item % nblk, k0 = 64 * kb, n0 = 32 * nb;
#pragma unroll 8
    for (int i = 0; i < 32; ++i) { const int kk = 2 * i + (lane >> 5); scr[kk * 33 + (lane & 31)] = W[(size_t)(k0 + kk) * N + n0 + (lane & 31)]; }
    LDS_WAIT(); asm volatile("" ::: "memory");
    const int c = lane & 7;
#pragma unroll
    for (int j = 0; j < 4; ++j) { const int n = (lane >> 3) + 8 * j; const LAS float* s = scr + (8 * c) * 33 + n;
        u32x4 o; o.x = cvt_pk_bf16(s[0 * 33], s[1 * 33]); o.y = cvt_pk_bf16(s[2 * 33], s[3 * 33]); o.z = cvt_pk_bf16(s[4 * 33], s[5 * 33]); o.w = cvt_pk_bf16(s[6 * 33], s[7 * 33]);
        *(u32x4*)(WT + (size_t)(row_off + n0 + n) * ldk + koff + k0 + 8 * c) = o; }
    LDS_WAIT(); asm volatile("" ::: "memory");
}
template <bool OUT_F32> __device__ __forceinline__ void rms_row(const float* xrow, const float* g, void* orow, int lane) {
    const f32x4* xr = (const f32x4*)xrow + lane; f32x4 v[8]; float ss = 0.f;
#pragma unroll
    for (int j = 0; j < 8; ++j) { v[j] = xr[64 * j]; ss += (v[j].x * v[j].x + v[j].y * v[j].y) + (v[j].z * v[j].z + v[j].w * v[j].w); }
    const float r = rsqrtf(wave_sum(ss) * (1.f / DM) + EPS);
    const f32x4* gr = (const f32x4*)g + lane;
#pragma unroll
    for (int j = 0; j < 8; ++j) { const f32x4 gg = gr[64 * j]; const f32x4 o = v[j] * r * gg;
        if (OUT_F32) ((f32x4*)orow)[lane + 64 * j] = o;
        else { u32x2 w; w.x = cvt_pk_bf16(o.x, o.y); w.y = cvt_pk_bf16(o.z, o.w); ((u32x2*)orow)[lane + 64 * j] = w; } }
}

constexpr int I_IN = 32 * 288, I_SQ = 32 * 64, I_BR = 16 * 64, I_UP = 32 * 256, I_DN = 128 * 64;
constexpr int CV_A0 = 0, CV_A1 = I_IN + 2 * I_SQ;
constexpr int CV_B1 = CV_A1 + 3 * I_SQ + 2 * I_BR;
constexpr int CV_C1 = CV_B1 + I_UP;
constexpr int CV_D1 = CV_C1 + I_DN;
__device__ __forceinline__ void convert_one(Frame& F, int it, LAS float* scr) {
    int r = it, K = DM, N = DM, ro = 0, ldk = DM, koff = 0, src_i; size_t wso;
    if (r < I_IN) { src_i = 7; N = NIN; wso = WS_WIN; const int n0 = 32 * (r % 288);
        if (n0 >= C_GB) { const int j = n0 - C_GB; ro = C_GA + (j >> 7) * 256 + 128 + (j & 127) - n0; }
        else if (n0 >= C_GA) { const int j = n0 - C_GA; ro = C_GA + (j >> 7) * 256 + (j & 127) - n0; } }
    else if ((r -= I_IN) < I_SQ) { src_i = 19; wso = WS_WIN; ro = NIN; }
    else if ((r -= I_SQ) < I_SQ) { src_i = 20; wso = WS_WIN; ro = NIN + DM; }
    else if ((r -= I_SQ) < I_SQ) { src_i = 15; wso = WS_WMIX; }
    else if ((r -= I_SQ) < I_SQ) { src_i = 18; wso = WS_WQ; }
    else if ((r -= I_SQ) < I_SQ) { src_i = 21; wso = WS_WXO; }
    else if ((r -= I_SQ) < I_BR) { src_i = 13; wso = WS_WA; K = 1024; }
    else if ((r -= I_BR) < I_BR) { src_i = 14; wso = WS_WA; K = 1024; koff = 1024; }
    else if ((r -= I_BR) < I_UP) { src_i = 23; wso = WS_WUP; N = FF; }
    else { r -= I_UP; src_i = 24; wso = WS_WDN; K = FF; ldk = FF; }
    p0_transpose_item(IN(src_i), K, N, (bf16_t*)(F.ws + wso), ro, scr, r, F.lane, ldk, koff);
}
__device__ __forceinline__ void convert_fill(Frame& F, int i0, int i1, int n_units) {
    const int rounds = (n_units + F.G - 1) / F.G, nfull = n_units - (rounds - 1) * F.G;
    int slot = F.bx - nfull, nslots = F.G - nfull;
    if (nslots == 0) { slot = F.bx; nslots = F.G; }
    if (slot < 0) return;
    LAS float* scr = (LAS float*)(F.lds + F.wave * 16384);
    for (int it = i0 + slot * NWAVES + F.wave; it < i1; it += nslots * NWAVES) convert_one(F, it, scr);
}
__device__ __forceinline__ void phase_prologue(Frame& F) {
    LAS float* scr = (LAS float*)(F.lds + F.wave * 16384);
    const int gw = F.bx * NWAVES + F.wave, NGW = F.G * NWAVES;
    for (int it = CV_A0 + gw; it < CV_A1; it += NGW) convert_one(F, it, scr);
    bf16_t* XN = WSP(bf16_t, WS_XN);
    for (int m = gw; m < MT + 1024; m += NGW) {
        const float* src = m < MP ? IN(0) + (size_t)m * DM : (m < MT ? IN(1) + (size_t)(m - MP) * DM : IN(5) + (size_t)(m - MT) * DM);
        rms_row<false>(src, m < MT ? IN(6) : IN(17), XN + (size_t)m * DM, F.lane);
    }
    bf16_t* WS = WSP(bf16_t, WS_WSP);
    for (int i = F.bx * 512 + F.tid; i < 4 * 128 * 128; i += F.G * 512) { const int t = (i >> 7) & 127, s = i & 127; const float w = (s <= t) ? IN(10)[i] : 0.f; WS[i] = (bf16_t)(cvt_pk_bf16(w, 0.f) & 0xffff); }
}

__device__ __forceinline__ void phase_mixprep(Frame& F) {
    const bf16_t* P1 = WSP(bf16_t, WS_P1);
    {
        bf16_t* YB = WSP(bf16_t, WS_YA);   const float* cw = IN(12); const float* st = IN(2);
        for (int it = F.bx * 512 + F.tid; it < MT * 128; it += F.G * 512) {
            const int row = it >> 7, c0 = (it & 127) * 8;
            const bf16_t* pr = P1 + (size_t)row * NIN;
            float cg[8], xi[8], p0[8], p1[8], p2[8], bg[8];
            unpack8(*(const u32x4*)(pr + C_CG + c0), cg); unpack8(*(const u32x4*)(pr + C_XIN + c0), xi); unpack8(*(const u32x4*)(pr + C_BG + c0), bg);
#pragma unroll
            for (int e = 0; e < 8; ++e) p0[e] = cg[e] * xi[e];
            int pos, b; const bool prompt = row < MP;
            if (prompt) { pos = row & 2047; b = row >> 11; } else { pos = (row - MP) & 7; b = (row - MP) >> 3; }
            if (pos >= 1) { unpack8(*(const u32x4*)(pr - NIN + C_CG + c0), cg); unpack8(*(const u32x4*)(pr - NIN + C_XIN + c0), xi);
#pragma unroll
                for (int e = 0; e < 8; ++e) p1[e] = cg[e] * xi[e]; }
            else if (prompt) {
#pragma unroll
                for (int e = 0; e < 8; ++e) p1[e] = 0.f; }
            else { const f32x4 a = *(const f32x4*)(st + ((size_t)b * 2 + 1) * 1024 + c0), c = *(const f32x4*)(st + ((size_t)b * 2 + 1) * 1024 + c0 + 4);
                p1[0] = a.x; p1[1] = a.y; p1[2] = a.z; p1[3] = a.w; p1[4] = c.x; p1[5] = c.y; p1[6] = c.z; p1[7] = c.w; }
            if (pos >= 2) { unpack8(*(const u32x4*)(pr - 2 * NIN + C_CG + c0), cg); unpack8(*(const u32x4*)(pr - 2 * NIN + C_XIN + c0), xi);
#pragma unroll
                for (int e = 0; e < 8; ++e) p2[e] = cg[e] * xi[e]; }
            else if (prompt) {
#pragma unroll
                for (int e = 0; e < 8; ++e) p2[e] = 0.f; }
            else { const int sr = (pos == 1) ? 1 : 0; const f32x4 a = *(const f32x4*)(st + ((size_t)b * 2 + sr) * 1024 + c0), c = *(const f32x4*)(st + ((size_t)b * 2 + sr) * 1024 + c0 + 4);
                p2[0] = a.x; p2[1] = a.y; p2[2] = a.z; p2[3] = a.w; p2[4] = c.x; p2[5] = c.y; p2[6] = c.z; p2[7] = c.w; }
            float y[8];
#pragma unroll
            for (int e = 0; e < 8; ++e) y[e] = bg[e] * (cw[c0 + e] * p2[e] + cw[1024 + c0 + e] * p1[e] + cw[2048 + c0 + e] * p0[e]);
            u32x4 w; w.x = cvt_pk_bf16(y[0], y[1]); w.y = cvt_pk_bf16(y[2], y[3]); w.z = cvt_pk_bf16(y[4], y[5]); w.w = cvt_pk_bf16(y[6], y[7]);
            *(u32x4*)(YB + (size_t)row * DM + 1024 + c0) = w;
            const int tail = prompt ? 2046 : 6;
            if (pos >= tail) { float* o = F.out + (prompt ? O_CP : O_CS) + ((size_t)b * 2 + (pos - tail)) * 1024 + c0;
                *(f32x4*)o = (f32x4){p0[0], p0[1], p0[2], p0[3]}; *(f32x4*)(o + 4) = (f32x4){p0[4], p0[5], p0[6], p0[7]}; }
        }
    }
    {
        const float* lg = IN(8); const float* lb = IN(9); const float* wsp = IN(10); const float* bsp = IN(11);
        bf16_t* YA = WSP(bf16_t, WS_YA);
        const int gw = F.bx * NWAVES + F.wave, NGW = F.G * NWAVES;
        for (int sq = gw; sq < 128; sq += NGW) {
            const int row0 = MP + sq * 8;
            float mu[8], rs[8];
#pragma unroll
            for (int t = 0; t < 8; ++t) {
                const bf16_t* pr = P1 + (size_t)(row0 + t) * NIN + C_V + 8 * F.lane;
                float a[8], b[8]; unpack8(*(const u32x4*)pr, a); unpack8(*(const u32x4*)(pr + 512), b);
                float s = 0.f;
#pragma unroll
                for (int e = 0; e < 8; ++e) s += a[e] + b[e];
                const float mean = wave_sum(s) * (1.f / 1024.f); float q = 0.f;
#pragma unroll
                for (int e = 0; e < 8; ++e) { const float da = a[e] - mean, db = b[e] - mean; q += da * da + db * db; }
                mu[t] = mean; rs[t] = rsqrtf(wave_sum(q) * (1.f / 1024.f) + EPS);
                asm volatile("" ::: "memory");
            }
#pragma unroll
            for (int j = 0; j < 2; ++j) {
                const int c0 = 8 * F.lane + 512 * j, g = c0 >> 8;
                float gg[8], bb[8];
                { const f32x4 a = *(const f32x4*)(lg + c0), b = *(const f32x4*)(lg + c0 + 4), c = *(const f32x4*)(lb + c0), d = *(const f32x4*)(lb + c0 + 4);
                  gg[0] = a.x; gg[1] = a.y; gg[2] = a.z; gg[3] = a.w; gg[4] = b.x; gg[5] = b.y; gg[6] = b.z; gg[7] = b.w;
                  bb[0] = c.x; bb[1] = c.y; bb[2] = c.z; bb[3] = c.w; bb[4] = d.x; bb[5] = d.y; bb[6] = d.z; bb[7] = d.w; }
                float vl[8][8];
#pragma unroll
                for (int t = 0; t < 8; ++t) {
                    float a[8]; unpack8(*(const u32x4*)(P1 + (size_t)(row0 + t) * NIN + C_V + c0), a);
#pragma unroll
                    for (int e = 0; e < 8; ++e) vl[t][e] = (a[e] - mu[t]) * rs[t] * gg[e] + bb[e];
                    float* o = F.out + O_CV + (size_t)(sq * 8 + t) * 1024 + c0;
                    *(f32x4*)o = (f32x4){vl[t][0], vl[t][1], vl[t][2], vl[t][3]}; *(f32x4*)(o + 4) = (f32x4){vl[t][4], vl[t][5], vl[t][6], vl[t][7]};
                }
#pragma unroll
                for (int t = 0; t < 8; ++t) {
                    float z[8]; const float bs = bsp[g * 128 + t];
#pragma unroll
                    for (int e = 0; e < 8; ++e) z[e] = bs;
#pragma unroll
                    for (int s = 0; s < 8; ++s) if (s <= t) { const float w = wsp[(size_t)g * 16384 + t * 128 + s];
#pragma unroll
                        for (int e = 0; e < 8; ++e) z[e] += w * vl[s][e]; }
                    float uf[8]; unpack8(*(const u32x4*)(P1 + (size_t)(row0 + t) * NIN + C_U + c0), uf);
                    u32x4 w; w.x = cvt_pk_bf16(uf[0] * z[0], uf[1] * z[1]); w.y = cvt_pk_bf16(uf[2] * z[2], uf[3] * z[3]); w.z = cvt_pk_bf16(uf[4] * z[4], uf[5] * z[5]); w.w = cvt_pk_bf16(uf[6] * z[6], uf[7] * z[7]);
                    *(u32x4*)(YA + (size_t)(row0 + t) * DM + c0) = w;
                }
            }
        }
    }
    {
        const float* lg = IN(8); const float* lb = IN(9);
        bf16_t* VT = WSP(bf16_t, WS_VT);
        LAS bf16_t* T = (LAS bf16_t*)F.lds;
        for (int un = F.bx; un < 256; un += F.G) {
            const int chunk = un >> 2, g = un & 3;
            const bool mine = ((F.lane >> 5) == (g & 1));
            const int cm = 256 * g + 8 * (F.lane & 31);
            float gg[8], bb[8];
            { const f32x4 a = *(const f32x4*)(lg + cm), b = *(const f32x4*)(lg + cm + 4), c = *(const f32x4*)(lb + cm), d = *(const f32x4*)(lb + cm + 4);
              gg[0] = a.x; gg[1] = a.y; gg[2] = a.z; gg[3] = a.w; gg[4] = b.x; gg[5] = b.y; gg[6] = b.z; gg[7] = b.w;
              bb[0] = c.x; bb[1] = c.y; bb[2] = c.z; bb[3] = c.w; bb[4] = d.x; bb[5] = d.y; bb[6] = d.z; bb[7] = d.w; }
            for (int rr = 0; rr < 16; ++rr) {
                const int s = F.wave * 16 + rr;
                const bf16_t* pr = P1 + (size_t)(chunk * 128 + s) * NIN + C_V + 8 * F.lane;
                float a[8], b[8]; unpack8(*(const u32x4*)pr, a); unpack8(*(const u32x4*)(pr + 512), b);
                float sm = 0.f;
#pragma unroll
                for (int e = 0; e < 8; ++e) sm += a[e] + b[e];
                const float mean = wave_sum(sm) * (1.f / 1024.f); float q = 0.f;
#pragma unroll
                for (int e = 0; e < 8; ++e) { const float da = a[e] - mean, db = b[e] - mean; q += da * da + db * db; }
                const float rstd = rsqrtf(wave_sum(q) * (1.f / 1024.f) + EPS);
                if (mine) {
                    float y[8];
#pragma unroll
                    for (int e = 0; e < 8; ++e) { const float x = (g >> 1) ? b[e] : a[e]; y[e] = (x - mean) * rstd * gg[e] + bb[e]; }
                    u32x4 w; w.x = cvt_pk_bf16(y[0], y[1]); w.y = cvt_pk_bf16(y[2], y[3]); w.z = cvt_pk_bf16(y[4], y[5]); w.w = cvt_pk_bf16(y[6], y[7]);
                    *(LAS u32x4*)(T + s * 264 + 8 * (F.lane & 31)) = w;
                }
            }
            __syncthreads();
#pragma unroll 2
            for (int itn = 0; itn < 8; ++itn) {
                const int idx = itn * 512 + F.tid, c = idx >> 4, sb = idx & 15;
                unsigned short h[8];
#pragma unroll
                for (int i = 0; i < 8; ++i) h[i] = T[(8 * sb + i) * 264 + c];
                u32x4 w; w.x = (unsigned)h[0] | ((unsigned)h[1] << 16); w.y = (unsigned)h[2] | ((unsigned)h[3] << 16); w.z = (unsigned)h[4] | ((unsigned)h[5] << 16); w.w = (unsigned)h[6] | ((unsigned)h[7] << 16);
                *(u32x4*)(VT + ((size_t)chunk * 1024 + g * 256 + c) * 128 + 8 * sb) = w;
            }
            __syncthreads();
        }
    }
}

__device__ __forceinline__ void sample_attn_unit(Frame& F, int unit, bool tail) {
    const int b = unit >> 2, h = unit & 3, lane = F.lane, wave = F.wave, r16 = lane & 15, kq = lane >> 4;
    const float* Kb = IN(3) + ((size_t)b * NMEM * XH + h) * XD;
    const float* Vb = IN(4) + ((size_t)b * NMEM * XH + h) * XD;
    const bf16_t* Qb = WSP(bf16_t, WS_Q) + (size_t)(MP + b * 8) * DM + h * XD;
    LAS bf16_t* sP = (LAS bf16_t*)F.lds;
    LAS float* sSt = (LAS float*)(F.lds + 16 * 528);
    LAS bf16_t* sQ = (LAS bf16_t*)(F.lds + 9472);
    if (tail) {
        const int t = F.tid >> 6, d0 = (F.tid & 63) * 8;
        const float* pp = WSP(float, WS_PART) + (size_t)(b * 8 + t) * DM + h * XD + d0;
        f32x4 a0 = {0.f, 0.f, 0.f, 0.f}, a1 = {0.f, 0.f, 0.f, 0.f};
#pragma unroll
        for (int s = 0; s < 8; ++s) { a0 = a0 + *(const f32x4*)(pp + (size_t)s * (MS * DM)); a1 = a1 + *(const f32x4*)(pp + (size_t)s * (MS * DM) + 4); }
        a0 = a0 * QSCALE; a1 = a1 * QSCALE;
        *(LAS bf16x8*)(sQ + t * 520 + d0) = pack8(a0, a1);
        __syncthreads();
    }
    f32x4 s0 = {0.f, 0.f, 0.f, 0.f}, s1 = {0.f, 0.f, 0.f, 0.f};
    const float* k0p = Kb + (size_t)(32 * wave + r16) * (XH * XD) + kq * 8;
    const float* k1p = k0p + (size_t)16 * (XH * XD);
    const bf16_t* qp = Qb + (size_t)(r16 & 7) * DM + kq * 8;
#pragma unroll 4
    for (int ds = 0; ds < 16; ++ds) {
        const f32x4 a0 = *(const f32x4*)(k0p + ds * 32), a1 = *(const f32x4*)(k0p + ds * 32 + 4);
        const f32x4 c0 = *(const f32x4*)(k1p + ds * 32), c1 = *(const f32x4*)(k1p + ds * 32 + 4);
        u32x4 qw = tail ? *(const LAS u32x4*)(sQ + (r16 & 7) * 520 + kq * 8 + ds * 32) : *(const u32x4*)(qp + ds * 32); if (r16 >= 8) qw = (u32x4){0u, 0u, 0u, 0u};
        const bf16x8 qf = __builtin_bit_cast(bf16x8, qw);
        s0 = __builtin_amdgcn_mfma_f32_16x16x32_bf16(pack8(a0, a1), qf, s0, 0, 0, 0);
        s1 = __builtin_amdgcn_mfma_f32_16x16x32_bf16(pack8(c0, c1), qf, s1, 0, 0, 0);
    }
    float mx = fmaxf(fmaxf(fmaxf(s0[0], s0[1]), fmaxf(s0[2], s0[3])), fmaxf(fmaxf(s1[0], s1[1]), fmaxf(s1[2], s1[3])));
    mx = fmaxf(mx, __shfl_xor(mx, 16)); mx = fmaxf(mx, __shfl_xor(mx, 32));
    float sm = 0.f;
#pragma unroll
    for (int j = 0; j < 4; ++j) { s0[j] = __expf(s0[j] - mx); s1[j] = __expf(s1[j] - mx); sm += s0[j] + s1[j]; }
    sm += __shfl_xor(sm, 16); sm += __shfl_xor(sm, 32);
    if (kq == 0) { sSt[(wave * 16 + r16) * 2] = mx; sSt[(wave * 16 + r16) * 2 + 1] = sm; }
    __syncthreads();
    float M = -3.0e38f;
#pragma unroll
    for (int w2 = 0; w2 < 8; ++w2) M = fmaxf(M, sSt[(w2 * 16 + r16) * 2]);
    float L = 0.f;
#pragma unroll
    for (int w2 = 0; w2 < 8; ++w2) L += sSt[(w2 * 16 + r16) * 2 + 1] * __expf(sSt[(w2 * 16 + r16) * 2] - M);
    const float f = __expf(mx - M) / L;
    { u32x2 w; w.x = cvt_pk_bf16(s0[0] * f, s0[1] * f); w.y = cvt_pk_bf16(s0[2] * f, s0[3] * f); *(LAS u32x2*)(sP + r16 * 264 + 32 * wave + 4 * kq) = w;
      w.x = cvt_pk_bf16(s1[0] * f, s1[1] * f); w.y = cvt_pk_bf16(s1[2] * f, s1[3] * f); *(LAS u32x2*)(sP + r16 * 264 + 32 * wave + 16 + 4 * kq) = w; }
    __syncthreads();
    f32x4 o[4];
#pragma unroll
    for (int c = 0; c < 4; ++c) o[c] = (f32x4){0.f, 0.f, 0.f, 0.f};
    const float* vp = Vb + (size_t)(kq * 8) * (XH * XD) + 64 * wave + 4 * r16;
#pragma unroll 2
    for (int ms = 0; ms < 8; ++ms) {
        const bf16x8 pf = *(const LAS bf16x8*)(sP + r16 * 264 + ms * 32 + kq * 8);
        f32x4 x[8];
#pragma unroll
        for (int j = 0; j < 8; ++j) x[j] = *(const f32x4*)(vp + (size_t)(ms * 32 + j) * (XH * XD));
#pragma unroll
        for (int c = 0; c < 4; ++c) {
            const bf16x8 a = pack8((f32x4){x[0][c], x[1][c], x[2][c], x[3][c]}, (f32x4){x[4][c], x[5][c], x[6][c], x[7][c]});
            o[c] = __builtin_amdgcn_mfma_f32_16x16x32_bf16(a, pf, o[c], 0, 0, 0);
        }
    }
    if (r16 < 8) {
        bf16_t* op = WSP(bf16_t, WS_O) + (size_t)(MP + b * 8 + r16) * DM + h * XD + 64 * wave + 16 * kq;
        u32x4 w0, w1;
        w0.x = cvt_pk_bf16(o[0][0], o[1][0]); w0.y = cvt_pk_bf16(o[2][0], o[3][0]); w0.z = cvt_pk_bf16(o[0][1], o[1][1]); w0.w = cvt_pk_bf16(o[2][1], o[3][1]);
        w1.x = cvt_pk_bf16(o[0][2], o[1][2]); w1.y = cvt_pk_bf16(o[2][2], o[3][2]); w1.z = cvt_pk_bf16(o[0][3], o[1][3]); w1.w = cvt_pk_bf16(o[2][3], o[3][3]);
        *(u32x4*)op = w0; *(u32x4*)(op + 8) = w1;
    }
    __syncthreads();
}

template <bool OUT_F32> __device__ __forceinline__ void phase_rms(Frame& F, const float* src, const float* g, void* dst, const float* part, const float* sbase, float* hout) {
    const int gw = F.bx * NWAVES + F.wave, NGW = F.G * NWAVES, lane = F.lane;
    for (int m = gw; m < MT; m += NGW) {
        void* orow = OUT_F32 ? (void*)((float*)dst + (size_t)m * DM) : (void*)((bf16_t*)dst + (size_t)m * DM);
        if (m < MP || part == nullptr) { rms_row<OUT_F32>(src + (size_t)m * DM, g, orow, lane); continue; }
        const int ms = m - MP;
        const f32x4* xr = (const f32x4*)(sbase + (size_t)ms * DM) + lane; f32x4 v[8]; float ss = 0.f;
#pragma unroll
        for (int j = 0; j < 8; ++j) v[j] = xr[64 * j];
#pragma unroll
        for (int s = 0; s < 8; ++s) { const f32x4* pr = (const f32x4*)(part + (size_t)s * (MS * DM) + (size_t)ms * DM) + lane;
#pragma unroll
            for (int j = 0; j < 8; ++j) v[j] = v[j] + pr[64 * j]; }
#pragma unroll
        for (int j = 0; j < 8; ++j) { ss += (v[j].x * v[j].x + v[j].y * v[j].y) + (v[j].z * v[j].z + v[j].w * v[j].w); if (hout) ((f32x4*)(hout + (size_t)ms * DM))[lane + 64 * j] = v[j]; }
        const float r = rsqrtf(wave_sum(ss) * (1.f / DM) + EPS);
        const f32x4* gr = (const f32x4*)g + lane;
#pragma unroll
        for (int j = 0; j < 8; ++j) { const f32x4 gg = gr[64 * j]; const f32x4 o = v[j] * r * gg;
            if (OUT_F32) ((f32x4*)orow)[lane + 64 * j] = o;
            else { u32x2 w; w.x = cvt_pk_bf16(o.x, o.y); w.y = cvt_pk_bf16(o.z, o.w); ((u32x2*)orow)[lane + 64 * j] = w; } }
    }
}

__global__ void __launch_bounds__(NWAVES * 64, 2) fwd_megakernel(Args args) {
    extern __shared__ __attribute__((aligned(16))) unsigned char lds_raw[];
    cg::grid_group grid = cg::this_grid();
    Frame F;
    F.lds = (LAS unsigned char*)lds_raw;
    F.tid = threadIdx.x; F.lane = F.tid & 63; F.wave = __builtin_amdgcn_readfirstlane(F.tid >> 6);
    F.G = gridDim.x; F.bx = blockIdx.x;
    F.out = args.out; F.ws = args.ws;
    volatile LAS unsigned* MISC = (volatile LAS unsigned*)(F.lds + 131072 + 320);
    if (F.tid < 32) MISC[F.tid] = 0u;
    __syncthreads();
    XcdBarrier xbar = xcd_barrier_post((unsigned*)(F.ws + WS_CTL) + 4096, MISC + 8);
#define SEAM0() do { grid.sync(); int t_ = threadIdx.x; asm volatile("" : "+v"(t_)); F.tid = t_; F.lane = t_ & 63; } while (0)
#define SEAM() do { xcd_barrier(xbar); int t_ = threadIdx.x; asm volatile("" : "+v"(t_)); F.tid = t_; F.lane = t_ & 63; } while (0)
#ifndef PHASE_MASK
#define PHASE_MASK 0xffffffffu
#endif
#define PH(k) ((PHASE_MASK >> (k)) & 1u)
    using namespace pg8;
    const char* XN = (const char*)(F.ws + WS_XN);
    const bool tail = (F.G == 256);

    if (PH(0)) phase_prologue(F);
    SEAM0();
    if (PH(1)) {
        SchedIn S{XN, (const char*)(F.ws + WS_WIN), F.G, F.bx};
        EpiIn E{WSP(bf16_t, WS_P1), F.out + O_MK, F.out + O_MV, WSP(bf16_t, WS_KP), WSP(bf16_t, WS_VPT)};
        gemm_phase<EpiIn, SchedIn, true>(F.lds, DM, DM, S, E);
        convert_fill(F, CV_A1, CV_B1, 1296 + 64);
    }
    SEAM();
    if (PH(2)) phase_mixprep(F);
    SEAM();
    if (PH(3)) {
        SchedSp S{(const char*)(F.ws + WS_WSP), (const char*)(F.ws + WS_VT), F.G, F.bx};
        EpiSp E{WSP(bf16_t, WS_P1), IN(11), WSP(bf16_t, WS_YA)};
        gemm_phase<EpiSp, SchedSp, true>(F.lds, 128, 128, S, E);
    }
    SEAM();
    if (PH(4)) {
        SchedRect S{(const char*)(F.ws + WS_YA), (const char*)(F.ws + WS_WA), (size_t)BM * DM * 2, (size_t)BM * DM * 2, 36, 8, F.G, F.bx, 32};
        EpiMerged E{WSP(bf16_t, WS_P1), WSP(bf16_t, WS_MRG)};
        gemm_phase<EpiMerged, SchedRect, true>(F.lds, DM, DM, S, E);
        convert_fill(F, CV_B1, CV_C1, 288);
    }
    SEAM();
    if (PH(6)) {
        SchedTail S{(const char*)(F.ws + WS_MRG), (const char*)(F.ws + WS_WMIX), (size_t)BM * DM * 2, (size_t)BM * DM * 2, 32, F.G, F.bx, tail};
        EpiTail<EpiRes> E{{IN(0), IN(1), MP, WSP(float, WS_H1)}, WSP(float, WS_PART)};
        gemm_phase<EpiTail<EpiRes>, SchedTail, true>(F.lds, DM, DM, S, E);
    }
    SEAM();
    phase_rms<false>(F, WSP(float, WS_H1), IN(16), WSP(bf16_t, WS_XN), tail ? WSP(float, WS_PART) : nullptr, IN(1), WSP(float, WS_H1) + (size_t)MP * DM);
    SEAM();
    if (PH(7)) {
        SchedTail S{XN, (const char*)(F.ws + WS_WQ), (size_t)BM * DM * 2, (size_t)BM * DM * 2, 32, F.G, F.bx, tail};
        EpiTail<EpiBf<0>> E{{WSP(bf16_t, WS_Q), DM, QSCALE}, WSP(float, WS_PART)};
        gemm_phase<EpiTail<EpiBf<0>>, SchedTail, true>(F.lds, DM, DM, S, E);
    }
    SEAM();
    if (PH(8)) {
        SchedS S{(const char*)(F.ws + WS_Q), (const char*)(F.ws + WS_KP), F.G, F.bx};
        EpiSoftmax E{WSP(bf16_t, WS_PS)};
        gemm_phase<EpiSoftmax, SchedS, false>(F.lds, DM, DM, S, E);
        __syncthreads();
        for (int un = F.bx; un < 512; un += F.G) sample_attn_unit(F, un, tail);
    }
    SEAM();
    if (PH(9)) {
        SchedO S{(const char*)(F.ws + WS_PS), (const char*)(F.ws + WS_VPT), F.G, F.bx};
        EpiBf<0> E{WSP(bf16_t, WS_O), DM, 1.0f};
        gemm_phase<EpiBf<0>, SchedO, true>(F.lds, 256, 256, S, E);
    }
    SEAM();
    if (PH(10)) {
        SchedTail S{(const char*)(F.ws + WS_O), (const char*)(F.ws + WS_WXO), (size_t)BM * DM * 2, (size_t)BM * DM * 2, 32, F.G, F.bx, tail};
        EpiTail<EpiRes> E{{WSP(float, WS_H1), WSP(float, WS_H1), 1 << 30, WSP(float, WS_H2)}, WSP(float, WS_PART)};
        gemm_phase<EpiTail<EpiRes>, SchedTail, true>(F.lds, DM, DM, S, E);
    }
    SEAM();
    phase_rms<false>(F, WSP(float, WS_H2), IN(22), WSP(bf16_t, WS_XN), tail ? WSP(float, WS_PART) : nullptr, WSP(float, WS_H1) + (size_t)MP * DM, WSP(float, WS_H2) + (size_t)MP * DM);
    SEAM();
    if (PH(11)) {
        SchedRect S{XN, (const char*)(F.ws + WS_WUP), (size_t)BM * DM * 2, (size_t)BM * DM * 2, 36, 32, F.G, F.bx, 32};
        EpiBf<1> E{WSP(bf16_t, WS_UP), FF, 1.0f};
        gemm_phase<EpiBf<1>, SchedRect, true>(F.lds, DM, DM, S, E);
        convert_fill(F, CV_C1, CV_D1, 36 * 32);
    }
    SEAM();
    if (PH(12)) {
        SchedTail S{(const char*)(F.ws + WS_UP), (const char*)(F.ws + WS_WDN), (size_t)BM * FF * 2, (size_t)BM * FF * 2, 128, F.G, F.bx, tail};
        EpiTail<EpiRes> E{{WSP(float, WS_H2), WSP(float, WS_H2), 1 << 30, WSP(float, WS_H2)}, WSP(float, WS_PART)};
        gemm_phase<EpiTail<EpiRes>, SchedTail, true>(F.lds, FF, FF, S, E);
    }
    SEAM();
    phase_rms<true>(F, WSP(float, WS_H2), IN(25), F.out + O_Y, tail ? WSP(float, WS_PART) : nullptr, WSP(float, WS_H2) + (size_t)MP * DM, nullptr);
}

extern "C" void kernel_launch(void* const* d_in, const int* in_sizes, int n_in, void* d_out, int out_size, void* d_ws, size_t ws_size, hipStream_t stream) {
    static int grid = 0;
    if (grid == 0) {
        if (n_in != 26 || ws_size < WS_END) { fprintf(stderr, "kernel_launch: unexpected n_in %d / ws_size %zu\n", n_in, ws_size); grid = -1; return; }
        int dev = 0, cus = 0, per_cu = 0;
        hipGetDevice(&dev);
        hipDeviceGetAttribute(&cus, hipDeviceAttributeMultiprocessorCount, dev);
        if (hipFuncSetAttribute((const void*)fwd_megakernel, hipFuncAttributeMaxDynamicSharedMemorySize, LDS_BYTES) != hipSuccess) { fprintf(stderr, "kernel_launch: hipFuncSetAttribute failed\n"); grid = -1; return; }
        if (hipOccupancyMaxActiveBlocksPerMultiprocessor(&per_cu, (const void*)fwd_megakernel, NWAVES * 64, LDS_BYTES) != hipSuccess || per_cu < 1) { fprintf(stderr, "kernel_launch: occupancy query says %d\n", per_cu); per_cu = 1; }
        (void)hipGetLastError();
        grid = cus;
        if (grid < 128) { fprintf(stderr, "kernel_launch: needs >= 128 CUs\n"); grid = -1; return; }
    }
    if (grid < 0) return;
    if (hipMemsetAsync((char*)d_ws + WS_CTL, 0, 65536, stream) != hipSuccess) { fprintf(stderr, "kernel_launch: memset failed\n"); return; }
    Args a{};
    for (int i = 0; i < 26; ++i) a.in[i] = (const float*)d_in[i];
    a.out = (float*)d_out; a.ws = (unsigned char*)d_ws;
    void* kargs[] = {&a};
    hipError_t e = hipLaunchCooperativeKernel((const void*)fwd_megakernel, dim3(grid), dim3(NWAVES * 64), kargs, LDS_BYTES, stream);
    if (e != hipSuccess) fprintf(stderr, "kernel_launch: cooperative launch failed: %s (grid %d)\n", hipGetErrorString(e), grid);
}
```

```cpp
#include <hip/hip_runtime.h>
#include <hip/hip_cooperative_groups.h>
#include <cstdio>
#include <cstdint>
namespace cg = cooperative_groups;

#define LAS __attribute__((address_space(3)))
typedef unsigned short bf16_t;
typedef short bf16x8 __attribute__((ext_vector_type(8)));
typedef float f32x4 __attribute__((ext_vector_type(4)));
typedef float f32x2 __attribute__((ext_vector_type(2)));
typedef unsigned u32x4 __attribute__((ext_vector_type(4)));
typedef unsigned u32x2 __attribute__((ext_vector_type(2)));

constexpr int DM = 2048, MP = 8192, MS = 1024, MT = MP + MS  ;
constexpr int NIN = 9216, FF = 8192, NMEM = 256, XH = 4, XD = 512;
constexpr int C_U = 0, C_V = 1024, C_BG = 2048, C_CG = 3072, C_XIN = 4096, C_GA = 5120, C_GB = 7168;
constexpr float EPS = 1e-6f, QSCALE = 0.04419417382415922f  ;
constexpr size_t O_Y = 0, O_MK = 18874368, O_MV = 20971520, O_CP = 23068672, O_CS = 23076864, O_CV = 23339008;
constexpr size_t MiB = 1u << 20;
constexpr size_t WS_CTL = 0, CTL_BYTES = 1 * MiB;
constexpr size_t WS_WIN = 2 * MiB;
constexpr size_t WS_WA = 54 * MiB, WS_WB = 58 * MiB;
constexpr size_t WS_WMIX = 62 * MiB, WS_WQ = 70 * MiB, WS_WXO = 78 * MiB;
constexpr size_t WS_WUP = 86 * MiB;
constexpr size_t WS_WDN = 118 * MiB;
constexpr size_t WS_WSP = 150 * MiB;
constexpr size_t WS_XN = 152 * MiB;
constexpr size_t WS_P1 = 192 * MiB;
constexpr size_t WS_UP = 192 * MiB;
constexpr size_t WS_VT = 354 * MiB;
constexpr size_t WS_YA = 370 * MiB, WS_YB = 388 * MiB;
constexpr size_t WS_TMP = 406 * MiB;
constexpr size_t WS_PART = 406 * MiB;
constexpr size_t WS_MRG = 478 * MiB;
constexpr size_t WS_H1 = 514 * MiB;
constexpr size_t WS_Q = 586 * MiB;
constexpr size_t WS_KP = 622 * MiB;
constexpr size_t WS_VPT = 626 * MiB;
constexpr size_t WS_PS = 630 * MiB;
constexpr size_t WS_O = 646 * MiB;
constexpr size_t WS_H2 = 682 * MiB;
constexpr size_t WS_END = 754 * MiB;

constexpr int LDS_BYTES = 147456;
constexpr int NWAVES = 8;

__device__ __forceinline__ unsigned cvt_pk_bf16(float lo, float hi) { unsigned r; asm volatile("v_cvt_pk_bf16_f32 %0, %1, %2" : "=v"(r) : "v"(lo), "v"(hi)); return r; }
__device__ __forceinline__ float bf_lo(unsigned u) { return __uint_as_float(u << 16); }
__device__ __forceinline__ float bf_hi(unsigned u) { return __uint_as_float(u & 0xffff0000u); }
__device__ __forceinline__ float bf1(bf16_t h) { return __uint_as_float(((unsigned)h) << 16); }
__device__ __forceinline__ bf16x8 pack8(f32x4 a, f32x4 b) {
    u32x4 w; w.x = cvt_pk_bf16(a.x, a.y); w.y = cvt_pk_bf16(a.z, a.w); w.z = cvt_pk_bf16(b.x, b.y); w.w = cvt_pk_bf16(b.z, b.w);
    return __builtin_bit_cast(bf16x8, w);
}
__device__ __forceinline__ void unpack8(u32x4 w, float (&f)[8]) {
    f[0] = bf_lo(w.x); f[1] = bf_hi(w.x); f[2] = bf_lo(w.y); f[3] = bf_hi(w.y); f[4] = bf_lo(w.z); f[5] = bf_hi(w.z); f[6] = bf_lo(w.w); f[7] = bf_hi(w.w);
}
__device__ __forceinline__ float wave_sum(float v) {
#pragma unroll
    for (int o = 1; o < 64; o <<= 1) v += __shfl_xor(v, o);
    return v;
}
__device__ __forceinline__ float sigmoidf_(float x) { return __builtin_amdgcn_rcpf(1.0f + __expf(-x)); }
#define LDS_WAIT() asm volatile("s_waitcnt lgkmcnt(0)" ::: "memory")

namespace pg8 {
constexpr int BM = 256, BK = 64, HALF = 128, HTB = HALF * BK * 2, STAGE_BYTES = 8 * HTB, NXCD = 8, WGM = 8;
__host__ __device__ __forceinline__ int lds_byte(int r, int c) { const int st = (r >> 4) * 2 + (c >> 5), rr = r & 15, cc = c & 31, ob = rr * 64 + cc * 2; return st * 1024 + (ob ^ (((ob >> 9) & 1) << 5)); }
__host__ __device__ __forceinline__ void stage_rc(int b, int& R, int& C) { const int st = b / 1024, sb = b % 1024, swz = sb ^ (((sb >> 9) & 1) << 5); R = (st >> 1) * 16 + swz / 64; C = (st & 1) * 32 + (swz % 64) / 2; }
__host__ __device__ __forceinline__ int perm32(int rho) { const int n = rho >> 4, i = rho & 15; return 8 * (i >> 2) + 4 * n + (i & 3); }

struct Unit { const char* A; const char* B; int orow, ocol, aux, nkt; };

__device__ __forceinline__ void rect_order(int L, int nM, int nN, int& pm, int& pn) {
    const int nwg = nM * nN; int wgid = L;
    { const int q = nwg / NXCD, r = nwg % NXCD, xcd = wgid % NXCD, off = wgid / NXCD; wgid = (xcd < r ? xcd * (q + 1) : r * (q + 1) + (xcd - r) * q) + off; }
    const int nig = WGM * nN, gid = wgid / nig, fm = gid * WGM, gsz = (nM - fm) < WGM ? (nM - fm) : WGM;
    pm = fm + ((wgid % nig) % gsz); pn = (wgid % nig) / gsz;
}

template <class Epi, class Sched, bool ALIGN_EPI>
__device__ __forceinline__ void gemm_phase(LAS unsigned char* lds, const int lda, const int ldb, const Sched& S, const Epi& E) {
    int tid_ = threadIdx.x; asm volatile("" : "+v"(tid_));
    const int tid = tid_, wid = __builtin_amdgcn_readfirstlane(tid >> 6), lane = tid & 63, wr = wid >> 2, wc = wid & 3, fr = lane & 15, fq = lane >> 4;
    unsigned voffA[2], voffB[2];
#pragma unroll
    for (int i = 0; i < 2; ++i) { int R, C; stage_rc(tid * 16 + i * 8192, R, C); const int Rb = Epi::PERM ? ((R & ~31) + perm32(R & 31)) : R;
        voffA[i] = (unsigned)(R * lda + C) * 2u; voffB[i] = (unsigned)(Rb * ldb + C) * 2u; }
    const size_t kstep = (size_t)(BK * 2);
    const size_t hstepA = (size_t)HALF * lda * 2, hstepB = (size_t)HALF * ldb * 2;
    const unsigned ldsw = (unsigned)wid * 1024u;
    const int aoff = lds_byte(wr * 64 + fr, fq * 8), boff = lds_byte(wc * 32 + fr, fq * 8);
#define PG8_SA(b, h) (((b) * 2 + (h)) * HTB)
#define PG8_SB(b, h) ((4 + (b) * 2 + (h)) * HTB)
#define PG8_STAGE(bufoff, gbase, voff) do { _Pragma("unroll") for (int _i = 0; _i < 2; ++_i) \
        __builtin_amdgcn_global_load_lds((const unsigned*)((const char*)(gbase) + (voff)[_i]), (LAS unsigned*)(lds + (bufoff) + ldsw + _i * 8192), 16, 0, 0); } while (0)
#define PG8_LDA(dst, b, h) do { _Pragma("unroll") for (int m = 0; m < 4; ++m) _Pragma("unroll") for (int k = 0; k < 2; ++k) dst[m][k] = *(const LAS bf16x8*)(lds + PG8_SA(b, h) + aoff + m * 2048 + k * 1024); } while (0)
#define PG8_LDB(dst, b, h) do { _Pragma("unroll") for (int n = 0; n < 2; ++n) _Pragma("unroll") for (int k = 0; k < 2; ++k) dst[n][k] = *(const LAS bf16x8*)(lds + PG8_SB(b, h) + boff + n * 2048 + k * 1024); } while (0)
#define PG8_MMA(ai, bj, At, Bt) do { __builtin_amdgcn_s_setprio(1); _Pragma("unroll") for (int m = 0; m < 4; ++m) _Pragma("unroll") for (int n = 0; n < 2; ++n) _Pragma("unroll") for (int k = 0; k < 2; ++k) \
        acc[ai][bj][m][n] = __builtin_amdgcn_mfma_f32_16x16x32_bf16(Bt[n][k], At[m][k], acc[ai][bj][m][n], 0, 0, 0); __builtin_amdgcn_s_setprio(0); } while (0)
#define PG8_WAIT_V(n) asm volatile("s_waitcnt vmcnt(" #n ")" ::: "memory")
#define PG8_WAIT_L(n) asm volatile("s_waitcnt lgkmcnt(" #n ")" ::: "memory")
#define PG8_BAR __builtin_amdgcn_s_barrier()
#define PG8_SCHED __builtin_amdgcn_sched_barrier(0)
    Unit cur, nxt; int ui = 0;
    if (!S.next(0, cur)) return;
    f32x4 acc[2][2][4][2];
#pragma unroll
    for (int a = 0; a < 2; ++a)
#pragma unroll
        for (int b = 0; b < 2; ++b)
#pragma unroll
            for (int m = 0; m < 4; ++m)
#pragma unroll
                for (int n = 0; n < 2; ++n) acc[a][b][m][n] = (f32x4){0.f, 0.f, 0.f, 0.f};
    bf16x8 At[4][2], B0[2][2], B1[2][2];
    const char* cA = cur.A; const char* cB = cur.B;
    PG8_STAGE(PG8_SB(0, 0), cB, voffB); PG8_STAGE(PG8_SB(0, 1), cB + hstepB, voffB); PG8_STAGE(PG8_SA(0, 0), cA, voffA); PG8_STAGE(PG8_SA(0, 1), cA + hstepA, voffA);
    if (wr == 1) PG8_BAR;
    PG8_WAIT_V(2); PG8_BAR;
    PG8_STAGE(PG8_SB(1, 0), cB + kstep, voffB); PG8_STAGE(PG8_SA(1, 0), cA + kstep, voffA); PG8_STAGE(PG8_SB(1, 1), cB + hstepB + kstep, voffB);
    PG8_WAIT_V(6); PG8_BAR;
    for (;;) {
        const bool has_next = S.next(ui + 1, nxt);
        int nt = cur.nkt; asm volatile("" : "+s"(nt));
        const char* nA = has_next ? nxt.A : cA; const char* nB = has_next ? nxt.B : cB;
        for (int t = 0; t < nt; t += 2) {
            const bool last = (t == nt - 2);
            const char* a1 = cA + (size_t)(t + 1) * kstep;
            const char* a2 = last ? nA : cA + (size_t)(t + 2) * kstep; const char* b2 = last ? nB : cB + (size_t)(t + 2) * kstep;
            const char* a3 = a2 + kstep; const char* b3 = b2 + kstep;
            if constexpr (Epi::MIDK) { if (t == (nt >> 1)) E.mid(acc, cur, wr, wc, fr, fq); }
            PG8_LDB(B0, 0, 0); PG8_LDB(B1, 0, 1); PG8_SCHED; PG8_LDA(At, 0, 0); PG8_STAGE(PG8_SA(1, 1), a1 + hstepA, voffA);
            PG8_WAIT_V(8); PG8_WAIT_L(0); PG8_BAR; PG8_MMA(0, 0, At, B0); PG8_MMA(0, 1, At, B1); PG8_BAR; PG8_SCHED;
            PG8_LDA(At, 0, 1); PG8_STAGE(PG8_SB(0, 0), b2, voffB); PG8_STAGE(PG8_SB(0, 1), b2 + hstepB, voffB); PG8_STAGE(PG8_SA(0, 0), a2, voffA);
            PG8_WAIT_V(8); PG8_WAIT_L(0); PG8_BAR; PG8_MMA(1, 0, At, B0); PG8_MMA(1, 1, At, B1); PG8_BAR; PG8_SCHED;
            PG8_LDB(B0, 1, 0); PG8_LDB(B1, 1, 1); PG8_SCHED; PG8_LDA(At, 1, 0); PG8_STAGE(PG8_SA(0, 1), a2 + hstepA, voffA);
            PG8_WAIT_V(8); PG8_WAIT_L(0); PG8_BAR; PG8_MMA(0, 0, At, B0); PG8_MMA(0, 1, At, B1); PG8_BAR; PG8_SCHED;
            PG8_LDA(At, 1, 1); PG8_STAGE(PG8_SB(1, 0), b3, voffB); PG8_STAGE(PG8_SB(1, 1), b3 + hstepB, voffB); PG8_STAGE(PG8_SA(1, 0), a3, voffA);
            PG8_WAIT_V(8); PG8_WAIT_L(0); PG8_BAR; PG8_MMA(1, 0, At, B0); PG8_MMA(1, 1, At, B1); PG8_BAR; PG8_SCHED;
        }
        if constexpr (ALIGN_EPI) { if (wr == 0) PG8_BAR; }
        if constexpr (!Epi::AFTER_DRAIN) { int fr_ = fr, fq_ = fq; asm volatile("" : "+v"(fr_), "+v"(fq_)); E(acc, cur, wr, wc, fr_, fq_); }
        if (!has_next) break;
#pragma unroll
        for (int a = 0; a < 2; ++a)
#pragma unroll
            for (int b = 0; b < 2; ++b)
#pragma unroll
                for (int m = 0; m < 4; ++m)
#pragma unroll
                    for (int n = 0; n < 2; ++n) acc[a][b][m][n] = (f32x4){0.f, 0.f, 0.f, 0.f};
        cur = nxt; cA = nA; cB = nB; ++ui;
        if constexpr (ALIGN_EPI) { if (wr == 1) PG8_BAR; }
    }
    PG8_WAIT_V(0);
    if constexpr (!ALIGN_EPI) { if (wr == 0) PG8_BAR; }
    PG8_BAR;
    if constexpr (Epi::AFTER_DRAIN) { E.fused(acc, cur, wr, wc, fr, fq, lds, wid, lane); }
#undef PG8_SA
#undef PG8_SB
#undef PG8_STAGE
#undef PG8_LDA
#undef PG8_LDB
#undef PG8_MMA
#undef PG8_WAIT_V
#undef PG8_WAIT_L
#undef PG8_BAR
#undef PG8_SCHED
}

struct SchedRect {
    const char* A; const char* B; size_t atile, btile; int nM, nN, G, c, NT;
    __device__ __forceinline__ bool next(int i, Unit& u) const {
        const int L = i * G + c; if (L >= nM * nN) return false;
        int pm, pn; rect_order(L, nM, nN, pm, pn);
        u.A = A + (size_t)pm * atile; u.B = B + (size_t)pn * btile; u.orow = pm * BM; u.ocol = pn * BM; u.aux = 0; u.nkt = NT; return true;
    }
};
struct SchedIn {
    const char* A; const char* B; int G, c;
    __device__ __forceinline__ bool next(int i, Unit& u) const {
        const int L = i * G + c; if (L >= 1296 + 64) return false;
        int pm, pn;
        if (L < 1296) { rect_order(L, 36, 36, pm, pn); u.orow = pm * BM; u.ocol = pn * BM; u.aux = 0; }
        else { const int l = L - 1296; pm = 36 + (l & 3); pn = 36 + (l >> 2); u.orow = (pm - 36) * BM; u.ocol = (pn - 36) * BM; u.aux = 1; }
        u.A = A + (size_t)pm * (BM * DM * 2); u.B = B + (size_t)pn * (BM * DM * 2); u.nkt = DM / BK; return true;
    }
};
struct SchedSp {
    const char* WSP; const char* VT; int G, c;
    __device__ __forceinline__ bool next(int i, Unit& u) const {
        const int L = i * G + c; if (L >= 256) return false;
        const int chunk = L >> 2, p = (L >> 1) & 1, gi = L & 1, g = 2 * p + gi;
        u.A = WSP + (size_t)p * (256 * 128 * 2); u.B = VT + ((size_t)chunk * 1024 + g * 256) * 128 * 2; u.orow = chunk * 128; u.ocol = g * 256; u.aux = gi; u.nkt = 2; return true;
    }
};
struct SchedS {
    const char* Q; const char* KP; int G, c;
    __device__ __forceinline__ bool next(int i, Unit& u) const {
        const int L = i * G + c; if (L >= 128 || i > 0) return false;
        const int b = L >> 5, h = (L >> 3) & 3, p = L & 7;
        u.A = Q + ((size_t)(b * 2048 + p * 256) * DM + h * XD) * 2; u.B = KP + ((size_t)(b * 256) * DM + h * XD) * 2;
        u.orow = (b * 4 + h) * 2048 + p * 256; u.ocol = 0; u.aux = 0; u.nkt = XD / BK; return true;
    }
};
struct SchedO {
    const char* PS; const char* VPT; int G, c;
    __device__ __forceinline__ bool next(int i, Unit& u) const {
        const int L = i * G + c; if (L >= 256) return false;
        const int b = L >> 6, h = (L >> 4) & 3, p = (L >> 1) & 7, pn = L & 1;
        u.A = PS + ((size_t)((b * 4 + h) * 2048 + p * 256) * 256) * 2; u.B = VPT + ((size_t)(b * 2048 + h * XD + pn * 256) * 256) * 2;
        u.orow = b * 2048 + p * 256; u.ocol = h * XD + pn * 256; u.aux = 0; u.nkt = 4; return true;
    }
};


struct SchedTail {
    const char* A; const char* B; size_t atile, btile; int NT, G, c; bool tail;
    __device__ __forceinline__ bool next(int i, Unit& u) const {
        if (!tail) { const int L = i * G + c; if (L >= 288) return false; int pm, pn; rect_order(L, 36, 8, pm, pn);
            u.A = A + (size_t)pm * atile; u.B = B + (size_t)pn * btile; u.orow = pm * BM; u.ocol = pn * BM; u.aux = 0; u.nkt = NT; return true; }
        const int vcu = (c & 7) * 32 + (c >> 3);
        if (i == 0) { const int pm = vcu >> 3, pn = vcu & 7; u.A = A + (size_t)pm * atile; u.B = B + (size_t)pn * btile; u.orow = pm * BM; u.ocol = pn * BM; u.aux = 0; u.nkt = NT; return true; }
        if (i == 1) { const int t = vcu >> 3, s = vcu & 7, pm = 32 + (t >> 3), pn = t & 7, nk = NT >> 3;
            u.A = A + (size_t)pm * atile + (size_t)(s * nk) * (BK * 2); u.B = B + (size_t)pn * btile + (size_t)(s * nk) * (BK * 2);
            u.orow = (t >> 3) * BM; u.ocol = pn * BM; u.aux = 1 + s; u.nkt = nk; return true; }
        return false;
    }
};
#define EPI_ROWS_BEGIN _Pragma("unroll") for (int ai = 0; ai < 2; ++ai) _Pragma("unroll") for (int m = 0; m < 4; ++m) { const int rl = ai * HALF + wr * 64 + m * 16 + fr;
#define EPI_ROWS_END }

struct EpiIn {
    static constexpr bool PERM = true, AFTER_DRAIN = false, MIDK = false;
    bf16_t* P1; float* memk; float* memv; bf16_t* KP; bf16_t* VPT;
    __device__ __forceinline__ void operator()(const f32x4 (&acc)[2][2][4][2], const Unit& u, int wr, int wc, int fr, int fq) const {
        const int cl0 = wc * 32 + 8 * fq;
        if (u.aux == 0) {
            const bool gate = u.ocol >= C_GA;
            EPI_ROWS_BEGIN
                bf16_t* rowp = P1 + (size_t)(u.orow + rl) * NIN + u.ocol + cl0;
#pragma unroll
                for (int bj = 0; bj < 2; ++bj) { f32x4 v0 = acc[ai][bj][m][0], v1 = acc[ai][bj][m][1];
                    if (gate) {
                        const f32x4 g0 = acc[ai][1][m][0], g1 = acc[ai][1][m][1];
#pragma unroll
                        for (int e = 0; e < 4; ++e) { const float sb0 = sigmoidf_(g0[e]), sb1 = sigmoidf_(g1[e]);
                            if (bj == 0) { v0[e] = sigmoidf_(v0[e]) * __builtin_amdgcn_rcpf(fmaxf(sb0, 1e-30f)); v1[e] = sigmoidf_(v1[e]) * __builtin_amdgcn_rcpf(fmaxf(sb1, 1e-30f)); }
                            else { v0[e] = fmaxf(sb0, 1e-30f); v1[e] = fmaxf(sb1, 1e-30f); } } }
                    u32x4 w; w.x = cvt_pk_bf16(v0[0], v0[1]); w.y = cvt_pk_bf16(v0[2], v0[3]); w.z = cvt_pk_bf16(v1[0], v1[1]); w.w = cvt_pk_bf16(v1[2], v1[3]);
                    *(u32x4*)(rowp + bj * HALF) = w; }
            EPI_ROWS_END
        } else {
            const bool isV = u.ocol >= DM; const int cb = u.ocol - (isV ? DM : 0) + cl0;
            float* fo = isV ? memv : memk;
            EPI_ROWS_BEGIN
                const int row = u.orow + rl;
#pragma unroll
                for (int bj = 0; bj < 2; ++bj) { const f32x4 v0 = acc[ai][bj][m][0], v1 = acc[ai][bj][m][1]; const int col = cb + bj * HALF;
                    *(f32x4*)(fo + (size_t)row * DM + col) = v0; *(f32x4*)(fo + (size_t)row * DM + col + 4) = v1;
                    u32x4 w; w.x = cvt_pk_bf16(v0[0], v0[1]); w.y = cvt_pk_bf16(v0[2], v0[3]); w.z = cvt_pk_bf16(v1[0], v1[1]); w.w = cvt_pk_bf16(v1[2], v1[3]);
                    if (!isV) { *(u32x4*)(KP + (size_t)row * DM + col) = w; }
                    else { bf16_t* vp = VPT + ((size_t)(row >> 8) * DM + col) * 256 + (row & 255);
                        vp[0 * 256] = (bf16_t)(w.x & 0xffff); vp[1 * 256] = (bf16_t)(w.x >> 16); vp[2 * 256] = (bf16_t)(w.y & 0xffff); vp[3 * 256] = (bf16_t)(w.y >> 16);
                        vp[4 * 256] = (bf16_t)(w.z & 0xffff); vp[5 * 256] = (bf16_t)(w.z >> 16); vp[6 * 256] = (bf16_t)(w.w & 0xffff); vp[7 * 256] = (bf16_t)(w.w >> 16); } }
            EPI_ROWS_END
        }
    }
};
struct EpiSp {
    static constexpr bool PERM = true, AFTER_DRAIN = false, MIDK = false;
    const bf16_t* P1; const float* bsp; bf16_t* YA;
    __device__ __forceinline__ void operator()(const f32x4 (&acc)[2][2][4][2], const Unit& u, int wr, int wc, int fr, int fq) const {
        const int g = u.ocol >> 8, cl0 = wc * 32 + 8 * fq;
#pragma unroll
        for (int ai = 0; ai < 2; ++ai) if (ai == u.aux) {
#pragma unroll
            for (int m = 0; m < 4; ++m) { const int t = wr * 64 + m * 16 + fr; const int row = u.orow + t; const float bs = bsp[g * 128 + t];
#pragma unroll
                for (int bj = 0; bj < 2; ++bj) { const int col = u.ocol + bj * HALF + cl0;
                    const u32x4 uw = *(const u32x4*)(P1 + (size_t)row * NIN + C_U + col); float uf[8]; unpack8(uw, uf);
                    const f32x4 v0 = acc[ai][bj][m][0], v1 = acc[ai][bj][m][1];
                    u32x4 w; w.x = cvt_pk_bf16(uf[0] * (v0[0] + bs), uf[1] * (v0[1] + bs)); w.y = cvt_pk_bf16(uf[2] * (v0[2] + bs), uf[3] * (v0[3] + bs));
                    w.z = cvt_pk_bf16(uf[4] * (v1[0] + bs), uf[5] * (v1[1] + bs)); w.w = cvt_pk_bf16(uf[6] * (v1[2] + bs), uf[7] * (v1[3] + bs));
                    *(u32x4*)(YA + (size_t)row * DM + col) = w; } }
        }
    }
};
struct EpiMerged {
    static constexpr bool PERM = true, AFTER_DRAIN = false, MIDK = true;
    const bf16_t* P1; bf16_t* MRG;
    __device__ __forceinline__ void mid(f32x4 (&acc)[2][2][4][2], const Unit& u, int wr, int wc, int fr, int fq) const {
        asm volatile("" : "+v"(fr), "+v"(fq));
        const bf16_t* pb = P1 + (size_t)(u.orow + wr * 64 + fr) * NIN + C_GA + (u.ocol >> 7) * 256 + wc * 32 + 8 * fq;
#pragma unroll
        for (int ai = 0; ai < 2; ++ai) {
            u32x4 r[4][2];
#pragma unroll
            for (int m = 0; m < 4; ++m)
#pragma unroll
                for (int bj = 0; bj < 2; ++bj) r[m][bj] = *(const u32x4*)(pb + (size_t)(ai * HALF + m * 16) * NIN + bj * 256);
#pragma unroll
            for (int m = 0; m < 4; ++m)
#pragma unroll
                for (int bj = 0; bj < 2; ++bj) { float f[8]; unpack8(r[m][bj], f);
#pragma unroll
                    for (int e = 0; e < 4; ++e) { acc[ai][bj][m][0][e] *= f[e]; acc[ai][bj][m][1][e] *= f[4 + e]; } }
            asm volatile("" ::: "memory");
        }
    }
    __device__ __forceinline__ void operator()(const f32x4 (&acc)[2][2][4][2], const Unit& u, int wr, int wc, int fr, int fq) const {
        const int cl0 = wc * 32 + 8 * fq;
        const bf16_t* pb = P1 + (size_t)(u.orow + wr * 64 + fr) * NIN + C_GA + (u.ocol >> 7) * 256 + 128 + cl0;
        EPI_ROWS_BEGIN
            const int row = u.orow + rl;
#pragma unroll
            for (int bj = 0; bj < 2; ++bj) { const int col = u.ocol + bj * HALF + cl0;
                float sb[8]; unpack8(*(const u32x4*)(pb + (size_t)(ai * HALF + m * 16) * NIN + bj * 256), sb);
                const f32x4 v0 = acc[ai][bj][m][0], v1 = acc[ai][bj][m][1];
                u32x4 w; w.x = cvt_pk_bf16(v0[0] * sb[0], v0[1] * sb[1]); w.y = cvt_pk_bf16(v0[2] * sb[2], v0[3] * sb[3]); w.z = cvt_pk_bf16(v1[0] * sb[4], v1[1] * sb[5]); w.w = cvt_pk_bf16(v1[2] * sb[6], v1[3] * sb[7]);
                *(u32x4*)(MRG + (size_t)row * DM + col) = w; }
        EPI_ROWS_END
    }
};
struct EpiRes {
    static constexpr bool PERM = false, AFTER_DRAIN = false, MIDK = false;
    const float* resA; const float* resB; int split; float* out;
    __device__ __forceinline__ void operator()(const f32x4 (&acc)[2][2][4][2], const Unit& u, int wr, int wc, int fr, int fq) const {
        const float* rbase = (u.orow < split) ? resA + (size_t)u.orow * DM : resB + (size_t)(u.orow - split) * DM;
        float* obase = out + (size_t)u.orow * DM;
        EPI_ROWS_BEGIN
#pragma unroll
            for (int bj = 0; bj < 2; ++bj)
#pragma unroll
                for (int n = 0; n < 2; ++n) { const size_t off = (size_t)rl * DM + u.ocol + bj * HALF + wc * 32 + 16 * n + 4 * fq;
                    const f32x4 r = *(const f32x4*)(rbase + off); *(f32x4*)(obase + off) = r + acc[ai][bj][m][n]; }
        EPI_ROWS_END
    }
};
template <int MODE  > struct EpiBf {
    static constexpr bool PERM = true, AFTER_DRAIN = false, MIDK = false;
    bf16_t* O; int ldc; float scale;
    __device__ __forceinline__ void operator()(const f32x4 (&acc)[2][2][4][2], const Unit& u, int wr, int wc, int fr, int fq) const {
        const int cl0 = wc * 32 + 8 * fq;
        EPI_ROWS_BEGIN
            bf16_t* rowp = O + (size_t)(u.orow + rl) * ldc + u.ocol + cl0;
#pragma unroll
            for (int bj = 0; bj < 2; ++bj) { f32x4 v0 = acc[ai][bj][m][0], v1 = acc[ai][bj][m][1];
                if (MODE == 0) { v0 = v0 * scale; v1 = v1 * scale; }
                else {
#pragma unroll
                    for (int e = 0; e < 4; ++e) { const float a = fmaxf(v0[e], 0.f), b = fmaxf(v1[e], 0.f); v0[e] = a * a; v1[e] = b * b; } }
                u32x4 w; w.x = cvt_pk_bf16(v0[0], v0[1]); w.y = cvt_pk_bf16(v0[2], v0[3]); w.z = cvt_pk_bf16(v1[0], v1[1]); w.w = cvt_pk_bf16(v1[2], v1[3]);
                *(u32x4*)(rowp + bj * HALF) = w; }
        EPI_ROWS_END
    }
};
struct EpiSoftmax {
    static constexpr bool PERM = true, AFTER_DRAIN = true, MIDK = false;
    bf16_t* PS;
    __device__ __forceinline__ void fused(f32x4 (&acc)[2][2][4][2], const Unit& u, int wr, int wc, int fr, int fq, LAS unsigned char* lds, int wid, int lane) const {
        LAS f32x2* X = (LAS f32x2*)lds;
        float mxl[2][4];
        EPI_ROWS_BEGIN
            float mx = -3.0e38f;
#pragma unroll
            for (int bj = 0; bj < 2; ++bj)
#pragma unroll
                for (int n = 0; n < 2; ++n) { const f32x4 v = acc[ai][bj][m][n]; mx = fmaxf(mx, fmaxf(fmaxf(v[0], v[1]), fmaxf(v[2], v[3]))); }
            mx = fmaxf(mx, __shfl_xor(mx, 16)); mx = fmaxf(mx, __shfl_xor(mx, 32));
            float s = 0.f;
#pragma unroll
            for (int bj = 0; bj < 2; ++bj)
#pragma unroll
                for (int n = 0; n < 2; ++n) { f32x4 v = acc[ai][bj][m][n];
#pragma unroll
                    for (int e = 0; e < 4; ++e) { v[e] = __expf(v[e] - mx); s += v[e]; }
                    acc[ai][bj][m][n] = v; }
            s += __shfl_xor(s, 16); s += __shfl_xor(s, 32);
            mxl[ai][m] = mx;
            if (fq == 0) X[rl * 4 + wc] = (f32x2){mx, s};
        EPI_ROWS_END
        LDS_WAIT(); __builtin_amdgcn_s_barrier(); asm volatile("" ::: "memory");
        const int cl0 = wc * 32 + 8 * fq;
        EPI_ROWS_BEGIN
            const f32x2 a = X[rl * 4 + 0], b = X[rl * 4 + 1], c = X[rl * 4 + 2], d = X[rl * 4 + 3];
            const float M = fmaxf(fmaxf(a.x, b.x), fmaxf(c.x, d.x));
            const float L = a.y * __expf(a.x - M) + b.y * __expf(b.x - M) + c.y * __expf(c.x - M) + d.y * __expf(d.x - M);
            const float f = __expf(mxl[ai][m] - M) / L;
            bf16_t* rowp = PS + (size_t)(u.orow + rl) * 256 + cl0;
#pragma unroll
            for (int bj = 0; bj < 2; ++bj) { const f32x4 v0 = acc[ai][bj][m][0] * f, v1 = acc[ai][bj][m][1] * f;
                u32x4 w; w.x = cvt_pk_bf16(v0[0], v0[1]); w.y = cvt_pk_bf16(v0[2], v0[3]); w.z = cvt_pk_bf16(v1[0], v1[1]); w.w = cvt_pk_bf16(v1[2], v1[3]);
                *(u32x4*)(rowp + bj * HALF) = w; }
        EPI_ROWS_END
        LDS_WAIT(); __builtin_amdgcn_s_barrier(); asm volatile("" ::: "memory");
    }
};

template <class Base> struct EpiTail {
    static constexpr bool PERM = Base::PERM, AFTER_DRAIN = false, MIDK = false;
    Base base; bf16_t* part;
    __device__ __forceinline__ void operator()(const f32x4 (&acc)[2][2][4][2], const Unit& u, int wr, int wc, int fr, int fq) const {
        if (u.aux == 0) { base(acc, u, wr, wc, fr, fq); return; }
        bf16_t* pb = part + (size_t)(u.aux - 1) * (MS * DM) + (size_t)u.orow * DM + u.ocol;
        EPI_ROWS_BEGIN
#pragma unroll
            for (int bj = 0; bj < 2; ++bj) {
                if (PERM) { const f32x4 v0 = acc[ai][bj][m][0], v1 = acc[ai][bj][m][1];
                    u32x4 w; w.x = cvt_pk_bf16(v0[0], v0[1]); w.y = cvt_pk_bf16(v0[2], v0[3]); w.z = cvt_pk_bf16(v1[0], v1[1]); w.w = cvt_pk_bf16(v1[2], v1[3]);
                    *(u32x4*)(pb + (size_t)rl * DM + bj * HALF + wc * 32 + 8 * fq) = w; }
                else {
#pragma unroll
                    for (int n = 0; n < 2; ++n) { const f32x4 v = acc[ai][bj][m][n]; u32x2 w; w.x = cvt_pk_bf16(v[0], v[1]); w.y = cvt_pk_bf16(v[2], v[3]);
                        *(u32x2*)(pb + (size_t)rl * DM + bj * HALF + wc * 32 + 16 * n + 4 * fq) = w; } }
            }
        EPI_ROWS_END
    }
};
}


#define XB_TMO      128
#define XB_XCNT(j)  (256  + 64 * (j))
#define XB_XSUB(j)  (1280 + 64 * (j))
#define XB_XGEN(j)  (2304 + 64 * (j))
#define XB_TOP      3328
#define XB_TOPGEN   3392
#define XCD_BAR_WORDS 3456
#define XB_SPIN_CAP (1u << 18)
__device__ __forceinline__ unsigned xb_ld(unsigned* p)              { return __hip_atomic_load(p, __ATOMIC_RELAXED, __HIP_MEMORY_SCOPE_AGENT); }
__device__ __forceinline__ unsigned xb_add(unsigned* p, unsigned v) { return __hip_atomic_fetch_add(p, v, __ATOMIC_RELAXED, __HIP_MEMORY_SCOPE_AGENT); }
__device__ __forceinline__ unsigned xb_xcc_id() { return (unsigned)__builtin_amdgcn_s_getreg((3 << 11) | 20) & 0xFu; }
#define XB_SPIN(cond, bar) do { unsigned _sp = 0; while (cond) { __builtin_amdgcn_s_sleep(1); \
    if ((++_sp & 255u) == 0u) { if (xb_ld(&(bar)[XB_TMO])) break; if (_sp > XB_SPIN_CAP) { atomicAdd(&(bar)[XB_TMO], 1u); break; } } } } while (0)
struct XcdBarrier { unsigned* bar; unsigned x; volatile LAS unsigned* st; };
__device__ __forceinline__ XcdBarrier xcd_barrier_post(unsigned* bar, volatile LAS unsigned* st) {
    XcdBarrier b; b.bar = bar; b.x = xb_xcc_id(); b.st = st;
    if (threadIdx.x == 0) (void)xb_add(&bar[XB_XCNT(b.x)], 1u);
    return b;
}
__device__ __forceinline__ void xcd_barrier_complete(unsigned* bar, unsigned x, unsigned& nloc, unsigned& nx) {
    const unsigned G = gridDim.x * gridDim.y * gridDim.z;
    unsigned sum, cnt, mine, sp = 0u;
    for (;;) {
        sum = 0u; cnt = 0u; mine = 0u;
#pragma unroll
        for (unsigned j = 0; j < 16; ++j) { const unsigned c = xb_ld(&bar[XB_XCNT(j)]); sum += c; cnt += (c > 0u) ? 1u : 0u; mine = (j == x) ? c : mine; }
        if (sum == G) break;
        __builtin_amdgcn_s_sleep(1);
        if ((++sp & 255u) == 0u) { if (xb_ld(&bar[XB_TMO])) break; if (sp > XB_SPIN_CAP) { atomicAdd(&bar[XB_TMO], 1u); break; } }
    }
    nloc = mine > 0u ? mine : 1u; nx = cnt > 0u ? cnt : 1u;
}
__device__ __forceinline__ void xcd_barrier(const XcdBarrier& b) {
    asm volatile("s_waitcnt vmcnt(0)" ::: "memory");
    __syncthreads();
    if (threadIdx.x == 0) {
        unsigned* bar = b.bar;
        __builtin_amdgcn_s_waitcnt(0);
        unsigned nloc = b.st[0], nx = b.st[1];
        if (nloc == 0u) { xcd_barrier_complete(bar, b.x, nloc, nx); b.st[0] = nloc; b.st[1] = nx; }
        const unsigned old = xb_add(&bar[XB_XSUB(b.x)], 1u);
        const unsigned gen = old / nloc;
        if (old + 1u == (gen + 1u) * nloc) {
            __builtin_amdgcn_fence(__ATOMIC_RELEASE, "agent");
            asm volatile("s_waitcnt vmcnt(0)" ::: "memory");
            const unsigned og = xb_add(&bar[XB_TOP], 1u);
            const unsigned tg = og / nx;
            if (og + 1u == (tg + 1u) * nx) xb_add(&bar[XB_TOPGEN], 1u);
            else XB_SPIN(xb_ld(&bar[XB_TOPGEN]) == tg, bar);
            __builtin_amdgcn_fence(__ATOMIC_ACQUIRE, "agent");
            xb_add(&bar[XB_XGEN(b.x)], 1u);
            asm volatile("s_waitcnt vmcnt(0)" ::: "memory");
        } else {
            XB_SPIN(xb_ld(&bar[XB_XGEN(b.x)]) == gen, bar);
            __builtin_amdgcn_fence(__ATOMIC_ACQUIRE, "agent");
            asm volatile("s_waitcnt vmcnt(0)" ::: "memory");
        }
    }
    __syncthreads();
}

struct Args { const float* in[26]; float* out; unsigned char* ws; };

struct Frame {
    LAS unsigned char* lds;
    int tid, lane, wave, G, bx;
    float* out; unsigned char* ws;
};
typedef const float* cfp_t;
__device__ __forceinline__ const float* karg_in(int i) {
    asm volatile("" : "+s"(i));
    const __attribute__((address_space(4))) cfp_t* ka = (const __attribute__((address_space(4))) cfp_t*)__builtin_amdgcn_kernarg_segment_ptr();
    return ka[i];
}
#define IN(i) karg_in(i)
#define WSP(T, off) ((T*)(F.ws + (off)))

__device__ __forceinline__ void p0_transpose_item(const float* W, int K, int N, bf16_t* WT, int row_off, LAS float* scr, int item, int lane, int ldk, int koff) {
    const int nblk = N / 32, kb = item / nblk, nb = item % nblk, k0 = 64 * kb, n0 = 32 * nb;
#pragma unroll 8
    for (int i = 0; i < 32; ++i) { const int kk = 2 * i + (lane >> 5); scr[kk * 33 + (lane & 31)] = W[(size_t)(k0 + kk) * N + n0 + (lane & 31)]; }
    LDS_WAIT(); asm volatile("" ::: "memory");
    const int c = lane & 7;
#pragma unroll
    for (int j = 0; j < 4; ++j) { const int n = (lane >> 3) + 8 * j; const LAS float* s = scr + (8 * c) * 33 + n;
        u32x4 o; o.x = cvt_pk_bf16(s[0 * 33], s[1 * 33]); o.y = cvt_pk_bf16(s[2 * 33], s[3 * 33]); o.z = cvt_pk_bf16(s[4 * 33], s[5 * 33]); o.w = cvt_pk_bf16(s[6 * 33], s[7 * 33]);
        *(u32x4*)(WT + (size_t)(row_off + n0 + n) * ldk + koff + k0 + 8 * c) = o; }
    LDS_WAIT(); asm volatile("" ::: "memory");
}
template <bool OUT_F32> __device__ __forceinline__ void rms_row(const float* xrow, const float* g, void* orow, int lane) {
    const f32x4* xr = (const f32x4*)xrow + lane; f32x4 v[8]; float ss = 0.f;
#pragma unroll
    for (int j = 0; j < 8; ++j) { v[j] = xr[64 * j]; ss += (v[j].x * v[j].x + v[j].y * v[j].y) + (v[j].z * v[j].z + v[j].w * v[j].w); }
    const float r = rsqrtf(wave_sum(ss) * (1.f / DM) + EPS);
    const f32x4* gr = (const f32x4*)g + lane;
#pragma unroll
    for (int j = 0; j < 8; ++j) { const f32x4 gg = gr[64 * j]; const f32x4 o = v[j] * r * gg;
        if (OUT_F32) ((f32x4*)orow)[lane + 64 * j] = o;
        else { u32x2 w; w.x = cvt_pk_bf16(o.x, o.y); w.y = cvt_pk_bf16(o.z, o.w); ((u32x2*)orow)[lane + 64 * j] = w; } }
}

constexpr int I_IN = 32 * 288, I_SQ = 32 * 64, I_BR = 16 * 64, I_UP = 32 * 256, I_DN = 128 * 64;
constexpr int CV_A0 = 0, CV_A1 = I_IN + 2 * I_SQ;
constexpr int CV_B1 = CV_A1 + 3 * I_SQ + 2 * I_BR;
constexpr int CV_C1 = CV_B1 + I_UP;
constexpr int CV_D1 = CV_C1 + I_DN;
__device__ __forceinline__ void convert_one(Frame& F, int it, LAS float* scr) {
    int r = it, K = DM, N = DM, ro = 0, ldk = DM, koff = 0, src_i; size_t wso;
    if (r < I_IN) { src_i = 7; N = NIN; wso = WS_WIN; const int n0 = 32 * (r % 288);
        if (n0 >= C_GB) { const int j = n0 - C_GB; ro = C_GA + (j >> 7) * 256 + 128 + (j & 127) - n0; }
        else if (n0 >= C_GA) { const int j = n0 - C_GA; ro = C_GA + (j >> 7) * 256 + (j & 127) - n0; } }
    else if ((r -= I_IN) < I_SQ) { src_i = 19; wso = WS_WIN; ro = NIN; }
    else if ((r -= I_SQ) < I_SQ) { src_i = 20; wso = WS_WIN; ro = NIN + DM; }
    else if ((r -= I_SQ) < I_SQ) { src_i = 15; wso = WS_WMIX; }
    else if ((r -= I_SQ) < I_SQ) { src_i = 18; wso = WS_WQ; }
    else if ((r -= I_SQ) < I_SQ) { src_i = 21; wso = WS_WXO; }
    else if ((r -= I_SQ) < I_BR) { src_i = 13; wso = WS_WA; K = 1024; }
    else if ((r -= I_BR) < I_BR) { src_i = 14; wso = WS_WA; K = 1024; koff = 1024; }
    else if ((r -= I_BR) < I_UP) { src_i = 23; wso = WS_WUP; N = FF; }
    else { r -= I_UP; src_i = 24; wso = WS_WDN; K = FF; ldk = FF; }
    p0_transpose_item(IN(src_i), K, N, (bf16_t*)(F.ws + wso), ro, scr, r, F.lane, ldk, koff);
}
__device__ __forceinline__ void convert_fill(Frame& F, int i0, int i1, int n_units) {
    const int rounds = (n_units + F.G - 1) / F.G, nfull = n_units - (rounds - 1) * F.G;
    int slot = F.bx - nfull, nslots = F.G - nfull;
    if (nslots == 0) { slot = F.bx; nslots = F.G; }
    if (slot < 0) return;
    LAS float* scr = (LAS float*)(F.lds + F.wave * 16384);
    for (int it = i0 + slot * NWAVES + F.wave; it < i1; it += nslots * NWAVES) convert_one(F, it, scr);
}
__device__ __forceinline__ void phase_prologue(Frame& F) {
    LAS float* scr = (LAS float*)(F.lds + F.wave * 16384);
    const int gw = F.bx * NWAVES + F.wave, NGW = F.G * NWAVES;
    for (int it = CV_A0 + gw; it < CV_A1; it += NGW) convert_one(F, it, scr);
    bf16_t* XN = WSP(bf16_t, WS_XN);
    for (int m = gw; m < MT + 1024; m += NGW) {
        const float* src = m < MP ? IN(0) + (size_t)m * DM : (m < MT ? IN(1) + (size_t)(m - MP) * DM : IN(5) + (size_t)(m - MT) * DM);
        rms_row<false>(src, m < MT ? IN(6) : IN(17), XN + (size_t)m * DM, F.lane);
    }
    bf16_t* WS = WSP(bf16_t, WS_WSP);
    for (int i = F.bx * 512 + F.tid; i < 4 * 128 * 128; i += F.G * 512) { const int t = (i >> 7) & 127, s = i & 127; const float w = (s <= t) ? IN(10)[i] : 0.f; WS[i] = (bf16_t)(cvt_pk_bf16(w, 0.f) & 0xffff); }
}

__device__ __forceinline__ void phase_mixprep(Frame& F) {
    const bf16_t* P1 = WSP(bf16_t, WS_P1);
    {
        bf16_t* YB = WSP(bf16_t, WS_YA);   const float* cw = IN(12); const float* st = IN(2);
        for (int it = F.bx * 512 + F.tid; it < MT * 128; it += F.G * 512) {
            const int row = it >> 7, c0 = (it & 127) * 8;
            const bf16_t* pr = P1 + (size_t)row * NIN;
            float cg[8], xi[8], p0[8], p1[8], p2[8], bg[8];
            unpack8(*(const u32x4*)(pr + C_CG + c0), cg); unpack8(*(const u32x4*)(pr + C_XIN + c0), xi); unpack8(*(const u32x4*)(pr + C_BG + c0), bg);
#pragma unroll
            for (int e = 0; e < 8; ++e) p0[e] = cg[e] * xi[e];
            int pos, b; const bool prompt = row < MP;
            if (prompt) { pos = row & 2047; b = row >> 11; } else { pos = (row - MP) & 7; b = (row - MP) >> 3; }
            if (pos >= 1) { unpack8(*(const u32x4*)(pr - NIN + C_CG + c0), cg); unpack8(*(const u32x4*)(pr - NIN + C_XIN + c0), xi);
#pragma unroll
                for (int e = 0; e < 8; ++e) p1[e] = cg[e] * xi[e]; }
            else if (prompt) {
#pragma unroll
                for (int e = 0; e < 8; ++e) p1[e] = 0.f; }
            else { const f32x4 a = *(const f32x4*)(st + ((size_t)b * 2 + 1) * 1024 + c0), c = *(const f32x4*)(st + ((size_t)b * 2 + 1) * 1024 + c0 + 4);
                p1[0] = a.x; p1[1] = a.y; p1[2] = a.z; p1[3] = a.w; p1[4] = c.x; p1[5] = c.y; p1[6] = c.z; p1[7] = c.w; }
            if (pos >= 2) { unpack8(*(const u32x4*)(pr - 2 * NIN + C_CG + c0), cg); unpack8(*(const u32x4*)(pr - 2 * NIN + C_XIN + c0), xi);
#pragma unroll
                for (int e = 0; e < 8; ++e) p2[e] = cg[e] * xi[e]; }
            else if (prompt) {
#pragma unroll
                for (int e = 0; e < 8; ++e) p2[e] = 0.f; }
            else { const int sr = (pos == 1) ? 1 : 0; const f32x4 a = *(const f32x4*)(st + ((size_t)b * 2 + sr) * 1024 + c0), c = *(const f32x4*)(st + ((size_t)b * 2 + sr) * 1024 + c0 + 4);
                p2[0] = a.x; p2[1] = a.y; p2[2] = a.z; p2[3] = a.w; p2[4] = c.x; p2[5] = c.y; p2[6] = c.z; p2[7] = c.w; }
            float y[8];
#pragma unroll
            for (int e = 0; e < 8; ++e) y[e] = bg[e] * (cw[c0 + e] * p2[e] + cw[1024 + c0 + e] * p1[e] + cw[2048 + c0 + e] * p0[e]);
            u32x4 w; w.x = cvt_pk_bf16(y[0], y[1]); w.y = cvt_pk_bf16(y[2], y[3]); w.z = cvt_pk_bf16(y[4], y[5]); w.w = cvt_pk_bf16(y[6], y[7]);
            *(u32x4*)(YB + (size_t)row * DM + 1024 + c0) = w;
            const int tail = prompt ? 2046 : 6;
            if (pos >= tail) { float* o = F.out + (prompt ? O_CP : O_CS) + ((size_t)b * 2 + (pos - tail)) * 1024 + c0;
                *(f32x4*)o = (f32x4){p0[0], p0[1], p0[2], p0[3]}; *(f32x4*)(o + 4) = (f32x4){p0[4], p0[5], p0[6], p0[7]}; }
        }
    }
    {
        const float* lg = IN(8); const float* lb = IN(9); const float* wsp = IN(10); const float* bsp = IN(11);
        bf16_t* YA = WSP(bf16_t, WS_YA);
        const int gw = F.bx * NWAVES + F.wave, NGW = F.G * NWAVES;
        for (int sq = gw; sq < 128; sq += NGW) {
            const int row0 = MP + sq * 8;
            float mu[8], rs[8];
#pragma unroll
            for (int t = 0; t < 8; ++t) {
                const bf16_t* pr = P1 + (size_t)(row0 + t) * NIN + C_V + 8 * F.lane;
                float a[8], b[8]; unpack8(*(const u32x4*)pr, a); unpack8(*(const u32x4*)(pr + 512), b);
                float s = 0.f;
#pragma unroll
                for (int e = 0; e < 8; ++e) s += a[e] + b[e];
                const float mean = wave_sum(s) * (1.f / 1024.f); float q = 0.f;
#pragma unroll
                for (int e = 0; e < 8; ++e) { const float da = a[e] - mean, db = b[e] - mean; q += da * da + db * db; }
                mu[t] = mean; rs[t] = rsqrtf(wave_sum(q) * (1.f / 1024.f) + EPS);
                asm volatile("" ::: "memory");
            }
#pragma unroll
            for (int j = 0; j < 2; ++j) {
                const int c0 = 8 * F.lane + 512 * j, g = c0 >> 8;
                float gg[8], bb[8];
                { const f32x4 a = *(const f32x4*)(lg + c0), b = *(const f32x4*)(lg + c0 + 4), c = *(const f32x4*)(lb + c0), d = *(const f32x4*)(lb + c0 + 4);
                  gg[0] = a.x; gg[1] = a.y; gg[2] = a.z; gg[3] = a.w; gg[4] = b.x; gg[5] = b.y; gg[6] = b.z; gg[7] = b.w;
                  bb[0] = c.x; bb[1] = c.y; bb[2] = c.z; bb[3] = c.w; bb[4] = d.x; bb[5] = d.y; bb[6] = d.z; bb[7] = d.w; }
                float vl[8][8];
#pragma unroll
                for (int t = 0; t < 8; ++t) {
                    float a[8]; unpack8(*(const u32x4*)(P1 + (size_t)(row0 + t) * NIN + C_V + c0), a);
#pragma unroll
                    for (int e = 0; e < 8; ++e) vl[t][e] = (a[e] - mu[t]) * rs[t] * gg[e] + bb[e];
                    float* o = F.out + O_CV + (size_t)(sq * 8 + t) * 1024 + c0;
                    *(f32x4*)o = (f32x4){vl[t][0], vl[t][1], vl[t][2], vl[t][3]}; *(f32x4*)(o + 4) = (f32x4){vl[t][4], vl[t][5], vl[t][6], vl[t][7]};
                }
#pragma unroll
                for (int t = 0; t < 8; ++t) {
                    float z[8]; const float bs = bsp[g * 128 + t];
#pragma unroll
                    for (int e = 0; e < 8; ++e) z[e] = bs;
#pragma unroll
                    for (int s = 0; s < 8; ++s) if (s <= t) { const float w = wsp[(size_t)g * 16384 + t * 128 + s];
#pragma unroll
                        for (int e = 0; e < 8; ++e) z[e] += w * vl[s][e]; }
                    float uf[8]; unpack8(*(const u32x4*)(P1 + (size_t)(row0 + t) * NIN + C_U + c0), uf);
                    u32x4 w; w.x = cvt_pk_bf16(uf[0] * z[0], uf[1] * z[1]); w.y = cvt_pk_bf16(uf[2] * z[2], uf[3] * z[3]); w.z = cvt_pk_bf16(uf[4] * z[4], uf[5] * z[5]); w.w = cvt_pk_bf16(uf[6] * z[6], uf[7] * z[7]);
                    *(u32x4*)(YA + (size_t)(row0 + t) * DM + c0) = w;
                }
            }
        }
    }
    {
        const float* lg = IN(8); const float* lb = IN(9);
        bf16_t* VT = WSP(bf16_t, WS_VT);
        LAS bf16_t* T = (LAS bf16_t*)F.lds;
        for (int un = F.bx; un < 256; un += F.G) {
            const int chunk = un >> 2, g = un & 3;
            const bool mine = ((F.lane >> 5) == (g & 1));
            const int cm = 256 * g + 8 * (F.lane & 31);
            float gg[8], bb[8];
            { const f32x4 a = *(const f32x4*)(lg + cm), b = *(const f32x4*)(lg + cm + 4), c = *(const f32x4*)(lb + cm), d = *(const f32x4*)(lb + cm + 4);
              gg[0] = a.x; gg[1] = a.y; gg[2] = a.z; gg[3] = a.w; gg[4] = b.x; gg[5] = b.y; gg[6] = b.z; gg[7] = b.w;
              bb[0] = c.x; bb[1] = c.y; bb[2] = c.z; bb[3] = c.w; bb[4] = d.x; bb[5] = d.y; bb[6] = d.z; bb[7] = d.w; }
            for (int rr = 0; rr < 16; ++rr) {
                const int s = F.wave * 16 + rr;
                const bf16_t* pr = P1 + (size_t)(chunk * 128 + s) * NIN + C_V + 8 * F.lane;
                float a[8], b[8]; unpack8(*(const u32x4*)pr, a); unpack8(*(const u32x4*)(pr + 512), b);
                float sm = 0.f;
#pragma unroll
                for (int e = 0; e < 8; ++e) sm += a[e] + b[e];
                const float mean = wave_sum(sm) * (1.f / 1024.f); float q = 0.f;
#pragma unroll
                for (int e = 0; e < 8; ++e) { const float da = a[e] - mean, db = b[e] - mean; q += da * da + db * db; }
                const float rstd = rsqrtf(wave_sum(q) * (1.f / 1024.f) + EPS);
                if (mine) {
                    float y[8];
#pragma unroll
                    for (int e = 0; e < 8; ++e) { const float x = (g >> 1) ? b[e] : a[e]; y[e] = (x - mean) * rstd * gg[e] + bb[e]; }
                    u32x4 w; w.x = cvt_pk_bf16(y[0], y[1]); w.y = cvt_pk_bf16(y[2], y[3]); w.z = cvt_pk_bf16(y[4], y[5]); w.w = cvt_pk_bf16(y[6], y[7]);
                    *(LAS u32x4*)(T + s * 264 + 8 * (F.lane & 31)) = w;
                }
            }
            __syncthreads();
#pragma unroll 2
            for (int itn = 0; itn < 8; ++itn) {
                const int idx = itn * 512 + F.tid, c = idx >> 4, sb = idx & 15;
                unsigned short h[8];
#pragma unroll
                for (int i = 0; i < 8; ++i) h[i] = T[(8 * sb + i) * 264 + c];
                u32x4 w; w.x = (unsigned)h[0] | ((unsigned)h[1] << 16); w.y = (unsigned)h[2] | ((unsigned)h[3] << 16); w.z = (unsigned)h[4] | ((unsigned)h[5] << 16); w.w = (unsigned)h[6] | ((unsigned)h[7] << 16);
                *(u32x4*)(VT + ((size_t)chunk * 1024 + g * 256 + c) * 128 + 8 * sb) = w;
            }
            __syncthreads();
        }
    }
}

__device__ __forceinline__ void sample_attn_unit(Frame& F, int unit, bool tail) {
    const int b = unit >> 2, h = unit & 3, lane = F.lane, wave = F.wave, r16 = lane & 15, kq = lane >> 4;
    const float* Kb = IN(3) + ((size_t)b * NMEM * XH + h) * XD;
    const float* Vb = IN(4) + ((size_t)b * NMEM * XH + h) * XD;
    const bf16_t* Qb = WSP(bf16_t, WS_Q) + (size_t)(MP + b * 8) * DM + h * XD;
    LAS bf16_t* sP = (LAS bf16_t*)F.lds;
    LAS float* sSt = (LAS float*)(F.lds + 16 * 528);
    LAS bf16_t* sQ = (LAS bf16_t*)(F.lds + 9472);
    if (tail) {
        const int t = F.tid >> 6, d0 = (F.tid & 63) * 8;
        const bf16_t* pp = WSP(bf16_t, WS_PART) + (size_t)(b * 8 + t) * DM + h * XD + d0;
        f32x4 a0 = {0.f, 0.f, 0.f, 0.f}, a1 = {0.f, 0.f, 0.f, 0.f};
#pragma unroll
        for (int s = 0; s < 8; ++s) { float f[8]; unpack8(*(const u32x4*)(pp + (size_t)s * (MS * DM)), f); a0 = a0 + (f32x4){f[0], f[1], f[2], f[3]}; a1 = a1 + (f32x4){f[4], f[5], f[6], f[7]}; }
        a0 = a0 * QSCALE; a1 = a1 * QSCALE;
        *(LAS bf16x8*)(sQ + t * 520 + d0) = pack8(a0, a1);
        __syncthreads();
    }
    f32x4 s0 = {0.f, 0.f, 0.f, 0.f}, s1 = {0.f, 0.f, 0.f, 0.f};
    const float* k0p = Kb + (size_t)(32 * wave + r16) * (XH * XD) + kq * 8;
    const float* k1p = k0p + (size_t)16 * (XH * XD);
    const bf16_t* qp = Qb + (size_t)(r16 & 7) * DM + kq * 8;
#pragma unroll 4
    for (int ds = 0; ds < 16; ++ds) {
        const f32x4 a0 = *(const f32x4*)(k0p + ds * 32), a1 = *(const f32x4*)(k0p + ds * 32 + 4);
        const f32x4 c0 = *(const f32x4*)(k1p + ds * 32), c1 = *(const f32x4*)(k1p + ds * 32 + 4);
        u32x4 qw = tail ? *(const LAS u32x4*)(sQ + (r16 & 7) * 520 + kq * 8 + ds * 32) : *(const u32x4*)(qp + ds * 32); if (r16 >= 8) qw = (u32x4){0u, 0u, 0u, 0u};
        const bf16x8 qf = __builtin_bit_cast(bf16x8, qw);
        s0 = __builtin_amdgcn_mfma_f32_16x16x32_bf16(pack8(a0, a1), qf, s0, 0, 0, 0);
        s1 = __builtin_amdgcn_mfma_f32_16x16x32_bf16(pack8(c0, c1), qf, s1, 0, 0, 0);
    }
    float mx = fmaxf(fmaxf(fmaxf(s0[0], s0[1]), fmaxf(s0[2], s0[3])), fmaxf(fmaxf(s1[0], s1[1]), fmaxf(s1[2], s1[3])));
    mx = fmaxf(mx, __shfl_xor(mx, 16)); mx = fmaxf(mx, __shfl_xor(mx, 32));
    float sm = 0.f;
#pragma unroll
    for (int j = 0; j < 4; ++j) { s0[j] = __expf(s0[j] - mx); s1[j] = __expf(s1[j] - mx); sm += s0[j] + s1[j]; }
    sm += __shfl_xor(sm, 16); sm += __shfl_xor(sm, 32);
    if (kq == 0) { sSt[(wave * 16 + r16) * 2] = mx; sSt[(wave * 16 + r16) * 2 + 1] = sm; }
    __syncthreads();
    float M = -3.0e38f;
#pragma unroll
    for (int w2 = 0; w2 < 8; ++w2) M = fmaxf(M, sSt[(w2 * 16 + r16) * 2]);
    float L = 0.f;
#pragma unroll
    for (int w2 = 0; w2 < 8; ++w2) L += sSt[(w2 * 16 + r16) * 2 + 1] * __expf(sSt[(w2 * 16 + r16) * 2] - M);
    const float f = __expf(mx - M) / L;
    { u32x2 w; w.x = cvt_pk_bf16(s0[0] * f, s0[1] * f); w.y = cvt_pk_bf16(s0[2] * f, s0[3] * f); *(LAS u32x2*)(sP + r16 * 264 + 32 * wave + 4 * kq) = w;
      w.x = cvt_pk_bf16(s1[0] * f, s1[1] * f); w.y = cvt_pk_bf16(s1[2] * f, s1[3] * f); *(LAS u32x2*)(sP + r16 * 264 + 32 * wave + 16 + 4 * kq) = w; }
    __syncthreads();
    f32x4 o[4];
#pragma unroll
    for (int c = 0; c < 4; ++c) o[c] = (f32x4){0.f, 0.f, 0.f, 0.f};
    const float* vp = Vb + (size_t)(kq * 8) * (XH * XD) + 64 * wave + 4 * r16;
#pragma unroll 2
    for (int ms = 0; ms < 8; ++ms) {
        const bf16x8 pf = *(const LAS bf16x8*)(sP + r16 * 264 + ms * 32 + kq * 8);
        f32x4 x[8];
#pragma unroll
        for (int j = 0; j < 8; ++j) x[j] = *(const f32x4*)(vp + (size_t)(ms * 32 + j) * (XH * XD));
#pragma unroll
        for (int c = 0; c < 4; ++c) {
            const bf16x8 a = pack8((f32x4){x[0][c], x[1][c], x[2][c], x[3][c]}, (f32x4){x[4][c], x[5][c], x[6][c], x[7][c]});
            o[c] = __builtin_amdgcn_mfma_f32_16x16x32_bf16(a, pf, o[c], 0, 0, 0);
        }
    }
    if (r16 < 8) {
        bf16_t* op = WSP(bf16_t, WS_O) + (size_t)(MP + b * 8 + r16) * DM + h * XD + 64 * wave + 16 * kq;
        u32x4 w0, w1;
        w0.x = cvt_pk_bf16(o[0][0], o[1][0]); w0.y = cvt_pk_bf16(o[2][0], o[3][0]); w0.z = cvt_pk_bf16(o[0][1], o[1][1]); w0.w = cvt_pk_bf16(o[2][1], o[3][1]);
        w1.x = cvt_pk_bf16(o[0][2], o[1][2]); w1.y = cvt_pk_bf16(o[2][2], o[3][2]); w1.z = cvt_pk_bf16(o[0][3], o[1][3]); w1.w = cvt_pk_bf16(o[2][3], o[3][3]);
        *(u32x4*)op = w0; *(u32x4*)(op + 8) = w1;
    }
    __syncthreads();
}

template <bool OUT_F32> __device__ __forceinline__ void phase_rms(Frame& F, const float* src, const float* g, void* dst, const bf16_t* part, const float* sbase, float* hout) {
    const int gw = F.bx * NWAVES + F.wave, NGW = F.G * NWAVES, lane = F.lane;
    for (int m = gw; m < MT; m += NGW) {
        void* orow = OUT_F32 ? (void*)((float*)dst + (size_t)m * DM) : (void*)((bf16_t*)dst + (size_t)m * DM);
        if (m < MP || part == nullptr) { rms_row<OUT_F32>(src + (size_t)m * DM, g, orow, lane); continue; }
        const int ms = m - MP;
        const f32x4* xr = (const f32x4*)(sbase + (size_t)ms * DM) + lane; f32x4 v[8]; float ss = 0.f;
#pragma unroll
        for (int j = 0; j < 8; ++j) v[j] = xr[64 * j];
#pragma unroll
        for (int s = 0; s < 8; ++s) { const u32x2* pr = (const u32x2*)(part + (size_t)s * (MS * DM) + (size_t)ms * DM) + lane;
#pragma unroll
            for (int j = 0; j < 8; ++j) { const u32x2 w = pr[64 * j]; v[j] = v[j] + (f32x4){bf_lo(w.x), bf_hi(w.x), bf_lo(w.y), bf_hi(w.y)}; } }
#pragma unroll
        for (int j = 0; j < 8; ++j) { ss += (v[j].x * v[j].x + v[j].y * v[j].y) + (v[j].z * v[j].z + v[j].w * v[j].w); if (hout) ((f32x4*)(hout + (size_t)ms * DM))[lane + 64 * j] = v[j]; }
        const float r = rsqrtf(wave_sum(ss) * (1.f / DM) + EPS);
        const f32x4* gr = (const f32x4*)g + lane;
#pragma unroll
        for (int j = 0; j < 8; ++j) { const f32x4 gg = gr[64 * j]; const f32x4 o = v[j] * r * gg;
            if (OUT_F32) ((f32x4*)orow)[lane + 64 * j] = o;
            else { u32x2 w; w.x = cvt_pk_bf16(o.x, o.y); w.y = cvt_pk_bf16(o.z, o.w); ((u32x2*)orow)[lane + 64 * j] = w; } }
    }
}

__global__ void __launch_bounds__(NWAVES * 64, 2) fwd_megakernel(Args args) {
    extern __shared__ __attribute__((aligned(16))) unsigned char lds_raw[];
    cg::grid_group grid = cg::this_grid();
    Frame F;
    F.lds = (LAS unsigned char*)lds_raw;
    F.tid = threadIdx.x; F.lane = F.tid & 63; F.wave = __builtin_amdgcn_readfirstlane(F.tid >> 6);
    F.G = gridDim.x; F.bx = blockIdx.x;
    F.out = args.out; F.ws = args.ws;
    volatile LAS unsigned* MISC = (volatile LAS unsigned*)(F.lds + 131072 + 320);
    if (F.tid < 32) MISC[F.tid] = 0u;
    __syncthreads();
    XcdBarrier xbar = xcd_barrier_post((unsigned*)(F.ws + WS_CTL) + 4096, MISC + 8);
#define SEAM0() do { grid.sync(); int t_ = threadIdx.x; asm volatile("" : "+v"(t_)); F.tid = t_; F.lane = t_ & 63; } while (0)
#define SEAM() do { xcd_barrier(xbar); int t_ = threadIdx.x; asm volatile("" : "+v"(t_)); F.tid = t_; F.lane = t_ & 63; { unsigned char* w_ = F.ws; float* o_ = F.out; asm volatile("" : "+s"(w_), "+s"(o_)); F.ws = w_; F.out = o_; } } while (0)
#ifndef PHASE_MASK
#define PHASE_MASK 0xffffffffu
#endif
#define PH(k) ((PHASE_MASK >> (k)) & 1u)
    using namespace pg8;
    const char* XN = (const char*)(F.ws + WS_XN);
    const bool tail = (F.G == 256);

    if (PH(0)) phase_prologue(F);
    SEAM0();
    if (PH(1)) {
        SchedIn S{XN, (const char*)(F.ws + WS_WIN), F.G, F.bx};
        EpiIn E{WSP(bf16_t, WS_P1), F.out + O_MK, F.out + O_MV, WSP(bf16_t, WS_KP), WSP(bf16_t, WS_VPT)};
        gemm_phase<EpiIn, SchedIn, true>(F.lds, DM, DM, S, E);
        convert_fill(F, CV_A1, CV_B1, 1296 + 64);
    }
    SEAM();
    if (PH(2)) phase_mixprep(F);
    SEAM();
    if (PH(3)) {
        SchedSp S{(const char*)(F.ws + WS_WSP), (const char*)(F.ws + WS_VT), F.G, F.bx};
        EpiSp E{WSP(bf16_t, WS_P1), IN(11), WSP(bf16_t, WS_YA)};
        gemm_phase<EpiSp, SchedSp, true>(F.lds, 128, 128, S, E);
    }
    SEAM();
    if (PH(4)) {
        SchedRect S{(const char*)(F.ws + WS_YA), (const char*)(F.ws + WS_WA), (size_t)BM * DM * 2, (size_t)BM * DM * 2, 36, 8, F.G, F.bx, 32};
        EpiMerged E{WSP(bf16_t, WS_P1), WSP(bf16_t, WS_MRG)};
        gemm_phase<EpiMerged, SchedRect, true>(F.lds, DM, DM, S, E);
        convert_fill(F, CV_B1, CV_C1, 288);
    }
    SEAM();
    if (PH(6)) {
        SchedTail S{(const char*)(F.ws + WS_MRG), (const char*)(F.ws + WS_WMIX), (size_t)BM * DM * 2, (size_t)BM * DM * 2, 32, F.G, F.bx, tail};
        EpiTail<EpiRes> E{{IN(0), IN(1), MP, WSP(float, WS_H1)}, WSP(bf16_t, WS_PART)};
        gemm_phase<EpiTail<EpiRes>, SchedTail, true>(F.lds, DM, DM, S, E);
    }
    SEAM();
    phase_rms<false>(F, WSP(float, WS_H1), IN(16), WSP(bf16_t, WS_XN), tail ? WSP(bf16_t, WS_PART) : nullptr, IN(1), WSP(float, WS_H1) + (size_t)MP * DM);
    SEAM();
    if (PH(7)) {
        SchedTail S{XN, (const char*)(F.ws + WS_WQ), (size_t)BM * DM * 2, (size_t)BM * DM * 2, 32, F.G, F.bx, tail};
        EpiTail<EpiBf<0>> E{{WSP(bf16_t, WS_Q), DM, QSCALE}, WSP(bf16_t, WS_PART)};
        gemm_phase<EpiTail<EpiBf<0>>, SchedTail, true>(F.lds, DM, DM, S, E);
    }
    SEAM();
    if (PH(8)) {
        SchedS S{(const char*)(F.ws + WS_Q), (const char*)(F.ws + WS_KP), F.G, F.bx};
        EpiSoftmax E{WSP(bf16_t, WS_PS)};
        gemm_phase<EpiSoftmax, SchedS, false>(F.lds, DM, DM, S, E);
        __syncthreads();
        for (int un = F.bx; un < 512; un += F.G) sample_attn_unit(F, un, tail);
    }
    SEAM();
    if (PH(9)) {
        SchedO S{(const char*)(F.ws + WS_PS), (const char*)(F.ws + WS_VPT), F.G, F.bx};
        EpiBf<0> E{WSP(bf16_t, WS_O), DM, 1.0f};
        gemm_phase<EpiBf<0>, SchedO, true>(F.lds, 256, 256, S, E);
    }
    SEAM();
    if (PH(10)) {
        SchedTail S{(const char*)(F.ws + WS_O), (const char*)(F.ws + WS_WXO), (size_t)BM * DM * 2, (size_t)BM * DM * 2, 32, F.G, F.bx, tail};
        EpiTail<EpiRes> E{{WSP(float, WS_H1), WSP(float, WS_H1), 1 << 30, WSP(float, WS_H2)}, WSP(bf16_t, WS_PART)};
        gemm_phase<EpiTail<EpiRes>, SchedTail, true>(F.lds, DM, DM, S, E);
    }
    SEAM();
    phase_rms<false>(F, WSP(float, WS_H2), IN(22), WSP(bf16_t, WS_XN), tail ? WSP(bf16_t, WS_PART) : nullptr, WSP(float, WS_H1) + (size_t)MP * DM, WSP(float, WS_H2) + (size_t)MP * DM);
    SEAM();
    if (PH(11)) {
        SchedRect S{XN, (const char*)(F.ws + WS_WUP), (size_t)BM * DM * 2, (size_t)BM * DM * 2, 36, 32, F.G, F.bx, 32};
        EpiBf<1> E{WSP(bf16_t, WS_UP), FF, 1.0f};
        gemm_phase<EpiBf<1>, SchedRect, true>(F.lds, DM, DM, S, E);
        convert_fill(F, CV_C1, CV_D1, 36 * 32);
    }
    SEAM();
    if (PH(12)) {
        SchedTail S{(const char*)(F.ws + WS_UP), (const char*)(F.ws + WS_WDN), (size_t)BM * FF * 2, (size_t)BM * FF * 2, 128, F.G, F.bx, tail};
        EpiTail<EpiRes> E{{WSP(float, WS_H2), WSP(float, WS_H2), 1 << 30, WSP(float, WS_H2)}, WSP(bf16_t, WS_PART)};
        gemm_phase<EpiTail<EpiRes>, SchedTail, true>(F.lds, FF, FF, S, E);
    }
    SEAM();
    phase_rms<true>(F, WSP(float, WS_H2), IN(25), F.out + O_Y, tail ? WSP(bf16_t, WS_PART) : nullptr, WSP(float, WS_H2) + (size_t)MP * DM, nullptr);
}

extern "C" void kernel_launch(void* const* d_in, const int* in_sizes, int n_in, void* d_out, int out_size, void* d_ws, size_t ws_size, hipStream_t stream) {
    static int grid = 0;
    if (grid == 0) {
        if (n_in != 26 || ws_size < WS_END) { fprintf(stderr, "kernel_launch: unexpected n_in %d / ws_size %zu\n", n_in, ws_size); grid = -1; return; }
        int dev = 0, cus = 0, per_cu = 0;
        hipGetDevice(&dev);
        hipDeviceGetAttribute(&cus, hipDeviceAttributeMultiprocessorCount, dev);
        if (hipFuncSetAttribute((const void*)fwd_megakernel, hipFuncAttributeMaxDynamicSharedMemorySize, LDS_BYTES) != hipSuccess) { fprintf(stderr, "kernel_launch: hipFuncSetAttribute failed\n"); grid = -1; return; }
        if (hipOccupancyMaxActiveBlocksPerMultiprocessor(&per_cu, (const void*)fwd_megakernel, NWAVES * 64, LDS_BYTES) != hipSuccess || per_cu < 1) { fprintf(stderr, "kernel_launch: occupancy query says %d\n", per_cu); per_cu = 1; }
        (void)hipGetLastError();
        grid = cus;
        if (grid < 128) { fprintf(stderr, "kernel_launch: needs >= 128 CUs\n"); grid = -1; return; }
    }
    if (grid < 0) return;
    if (hipMemsetAsync((char*)d_ws + WS_CTL, 0, 65536, stream) != hipSuccess) { fprintf(stderr, "kernel_launch: memset failed\n"); return; }
    Args a{};
    for (int i = 0; i < 26; ++i) a.in[i] = (const float*)d_in[i];
    a.out = (float*)d_out; a.ws = (unsigned char*)d_ws;
    void* kargs[] = {&a};
    hipError_t e = hipLaunchCooperativeKernel((const void*)fwd_megakernel, dim3(grid), dim3(NWAVES * 64), kargs, LDS_BYTES, stream);
    if (e != hipSuccess) fprintf(stderr, "kernel_launch: cooperative launch failed: %s (grid %d)\n", hipGetErrorString(e), grid);
}
```

```cpp
#include <hip/hip_runtime.h>
#include <hip/hip_cooperative_groups.h>
#include <cstdio>
#include <cstdint>
namespace cg = cooperative_groups;

#define LAS __attribute__((address_space(3)))
typedef unsigned short bf16_t;
typedef short bf16x8 __attribute__((ext_vector_type(8)));
typedef float f32x4 __attribute__((ext_vector_type(4)));
typedef float f32x2 __attribute__((ext_vector_type(2)));
typedef unsigned u32x4 __attribute__((ext_vector_type(4)));
typedef unsigned u32x2 __attribute__((ext_vector_type(2)));

constexpr int DM = 2048, MP = 8192, MS = 1024, MT = MP + MS  ;
constexpr int NIN = 9216, FF = 8192, NMEM = 256, XH = 4, XD = 512;
constexpr int C_U = 0, C_V = 1024, C_BG = 2048, C_CG = 3072, C_XIN = 4096, C_GA = 5120, C_GB = 7168;
constexpr float EPS = 1e-6f, QSCALE = 0.04419417382415922f  ;
constexpr size_t O_Y = 0, O_MK = 18874368, O_MV = 20971520, O_CP = 23068672, O_CS = 23076864, O_CV = 23339008;
constexpr size_t MiB = 1u << 20;
constexpr size_t WS_CTL = 0, CTL_BYTES = 1 * MiB;
constexpr size_t WS_WIN = 2 * MiB;
constexpr size_t WS_WA = 54 * MiB, WS_WB = 58 * MiB;
constexpr size_t WS_WMIX = 62 * MiB, WS_WQ = 70 * MiB, WS_WXO = 78 * MiB;
constexpr size_t WS_WUP = 86 * MiB;
constexpr size_t WS_WDN = 118 * MiB;
constexpr size_t WS_WSP = 150 * MiB;
constexpr size_t WS_XN = 152 * MiB;
constexpr size_t WS_P1 = 192 * MiB;
constexpr size_t WS_UP = 192 * MiB;
constexpr size_t WS_VT = 354 * MiB;
constexpr size_t WS_YA = 370 * MiB, WS_YB = 388 * MiB;
constexpr size_t WS_TMP = 406 * MiB;
constexpr size_t WS_PART = 406 * MiB;
constexpr size_t WS_MRG = 478 * MiB;
constexpr size_t WS_H1 = 514 * MiB;
constexpr size_t WS_Q = 586 * MiB;
constexpr size_t WS_KP = 622 * MiB;
constexpr size_t WS_VPT = 626 * MiB;
constexpr size_t WS_PS = 630 * MiB;
constexpr size_t WS_O = 646 * MiB;
constexpr size_t WS_H2 = 682 * MiB;
constexpr size_t WS_END = 754 * MiB;

constexpr int LDS_BYTES = 147456;
constexpr int NWAVES = 8;

__device__ __forceinline__ unsigned cvt_pk_bf16(float lo, float hi) { unsigned r; asm volatile("v_cvt_pk_bf16_f32 %0, %1, %2" : "=v"(r) : "v"(lo), "v"(hi)); return r; }
__device__ __forceinline__ float bf_lo(unsigned u) { return __uint_as_float(u << 16); }
__device__ __forceinline__ float bf_hi(unsigned u) { return __uint_as_float(u & 0xffff0000u); }
__device__ __forceinline__ float bf1(bf16_t h) { return __uint_as_float(((unsigned)h) << 16); }
__device__ __forceinline__ bf16x8 pack8(f32x4 a, f32x4 b) {
    u32x4 w; w.x = cvt_pk_bf16(a.x, a.y); w.y = cvt_pk_bf16(a.z, a.w); w.z = cvt_pk_bf16(b.x, b.y); w.w = cvt_pk_bf16(b.z, b.w);
    return __builtin_bit_cast(bf16x8, w);
}
__device__ __forceinline__ void unpack8(u32x4 w, float (&f)[8]) {
    f[0] = bf_lo(w.x); f[1] = bf_hi(w.x); f[2] = bf_lo(w.y); f[3] = bf_hi(w.y); f[4] = bf_lo(w.z); f[5] = bf_hi(w.z); f[6] = bf_lo(w.w); f[7] = bf_hi(w.w);
}
__device__ __forceinline__ float wave_sum(float v) {
#pragma unroll
    for (int o = 1; o < 64; o <<= 1) v += __shfl_xor(v, o);
    return v;
}
__device__ __forceinline__ float sigmoidf_(float x) { return __builtin_amdgcn_rcpf(1.0f + __expf(-x)); }
#define LDS_WAIT() asm volatile("s_waitcnt lgkmcnt(0)" ::: "memory")

namespace pg8 {
constexpr int BM = 256, BK = 64, HALF = 128, HTB = HALF * BK * 2, STAGE_BYTES = 8 * HTB, NXCD = 8, WGM = 8;
__host__ __device__ __forceinline__ int lds_byte(int r, int c) { const int st = (r >> 4) * 2 + (c >> 5), rr = r & 15, cc = c & 31, ob = rr * 64 + cc * 2; return st * 1024 + (ob ^ (((ob >> 9) & 1) << 5)); }
__host__ __device__ __forceinline__ void stage_rc(int b, int& R, int& C) { const int st = b / 1024, sb = b % 1024, swz = sb ^ (((sb >> 9) & 1) << 5); R = (st >> 1) * 16 + swz / 64; C = (st & 1) * 32 + (swz % 64) / 2; }
__host__ __device__ __forceinline__ int perm32(int rho) { const int n = rho >> 4, i = rho & 15; return 8 * (i >> 2) + 4 * n + (i & 3); }

struct Unit { const char* A; const char* B; int orow, ocol, aux, nkt; };

__device__ __forceinline__ void rect_order(int L, int nM, int nN, int& pm, int& pn) {
    const int nwg = nM * nN; int wgid = L;
    { const int q = nwg / NXCD, r = nwg % NXCD, xcd = wgid % NXCD, off = wgid / NXCD; wgid = (xcd < r ? xcd * (q + 1) : r * (q + 1) + (xcd - r) * q) + off; }
    const int nig = WGM * nN, gid = wgid / nig, fm = gid * WGM, gsz = (nM - fm) < WGM ? (nM - fm) : WGM;
    pm = fm + ((wgid % nig) % gsz); pn = (wgid % nig) / gsz;
}

template <class Epi, class Sched, bool ALIGN_EPI>
__device__ __forceinline__ void gemm_phase(LAS unsigned char* lds, const int lda, const int ldb, const Sched& S, const Epi& E) {
    int tid_ = threadIdx.x; asm volatile("" : "+v"(tid_));
    const int tid = tid_, wid = __builtin_amdgcn_readfirstlane(tid >> 6), lane = tid & 63, wr = wid >> 2, wc = wid & 3, fr = lane & 15, fq = lane >> 4;
    unsigned voffA[2], voffB[2];
#pragma unroll
    for (int i = 0; i < 2; ++i) { int R, C; stage_rc(tid * 16 + i * 8192, R, C); const int Rb = Epi::PERM ? ((R & ~31) + perm32(R & 31)) : R;
        voffA[i] = (unsigned)(R * lda + C) * 2u; voffB[i] = (unsigned)(Rb * ldb + C) * 2u; }
    const size_t kstep = (size_t)(BK * 2);
    const size_t hstepA = (size_t)HALF * lda * 2, hstepB = (size_t)HALF * ldb * 2;
    const unsigned ldsw = (unsigned)wid * 1024u;
    const int aoff = lds_byte(wr * 64 + fr, fq * 8), boff = lds_byte(wc * 32 + fr, fq * 8);
#define PG8_SA(b, h) (((b) * 2 + (h)) * HTB)
#define PG8_SB(b, h) ((4 + (b) * 2 + (h)) * HTB)
#define PG8_STAGE(bufoff, gbase, voff) do { _Pragma("unroll") for (int _i = 0; _i < 2; ++_i) \
        __builtin_amdgcn_global_load_lds((const unsigned*)((const char*)(gbase) + (voff)[_i]), (LAS unsigned*)(lds + (bufoff) + ldsw + _i * 8192), 16, 0, 0); } while (0)
#define PG8_LDA(dst, b, h) do { _Pragma("unroll") for (int m = 0; m < 4; ++m) _Pragma("unroll") for (int k = 0; k < 2; ++k) dst[m][k] = *(const LAS bf16x8*)(lds + PG8_SA(b, h) + aoff + m * 2048 + k * 1024); } while (0)
#define PG8_LDB(dst, b, h) do { _Pragma("unroll") for (int n = 0; n < 2; ++n) _Pragma("unroll") for (int k = 0; k < 2; ++k) dst[n][k] = *(const LAS bf16x8*)(lds + PG8_SB(b, h) + boff + n * 2048 + k * 1024); } while (0)
#define PG8_MMA(ai, bj, At, Bt) do { __builtin_amdgcn_s_setprio(1); _Pragma("unroll") for (int m = 0; m < 4; ++m) _Pragma("unroll") for (int n = 0; n < 2; ++n) _Pragma("unroll") for (int k = 0; k < 2; ++k) \
        acc[ai][bj][m][n] = __builtin_amdgcn_mfma_f32_16x16x32_bf16(Bt[n][k], At[m][k], acc[ai][bj][m][n], 0, 0, 0); __builtin_amdgcn_s_setprio(0); } while (0)
#define PG8_WAIT_V(n) asm volatile("s_waitcnt vmcnt(" #n ")" ::: "memory")
#define PG8_WAIT_L(n) asm volatile("s_waitcnt lgkmcnt(" #n ")" ::: "memory")
#define PG8_BAR __builtin_amdgcn_s_barrier()
#define PG8_SCHED __builtin_amdgcn_sched_barrier(0)
    Unit cur, nxt; int ui = 0;
    if (!S.next(0, cur)) return;
    f32x4 acc[2][2][4][2];
#pragma unroll
    for (int a = 0; a < 2; ++a)
#pragma unroll
        for (int b = 0; b < 2; ++b)
#pragma unroll
            for (int m = 0; m < 4; ++m)
#pragma unroll
                for (int n = 0; n < 2; ++n) acc[a][b][m][n] = (f32x4){0.f, 0.f, 0.f, 0.f};
    bf16x8 At[4][2], B0[2][2], B1[2][2];
    const char* cA = cur.A; const char* cB = cur.B;
    PG8_STAGE(PG8_SB(0, 0), cB, voffB); PG8_STAGE(PG8_SB(0, 1), cB + hstepB, voffB); PG8_STAGE(PG8_SA(0, 0), cA, voffA); PG8_STAGE(PG8_SA(0, 1), cA + hstepA, voffA);
    if (wr == 1) PG8_BAR;
    PG8_WAIT_V(2); PG8_BAR;
    PG8_STAGE(PG8_SB(1, 0), cB + kstep, voffB); PG8_STAGE(PG8_SA(1, 0), cA + kstep, voffA); PG8_STAGE(PG8_SB(1, 1), cB + hstepB + kstep, voffB);
    PG8_WAIT_V(6); PG8_BAR;
    for (;;) {
        const bool has_next = S.next(ui + 1, nxt);
        int nt = cur.nkt; asm volatile("" : "+s"(nt));
        const char* nA = has_next ? nxt.A : cA; const char* nB = has_next ? nxt.B : cB;
        for (int t = 0; t < nt; t += 2) {
            const bool last = (t == nt - 2);
            const char* a1 = cA + (size_t)(t + 1) * kstep;
            const char* a2 = last ? nA : cA + (size_t)(t + 2) * kstep; const char* b2 = last ? nB : cB + (size_t)(t + 2) * kstep;
            const char* a3 = a2 + kstep; const char* b3 = b2 + kstep;
            if constexpr (Epi::MIDK) { if (t == (nt >> 1)) E.mid(acc, cur, wr, wc, fr, fq); }
            PG8_LDB(B0, 0, 0); PG8_LDB(B1, 0, 1); PG8_SCHED; PG8_LDA(At, 0, 0); PG8_STAGE(PG8_SA(1, 1), a1 + hstepA, voffA);
            PG8_WAIT_V(8); PG8_WAIT_L(0); PG8_BAR; PG8_MMA(0, 0, At, B0); PG8_MMA(0, 1, At, B1); PG8_BAR; PG8_SCHED;
            PG8_LDA(At, 0, 1); PG8_STAGE(PG8_SB(0, 0), b2, voffB); PG8_STAGE(PG8_SB(0, 1), b2 + hstepB, voffB); PG8_STAGE(PG8_SA(0, 0), a2, voffA);
            PG8_WAIT_V(8); PG8_WAIT_L(0); PG8_BAR; PG8_MMA(1, 0, At, B0); PG8_MMA(1, 1, At, B1); PG8_BAR; PG8_SCHED;
            PG8_LDB(B0, 1, 0); PG8_LDB(B1, 1, 1); PG8_SCHED; PG8_LDA(At, 1, 0); PG8_STAGE(PG8_SA(0, 1), a2 + hstepA, voffA);
            PG8_WAIT_V(8); PG8_WAIT_L(0); PG8_BAR; PG8_MMA(0, 0, At, B0); PG8_MMA(0, 1, At, B1); PG8_BAR; PG8_SCHED;
            PG8_LDA(At, 1, 1); PG8_STAGE(PG8_SB(1, 0), b3, voffB); PG8_STAGE(PG8_SB(1, 1), b3 + hstepB, voffB); PG8_STAGE(PG8_SA(1, 0), a3, voffA);
            PG8_WAIT_V(8); PG8_WAIT_L(0); PG8_BAR; PG8_MMA(1, 0, At, B0); PG8_MMA(1, 1, At, B1); PG8_BAR; PG8_SCHED;
        }
        if constexpr (ALIGN_EPI) { if (wr == 0) PG8_BAR; }
        if constexpr (!Epi::AFTER_DRAIN) { int fr_ = fr, fq_ = fq; asm volatile("" : "+v"(fr_), "+v"(fq_)); E(acc, cur, wr, wc, fr_, fq_); }
        if (!has_next) break;
#pragma unroll
        for (int a = 0; a < 2; ++a)
#pragma unroll
            for (int b = 0; b < 2; ++b)
#pragma unroll
                for (int m = 0; m < 4; ++m)
#pragma unroll
                    for (int n = 0; n < 2; ++n) acc[a][b][m][n] = (f32x4){0.f, 0.f, 0.f, 0.f};
        cur = nxt; cA = nA; cB = nB; ++ui;
        if constexpr (ALIGN_EPI) { if (wr == 1) PG8_BAR; }
    }
    PG8_WAIT_V(0);
    if constexpr (!ALIGN_EPI) { if (wr == 0) PG8_BAR; }
    PG8_BAR;
    if constexpr (Epi::AFTER_DRAIN) { E.fused(acc, cur, wr, wc, fr, fq, lds, wid, lane); }
#undef PG8_SA
#undef PG8_SB
#undef PG8_STAGE
#undef PG8_LDA
#undef PG8_LDB
#undef PG8_MMA
#undef PG8_WAIT_V
#undef PG8_WAIT_L
#undef PG8_BAR
#undef PG8_SCHED
}

struct SchedRect {
    const char* A; const char* B; size_t atile, btile; int nM, nN, G, c, NT;
    __device__ __forceinline__ bool next(int i, Unit& u) const {
        const int L = i * G + c; if (L >= nM * nN) return false;
        int pm, pn; rect_order(L, nM, nN, pm, pn);
        u.A = A + (size_t)pm * atile; u.B = B + (size_t)pn * btile; u.orow = pm * BM; u.ocol = pn * BM; u.aux = 0; u.nkt = NT; return true;
    }
};
struct SchedIn {
    const char* A; const char* B; int G, c;
    __device__ __forceinline__ bool next(int i, Unit& u) const {
        const int L = i * G + c; if (L >= 1296 + 64) return false;
        int pm, pn;
        if (L < 1296) { rect_order(L, 36, 36, pm, pn); u.orow = pm * BM; u.ocol = pn * BM; u.aux = 0; }
        else { const int l = L - 1296; pm = 36 + (l & 3); pn = 36 + (l >> 2); u.orow = (pm - 36) * BM; u.ocol = (pn - 36) * BM; u.aux = 1; }
        u.A = A + (size_t)pm * (BM * DM * 2); u.B = B + (size_t)pn * (BM * DM * 2); u.nkt = DM / BK; return true;
    }
};
struct SchedSp {
    const char* WSP; const char* VT; int G, c;
    __device__ __forceinline__ bool next(int i, Unit& u) const {
        const int L = i * G + c; if (L >= 256) return false;
        const int chunk = L >> 2, p = (L >> 1) & 1, gi = L & 1, g = 2 * p + gi;
        u.A = WSP + (size_t)p * (256 * 128 * 2); u.B = VT + ((size_t)chunk * 1024 + g * 256) * 128 * 2; u.orow = chunk * 128; u.ocol = g * 256; u.aux = gi; u.nkt = 2; return true;
    }
};
struct SchedS {
    const char* Q; const char* KP; int G, c;
    __device__ __forceinline__ bool next(int i, Unit& u) const {
        const int L = i * G + c; if (L >= 128 || i > 0) return false;
        const int b = L >> 5, h = (L >> 3) & 3, p = L & 7;
        u.A = Q + ((size_t)(b * 2048 + p * 256) * DM + h * XD) * 2; u.B = KP + ((size_t)(b * 256) * DM + h * XD) * 2;
        u.orow = (b * 4 + h) * 2048 + p * 256; u.ocol = 0; u.aux = 0; u.nkt = XD / BK; return true;
    }
};
struct SchedO {
    const char* PS; const char* VPT; int G, c;
    __device__ __forceinline__ bool next(int i, Unit& u) const {
        const int L = i * G + c; if (L >= 256) return false;
        const int b = L >> 6, h = (L >> 4) & 3, p = (L >> 1) & 7, pn = L & 1;
        u.A = PS + ((size_t)((b * 4 + h) * 2048 + p * 256) * 256) * 2; u.B = VPT + ((size_t)(b * 2048 + h * XD + pn * 256) * 256) * 2;
        u.orow = b * 2048 + p * 256; u.ocol = h * XD + pn * 256; u.aux = 0; u.nkt = 4; return true;
    }
};


struct SchedTail {
    const char* A; const char* B; size_t atile, btile; int NT, G, c; bool tail;
    __device__ __forceinline__ bool next(int i, Unit& u) const {
        if (!tail) { const int L = i * G + c; if (L >= 288) return false; int pm, pn; rect_order(L, 36, 8, pm, pn);
            u.A = A + (size_t)pm * atile; u.B = B + (size_t)pn * btile; u.orow = pm * BM; u.ocol = pn * BM; u.aux = 0; u.nkt = NT; return true; }
        const int vcu = (c & 7) * 32 + (c >> 3);
        if (i == 0) { const int pm = vcu >> 3, pn = vcu & 7; u.A = A + (size_t)pm * atile; u.B = B + (size_t)pn * btile; u.orow = pm * BM; u.ocol = pn * BM; u.aux = 0; u.nkt = NT; return true; }
        if (i == 1) { const int t = vcu >> 3, s = vcu & 7, pm = 32 + (t >> 3), pn = t & 7, nk = NT >> 3;
            u.A = A + (size_t)pm * atile + (size_t)(s * nk) * (BK * 2); u.B = B + (size_t)pn * btile + (size_t)(s * nk) * (BK * 2);
            u.orow = (t >> 3) * BM; u.ocol = pn * BM; u.aux = 1 + s; u.nkt = nk; return true; }
        return false;
    }
};
#define EPI_ROWS_BEGIN _Pragma("unroll") for (int ai = 0; ai < 2; ++ai) _Pragma("unroll") for (int m = 0; m < 4; ++m) { const int rl = ai * HALF + wr * 64 + m * 16 + fr;
#define EPI_ROWS_END }

struct EpiIn {
    static constexpr bool PERM = true, AFTER_DRAIN = false, MIDK = false;
    bf16_t* P1; float* memk; float* memv; bf16_t* KP; bf16_t* VPT;
    __device__ __forceinline__ void operator()(const f32x4 (&acc)[2][2][4][2], const Unit& u, int wr, int wc, int fr, int fq) const {
        const int cl0 = wc * 32 + 8 * fq;
        if (u.aux == 0) {
            const bool gate = u.ocol >= C_GA;
            EPI_ROWS_BEGIN
                bf16_t* rowp = P1 + (size_t)(u.orow + rl) * NIN + u.ocol + cl0;
#pragma unroll
                for (int bj = 0; bj < 2; ++bj) { f32x4 v0 = acc[ai][bj][m][0], v1 = acc[ai][bj][m][1];
                    if (gate) {
                        const f32x4 g0 = acc[ai][1][m][0], g1 = acc[ai][1][m][1];
#pragma unroll
                        for (int e = 0; e < 4; ++e) { const float sb0 = sigmoidf_(g0[e]), sb1 = sigmoidf_(g1[e]);
                            if (bj == 0) { v0[e] = sigmoidf_(v0[e]) * __builtin_amdgcn_rcpf(fmaxf(sb0, 1e-30f)); v1[e] = sigmoidf_(v1[e]) * __builtin_amdgcn_rcpf(fmaxf(sb1, 1e-30f)); }
                            else { v0[e] = fmaxf(sb0, 1e-30f); v1[e] = fmaxf(sb1, 1e-30f); } } }
                    u32x4 w; w.x = cvt_pk_bf16(v0[0], v0[1]); w.y = cvt_pk_bf16(v0[2], v0[3]); w.z = cvt_pk_bf16(v1[0], v1[1]); w.w = cvt_pk_bf16(v1[2], v1[3]);
                    *(u32x4*)(rowp + bj * HALF) = w; }
            EPI_ROWS_END
        } else {
            const bool isV = u.ocol >= DM; const int cb = u.ocol - (isV ? DM : 0) + cl0;
            float* fo = isV ? memv : memk;
            EPI_ROWS_BEGIN
                const int row = u.orow + rl;
#pragma unroll
                for (int bj = 0; bj < 2; ++bj) { const f32x4 v0 = acc[ai][bj][m][0], v1 = acc[ai][bj][m][1]; const int col = cb + bj * HALF;
                    *(f32x4*)(fo + (size_t)row * DM + col) = v0; *(f32x4*)(fo + (size_t)row * DM + col + 4) = v1;
                    u32x4 w; w.x = cvt_pk_bf16(v0[0], v0[1]); w.y = cvt_pk_bf16(v0[2], v0[3]); w.z = cvt_pk_bf16(v1[0], v1[1]); w.w = cvt_pk_bf16(v1[2], v1[3]);
                    if (!isV) { *(u32x4*)(KP + (size_t)row * DM + col) = w; }
                    else { bf16_t* vp = VPT + ((size_t)(row >> 8) * DM + col) * 256 + (row & 255);
                        vp[0 * 256] = (bf16_t)(w.x & 0xffff); vp[1 * 256] = (bf16_t)(w.x >> 16); vp[2 * 256] = (bf16_t)(w.y & 0xffff); vp[3 * 256] = (bf16_t)(w.y >> 16);
                        vp[4 * 256] = (bf16_t)(w.z & 0xffff); vp[5 * 256] = (bf16_t)(w.z >> 16); vp[6 * 256] = (bf16_t)(w.w & 0xffff); vp[7 * 256] = (bf16_t)(w.w >> 16); } }
            EPI_ROWS_END
        }
    }
};
struct EpiSp {
    static constexpr bool PERM = true, AFTER_DRAIN = false, MIDK = false;
    const bf16_t* P1; const float* bsp; bf16_t* YA;
    __device__ __forceinline__ void operator()(const f32x4 (&acc)[2][2][4][2], const Unit& u, int wr, int wc, int fr, int fq) const {
        const int g = u.ocol >> 8, cl0 = wc * 32 + 8 * fq;
#pragma unroll
        for (int ai = 0; ai < 2; ++ai) if (ai == u.aux) {
#pragma unroll
            for (int m = 0; m < 4; ++m) { const int t = wr * 64 + m * 16 + fr; const int row = u.orow + t; const float bs = bsp[g * 128 + t];
#pragma unroll
                for (int bj = 0; bj < 2; ++bj) { const int col = u.ocol + bj * HALF + cl0;
                    const u32x4 uw = *(const u32x4*)(P1 + (size_t)row * NIN + C_U + col); float uf[8]; unpack8(uw, uf);
                    const f32x4 v0 = acc[ai][bj][m][0], v1 = acc[ai][bj][m][1];
                    u32x4 w; w.x = cvt_pk_bf16(uf[0] * (v0[0] + bs), uf[1] * (v0[1] + bs)); w.y = cvt_pk_bf16(uf[2] * (v0[2] + bs), uf[3] * (v0[3] + bs));
                    w.z = cvt_pk_bf16(uf[4] * (v1[0] + bs), uf[5] * (v1[1] + bs)); w.w = cvt_pk_bf16(uf[6] * (v1[2] + bs), uf[7] * (v1[3] + bs));
                    *(u32x4*)(YA + (size_t)row * DM + col) = w; } }
        }
    }
};
struct EpiMerged {
    static constexpr bool PERM = true, AFTER_DRAIN = false, MIDK = true;
    const bf16_t* P1; bf16_t* MRG;
    __device__ __forceinline__ void mid(f32x4 (&acc)[2][2][4][2], const Unit& u, int wr, int wc, int fr, int fq) const {
        asm volatile("" : "+v"(fr), "+v"(fq));
        const bf16_t* pb = P1 + (size_t)(u.orow + wr * 64 + fr) * NIN + C_GA + (u.ocol >> 7) * 256 + wc * 32 + 8 * fq;
#pragma unroll
        for (int ai = 0; ai < 2; ++ai) {
            u32x4 r[4][2];
#pragma unroll
            for (int m = 0; m < 4; ++m)
#pragma unroll
                for (int bj = 0; bj < 2; ++bj) r[m][bj] = *(const u32x4*)(pb + (size_t)(ai * HALF + m * 16) * NIN + bj * 256);
#pragma unroll
            for (int m = 0; m < 4; ++m)
#pragma unroll
                for (int bj = 0; bj < 2; ++bj) { float f[8]; unpack8(r[m][bj], f);
#pragma unroll
                    for (int e = 0; e < 4; ++e) { acc[ai][bj][m][0][e] *= f[e]; acc[ai][bj][m][1][e] *= f[4 + e]; } }
            asm volatile("" ::: "memory");
        }
    }
    __device__ __forceinline__ void operator()(const f32x4 (&acc)[2][2][4][2], const Unit& u, int wr, int wc, int fr, int fq) const {
        const int cl0 = wc * 32 + 8 * fq;
        const bf16_t* pb = P1 + (size_t)(u.orow + wr * 64 + fr) * NIN + C_GA + (u.ocol >> 7) * 256 + 128 + cl0;
        EPI_ROWS_BEGIN
            const int row = u.orow + rl;
#pragma unroll
            for (int bj = 0; bj < 2; ++bj) { const int col = u.ocol + bj * HALF + cl0;
                float sb[8]; unpack8(*(const u32x4*)(pb + (size_t)(ai * HALF + m * 16) * NIN + bj * 256), sb);
                const f32x4 v0 = acc[ai][bj][m][0], v1 = acc[ai][bj][m][1];
                u32x4 w; w.x = cvt_pk_bf16(v0[0] * sb[0], v0[1] * sb[1]); w.y = cvt_pk_bf16(v0[2] * sb[2], v0[3] * sb[3]); w.z = cvt_pk_bf16(v1[0] * sb[4], v1[1] * sb[5]); w.w = cvt_pk_bf16(v1[2] * sb[6], v1[3] * sb[7]);
                *(u32x4*)(MRG + (size_t)row * DM + col) = w; }
        EPI_ROWS_END
    }
};
struct EpiRes {
    static constexpr bool PERM = false, AFTER_DRAIN = false, MIDK = false;
    const float* resA; const float* resB; int split; float* out;
    __device__ __forceinline__ void operator()(const f32x4 (&acc)[2][2][4][2], const Unit& u, int wr, int wc, int fr, int fq) const {
        const float* rbase = (u.orow < split) ? resA + (size_t)u.orow * DM : resB + (size_t)(u.orow - split) * DM;
        float* obase = out + (size_t)u.orow * DM;
        EPI_ROWS_BEGIN
#pragma unroll
            for (int bj = 0; bj < 2; ++bj)
#pragma unroll
                for (int n = 0; n < 2; ++n) { const size_t off = (size_t)rl * DM + u.ocol + bj * HALF + wc * 32 + 16 * n + 4 * fq;
                    const f32x4 r = *(const f32x4*)(rbase + off); *(f32x4*)(obase + off) = r + acc[ai][bj][m][n]; }
        EPI_ROWS_END
    }
};
template <int MODE  > struct EpiBf {
    static constexpr bool PERM = true, AFTER_DRAIN = false, MIDK = false;
    bf16_t* O; int ldc; float scale;
    __device__ __forceinline__ void operator()(const f32x4 (&acc)[2][2][4][2], const Unit& u, int wr, int wc, int fr, int fq) const {
        const int cl0 = wc * 32 + 8 * fq;
        EPI_ROWS_BEGIN
            bf16_t* rowp = O + (size_t)(u.orow + rl) * ldc + u.ocol + cl0;
#pragma unroll
            for (int bj = 0; bj < 2; ++bj) { f32x4 v0 = acc[ai][bj][m][0], v1 = acc[ai][bj][m][1];
                if (MODE == 0) { v0 = v0 * scale; v1 = v1 * scale; }
                else {
#pragma unroll
                    for (int e = 0; e < 4; ++e) { const float a = fmaxf(v0[e], 0.f), b = fmaxf(v1[e], 0.f); v0[e] = a * a; v1[e] = b * b; } }
                u32x4 w; w.x = cvt_pk_bf16(v0[0], v0[1]); w.y = cvt_pk_bf16(v0[2], v0[3]); w.z = cvt_pk_bf16(v1[0], v1[1]); w.w = cvt_pk_bf16(v1[2], v1[3]);
                *(u32x4*)(rowp + bj * HALF) = w; }
        EPI_ROWS_END
    }
};
struct EpiSoftmax {
    static constexpr bool PERM = true, AFTER_DRAIN = true, MIDK = false;
    bf16_t* PS;
    __device__ __forceinline__ void fused(f32x4 (&acc)[2][2][4][2], const Unit& u, int wr, int wc, int fr, int fq, LAS unsigned char* lds, int wid, int lane) const {
        LAS f32x2* X = (LAS f32x2*)lds;
        float mxl[2][4];
        EPI_ROWS_BEGIN
            float mx = -3.0e38f;
#pragma unroll
            for (int bj = 0; bj < 2; ++bj)
#pragma unroll
                for (int n = 0; n < 2; ++n) { const f32x4 v = acc[ai][bj][m][n]; mx = fmaxf(mx, fmaxf(fmaxf(v[0], v[1]), fmaxf(v[2], v[3]))); }
            mx = fmaxf(mx, __shfl_xor(mx, 16)); mx = fmaxf(mx, __shfl_xor(mx, 32));
            float s = 0.f;
#pragma unroll
            for (int bj = 0; bj < 2; ++bj)
#pragma unroll
                for (int n = 0; n < 2; ++n) { f32x4 v = acc[ai][bj][m][n];
#pragma unroll
                    for (int e = 0; e < 4; ++e) { v[e] = __expf(v[e] - mx); s += v[e]; }
                    acc[ai][bj][m][n] = v; }
            s += __shfl_xor(s, 16); s += __shfl_xor(s, 32);
            mxl[ai][m] = mx;
            if (fq == 0) X[rl * 4 + wc] = (f32x2){mx, s};
        EPI_ROWS_END
        LDS_WAIT(); __builtin_amdgcn_s_barrier(); asm volatile("" ::: "memory");
        const int cl0 = wc * 32 + 8 * fq;
        EPI_ROWS_BEGIN
            const f32x2 a = X[rl * 4 + 0], b = X[rl * 4 + 1], c = X[rl * 4 + 2], d = X[rl * 4 + 3];
            const float M = fmaxf(fmaxf(a.x, b.x), fmaxf(c.x, d.x));
            const float L = a.y * __expf(a.x - M) + b.y * __expf(b.x - M) + c.y * __expf(c.x - M) + d.y * __expf(d.x - M);
            const float f = __expf(mxl[ai][m] - M) / L;
            bf16_t* rowp = PS + (size_t)(u.orow + rl) * 256 + cl0;
#pragma unroll
            for (int bj = 0; bj < 2; ++bj) { const f32x4 v0 = acc[ai][bj][m][0] * f, v1 = acc[ai][bj][m][1] * f;
                u32x4 w; w.x = cvt_pk_bf16(v0[0], v0[1]); w.y = cvt_pk_bf16(v0[2], v0[3]); w.z = cvt_pk_bf16(v1[0], v1[1]); w.w = cvt_pk_bf16(v1[2], v1[3]);
                *(u32x4*)(rowp + bj * HALF) = w; }
        EPI_ROWS_END
        LDS_WAIT(); __builtin_amdgcn_s_barrier(); asm volatile("" ::: "memory");
    }
};

template <class Base> struct EpiTail {
    static constexpr bool PERM = Base::PERM, AFTER_DRAIN = false, MIDK = false;
    Base base; bf16_t* part;
    __device__ __forceinline__ void operator()(const f32x4 (&acc)[2][2][4][2], const Unit& u, int wr, int wc, int fr, int fq) const {
        if (u.aux == 0) { base(acc, u, wr, wc, fr, fq); return; }
        bf16_t* pb = part + (size_t)(u.aux - 1) * (MS * DM) + (size_t)u.orow * DM + u.ocol;
        EPI_ROWS_BEGIN
#pragma unroll
            for (int bj = 0; bj < 2; ++bj) {
                if (PERM) { const f32x4 v0 = acc[ai][bj][m][0], v1 = acc[ai][bj][m][1];
                    u32x4 w; w.x = cvt_pk_bf16(v0[0], v0[1]); w.y = cvt_pk_bf16(v0[2], v0[3]); w.z = cvt_pk_bf16(v1[0], v1[1]); w.w = cvt_pk_bf16(v1[2], v1[3]);
                    *(u32x4*)(pb + (size_t)rl * DM + bj * HALF + wc * 32 + 8 * fq) = w; }
                else {
#pragma unroll
                    for (int n = 0; n < 2; ++n) { const f32x4 v = acc[ai][bj][m][n]; u32x2 w; w.x = cvt_pk_bf16(v[0], v[1]); w.y = cvt_pk_bf16(v[2], v[3]);
                        *(u32x2*)(pb + (size_t)rl * DM + bj * HALF + wc * 32 + 16 * n + 4 * fq) = w; } }
            }
        EPI_ROWS_END
    }
};
}


#define XB_TMO      128
#define XB_XCNT(j)  (256  + 64 * (j))
#define XB_XSUB(j)  (1280 + 64 * (j))
#define XB_XGEN(j)  (2304 + 64 * (j))
#define XB_TOP      3328
#define XB_TOPGEN   3392
#define XCD_BAR_WORDS 3456
#define XB_SPIN_CAP (1u << 18)
__device__ __forceinline__ unsigned xb_ld(unsigned* p)              { return __hip_atomic_load(p, __ATOMIC_RELAXED, __HIP_MEMORY_SCOPE_AGENT); }
__device__ __forceinline__ unsigned xb_add(unsigned* p, unsigned v) { return __hip_atomic_fetch_add(p, v, __ATOMIC_RELAXED, __HIP_MEMORY_SCOPE_AGENT); }
__device__ __forceinline__ unsigned xb_xcc_id() { return (unsigned)__builtin_amdgcn_s_getreg((3 << 11) | 20) & 0xFu; }
#define XB_SPIN(cond, bar) do { unsigned _sp = 0; while (cond) { __builtin_amdgcn_s_sleep(1); \
    if ((++_sp & 255u) == 0u) { if (xb_ld(&(bar)[XB_TMO])) break; if (_sp > XB_SPIN_CAP) { atomicAdd(&(bar)[XB_TMO], 1u); break; } } } } while (0)
struct XcdBarrier { unsigned* bar; unsigned x; volatile LAS unsigned* st; };
__device__ __forceinline__ XcdBarrier xcd_barrier_post(unsigned* bar, volatile LAS unsigned* st) {
    XcdBarrier b; b.bar = bar; b.x = xb_xcc_id(); b.st = st;
    if (threadIdx.x == 0) (void)xb_add(&bar[XB_XCNT(b.x)], 1u);
    return b;
}
__device__ __forceinline__ void xcd_barrier_complete(unsigned* bar, unsigned x, unsigned& nloc, unsigned& nx) {
    const unsigned G = gridDim.x * gridDim.y * gridDim.z;
    unsigned sum, cnt, mine, sp = 0u;
    for (;;) {
        sum = 0u; cnt = 0u; mine = 0u;
#pragma unroll
        for (unsigned j = 0; j < 16; ++j) { const unsigned c = xb_ld(&bar[XB_XCNT(j)]); sum += c; cnt += (c > 0u) ? 1u : 0u; mine = (j == x) ? c : mine; }
        if (sum == G) break;
        __builtin_amdgcn_s_sleep(1);
        if ((++sp & 255u) == 0u) { if (xb_ld(&bar[XB_TMO])) break; if (sp > XB_SPIN_CAP) { atomicAdd(&bar[XB_TMO], 1u); break; } }
    }
    nloc = mine > 0u ? mine : 1u; nx = cnt > 0u ? cnt : 1u;
}
__device__ __forceinline__ void xcd_barrier(const XcdBarrier& b) {
    asm volatile("s_waitcnt vmcnt(0)" ::: "memory");
    __syncthreads();
    if (threadIdx.x == 0) {
        unsigned* bar = b.bar;
        __builtin_amdgcn_s_waitcnt(0);
        unsigned nloc = b.st[0], nx = b.st[1];
        if (nloc == 0u) { xcd_barrier_complete(bar, b.x, nloc, nx); b.st[0] = nloc; b.st[1] = nx; }
        const unsigned old = xb_add(&bar[XB_XSUB(b.x)], 1u);
        const unsigned gen = old / nloc;
        if (old + 1u == (gen + 1u) * nloc) {
            __builtin_amdgcn_fence(__ATOMIC_RELEASE, "agent");
            asm volatile("s_waitcnt vmcnt(0)" ::: "memory");
            const unsigned og = xb_add(&bar[XB_TOP], 1u);
            const unsigned tg = og / nx;
            if (og + 1u == (tg + 1u) * nx) xb_add(&bar[XB_TOPGEN], 1u);
            else XB_SPIN(xb_ld(&bar[XB_TOPGEN]) == tg, bar);
            __builtin_amdgcn_fence(__ATOMIC_ACQUIRE, "agent");
            xb_add(&bar[XB_XGEN(b.x)], 1u);
            asm volatile("s_waitcnt vmcnt(0)" ::: "memory");
        } else {
            XB_SPIN(xb_ld(&bar[XB_XGEN(b.x)]) == gen, bar);
            __builtin_amdgcn_fence(__ATOMIC_ACQUIRE, "agent");
            asm volatile("s_waitcnt vmcnt(0)" ::: "memory");
        }
    }
    __syncthreads();
}

struct Args { const float* in[26]; float* out; unsigned char* ws; };

struct Frame {
    LAS unsigned char* lds;
    int tid, lane, wave, G, bx;
    float* out; unsigned char* ws;
};
typedef const float* cfp_t;
__device__ __forceinline__ const float* karg_in(int i) {
    asm volatile("" : "+s"(i));
    const __attribute__((address_space(4))) cfp_t* ka = (const __attribute__((address_space(4))) cfp_t*)__builtin_amdgcn_kernarg_segment_ptr();
    return ka[i];
}
#define IN(i) karg_in(i)
#define WSP(T, off) ((T*)(F.ws + (off)))

__device__ __forceinline__ void p0_transpose_item(const float* W, int K, int N, bf16_t* WT, int row_off, LAS float* scr, int item, int lane, int ldk, int koff) {
    const int nblk = N / 32, kb = item / nblk, nb = item % nblk, k0 = 64 * kb, n0 = 32 * nb;
#pragma unroll 8
    for (int i = 0; i < 32; ++i) { const int kk = 2 * i + (lane >> 5); scr[kk * 33 + (lane & 31)] = W[(size_t)(k0 + kk) * N + n0 + (lane & 31)]; }
    LDS_WAIT(); asm volatile("" ::: "memory");
    const int c = lane & 7;
#pragma unroll
    for (int j = 0; j < 4; ++j) { const int n = (lane >> 3) + 8 * j; const LAS float* s = scr + (8 * c) * 33 + n;
        u32x4 o; o.x = cvt_pk_bf16(s[0 * 33], s[1 * 33]); o.y = cvt_pk_bf16(s[2 * 33], s[3 * 33]); o.z = cvt_pk_bf16(s[4 * 33], s[5 * 33]); o.w = cvt_pk_bf16(s[6 * 33], s[7 * 33]);
        *(u32x4*)(WT + (size_t)(row_off + n0 + n) * ldk + koff + k0 + 8 * c) = o; }
    LDS_WAIT(); asm volatile("" ::: "memory");
}
template <bool OUT_F32> __device__ __forceinline__ void rms_row(const float* xrow, const float* g, void* orow, int lane) {
    const f32x4* xr = (const f32x4*)xrow + lane; f32x4 v[8]; float ss = 0.f;
#pragma unroll
    for (int j = 0; j < 8; ++j) { v[j] = xr[64 * j]; ss += (v[j].x * v[j].x + v[j].y * v[j].y) + (v[j].z * v[j].z + v[j].w * v[j].w); }
    const float r = rsqrtf(wave_sum(ss) * (1.f / DM) + EPS);
    const f32x4* gr = (const f32x4*)g + lane;
#pragma unroll
    for (int j = 0; j < 8; ++j) { const f32x4 gg = gr[64 * j]; const f32x4 o = v[j] * r * gg;
        if (OUT_F32) ((f32x4*)orow)[lane + 64 * j] = o;
        else { u32x2 w; w.x = cvt_pk_bf16(o.x, o.y); w.y = cvt_pk_bf16(o.z, o.w); ((u32x2*)orow)[lane + 64 * j] = w; } }
}

constexpr int I_IN = 32 * 288, I_SQ = 32 * 64, I_BR = 16 * 64, I_UP = 32 * 256, I_DN = 128 * 64;
constexpr int CV_A0 = 0, CV_A1 = I_IN + 2 * I_SQ;
constexpr int CV_B1 = CV_A1 + 3 * I_SQ + 2 * I_BR;
constexpr int CV_C1 = CV_B1 + I_UP;
constexpr int CV_D1 = CV_C1 + I_DN;
__device__ __forceinline__ void convert_one(Frame& F, int it, LAS float* scr) {
    int r = it, K = DM, N = DM, ro = 0, ldk = DM, koff = 0, src_i; size_t wso;
    if (r < I_IN) { src_i = 7; N = NIN; wso = WS_WIN; const int n0 = 32 * (r % 288);
        if (n0 >= C_GB) { const int j = n0 - C_GB; ro = C_GA + (j >> 7) * 256 + 128 + (j & 127) - n0; }
        else if (n0 >= C_GA) { const int j = n0 - C_GA; ro = C_GA + (j >> 7) * 256 + (j & 127) - n0; } }
    else if ((r -= I_IN) < I_SQ) { src_i = 19; wso = WS_WIN; ro = NIN; }
    else if ((r -= I_SQ) < I_SQ) { src_i = 20; wso = WS_WIN; ro = NIN + DM; }
    else if ((r -= I_SQ) < I_SQ) { src_i = 15; wso = WS_WMIX; }
    else if ((r -= I_SQ) < I_SQ) { src_i = 18; wso = WS_WQ; }
    else if ((r -= I_SQ) < I_SQ) { src_i = 21; wso = WS_WXO; }
    else if ((r -= I_SQ) < I_BR) { src_i = 13; wso = WS_WA; K = 1024; }
    else if ((r -= I_BR) < I_BR) { src_i = 14; wso = WS_WA; K = 1024; koff = 1024; }
    else if ((r -= I_BR) < I_UP) { src_i = 23; wso = WS_WUP; N = FF; }
    else { r -= I_UP; src_i = 24; wso = WS_WDN; K = FF; ldk = FF; }
    p0_transpose_item(IN(src_i), K, N, (bf16_t*)(F.ws + wso), ro, scr, r, F.lane, ldk, koff);
}
__device__ __forceinline__ void convert_fill(Frame& F, int i0, int i1, int n_units) {
    const int rounds = (n_units + F.G - 1) / F.G, nfull = n_units - (rounds - 1) * F.G;
    int slot = F.bx - nfull, nslots = F.G - nfull;
    if (nslots == 0) { slot = F.bx; nslots = F.G; }
    if (slot < 0) return;
    LAS float* scr = (LAS float*)(F.lds + F.wave * 16384);
    for (int it = i0 + slot * NWAVES + F.wave; it < i1; it += nslots * NWAVES) convert_one(F, it, scr);
}
template <int R> __device__ __forceinline__ void ln_stats(const bf16_t* p, size_t rstride, float (&mean)[R], float (&rstd)[R], float (&lo)[R][8], float (&hi)[R][8]) {
#pragma unroll
    for (int r = 0; r < R; ++r) { unpack8(*(const u32x4*)(p + r * rstride), lo[r]); unpack8(*(const u32x4*)(p + r * rstride + 512), hi[r]); }
    float s[R];
#pragma unroll
    for (int r = 0; r < R; ++r) { s[r] = 0.f;
#pragma unroll
        for (int e = 0; e < 8; ++e) s[r] += lo[r][e] + hi[r][e]; }
#pragma unroll
    for (int o = 1; o < 64; o <<= 1)
#pragma unroll
        for (int r = 0; r < R; ++r) s[r] += __shfl_xor(s[r], o);
#pragma unroll
    for (int r = 0; r < R; ++r) { mean[r] = s[r] * (1.f / 1024.f); s[r] = 0.f;
#pragma unroll
        for (int e = 0; e < 8; ++e) { const float d0 = lo[r][e] - mean[r], d1 = hi[r][e] - mean[r]; s[r] += d0 * d0 + d1 * d1; } }
#pragma unroll
    for (int o = 1; o < 64; o <<= 1)
#pragma unroll
        for (int r = 0; r < R; ++r) s[r] += __shfl_xor(s[r], o);
#pragma unroll
    for (int r = 0; r < R; ++r) rstd[r] = rsqrtf(s[r] * (1.f / 1024.f) + EPS);
}
template <bool OUT_F32> __device__ __forceinline__ void rms_rows2(const float* x0, const float* g0, void* o0, const float* x1, const float* g1, void* o1, int lane) {
    const f32x4* xr0 = (const f32x4*)x0 + lane; const f32x4* xr1 = (const f32x4*)x1 + lane; f32x4 v0[8], v1[8]; float s0 = 0.f, s1 = 0.f;
#pragma unroll
    for (int j = 0; j < 8; ++j) { v0[j] = xr0[64 * j]; v1[j] = xr1[64 * j]; }
#pragma unroll
    for (int j = 0; j < 8; ++j) { s0 += (v0[j].x * v0[j].x + v0[j].y * v0[j].y) + (v0[j].z * v0[j].z + v0[j].w * v0[j].w); s1 += (v1[j].x * v1[j].x + v1[j].y * v1[j].y) + (v1[j].z * v1[j].z + v1[j].w * v1[j].w); }
#pragma unroll
    for (int o = 1; o < 64; o <<= 1) { s0 += __shfl_xor(s0, o); s1 += __shfl_xor(s1, o); }
    const float r0 = rsqrtf(s0 * (1.f / DM) + EPS), r1 = rsqrtf(s1 * (1.f / DM) + EPS);
    const f32x4* gr0 = (const f32x4*)g0 + lane; const f32x4* gr1 = (const f32x4*)g1 + lane;
#pragma unroll
    for (int j = 0; j < 8; ++j) { const f32x4 a = v0[j] * r0 * gr0[64 * j], b = v1[j] * r1 * gr1[64 * j];
        if (OUT_F32) { ((f32x4*)o0)[lane + 64 * j] = a; ((f32x4*)o1)[lane + 64 * j] = b; }
        else { u32x2 w; w.x = cvt_pk_bf16(a.x, a.y); w.y = cvt_pk_bf16(a.z, a.w); ((u32x2*)o0)[lane + 64 * j] = w; w.x = cvt_pk_bf16(b.x, b.y); w.y = cvt_pk_bf16(b.z, b.w); ((u32x2*)o1)[lane + 64 * j] = w; } }
}
__device__ __forceinline__ void phase_prologue(Frame& F) {
    LAS float* scr = (LAS float*)(F.lds + F.wave * 16384);
    const int gw = F.bx * NWAVES + F.wave, NGW = F.G * NWAVES;
    for (int it = CV_A0 + gw; it < CV_A1; it += NGW) convert_one(F, it, scr);
    bf16_t* XN = WSP(bf16_t, WS_XN);
    { const float* xp = IN(0); const float* xs = IN(1); const float* xm = IN(5); const float* gx = IN(6); const float* gm = IN(17);
      for (int m = gw; m < MT + 1024; m += 2 * NGW) {
        const int m2 = m + NGW;
        const float* s0 = m < MP ? xp + (size_t)m * DM : (m < MT ? xs + (size_t)(m - MP) * DM : xm + (size_t)(m - MT) * DM);
        if (m2 < MT + 1024) { const float* s1 = m2 < MP ? xp + (size_t)m2 * DM : (m2 < MT ? xs + (size_t)(m2 - MP) * DM : xm + (size_t)(m2 - MT) * DM);
            rms_rows2<false>(s0, m < MT ? gx : gm, XN + (size_t)m * DM, s1, m2 < MT ? gx : gm, XN + (size_t)m2 * DM, F.lane); }
        else rms_row<false>(s0, m < MT ? gx : gm, XN + (size_t)m * DM, F.lane);
      } }
    bf16_t* WS = WSP(bf16_t, WS_WSP);
    for (int i = F.bx * 512 + F.tid; i < 4 * 128 * 128; i += F.G * 512) { const int t = (i >> 7) & 127, s = i & 127; const float w = (s <= t) ? IN(10)[i] : 0.f; WS[i] = (bf16_t)(cvt_pk_bf16(w, 0.f) & 0xffff); }
}

__device__ __forceinline__ void phase_mixprep(Frame& F) {
    const bf16_t* P1 = WSP(bf16_t, WS_P1);
    {
        bf16_t* YB = WSP(bf16_t, WS_YA);   const float* cw = IN(12); const float* st = IN(2);
        for (int it = F.bx * 512 + F.tid; it < MT * 128; it += F.G * 512) {
            const int row = it >> 7, c0 = (it & 127) * 8;
            const bf16_t* pr = P1 + (size_t)row * NIN;
            float cg[8], xi[8], p0[8], p1[8], p2[8], bg[8];
            unpack8(*(const u32x4*)(pr + C_CG + c0), cg); unpack8(*(const u32x4*)(pr + C_XIN + c0), xi); unpack8(*(const u32x4*)(pr + C_BG + c0), bg);
#pragma unroll
            for (int e = 0; e < 8; ++e) p0[e] = cg[e] * xi[e];
            int pos, b; const bool prompt = row < MP;
            if (prompt) { pos = row & 2047; b = row >> 11; } else { pos = (row - MP) & 7; b = (row - MP) >> 3; }
            if (pos >= 1) { unpack8(*(const u32x4*)(pr - NIN + C_CG + c0), cg); unpack8(*(const u32x4*)(pr - NIN + C_XIN + c0), xi);
#pragma unroll
                for (int e = 0; e < 8; ++e) p1[e] = cg[e] * xi[e]; }
            else if (prompt) {
#pragma unroll
                for (int e = 0; e < 8; ++e) p1[e] = 0.f; }
            else { const f32x4 a = *(const f32x4*)(st + ((size_t)b * 2 + 1) * 1024 + c0), c = *(const f32x4*)(st + ((size_t)b * 2 + 1) * 1024 + c0 + 4);
                p1[0] = a.x; p1[1] = a.y; p1[2] = a.z; p1[3] = a.w; p1[4] = c.x; p1[5] = c.y; p1[6] = c.z; p1[7] = c.w; }
            if (pos >= 2) { unpack8(*(const u32x4*)(pr - 2 * NIN + C_CG + c0), cg); unpack8(*(const u32x4*)(pr - 2 * NIN + C_XIN + c0), xi);
#pragma unroll
                for (int e = 0; e < 8; ++e) p2[e] = cg[e] * xi[e]; }
            else if (prompt) {
#pragma unroll
                for (int e = 0; e < 8; ++e) p2[e] = 0.f; }
            else { const int sr = (pos == 1) ? 1 : 0; const f32x4 a = *(const f32x4*)(st + ((size_t)b * 2 + sr) * 1024 + c0), c = *(const f32x4*)(st + ((size_t)b * 2 + sr) * 1024 + c0 + 4);
                p2[0] = a.x; p2[1] = a.y; p2[2] = a.z; p2[3] = a.w; p2[4] = c.x; p2[5] = c.y; p2[6] = c.z; p2[7] = c.w; }
            float y[8];
#pragma unroll
            for (int e = 0; e < 8; ++e) y[e] = bg[e] * (cw[c0 + e] * p2[e] + cw[1024 + c0 + e] * p1[e] + cw[2048 + c0 + e] * p0[e]);
            u32x4 w; w.x = cvt_pk_bf16(y[0], y[1]); w.y = cvt_pk_bf16(y[2], y[3]); w.z = cvt_pk_bf16(y[4], y[5]); w.w = cvt_pk_bf16(y[6], y[7]);
            *(u32x4*)(YB + (size_t)row * DM + 1024 + c0) = w;
            const int tail = prompt ? 2046 : 6;
            if (pos >= tail) { float* o = F.out + (prompt ? O_CP : O_CS) + ((size_t)b * 2 + (pos - tail)) * 1024 + c0;
                *(f32x4*)o = (f32x4){p0[0], p0[1], p0[2], p0[3]}; *(f32x4*)(o + 4) = (f32x4){p0[4], p0[5], p0[6], p0[7]}; }
        }
    }
    {
        const float* lg = IN(8); const float* lb = IN(9); const float* wsp = IN(10); const float* bsp = IN(11);
        bf16_t* YA = WSP(bf16_t, WS_YA);
        const int gw = F.bx * NWAVES + F.wave, NGW = F.G * NWAVES;
        for (int item = gw; item < 256; item += NGW) {
            const int sq = item >> 1, jsel = item & 1;
            const int row0 = MP + sq * 8;
            float mu[8], rs[8];
            { float m4[4], r4[4], vlo[4][8], vhi[4][8];
              ln_stats<4>(P1 + (size_t)row0 * NIN + C_V + 8 * F.lane, NIN, m4, r4, vlo, vhi);
#pragma unroll
              for (int t = 0; t < 4; ++t) { mu[t] = m4[t]; rs[t] = r4[t]; }
              ln_stats<4>(P1 + (size_t)(row0 + 4) * NIN + C_V + 8 * F.lane, NIN, m4, r4, vlo, vhi);
#pragma unroll
              for (int t = 0; t < 4; ++t) { mu[4 + t] = m4[t]; rs[4 + t] = r4[t]; } }
            {
                const int j = jsel; const int c0 = 8 * F.lane + 512 * j, g = c0 >> 8;
                float gg[8], bb[8];
                { const f32x4 a = *(const f32x4*)(lg + c0), b = *(const f32x4*)(lg + c0 + 4), c = *(const f32x4*)(lb + c0), d = *(const f32x4*)(lb + c0 + 4);
                  gg[0] = a.x; gg[1] = a.y; gg[2] = a.z; gg[3] = a.w; gg[4] = b.x; gg[5] = b.y; gg[6] = b.z; gg[7] = b.w;
                  bb[0] = c.x; bb[1] = c.y; bb[2] = c.z; bb[3] = c.w; bb[4] = d.x; bb[5] = d.y; bb[6] = d.z; bb[7] = d.w; }
                float vl[8][8];
#pragma unroll
                for (int t = 0; t < 8; ++t) {
                    float a[8]; unpack8(*(const u32x4*)(P1 + (size_t)(row0 + t) * NIN + C_V + c0), a);
#pragma unroll
                    for (int e = 0; e < 8; ++e) vl[t][e] = (a[e] - mu[t]) * rs[t] * gg[e] + bb[e];
                    float* o = F.out + O_CV + (size_t)(sq * 8 + t) * 1024 + c0;
                    *(f32x4*)o = (f32x4){vl[t][0], vl[t][1], vl[t][2], vl[t][3]}; *(f32x4*)(o + 4) = (f32x4){vl[t][4], vl[t][5], vl[t][6], vl[t][7]};
                }
#pragma unroll
                for (int t = 0; t < 8; ++t) {
                    float z[8]; const float bs = bsp[g * 128 + t];
#pragma unroll
                    for (int e = 0; e < 8; ++e) z[e] = bs;
#pragma unroll
                    for (int s = 0; s < 8; ++s) if (s <= t) { const float w = wsp[(size_t)g * 16384 + t * 128 + s];
#pragma unroll
                        for (int e = 0; e < 8; ++e) z[e] += w * vl[s][e]; }
                    float uf[8]; unpack8(*(const u32x4*)(P1 + (size_t)(row0 + t) * NIN + C_U + c0), uf);
                    u32x4 w; w.x = cvt_pk_bf16(uf[0] * z[0], uf[1] * z[1]); w.y = cvt_pk_bf16(uf[2] * z[2], uf[3] * z[3]); w.z = cvt_pk_bf16(uf[4] * z[4], uf[5] * z[5]); w.w = cvt_pk_bf16(uf[6] * z[6], uf[7] * z[7]);
                    *(u32x4*)(YA + (size_t)(row0 + t) * DM + c0) = w;
                }
            }
        }
    }
    {
        const float* lg = IN(8); const float* lb = IN(9);
        bf16_t* VT = WSP(bf16_t, WS_VT);
        LAS bf16_t* T = (LAS bf16_t*)F.lds;
        for (int un = F.bx; un < 256; un += F.G) {
            const int chunk = un >> 2, g = un & 3;
            const bool mine = ((F.lane >> 5) == (g & 1));
            const int cm = 256 * g + 8 * (F.lane & 31);
            float gg[8], bb[8];
            { const f32x4 a = *(const f32x4*)(lg + cm), b = *(const f32x4*)(lg + cm + 4), c = *(const f32x4*)(lb + cm), d = *(const f32x4*)(lb + cm + 4);
              gg[0] = a.x; gg[1] = a.y; gg[2] = a.z; gg[3] = a.w; gg[4] = b.x; gg[5] = b.y; gg[6] = b.z; gg[7] = b.w;
              bb[0] = c.x; bb[1] = c.y; bb[2] = c.z; bb[3] = c.w; bb[4] = d.x; bb[5] = d.y; bb[6] = d.z; bb[7] = d.w; }
            for (int rr = 0; rr < 16; rr += 4) {
                const int s0 = F.wave * 16 + rr;
                float mean[4], rstd[4], vlo[4][8], vhi[4][8];
                ln_stats<4>(P1 + (size_t)(chunk * 128 + s0) * NIN + C_V + 8 * F.lane, NIN, mean, rstd, vlo, vhi);
                if (mine) {
#pragma unroll
                    for (int r = 0; r < 4; ++r) {
                        float y[8];
#pragma unroll
                        for (int e = 0; e < 8; ++e) { const float xl = vlo[r][e], xh = vhi[r][e]; const float x = (g >> 1) ? xh : xl; y[e] = (x - mean[r]) * rstd[r] * gg[e] + bb[e]; }
                        u32x4 w; w.x = cvt_pk_bf16(y[0], y[1]); w.y = cvt_pk_bf16(y[2], y[3]); w.z = cvt_pk_bf16(y[4], y[5]); w.w = cvt_pk_bf16(y[6], y[7]);
                        *(LAS u32x4*)(T + (s0 + r) * 264 + 8 * (F.lane & 31)) = w;
                    }
                }
            }
            __syncthreads();
#pragma unroll 2
            for (int itn = 0; itn < 8; ++itn) {
                const int idx = itn * 512 + F.tid, c = idx >> 4, sb = idx & 15;
                unsigned short h[8];
#pragma unroll
                for (int i = 0; i < 8; ++i) h[i] = T[(8 * sb + i) * 264 + c];
                u32x4 w; w.x = (unsigned)h[0] | ((unsigned)h[1] << 16); w.y = (unsigned)h[2] | ((unsigned)h[3] << 16); w.z = (unsigned)h[4] | ((unsigned)h[5] << 16); w.w = (unsigned)h[6] | ((unsigned)h[7] << 16);
                *(u32x4*)(VT + ((size_t)chunk * 1024 + g * 256 + c) * 128 + 8 * sb) = w;
            }
            __syncthreads();
        }
    }
}

__device__ __forceinline__ void sample_attn_unit(Frame& F, int unit, bool tail) {
    const int b = unit >> 2, h = unit & 3, lane = F.lane, wave = F.wave, r16 = lane & 15, kq = lane >> 4;
    const float* Kb = IN(3) + ((size_t)b * NMEM * XH + h) * XD;
    const float* Vb = IN(4) + ((size_t)b * NMEM * XH + h) * XD;
    const bf16_t* Qb = WSP(bf16_t, WS_Q) + (size_t)(MP + b * 8) * DM + h * XD;
    LAS bf16_t* sP = (LAS bf16_t*)F.lds;
    LAS float* sSt = (LAS float*)(F.lds + 16 * 528);
    LAS bf16_t* sQ = (LAS bf16_t*)(F.lds + 9472);
    if (tail) {
        const int t = F.tid >> 6, d0 = (F.tid & 63) * 8;
        const bf16_t* pp = WSP(bf16_t, WS_PART) + (size_t)(b * 8 + t) * DM + h * XD + d0;
        f32x4 a0 = {0.f, 0.f, 0.f, 0.f}, a1 = {0.f, 0.f, 0.f, 0.f};
#pragma unroll
        for (int s = 0; s < 8; ++s) { float f[8]; unpack8(*(const u32x4*)(pp + (size_t)s * (MS * DM)), f); a0 = a0 + (f32x4){f[0], f[1], f[2], f[3]}; a1 = a1 + (f32x4){f[4], f[5], f[6], f[7]}; }
        a0 = a0 * QSCALE; a1 = a1 * QSCALE;
        *(LAS bf16x8*)(sQ + t * 520 + d0) = pack8(a0, a1);
        __syncthreads();
    }
    f32x4 s0 = {0.f, 0.f, 0.f, 0.f}, s1 = {0.f, 0.f, 0.f, 0.f};
    const float* k0p = Kb + (size_t)(32 * wave + r16) * (XH * XD) + kq * 8;
    const float* k1p = k0p + (size_t)16 * (XH * XD);
    const bf16_t* qp = Qb + (size_t)(r16 & 7) * DM + kq * 8;
#pragma unroll 4
    for (int ds = 0; ds < 16; ++ds) {
        const f32x4 a0 = *(const f32x4*)(k0p + ds * 32), a1 = *(const f32x4*)(k0p + ds * 32 + 4);
        const f32x4 c0 = *(const f32x4*)(k1p + ds * 32), c1 = *(const f32x4*)(k1p + ds * 32 + 4);
        u32x4 qw = tail ? *(const LAS u32x4*)(sQ + (r16 & 7) * 520 + kq * 8 + ds * 32) : *(const u32x4*)(qp + ds * 32); if (r16 >= 8) qw = (u32x4){0u, 0u, 0u, 0u};
        const bf16x8 qf = __builtin_bit_cast(bf16x8, qw);
        s0 = __builtin_amdgcn_mfma_f32_16x16x32_bf16(pack8(a0, a1), qf, s0, 0, 0, 0);
        s1 = __builtin_amdgcn_mfma_f32_16x16x32_bf16(pack8(c0, c1), qf, s1, 0, 0, 0);
    }
    float mx = fmaxf(fmaxf(fmaxf(s0[0], s0[1]), fmaxf(s0[2], s0[3])), fmaxf(fmaxf(s1[0], s1[1]), fmaxf(s1[2], s1[3])));
    mx = fmaxf(mx, __shfl_xor(mx, 16)); mx = fmaxf(mx, __shfl_xor(mx, 32));
    float sm = 0.f;
#pragma unroll
    for (int j = 0; j < 4; ++j) { s0[j] = __expf(s0[j] - mx); s1[j] = __expf(s1[j] - mx); sm += s0[j] + s1[j]; }
    sm += __shfl_xor(sm, 16); sm += __shfl_xor(sm, 32);
    if (kq == 0) { sSt[(wave * 16 + r16) * 2] = mx; sSt[(wave * 16 + r16) * 2 + 1] = sm; }
    __syncthreads();
    float M = -3.0e38f;
#pragma unroll
    for (int w2 = 0; w2 < 8; ++w2) M = fmaxf(M, sSt[(w2 * 16 + r16) * 2]);
    float L = 0.f;
#pragma unroll
    for (int w2 = 0; w2 < 8; ++w2) L += sSt[(w2 * 16 + r16) * 2 + 1] * __expf(sSt[(w2 * 16 + r16) * 2] - M);
    const float f = __expf(mx - M) / L;
    { u32x2 w; w.x = cvt_pk_bf16(s0[0] * f, s0[1] * f); w.y = cvt_pk_bf16(s0[2] * f, s0[3] * f); *(LAS u32x2*)(sP + r16 * 264 + 32 * wave + 4 * kq) = w;
      w.x = cvt_pk_bf16(s1[0] * f, s1[1] * f); w.y = cvt_pk_bf16(s1[2] * f, s1[3] * f); *(LAS u32x2*)(sP + r16 * 264 + 32 * wave + 16 + 4 * kq) = w; }
    __syncthreads();
    f32x4 o[4];
#pragma unroll
    for (int c = 0; c < 4; ++c) o[c] = (f32x4){0.f, 0.f, 0.f, 0.f};
    const float* vp = Vb + (size_t)(kq * 8) * (XH * XD) + 64 * wave + 4 * r16;
#pragma unroll 2
    for (int ms = 0; ms < 8; ++ms) {
        const bf16x8 pf = *(const LAS bf16x8*)(sP + r16 * 264 + ms * 32 + kq * 8);
        f32x4 x[8];
#pragma unroll
        for (int j = 0; j < 8; ++j) x[j] = *(const f32x4*)(vp + (size_t)(ms * 32 + j) * (XH * XD));
#pragma unroll
        for (int c = 0; c < 4; ++c) {
            const bf16x8 a = pack8((f32x4){x[0][c], x[1][c], x[2][c], x[3][c]}, (f32x4){x[4][c], x[5][c], x[6][c], x[7][c]});
            o[c] = __builtin_amdgcn_mfma_f32_16x16x32_bf16(a, pf, o[c], 0, 0, 0);
        }
    }
    if (r16 < 8) {
        bf16_t* op = WSP(bf16_t, WS_O) + (size_t)(MP + b * 8 + r16) * DM + h * XD + 64 * wave + 16 * kq;
        u32x4 w0, w1;
        w0.x = cvt_pk_bf16(o[0][0], o[1][0]); w0.y = cvt_pk_bf16(o[2][0], o[3][0]); w0.z = cvt_pk_bf16(o[0][1], o[1][1]); w0.w = cvt_pk_bf16(o[2][1], o[3][1]);
        w1.x = cvt_pk_bf16(o[0][2], o[1][2]); w1.y = cvt_pk_bf16(o[2][2], o[3][2]); w1.z = cvt_pk_bf16(o[0][3], o[1][3]); w1.w = cvt_pk_bf16(o[2][3], o[3][3]);
        *(u32x4*)op = w0; *(u32x4*)(op + 8) = w1;
    }
    __syncthreads();
}

template <bool OUT_F32> __device__ __forceinline__ void phase_rms(Frame& F, const float* src, const float* g, void* dst, const bf16_t* part, const float* sbase, float* hout) {
    const int gw = F.bx * NWAVES + F.wave, NGW = F.G * NWAVES, lane = F.lane;
    for (int mm = gw; mm < MT; mm += 2 * NGW) {
      const int m2 = mm + NGW; const bool reg0 = (mm < MP || part == nullptr), reg1 = (m2 < MT) && (m2 < MP || part == nullptr);
      if (reg0 && reg1) { rms_rows2<OUT_F32>(src + (size_t)mm * DM, g, OUT_F32 ? (void*)((float*)dst + (size_t)mm * DM) : (void*)((bf16_t*)dst + (size_t)mm * DM),
                                              src + (size_t)m2 * DM, g, OUT_F32 ? (void*)((float*)dst + (size_t)m2 * DM) : (void*)((bf16_t*)dst + (size_t)m2 * DM), lane); continue; }
      for (int m = mm; m <= m2 && m < MT; m += NGW) {
        void* orow = OUT_F32 ? (void*)((float*)dst + (size_t)m * DM) : (void*)((bf16_t*)dst + (size_t)m * DM);
        if (m < MP || part == nullptr) { rms_row<OUT_F32>(src + (size_t)m * DM, g, orow, lane); continue; }
        const int ms = m - MP;
        const f32x4* xr = (const f32x4*)(sbase + (size_t)ms * DM) + lane; f32x4 v[8]; float ss = 0.f;
#pragma unroll
        for (int j = 0; j < 8; ++j) v[j] = xr[64 * j];
#pragma unroll
        for (int s = 0; s < 8; ++s) { const u32x2* pr = (const u32x2*)(part + (size_t)s * (MS * DM) + (size_t)ms * DM) + lane;
#pragma unroll
            for (int j = 0; j < 8; ++j) { const u32x2 w = pr[64 * j]; v[j] = v[j] + (f32x4){bf_lo(w.x), bf_hi(w.x), bf_lo(w.y), bf_hi(w.y)}; } }
#pragma unroll
        for (int j = 0; j < 8; ++j) { ss += (v[j].x * v[j].x + v[j].y * v[j].y) + (v[j].z * v[j].z + v[j].w * v[j].w); if (hout) ((f32x4*)(hout + (size_t)ms * DM))[lane + 64 * j] = v[j]; }
        const float r = rsqrtf(wave_sum(ss) * (1.f / DM) + EPS);
        const f32x4* gr = (const f32x4*)g + lane;
#pragma unroll
        for (int j = 0; j < 8; ++j) { const f32x4 gg = gr[64 * j]; const f32x4 o = v[j] * r * gg;
            if (OUT_F32) ((f32x4*)orow)[lane + 64 * j] = o;
            else { u32x2 w; w.x = cvt_pk_bf16(o.x, o.y); w.y = cvt_pk_bf16(o.z, o.w); ((u32x2*)orow)[lane + 64 * j] = w; } }
      }
    }
}

__global__ void __launch_bounds__(NWAVES * 64, 2) fwd_megakernel(Args args) {
    extern __shared__ __attribute__((aligned(16))) unsigned char lds_raw[];
    cg::grid_group grid = cg::this_grid();
    Frame F;
    F.lds = (LAS unsigned char*)lds_raw;
    F.tid = threadIdx.x; F.lane = F.tid & 63; F.wave = __builtin_amdgcn_readfirstlane(F.tid >> 6);
    F.G = gridDim.x; F.bx = blockIdx.x;
    F.out = args.out; F.ws = args.ws;
    volatile LAS unsigned* MISC = (volatile LAS unsigned*)(F.lds + 131072 + 320);
    if (F.tid < 32) MISC[F.tid] = 0u;
    __syncthreads();
    XcdBarrier xbar = xcd_barrier_post((unsigned*)(F.ws + WS_CTL) + 4096, MISC + 8);
#define SEAM0() do { grid.sync(); int t_ = threadIdx.x; asm volatile("" : "+v"(t_)); F.tid = t_; F.lane = t_ & 63; } while (0)
#define SEAM() do { xcd_barrier(xbar); int t_ = threadIdx.x; asm volatile("" : "+v"(t_)); F.tid = t_; F.lane = t_ & 63; { unsigned char* w_ = F.ws; float* o_ = F.out; asm volatile("" : "+s"(w_), "+s"(o_)); F.ws = w_; F.out = o_; } } while (0)
#ifndef PHASE_MASK
#define PHASE_MASK 0xffffffffu
#endif
#define PH(k) ((PHASE_MASK >> (k)) & 1u)
    using namespace pg8;
    const char* XN = (const char*)(F.ws + WS_XN);
    const bool tail = (F.G == 256);

    if (PH(0)) phase_prologue(F);
    SEAM0();
    if (PH(1)) {
        SchedIn S{XN, (const char*)(F.ws + WS_WIN), F.G, F.bx};
        EpiIn E{WSP(bf16_t, WS_P1), F.out + O_MK, F.out + O_MV, WSP(bf16_t, WS_KP), WSP(bf16_t, WS_VPT)};
        gemm_phase<EpiIn, SchedIn, true>(F.lds, DM, DM, S, E);
        convert_fill(F, CV_A1, CV_B1, 1296 + 64);
    }
    SEAM();
    if (PH(2)) phase_mixprep(F);
    SEAM();
    if (PH(3)) {
        SchedSp S{(const char*)(F.ws + WS_WSP), (const char*)(F.ws + WS_VT), F.G, F.bx};
        EpiSp E{WSP(bf16_t, WS_P1), IN(11), WSP(bf16_t, WS_YA)};
        gemm_phase<EpiSp, SchedSp, true>(F.lds, 128, 128, S, E);
    }
    SEAM();
    if (PH(4)) {
        SchedRect S{(const char*)(F.ws + WS_YA), (const char*)(F.ws + WS_WA), (size_t)BM * DM * 2, (size_t)BM * DM * 2, 36, 8, F.G, F.bx, 32};
        EpiMerged E{WSP(bf16_t, WS_P1), WSP(bf16_t, WS_MRG)};
        gemm_phase<EpiMerged, SchedRect, true>(F.lds, DM, DM, S, E);
        convert_fill(F, CV_B1, CV_C1, 288);
    }
    SEAM();
    if (PH(6)) {
        SchedTail S{(const char*)(F.ws + WS_MRG), (const char*)(F.ws + WS_WMIX), (size_t)BM * DM * 2, (size_t)BM * DM * 2, 32, F.G, F.bx, tail};
        EpiTail<EpiRes> E{{IN(0), IN(1), MP, WSP(float, WS_H1)}, WSP(bf16_t, WS_PART)};
        gemm_phase<EpiTail<EpiRes>, SchedTail, true>(F.lds, DM, DM, S, E);
    }
    SEAM();
    phase_rms<false>(F, WSP(float, WS_H1), IN(16), WSP(bf16_t, WS_XN), tail ? WSP(bf16_t, WS_PART) : nullptr, IN(1), WSP(float, WS_H1) + (size_t)MP * DM);
    SEAM();
    if (PH(7)) {
        SchedTail S{XN, (const char*)(F.ws + WS_WQ), (size_t)BM * DM * 2, (size_t)BM * DM * 2, 32, F.G, F.bx, tail};
        EpiTail<EpiBf<0>> E{{WSP(bf16_t, WS_Q), DM, QSCALE}, WSP(bf16_t, WS_PART)};
        gemm_phase<EpiTail<EpiBf<0>>, SchedTail, true>(F.lds, DM, DM, S, E);
    }
    SEAM();
    if (PH(8)) {
        SchedS S{(const char*)(F.ws + WS_Q), (const char*)(F.ws + WS_KP), F.G, F.bx};
        EpiSoftmax E{WSP(bf16_t, WS_PS)};
        gemm_phase<EpiSoftmax, SchedS, false>(F.lds, DM, DM, S, E);
        __syncthreads();
        for (int un = F.bx; un < 512; un += F.G) sample_attn_unit(F, un, tail);
    }
    SEAM();
    if (PH(9)) {
        SchedO S{(const char*)(F.ws + WS_PS), (const char*)(F.ws + WS_VPT), F.G, F.bx};
        EpiBf<0> E{WSP(bf16_t, WS_O), DM, 1.0f};
        gemm_phase<EpiBf<0>, SchedO, true>(F.lds, 256, 256, S, E);
    }
    SEAM();
    if (PH(10)) {
        SchedTail S{(const char*)(F.ws + WS_O), (const char*)(F.ws + WS_WXO), (size_t)BM * DM * 2, (size_t)BM * DM * 2, 32, F.G, F.bx, tail};
        EpiTail<EpiRes> E{{WSP(float, WS_H1), WSP(float, WS_H1), 1 << 30, WSP(float, WS_H2)}, WSP(bf16_t, WS_PART)};
        gemm_phase<EpiTail<EpiRes>, SchedTail, true>(F.lds, DM, DM, S, E);
    }
    SEAM();
    phase_rms<false>(F, WSP(float, WS_H2), IN(22), WSP(bf16_t, WS_XN), tail ? WSP(bf16_t, WS_PART) : nullptr, WSP(float, WS_H1) + (size_t)MP * DM, WSP(float, WS_H2) + (size_t)MP * DM);
    SEAM();
    if (PH(11)) {
        SchedRect S{XN, (const char*)(F.ws + WS_WUP), (size_t)BM * DM * 2, (size_t)BM * DM * 2, 36, 32, F.G, F.bx, 32};
        EpiBf<1> E{WSP(bf16_t, WS_UP), FF, 1.0f};
        gemm_phase<EpiBf<1>, SchedRect, true>(F.lds, DM, DM, S, E);
        convert_fill(F, CV_C1, CV_D1, 36 * 32);
    }
    SEAM();
    if (PH(12)) {
        SchedTail S{(const char*)(F.ws + WS_UP), (const char*)(F.ws + WS_WDN), (size_t)BM * FF * 2, (size_t)BM * FF * 2, 128, F.G, F.bx, tail};
        EpiTail<EpiRes> E{{WSP(float, WS_H2), WSP(float, WS_H2), 1 << 30, WSP(float, WS_H2)}, WSP(bf16_t, WS_PART)};
        gemm_phase<EpiTail<EpiRes>, SchedTail, true>(F.lds, FF, FF, S, E);
    }
    SEAM();
    phase_rms<true>(F, WSP(float, WS_H2), IN(25), F.out + O_Y, tail ? WSP(bf16_t, WS_PART) : nullptr, WSP(float, WS_H2) + (size_t)MP * DM, nullptr);
}

extern "C" void kernel_launch(void* const* d_in, const int* in_sizes, int n_in, void* d_out, int out_size, void* d_ws, size_t ws_size, hipStream_t stream) {
    static int grid = 0;
    if (grid == 0) {
        if (n_in != 26 || ws_size < WS_END) { fprintf(stderr, "kernel_launch: unexpected n_in %d / ws_size %zu\n", n_in, ws_size); grid = -1; return; }
        int dev = 0, cus = 0, per_cu = 0;
        hipGetDevice(&dev);
        hipDeviceGetAttribute(&cus, hipDeviceAttributeMultiprocessorCount, dev);
        if (hipFuncSetAttribute((const void*)fwd_megakernel, hipFuncAttributeMaxDynamicSharedMemorySize, LDS_BYTES) != hipSuccess) { fprintf(stderr, "kernel_launch: hipFuncSetAttribute failed\n"); grid = -1; return; }
        if (hipOccupancyMaxActiveBlocksPerMultiprocessor(&per_cu, (const void*)fwd_megakernel, NWAVES * 64, LDS_BYTES) != hipSuccess || per_cu < 1) { fprintf(stderr, "kernel_launch: occupancy query says %d\n", per_cu); per_cu = 1; }
        (void)hipGetLastError();
        grid = cus;
        if (grid < 128) { fprintf(stderr, "kernel_launch: needs >= 128 CUs\n"); grid = -1; return; }
    }
    if (grid < 0) return;
    if (hipMemsetAsync((char*)d_ws + WS_CTL, 0, 65536, stream) != hipSuccess) { fprintf(stderr, "kernel_launch: memset failed\n"); return; }
    Args a{};
    for (int i = 0; i < 26; ++i) a.in[i] = (const float*)d_in[i];
    a.out = (float*)d_out; a.ws = (unsigned char*)d_ws;
    void* kargs[] = {&a};
    hipError_t e = hipLaunchCooperativeKernel((const void*)fwd_megakernel, dim3(grid), dim3(NWAVES * 64), kargs, LDS_BYTES, stream);
    if (e != hipSuccess) fprintf(stderr, "kernel_launch: cooperative launch failed: %s (grid %d)\n", hipGetErrorString(e), grid);
}
```

```cpp
#include <hip/hip_runtime.h>
#include <hip/hip_cooperative_groups.h>
#include <cstdio>
#include <cstdint>
namespace cg = cooperative_groups;

#define LAS __attribute__((address_space(3)))
typedef unsigned short bf16_t;
typedef short bf16x8 __attribute__((ext_vector_type(8)));
typedef float f32x4 __attribute__((ext_vector_type(4)));
typedef float f32x2 __attribute__((ext_vector_type(2)));
typedef unsigned u32x4 __attribute__((ext_vector_type(4)));
typedef unsigned u32x2 __attribute__((ext_vector_type(2)));

constexpr int DM = 2048, MP = 8192, MS = 1024, MT = MP + MS  ;
constexpr int NIN = 9216, FF = 8192, NMEM = 256, XH = 4, XD = 512;
constexpr int C_U = 0, C_V = 1024, C_BG = 2048, C_CG = 3072, C_XIN = 4096, C_GA = 5120, C_GB = 7168;
constexpr float EPS = 1e-6f, QSCALE = 0.04419417382415922f  ;
constexpr size_t O_Y = 0, O_MK = 18874368, O_MV = 20971520, O_CP = 23068672, O_CS = 23076864, O_CV = 23339008;
constexpr size_t MiB = 1u << 20;
constexpr size_t WS_CTL = 0, CTL_BYTES = 1 * MiB;
constexpr size_t WS_WIN = 2 * MiB;
constexpr size_t WS_WA = 54 * MiB, WS_WB = 58 * MiB;
constexpr size_t WS_WMIX = 62 * MiB, WS_WQ = 70 * MiB, WS_WXO = 78 * MiB;
constexpr size_t WS_WUP = 86 * MiB;
constexpr size_t WS_WDN = 118 * MiB;
constexpr size_t WS_WSP = 150 * MiB;
constexpr size_t WS_XN = 152 * MiB;
constexpr size_t WS_P1 = 192 * MiB;
constexpr size_t WS_UP = 192 * MiB;
constexpr size_t WS_VT = 354 * MiB;
constexpr size_t WS_YA = 370 * MiB, WS_YB = 388 * MiB;
constexpr size_t WS_TMP = 406 * MiB;
constexpr size_t WS_PART = 406 * MiB;
constexpr size_t WS_MRG = 478 * MiB;
constexpr size_t WS_H1 = 514 * MiB;
constexpr size_t WS_Q = 586 * MiB;
constexpr size_t WS_KP = 622 * MiB;
constexpr size_t WS_VPT = 626 * MiB;
constexpr size_t WS_PS = 630 * MiB;
constexpr size_t WS_O = 646 * MiB;
constexpr size_t WS_H2 = 682 * MiB;
constexpr size_t WS_END = 754 * MiB;

constexpr int LDS_BYTES = 147456;
constexpr int NWAVES = 8;

__device__ __forceinline__ unsigned cvt_pk_bf16(float lo, float hi) { unsigned r; asm volatile("v_cvt_pk_bf16_f32 %0, %1, %2" : "=v"(r) : "v"(lo), "v"(hi)); return r; }
__device__ __forceinline__ float bf_lo(unsigned u) { return __uint_as_float(u << 16); }
__device__ __forceinline__ float bf_hi(unsigned u) { return __uint_as_float(u & 0xffff0000u); }
__device__ __forceinline__ float bf1(bf16_t h) { return __uint_as_float(((unsigned)h) << 16); }
__device__ __forceinline__ bf16x8 pack8(f32x4 a, f32x4 b) {
    u32x4 w; w.x = cvt_pk_bf16(a.x, a.y); w.y = cvt_pk_bf16(a.z, a.w); w.z = cvt_pk_bf16(b.x, b.y); w.w = cvt_pk_bf16(b.z, b.w);
    return __builtin_bit_cast(bf16x8, w);
}
__device__ __forceinline__ void unpack8(u32x4 w, float (&f)[8]) {
    f[0] = bf_lo(w.x); f[1] = bf_hi(w.x); f[2] = bf_lo(w.y); f[3] = bf_hi(w.y); f[4] = bf_lo(w.z); f[5] = bf_hi(w.z); f[6] = bf_lo(w.w); f[7] = bf_hi(w.w);
}
__device__ __forceinline__ float wave_sum(float v) {
#pragma unroll
    for (int o = 1; o < 64; o <<= 1) v += __shfl_xor(v, o);
    return v;
}
__device__ __forceinline__ float sigmoidf_(float x) { return __builtin_amdgcn_rcpf(1.0f + __expf(-x)); }
#define LDS_WAIT() asm volatile("s_waitcnt lgkmcnt(0)" ::: "memory")

namespace pg8 {
constexpr int BM = 256, BK = 64, HALF = 128, HTB = HALF * BK * 2, STAGE_BYTES = 8 * HTB, NXCD = 8, WGM = 8;
__host__ __device__ __forceinline__ int lds_byte(int r, int c) { const int st = (r >> 4) * 2 + (c >> 5), rr = r & 15, cc = c & 31, ob = rr * 64 + cc * 2; return st * 1024 + (ob ^ (((ob >> 9) & 1) << 5)); }
__host__ __device__ __forceinline__ void stage_rc(int b, int& R, int& C) { const int st = b / 1024, sb = b % 1024, swz = sb ^ (((sb >> 9) & 1) << 5); R = (st >> 1) * 16 + swz / 64; C = (st & 1) * 32 + (swz % 64) / 2; }
__host__ __device__ __forceinline__ int perm32(int rho) { const int n = rho >> 4, i = rho & 15; return 8 * (i >> 2) + 4 * n + (i & 3); }

struct Unit { const char* A; const char* B; int orow, ocol, aux, nkt; };

__device__ __forceinline__ void rect_order(int L, int nM, int nN, int& pm, int& pn) {
    const int nwg = nM * nN; int wgid = L;
    { const int q = nwg / NXCD, r = nwg % NXCD, xcd = wgid % NXCD, off = wgid / NXCD; wgid = (xcd < r ? xcd * (q + 1) : r * (q + 1) + (xcd - r) * q) + off; }
    const int nig = WGM * nN, gid = wgid / nig, fm = gid * WGM, gsz = (nM - fm) < WGM ? (nM - fm) : WGM;
    pm = fm + ((wgid % nig) % gsz); pn = (wgid % nig) / gsz;
}

template <class Epi, class Sched, bool ALIGN_EPI>
__device__ __forceinline__ void gemm_phase(LAS unsigned char* lds, const int lda, const int ldb, const Sched& S, const Epi& E) {
    int tid_ = threadIdx.x; asm volatile("" : "+v"(tid_));
    const int tid = tid_, wid = __builtin_amdgcn_readfirstlane(tid >> 6), lane = tid & 63, wr = wid >> 2, wc = wid & 3, fr = lane & 15, fq = lane >> 4;
    unsigned voffA[2], voffB[2];
#pragma unroll
    for (int i = 0; i < 2; ++i) { int R, C; stage_rc(tid * 16 + i * 8192, R, C); const int Rb = Epi::PERM ? ((R & ~31) + perm32(R & 31)) : R;
        voffA[i] = (unsigned)(R * lda + C) * 2u; voffB[i] = (unsigned)(Rb * ldb + C) * 2u; }
    const size_t kstep = (size_t)(BK * 2);
    const size_t hstepA = (size_t)HALF * lda * 2, hstepB = (size_t)HALF * ldb * 2;
    const unsigned ldsw = (unsigned)wid * 1024u;
    const int aoff = lds_byte(wr * 64 + fr, fq * 8), boff = lds_byte(wc * 32 + fr, fq * 8);
#define PG8_SA(b, h) (((b) * 2 + (h)) * HTB)
#define PG8_SB(b, h) ((4 + (b) * 2 + (h)) * HTB)
#define PG8_STAGE(bufoff, gbase, voff) do { _Pragma("unroll") for (int _i = 0; _i < 2; ++_i) \
        __builtin_amdgcn_global_load_lds((const unsigned*)((const char*)(gbase) + (voff)[_i]), (LAS unsigned*)(lds + (bufoff) + ldsw + _i * 8192), 16, 0, 0); } while (0)
#define PG8_LDA(dst, b, h) do { _Pragma("unroll") for (int m = 0; m < 4; ++m) _Pragma("unroll") for (int k = 0; k < 2; ++k) dst[m][k] = *(const LAS bf16x8*)(lds + PG8_SA(b, h) + aoff + m * 2048 + k * 1024); } while (0)
#define PG8_LDB(dst, b, h) do { _Pragma("unroll") for (int n = 0; n < 2; ++n) _Pragma("unroll") for (int k = 0; k < 2; ++k) dst[n][k] = *(const LAS bf16x8*)(lds + PG8_SB(b, h) + boff + n * 2048 + k * 1024); } while (0)
#define PG8_MMA(ai, bj, At, Bt) do { __builtin_amdgcn_s_setprio(1); _Pragma("unroll") for (int m = 0; m < 4; ++m) _Pragma("unroll") for (int n = 0; n < 2; ++n) _Pragma("unroll") for (int k = 0; k < 2; ++k) \
        acc[ai][bj][m][n] = __builtin_amdgcn_mfma_f32_16x16x32_bf16(Bt[n][k], At[m][k], acc[ai][bj][m][n], 0, 0, 0); __builtin_amdgcn_s_setprio(0); } while (0)
#define PG8_WAIT_V(n) asm volatile("s_waitcnt vmcnt(" #n ")" ::: "memory")
#define PG8_WAIT_L(n) asm volatile("s_waitcnt lgkmcnt(" #n ")" ::: "memory")
#define PG8_BAR __builtin_amdgcn_s_barrier()
#define PG8_SCHED __builtin_amdgcn_sched_barrier(0)
    Unit cur, nxt; int ui = 0;
    if (!S.next(0, cur)) return;
    f32x4 acc[2][2][4][2];
#pragma unroll
    for (int a = 0; a < 2; ++a)
#pragma unroll
        for (int b = 0; b < 2; ++b)
#pragma unroll
            for (int m = 0; m < 4; ++m)
#pragma unroll
                for (int n = 0; n < 2; ++n) acc[a][b][m][n] = (f32x4){0.f, 0.f, 0.f, 0.f};
    bf16x8 At[4][2], B0[2][2], B1[2][2];
    const char* cA = cur.A; const char* cB = cur.B;
    PG8_STAGE(PG8_SB(0, 0), cB, voffB); PG8_STAGE(PG8_SB(0, 1), cB + hstepB, voffB); PG8_STAGE(PG8_SA(0, 0), cA, voffA); PG8_STAGE(PG8_SA(0, 1), cA + hstepA, voffA);
    if (wr == 1) PG8_BAR;
    PG8_WAIT_V(2); PG8_BAR;
    PG8_STAGE(PG8_SB(1, 0), cB + kstep, voffB); PG8_STAGE(PG8_SA(1, 0), cA + kstep, voffA); PG8_STAGE(PG8_SB(1, 1), cB + hstepB + kstep, voffB);
    PG8_WAIT_V(6); PG8_BAR;
    for (;;) {
        const bool has_next = S.next(ui + 1, nxt);
        int nt = cur.nkt; asm volatile("" : "+s"(nt));
        const char* nA = has_next ? nxt.A : cA; const char* nB = has_next ? nxt.B : cB;
        for (int t = 0; t < nt; t += 2) {
            const bool last = (t == nt - 2);
            const char* a1 = cA + (size_t)(t + 1) * kstep;
            const char* a2 = last ? nA : cA + (size_t)(t + 2) * kstep; const char* b2 = last ? nB : cB + (size_t)(t + 2) * kstep;
            const char* a3 = a2 + kstep; const char* b3 = b2 + kstep;
            if constexpr (Epi::MIDK) { if (t == (nt >> 1)) E.mid(acc, cur, wr, wc, fr, fq); }
            PG8_LDB(B0, 0, 0); PG8_LDB(B1, 0, 1); PG8_SCHED; PG8_LDA(At, 0, 0); PG8_STAGE(PG8_SA(1, 1), a1 + hstepA, voffA);
            PG8_WAIT_V(8); PG8_WAIT_L(0); PG8_BAR; PG8_MMA(0, 0, At, B0); PG8_MMA(0, 1, At, B1); PG8_BAR; PG8_SCHED;
            PG8_LDA(At, 0, 1); PG8_STAGE(PG8_SB(0, 0), b2, voffB); PG8_STAGE(PG8_SB(0, 1), b2 + hstepB, voffB); PG8_STAGE(PG8_SA(0, 0), a2, voffA);
            PG8_WAIT_V(8); PG8_WAIT_L(0); PG8_BAR; PG8_MMA(1, 0, At, B0); PG8_MMA(1, 1, At, B1); PG8_BAR; PG8_SCHED;
            PG8_LDB(B0, 1, 0); PG8_LDB(B1, 1, 1); PG8_SCHED; PG8_LDA(At, 1, 0); PG8_STAGE(PG8_SA(0, 1), a2 + hstepA, voffA);
            PG8_WAIT_V(8); PG8_WAIT_L(0); PG8_BAR; PG8_MMA(0, 0, At, B0); PG8_MMA(0, 1, At, B1); PG8_BAR; PG8_SCHED;
            PG8_LDA(At, 1, 1); PG8_STAGE(PG8_SB(1, 0), b3, voffB); PG8_STAGE(PG8_SB(1, 1), b3 + hstepB, voffB); PG8_STAGE(PG8_SA(1, 0), a3, voffA);
            PG8_WAIT_V(8); PG8_WAIT_L(0); PG8_BAR; PG8_MMA(1, 0, At, B0); PG8_MMA(1, 1, At, B1); PG8_BAR; PG8_SCHED;
        }
        if constexpr (ALIGN_EPI) { if (wr == 0) PG8_BAR; }
        if constexpr (!Epi::AFTER_DRAIN) { int fr_ = fr, fq_ = fq; asm volatile("" : "+v"(fr_), "+v"(fq_)); E(acc, cur, wr, wc, fr_, fq_); }
        if (!has_next) break;
#pragma unroll
        for (int a = 0; a < 2; ++a)
#pragma unroll
            for (int b = 0; b < 2; ++b)
#pragma unroll
                for (int m = 0; m < 4; ++m)
#pragma unroll
                    for (int n = 0; n < 2; ++n) acc[a][b][m][n] = (f32x4){0.f, 0.f, 0.f, 0.f};
        cur = nxt; cA = nA; cB = nB; ++ui;
        if constexpr (ALIGN_EPI) { if (wr == 1) PG8_BAR; }
    }
    PG8_WAIT_V(0);
    if constexpr (!ALIGN_EPI) { if (wr == 0) PG8_BAR; }
    PG8_BAR;
    if constexpr (Epi::AFTER_DRAIN) { E.fused(acc, cur, wr, wc, fr, fq, lds, wid, lane); }
#undef PG8_SA
#undef PG8_SB
#undef PG8_STAGE
#undef PG8_LDA
#undef PG8_LDB
#undef PG8_MMA
#undef PG8_WAIT_V
#undef PG8_WAIT_L
#undef PG8_BAR
#undef PG8_SCHED
}

struct SchedRect {
    const char* A; const char* B; size_t atile, btile; int nM, nN, G, c, NT;
    __device__ __forceinline__ bool next(int i, Unit& u) const {
        const int L = i * G + c; if (L >= nM * nN) return false;
        int pm, pn; rect_order(L, nM, nN, pm, pn);
        u.A = A + (size_t)pm * atile; u.B = B + (size_t)pn * btile; u.orow = pm * BM; u.ocol = pn * BM; u.aux = 0; u.nkt = NT; return true;
    }
};
struct SchedIn {
    const char* A; const char* B; int G, c;
    __device__ __forceinline__ bool next(int i, Unit& u) const {
        const int L = i * G + c; if (L >= 1296 + 64) return false;
        int pm, pn;
        if (L < 1296) { rect_order(L, 36, 36, pm, pn); u.orow = pm * BM; u.ocol = pn * BM; u.aux = 0; }
        else { const int l = L - 1296; pm = 36 + (l & 3); pn = 36 + (l >> 2); u.orow = (pm - 36) * BM; u.ocol = (pn - 36) * BM; u.aux = 1; }
        u.A = A + (size_t)pm * (BM * DM * 2); u.B = B + (size_t)pn * (BM * DM * 2); u.nkt = DM / BK; return true;
    }
};
struct SchedSp {
    const char* WSP; const char* VT; int G, c;
    __device__ __forceinline__ bool next(int i, Unit& u) const {
        const int L = i * G + c; if (L >= 256) return false;
        const int chunk = L >> 2, p = (L >> 1) & 1, gi = L & 1, g = 2 * p + gi;
        u.A = WSP + (size_t)p * (256 * 128 * 2); u.B = VT + ((size_t)chunk * 1024 + g * 256) * 128 * 2; u.orow = chunk * 128; u.ocol = g * 256; u.aux = gi; u.nkt = 2; return true;
    }
};
struct SchedS {
    const char* Q; const char* KP; int G, c;
    __device__ __forceinline__ bool next(int i, Unit& u) const {
        const int L = i * G + c; if (L >= 128 || i > 0) return false;
        const int b = L >> 5, h = (L >> 3) & 3, p = L & 7;
        u.A = Q + ((size_t)(b * 2048 + p * 256) * DM + h * XD) * 2; u.B = KP + ((size_t)(b * 256) * DM + h * XD) * 2;
        u.orow = (b * 4 + h) * 2048 + p * 256; u.ocol = 0; u.aux = 0; u.nkt = XD / BK; return true;
    }
};
struct SchedO {
    const char* PS; const char* VPT; int G, c;
    __device__ __forceinline__ bool next(int i, Unit& u) const {
        if (c >= 128 || i >= 2) return false;
        const int b = c >> 5, h = (c >> 3) & 3, p = c & 7, pn = i;
        u.A = PS + ((size_t)((b * 4 + h) * 2048 + p * 256) * 256) * 2; u.B = VPT + ((size_t)(b * 2048 + h * XD + pn * 256) * 256) * 2;
        u.orow = b * 2048 + p * 256; u.ocol = h * XD + pn * 256; u.aux = 0; u.nkt = 4; return true;
    }
};

struct SchedTail {
    const char* A; const char* B; size_t atile, btile; int NT, G, c; bool tail;
    __device__ __forceinline__ bool next(int i, Unit& u) const {
        if (!tail) { const int L = i * G + c; if (L >= 288) return false; int pm, pn; rect_order(L, 36, 8, pm, pn);
            u.A = A + (size_t)pm * atile; u.B = B + (size_t)pn * btile; u.orow = pm * BM; u.ocol = pn * BM; u.aux = 0; u.nkt = NT; return true; }
        const int vcu = (c & 7) * 32 + (c >> 3);
        if (i == 0) { const int pm = vcu >> 3, pn = vcu & 7; u.A = A + (size_t)pm * atile; u.B = B + (size_t)pn * btile; u.orow = pm * BM; u.ocol = pn * BM; u.aux = 0; u.nkt = NT; return true; }
        if (i == 1) { const int t = vcu >> 3, s = vcu & 7, pm = 32 + (t >> 3), pn = t & 7, nk = NT >> 3;
            u.A = A + (size_t)pm * atile + (size_t)(s * nk) * (BK * 2); u.B = B + (size_t)pn * btile + (size_t)(s * nk) * (BK * 2);
            u.orow = (t >> 3) * BM; u.ocol = pn * BM; u.aux = 1 + s; u.nkt = nk; return true; }
        return false;
    }
};
#define EPI_ROWS_BEGIN _Pragma("unroll") for (int ai = 0; ai < 2; ++ai) _Pragma("unroll") for (int m = 0; m < 4; ++m) { const int rl = ai * HALF + wr * 64 + m * 16 + fr;
#define EPI_ROWS_END }

struct EpiIn {
    static constexpr bool PERM = true, AFTER_DRAIN = false, MIDK = false;
    bf16_t* P1; float* memk; float* memv; bf16_t* KP; bf16_t* VPT;
    __device__ __forceinline__ void operator()(const f32x4 (&acc)[2][2][4][2], const Unit& u, int wr, int wc, int fr, int fq) const {
        const int cl0 = wc * 32 + 8 * fq;
        if (u.aux == 0) {
            const bool gate = u.ocol >= C_GA;
            EPI_ROWS_BEGIN
                bf16_t* rowp = P1 + (size_t)(u.orow + rl) * NIN + u.ocol + cl0;
#pragma unroll
                for (int bj = 0; bj < 2; ++bj) { f32x4 v0 = acc[ai][bj][m][0], v1 = acc[ai][bj][m][1];
                    if (gate) {
                        const f32x4 g0 = acc[ai][1][m][0], g1 = acc[ai][1][m][1];
#pragma unroll
                        for (int e = 0; e < 4; ++e) { const float sb0 = sigmoidf_(g0[e]), sb1 = sigmoidf_(g1[e]);
                            if (bj == 0) { v0[e] = sigmoidf_(v0[e]) * __builtin_amdgcn_rcpf(fmaxf(sb0, 1e-30f)); v1[e] = sigmoidf_(v1[e]) * __builtin_amdgcn_rcpf(fmaxf(sb1, 1e-30f)); }
                            else { v0[e] = fmaxf(sb0, 1e-30f); v1[e] = fmaxf(sb1, 1e-30f); } } }
                    u32x4 w; w.x = cvt_pk_bf16(v0[0], v0[1]); w.y = cvt_pk_bf16(v0[2], v0[3]); w.z = cvt_pk_bf16(v1[0], v1[1]); w.w = cvt_pk_bf16(v1[2], v1[3]);
                    *(u32x4*)(rowp + bj * HALF) = w; }
            EPI_ROWS_END
        } else {
            const bool isV = u.ocol >= DM; const int cb = u.ocol - (isV ? DM : 0) + cl0;
            float* fo = isV ? memv : memk;
            EPI_ROWS_BEGIN
                const int row = u.orow + rl;
#pragma unroll
                for (int bj = 0; bj < 2; ++bj) { const f32x4 v0 = acc[ai][bj][m][0], v1 = acc[ai][bj][m][1]; const int col = cb + bj * HALF;
                    *(f32x4*)(fo + (size_t)row * DM + col) = v0; *(f32x4*)(fo + (size_t)row * DM + col + 4) = v1;
                    u32x4 w; w.x = cvt_pk_bf16(v0[0], v0[1]); w.y = cvt_pk_bf16(v0[2], v0[3]); w.z = cvt_pk_bf16(v1[0], v1[1]); w.w = cvt_pk_bf16(v1[2], v1[3]);
                    if (!isV) { *(u32x4*)(KP + (size_t)row * DM + col) = w; }
                    else { bf16_t* vp = VPT + ((size_t)(row >> 8) * DM + col) * 256 + (row & 255);
                        vp[0 * 256] = (bf16_t)(w.x & 0xffff); vp[1 * 256] = (bf16_t)(w.x >> 16); vp[2 * 256] = (bf16_t)(w.y & 0xffff); vp[3 * 256] = (bf16_t)(w.y >> 16);
                        vp[4 * 256] = (bf16_t)(w.z & 0xffff); vp[5 * 256] = (bf16_t)(w.z >> 16); vp[6 * 256] = (bf16_t)(w.w & 0xffff); vp[7 * 256] = (bf16_t)(w.w >> 16); } }
            EPI_ROWS_END
        }
    }
};
struct EpiSp {
    static constexpr bool PERM = true, AFTER_DRAIN = false, MIDK = false;
    const bf16_t* P1; const float* bsp; bf16_t* YA;
    __device__ __forceinline__ void operator()(const f32x4 (&acc)[2][2][4][2], const Unit& u, int wr, int wc, int fr, int fq) const {
        const int g = u.ocol >> 8, cl0 = wc * 32 + 8 * fq;
#pragma unroll
        for (int ai = 0; ai < 2; ++ai) if (ai == u.aux) {
#pragma unroll
            for (int m = 0; m < 4; ++m) { const int t = wr * 64 + m * 16 + fr; const int row = u.orow + t; const float bs = bsp[g * 128 + t];
#pragma unroll
                for (int bj = 0; bj < 2; ++bj) { const int col = u.ocol + bj * HALF + cl0;
                    const u32x4 uw = *(const u32x4*)(P1 + (size_t)row * NIN + C_U + col); float uf[8]; unpack8(uw, uf);
                    const f32x4 v0 = acc[ai][bj][m][0], v1 = acc[ai][bj][m][1];
                    u32x4 w; w.x = cvt_pk_bf16(uf[0] * (v0[0] + bs), uf[1] * (v0[1] + bs)); w.y = cvt_pk_bf16(uf[2] * (v0[2] + bs), uf[3] * (v0[3] + bs));
                    w.z = cvt_pk_bf16(uf[4] * (v1[0] + bs), uf[5] * (v1[1] + bs)); w.w = cvt_pk_bf16(uf[6] * (v1[2] + bs), uf[7] * (v1[3] + bs));
                    *(u32x4*)(YA + (size_t)row * DM + col) = w; } }
        }
    }
};
struct EpiMerged {
    static constexpr bool PERM = true, AFTER_DRAIN = false, MIDK = true;
    const bf16_t* P1; bf16_t* MRG;
    __device__ __forceinline__ void mid(f32x4 (&acc)[2][2][4][2], const Unit& u, int wr, int wc, int fr, int fq) const {
        asm volatile("" : "+v"(fr), "+v"(fq));
        const bf16_t* pb = P1 + (size_t)(u.orow + wr * 64 + fr) * NIN + C_GA + (u.ocol >> 7) * 256 + wc * 32 + 8 * fq;
#pragma unroll
        for (int ai = 0; ai < 2; ++ai) {
            u32x4 r[4][2];
#pragma unroll
            for (int m = 0; m < 4; ++m)
#pragma unroll
                for (int bj = 0; bj < 2; ++bj) r[m][bj] = *(const u32x4*)(pb + (size_t)(ai * HALF + m * 16) * NIN + bj * 256);
#pragma unroll
            for (int m = 0; m < 4; ++m)
#pragma unroll
                for (int bj = 0; bj < 2; ++bj) { float f[8]; unpack8(r[m][bj], f);
#pragma unroll
                    for (int e = 0; e < 4; ++e) { acc[ai][bj][m][0][e] *= f[e]; acc[ai][bj][m][1][e] *= f[4 + e]; } }
            asm volatile("" ::: "memory");
        }
    }
    __device__ __forceinline__ void operator()(const f32x4 (&acc)[2][2][4][2], const Unit& u, int wr, int wc, int fr, int fq) const {
        const int cl0 = wc * 32 + 8 * fq;
        const bf16_t* pb = P1 + (size_t)(u.orow + wr * 64 + fr) * NIN + C_GA + (u.ocol >> 7) * 256 + 128 + cl0;
        EPI_ROWS_BEGIN
            const int row = u.orow + rl;
#pragma unroll
            for (int bj = 0; bj < 2; ++bj) { const int col = u.ocol + bj * HALF + cl0;
                float sb[8]; unpack8(*(const u32x4*)(pb + (size_t)(ai * HALF + m * 16) * NIN + bj * 256), sb);
                const f32x4 v0 = acc[ai][bj][m][0], v1 = acc[ai][bj][m][1];
                u32x4 w; w.x = cvt_pk_bf16(v0[0] * sb[0], v0[1] * sb[1]); w.y = cvt_pk_bf16(v0[2] * sb[2], v0[3] * sb[3]); w.z = cvt_pk_bf16(v1[0] * sb[4], v1[1] * sb[5]); w.w = cvt_pk_bf16(v1[2] * sb[6], v1[3] * sb[7]);
                *(u32x4*)(MRG + (size_t)row * DM + col) = w; }
        EPI_ROWS_END
    }
};
template <bool RES_F32> struct EpiRes {
    static constexpr bool PERM = true, AFTER_DRAIN = false, MIDK = false;
    const float* resA; const float* resB; int split; const bf16_t* resH; bf16_t* out;
    __device__ __forceinline__ void operator()(const f32x4 (&acc)[2][2][4][2], const Unit& u, int wr, int wc, int fr, int fq) const {
        const float* rbase = (u.orow < split) ? resA + (size_t)u.orow * DM : resB + (size_t)(u.orow - split) * DM;
        const int cl0 = wc * 32 + 8 * fq;
        EPI_ROWS_BEGIN
#pragma unroll
            for (int bj = 0; bj < 2; ++bj) { const size_t off = (size_t)rl * DM + u.ocol + bj * HALF + cl0;
                f32x4 r0, r1;
                if (RES_F32) { r0 = *(const f32x4*)(rbase + off); r1 = *(const f32x4*)(rbase + off + 4); }
                else { float f[8]; unpack8(*(const u32x4*)(resH + (size_t)u.orow * DM + off), f); r0 = (f32x4){f[0], f[1], f[2], f[3]}; r1 = (f32x4){f[4], f[5], f[6], f[7]}; }
                const f32x4 v0 = r0 + acc[ai][bj][m][0], v1 = r1 + acc[ai][bj][m][1];
                u32x4 w; w.x = cvt_pk_bf16(v0[0], v0[1]); w.y = cvt_pk_bf16(v0[2], v0[3]); w.z = cvt_pk_bf16(v1[0], v1[1]); w.w = cvt_pk_bf16(v1[2], v1[3]);
                *(u32x4*)(out + (size_t)u.orow * DM + off) = w; }
        EPI_ROWS_END
    }
};
template <int MODE  > struct EpiBf {
    static constexpr bool PERM = true, AFTER_DRAIN = false, MIDK = false;
    bf16_t* O; int ldc; float scale;
    __device__ __forceinline__ void operator()(const f32x4 (&acc)[2][2][4][2], const Unit& u, int wr, int wc, int fr, int fq) const {
        const int cl0 = wc * 32 + 8 * fq;
        EPI_ROWS_BEGIN
            bf16_t* rowp = O + (size_t)(u.orow + rl) * ldc + u.ocol + cl0;
#pragma unroll
            for (int bj = 0; bj < 2; ++bj) { f32x4 v0 = acc[ai][bj][m][0], v1 = acc[ai][bj][m][1];
                if (MODE == 0) { v0 = v0 * scale; v1 = v1 * scale; }
                else {
#pragma unroll
                    for (int e = 0; e < 4; ++e) { const float a = fmaxf(v0[e], 0.f), b = fmaxf(v1[e], 0.f); v0[e] = a * a; v1[e] = b * b; } }
                u32x4 w; w.x = cvt_pk_bf16(v0[0], v0[1]); w.y = cvt_pk_bf16(v0[2], v0[3]); w.z = cvt_pk_bf16(v1[0], v1[1]); w.w = cvt_pk_bf16(v1[2], v1[3]);
                *(u32x4*)(rowp + bj * HALF) = w; }
        EPI_ROWS_END
    }
};
struct EpiSoftmax {
    static constexpr bool PERM = true, AFTER_DRAIN = true, MIDK = false;
    bf16_t* PS;
    __device__ __forceinline__ void fused(f32x4 (&acc)[2][2][4][2], const Unit& u, int wr, int wc, int fr, int fq, LAS unsigned char* lds, int wid, int lane) const {
        LAS f32x2* X = (LAS f32x2*)lds;
        float mxl[2][4];
        EPI_ROWS_BEGIN
            float mx = -3.0e38f;
#pragma unroll
            for (int bj = 0; bj < 2; ++bj)
#pragma unroll
                for (int n = 0; n < 2; ++n) { const f32x4 v = acc[ai][bj][m][n]; mx = fmaxf(mx, fmaxf(fmaxf(v[0], v[1]), fmaxf(v[2], v[3]))); }
            mx = fmaxf(mx, __shfl_xor(mx, 16)); mx = fmaxf(mx, __shfl_xor(mx, 32));
            float s = 0.f;
#pragma unroll
            for (int bj = 0; bj < 2; ++bj)
#pragma unroll
                for (int n = 0; n < 2; ++n) { f32x4 v = acc[ai][bj][m][n];
#pragma unroll
                    for (int e = 0; e < 4; ++e) { v[e] = __expf(v[e] - mx); s += v[e]; }
                    acc[ai][bj][m][n] = v; }
            s += __shfl_xor(s, 16); s += __shfl_xor(s, 32);
            mxl[ai][m] = mx;
            if (fq == 0) X[rl * 4 + wc] = (f32x2){mx, s};
        EPI_ROWS_END
        LDS_WAIT(); __builtin_amdgcn_s_barrier(); asm volatile("" ::: "memory");
        const int cl0 = wc * 32 + 8 * fq;
        EPI_ROWS_BEGIN
            const f32x2 a = X[rl * 4 + 0], b = X[rl * 4 + 1], c = X[rl * 4 + 2], d = X[rl * 4 + 3];
            const float M = fmaxf(fmaxf(a.x, b.x), fmaxf(c.x, d.x));
            const float L = a.y * __expf(a.x - M) + b.y * __expf(b.x - M) + c.y * __expf(c.x - M) + d.y * __expf(d.x - M);
            const float f = __expf(mxl[ai][m] - M) / L;
            bf16_t* rowp = PS + (size_t)(u.orow + rl) * 256 + cl0;
#pragma unroll
            for (int bj = 0; bj < 2; ++bj) { const f32x4 v0 = acc[ai][bj][m][0] * f, v1 = acc[ai][bj][m][1] * f;
                u32x4 w; w.x = cvt_pk_bf16(v0[0], v0[1]); w.y = cvt_pk_bf16(v0[2], v0[3]); w.z = cvt_pk_bf16(v1[0], v1[1]); w.w = cvt_pk_bf16(v1[2], v1[3]);
                *(u32x4*)(rowp + bj * HALF) = w; }
        EPI_ROWS_END
        LDS_WAIT(); __builtin_amdgcn_s_barrier(); asm volatile("" ::: "memory");
    }
};

template <class Base> struct EpiTail {
    static constexpr bool PERM = Base::PERM, AFTER_DRAIN = false, MIDK = false;
    Base base; bf16_t* part;
    __device__ __forceinline__ void operator()(const f32x4 (&acc)[2][2][4][2], const Unit& u, int wr, int wc, int fr, int fq) const {
        if (u.aux == 0) { base(acc, u, wr, wc, fr, fq); return; }
        bf16_t* pb = part + (size_t)(u.aux - 1) * (MS * DM) + (size_t)u.orow * DM + u.ocol;
        EPI_ROWS_BEGIN
#pragma unroll
            for (int bj = 0; bj < 2; ++bj) {
                if (PERM) { const f32x4 v0 = acc[ai][bj][m][0], v1 = acc[ai][bj][m][1];
                    u32x4 w; w.x = cvt_pk_bf16(v0[0], v0[1]); w.y = cvt_pk_bf16(v0[2], v0[3]); w.z = cvt_pk_bf16(v1[0], v1[1]); w.w = cvt_pk_bf16(v1[2], v1[3]);
                    *(u32x4*)(pb + (size_t)rl * DM + bj * HALF + wc * 32 + 8 * fq) = w; }
                else {
#pragma unroll
                    for (int n = 0; n < 2; ++n) { const f32x4 v = acc[ai][bj][m][n]; u32x2 w; w.x = cvt_pk_bf16(v[0], v[1]); w.y = cvt_pk_bf16(v[2], v[3]);
                        *(u32x2*)(pb + (size_t)rl * DM + bj * HALF + wc * 32 + 16 * n + 4 * fq) = w; } }
            }
        EPI_ROWS_END
    }
};
}


#define XB_TMO      128
#define XB_XCNT(j)  (256  + 64 * (j))
#define XB_XSUB(j)  (1280 + 64 * (j))
#define XB_XGEN(j)  (2304 + 64 * (j))
#define XB_TOP      3328
#define XB_TOPGEN   3392
#define XCD_BAR_WORDS 3456
#define XB_SPIN_CAP (1u << 18)
__device__ __forceinline__ unsigned xb_ld(unsigned* p)              { return __hip_atomic_load(p, __ATOMIC_RELAXED, __HIP_MEMORY_SCOPE_AGENT); }
__device__ __forceinline__ unsigned xb_add(unsigned* p, unsigned v) { return __hip_atomic_fetch_add(p, v, __ATOMIC_RELAXED, __HIP_MEMORY_SCOPE_AGENT); }
__device__ __forceinline__ unsigned xb_xcc_id() { return (unsigned)__builtin_amdgcn_s_getreg((3 << 11) | 20) & 0xFu; }
#define XB_SPIN(cond, bar) do { unsigned _sp = 0; while (cond) { __builtin_amdgcn_s_sleep(1); \
    if ((++_sp & 255u) == 0u) { if (xb_ld(&(bar)[XB_TMO])) break; if (_sp > XB_SPIN_CAP) { atomicAdd(&(bar)[XB_TMO], 1u); break; } } } } while (0)
struct XcdBarrier { unsigned* bar; unsigned x; volatile LAS unsigned* st; };
__device__ __forceinline__ XcdBarrier xcd_barrier_post(unsigned* bar, volatile LAS unsigned* st) {
    XcdBarrier b; b.bar = bar; b.x = xb_xcc_id(); b.st = st;
    if (threadIdx.x == 0) (void)xb_add(&bar[XB_XCNT(b.x)], 1u);
    return b;
}
__device__ __forceinline__ void xcd_barrier_complete(unsigned* bar, unsigned x, unsigned& nloc, unsigned& nx) {
    const unsigned G = gridDim.x * gridDim.y * gridDim.z;
    unsigned sum, cnt, mine, sp = 0u;
    for (;;) {
        sum = 0u; cnt = 0u; mine = 0u;
#pragma unroll
        for (unsigned j = 0; j < 16; ++j) { const unsigned c = xb_ld(&bar[XB_XCNT(j)]); sum += c; cnt += (c > 0u) ? 1u : 0u; mine = (j == x) ? c : mine; }
        if (sum == G) break;
        __builtin_amdgcn_s_sleep(1);
        if ((++sp & 255u) == 0u) { if (xb_ld(&bar[XB_TMO])) break; if (sp > XB_SPIN_CAP) { atomicAdd(&bar[XB_TMO], 1u); break; } }
    }
    nloc = mine > 0u ? mine : 1u; nx = cnt > 0u ? cnt : 1u;
}
__device__ __forceinline__ void xcd_barrier(const XcdBarrier& b) {
    asm volatile("s_waitcnt vmcnt(0)" ::: "memory");
    __syncthreads();
    if (threadIdx.x == 0) {
        unsigned* bar = b.bar;
        __builtin_amdgcn_s_waitcnt(0);
        unsigned nloc = b.st[0], nx = b.st[1];
        if (nloc == 0u) { xcd_barrier_complete(bar, b.x, nloc, nx); b.st[0] = nloc; b.st[1] = nx; }
        const unsigned old = xb_add(&bar[XB_XSUB(b.x)], 1u);
        const unsigned gen = old / nloc;
        if (old + 1u == (gen + 1u) * nloc) {
            __builtin_amdgcn_fence(__ATOMIC_RELEASE, "agent");
            asm volatile("s_waitcnt vmcnt(0)" ::: "memory");
            const unsigned og = xb_add(&bar[XB_TOP], 1u);
            const unsigned tg = og / nx;
            if (og + 1u == (tg + 1u) * nx) xb_add(&bar[XB_TOPGEN], 1u);
            else XB_SPIN(xb_ld(&bar[XB_TOPGEN]) == tg, bar);
            __builtin_amdgcn_fence(__ATOMIC_ACQUIRE, "agent");
            xb_add(&bar[XB_XGEN(b.x)], 1u);
            asm volatile("s_waitcnt vmcnt(0)" ::: "memory");
        } else {
            XB_SPIN(xb_ld(&bar[XB_XGEN(b.x)]) == gen, bar);
            __builtin_amdgcn_fence(__ATOMIC_ACQUIRE, "agent");
            asm volatile("s_waitcnt vmcnt(0)" ::: "memory");
        }
    }
    __syncthreads();
}

struct Args { const float* in[26]; float* out; unsigned char* ws; };

struct Frame {
    LAS unsigned char* lds;
    int tid, lane, wave, G, bx;
    float* out; unsigned char* ws;
};
typedef const float* cfp_t;
__device__ __forceinline__ const float* karg_in(int i) {
    asm volatile("" : "+s"(i));
    const __attribute__((address_space(4))) cfp_t* ka = (const __attribute__((address_space(4))) cfp_t*)__builtin_amdgcn_kernarg_segment_ptr();
    return ka[i];
}
#define IN(i) karg_in(i)
#define WSP(T, off) ((T*)(F.ws + (off)))

__device__ __forceinline__ void p0_transpose_item(const float* W, int K, int N, bf16_t* WT, int row_off, LAS float* scr, int item, int lane, int ldk, int koff) {
    const int nblk = N / 32, kb = item / nblk, nb = item % nblk, k0 = 64 * kb, n0 = 32 * nb;
#pragma unroll 8
    for (int i = 0; i < 32; ++i) { const int kk = 2 * i + (lane >> 5); scr[kk * 33 + (lane & 31)] = W[(size_t)(k0 + kk) * N + n0 + (lane & 31)]; }
    LDS_WAIT(); asm volatile("" ::: "memory");
    const int c = lane & 7;
#pragma unroll
    for (int j = 0; j < 4; ++j) { const int n = (lane >> 3) + 8 * j; const LAS float* s = scr + (8 * c) * 33 + n;
        u32x4 o; o.x = cvt_pk_bf16(s[0 * 33], s[1 * 33]); o.y = cvt_pk_bf16(s[2 * 33], s[3 * 33]); o.z = cvt_pk_bf16(s[4 * 33], s[5 * 33]); o.w = cvt_pk_bf16(s[6 * 33], s[7 * 33]);
        *(u32x4*)(WT + (size_t)(row_off + n0 + n) * ldk + koff + k0 + 8 * c) = o; }
    LDS_WAIT(); asm volatile("" ::: "memory");
}
template <bool OUT_F32> __device__ __forceinline__ void rms_row(const float* xrow, const float* g, void* orow, int lane) {
    const f32x4* xr = (const f32x4*)xrow + lane; f32x4 v[8]; float ss = 0.f;
#pragma unroll
    for (int j = 0; j < 8; ++j) { v[j] = xr[64 * j]; ss += (v[j].x * v[j].x + v[j].y * v[j].y) + (v[j].z * v[j].z + v[j].w * v[j].w); }
    const float r = rsqrtf(wave_sum(ss) * (1.f / DM) + EPS);
    const f32x4* gr = (const f32x4*)g + lane;
#pragma unroll
    for (int j = 0; j < 8; ++j) { const f32x4 gg = gr[64 * j]; const f32x4 o = v[j] * r * gg;
        if (OUT_F32) ((f32x4*)orow)[lane + 64 * j] = o;
        else { u32x2 w; w.x = cvt_pk_bf16(o.x, o.y); w.y = cvt_pk_bf16(o.z, o.w); ((u32x2*)orow)[lane + 64 * j] = w; } }
}

constexpr int I_IN = 32 * 288, I_SQ = 32 * 64, I_BR = 16 * 64, I_UP = 32 * 256, I_DN = 128 * 64;
constexpr int CV_A0 = 0, CV_A1 = I_IN + 2 * I_SQ;
constexpr int CV_B1 = CV_A1 + 3 * I_SQ + 2 * I_BR;
constexpr int CV_C1 = CV_B1 + I_UP;
constexpr int CV_D1 = CV_C1 + I_DN;
__device__ __forceinline__ void convert_one(Frame& F, int it, LAS float* scr) {
    int r = it, K = DM, N = DM, ro = 0, ldk = DM, koff = 0, src_i; size_t wso;
    if (r < I_IN) { src_i = 7; N = NIN; wso = WS_WIN; const int n0 = 32 * (r % 288);
        if (n0 >= C_GB) { const int j = n0 - C_GB; ro = C_GA + (j >> 7) * 256 + 128 + (j & 127) - n0; }
        else if (n0 >= C_GA) { const int j = n0 - C_GA; ro = C_GA + (j >> 7) * 256 + (j & 127) - n0; } }
    else if ((r -= I_IN) < I_SQ) { src_i = 19; wso = WS_WIN; ro = NIN; }
    else if ((r -= I_SQ) < I_SQ) { src_i = 20; wso = WS_WIN; ro = NIN + DM; }
    else if ((r -= I_SQ) < I_SQ) { src_i = 15; wso = WS_WMIX; }
    else if ((r -= I_SQ) < I_SQ) { src_i = 18; wso = WS_WQ; }
    else if ((r -= I_SQ) < I_SQ) { src_i = 21; wso = WS_WXO; }
    else if ((r -= I_SQ) < I_BR) { src_i = 13; wso = WS_WA; K = 1024; }
    else if ((r -= I_BR) < I_BR) { src_i = 14; wso = WS_WA; K = 1024; koff = 1024; }
    else if ((r -= I_BR) < I_UP) { src_i = 23; wso = WS_WUP; N = FF; }
    else { r -= I_UP; src_i = 24; wso = WS_WDN; K = FF; ldk = FF; }
    p0_transpose_item(IN(src_i), K, N, (bf16_t*)(F.ws + wso), ro, scr, r, F.lane, ldk, koff);
}
__device__ __forceinline__ void convert_fill(Frame& F, int i0, int i1, int n_units) {
    const int rounds = (n_units + F.G - 1) / F.G, nfull = n_units - (rounds - 1) * F.G;
    int slot = F.bx - nfull, nslots = F.G - nfull;
    if (nslots == 0) { slot = F.bx; nslots = F.G; }
    if (slot < 0) return;
    LAS float* scr = (LAS float*)(F.lds + F.wave * 16384);
    for (int it = i0 + slot * NWAVES + F.wave; it < i1; it += nslots * NWAVES) convert_one(F, it, scr);
}
template <int R> __device__ __forceinline__ void ln_stats(const bf16_t* p, size_t rstride, float (&mean)[R], float (&rstd)[R], float (&lo)[R][8], float (&hi)[R][8]) {
#pragma unroll
    for (int r = 0; r < R; ++r) { unpack8(*(const u32x4*)(p + r * rstride), lo[r]); unpack8(*(const u32x4*)(p + r * rstride + 512), hi[r]); }
    float s[R];
#pragma unroll
    for (int r = 0; r < R; ++r) { s[r] = 0.f;
#pragma unroll
        for (int e = 0; e < 8; ++e) s[r] += lo[r][e] + hi[r][e]; }
#pragma unroll
    for (int o = 1; o < 64; o <<= 1)
#pragma unroll
        for (int r = 0; r < R; ++r) s[r] += __shfl_xor(s[r], o);
#pragma unroll
    for (int r = 0; r < R; ++r) { mean[r] = s[r] * (1.f / 1024.f); s[r] = 0.f;
#pragma unroll
        for (int e = 0; e < 8; ++e) { const float d0 = lo[r][e] - mean[r], d1 = hi[r][e] - mean[r]; s[r] += d0 * d0 + d1 * d1; } }
#pragma unroll
    for (int o = 1; o < 64; o <<= 1)
#pragma unroll
        for (int r = 0; r < R; ++r) s[r] += __shfl_xor(s[r], o);
#pragma unroll
    for (int r = 0; r < R; ++r) rstd[r] = rsqrtf(s[r] * (1.f / 1024.f) + EPS);
}
template <bool OUT_F32> __device__ __forceinline__ void rms_rows2(const float* x0, const float* g0, void* o0, const float* x1, const float* g1, void* o1, int lane) {
    const f32x4* xr0 = (const f32x4*)x0 + lane; const f32x4* xr1 = (const f32x4*)x1 + lane; f32x4 v0[8], v1[8]; float s0 = 0.f, s1 = 0.f;
#pragma unroll
    for (int j = 0; j < 8; ++j) { v0[j] = xr0[64 * j]; v1[j] = xr1[64 * j]; }
#pragma unroll
    for (int j = 0; j < 8; ++j) { s0 += (v0[j].x * v0[j].x + v0[j].y * v0[j].y) + (v0[j].z * v0[j].z + v0[j].w * v0[j].w); s1 += (v1[j].x * v1[j].x + v1[j].y * v1[j].y) + (v1[j].z * v1[j].z + v1[j].w * v1[j].w); }
#pragma unroll
    for (int o = 1; o < 64; o <<= 1) { s0 += __shfl_xor(s0, o); s1 += __shfl_xor(s1, o); }
    const float r0 = rsqrtf(s0 * (1.f / DM) + EPS), r1 = rsqrtf(s1 * (1.f / DM) + EPS);
    const f32x4* gr0 = (const f32x4*)g0 + lane; const f32x4* gr1 = (const f32x4*)g1 + lane;
#pragma unroll
    for (int j = 0; j < 8; ++j) { const f32x4 a = v0[j] * r0 * gr0[64 * j], b = v1[j] * r1 * gr1[64 * j];
        if (OUT_F32) { ((f32x4*)o0)[lane + 64 * j] = a; ((f32x4*)o1)[lane + 64 * j] = b; }
        else { u32x2 w; w.x = cvt_pk_bf16(a.x, a.y); w.y = cvt_pk_bf16(a.z, a.w); ((u32x2*)o0)[lane + 64 * j] = w; w.x = cvt_pk_bf16(b.x, b.y); w.y = cvt_pk_bf16(b.z, b.w); ((u32x2*)o1)[lane + 64 * j] = w; } }
}
__device__ __forceinline__ void phase_prologue(Frame& F) {
    LAS float* scr = (LAS float*)(F.lds + F.wave * 16384);
    const int gw = F.bx * NWAVES + F.wave, NGW = F.G * NWAVES;
    for (int it = CV_A0 + gw; it < CV_A1; it += NGW) convert_one(F, it, scr);
    bf16_t* XN = WSP(bf16_t, WS_XN);
    { const float* xp = IN(0); const float* xs = IN(1); const float* xm = IN(5); const float* gx = IN(6); const float* gm = IN(17);
      for (int m = gw; m < MT + 1024; m += 2 * NGW) {
        const int m2 = m + NGW;
        const float* s0 = m < MP ? xp + (size_t)m * DM : (m < MT ? xs + (size_t)(m - MP) * DM : xm + (size_t)(m - MT) * DM);
        if (m2 < MT + 1024) { const float* s1 = m2 < MP ? xp + (size_t)m2 * DM : (m2 < MT ? xs + (size_t)(m2 - MP) * DM : xm + (size_t)(m2 - MT) * DM);
            rms_rows2<false>(s0, m < MT ? gx : gm, XN + (size_t)m * DM, s1, m2 < MT ? gx : gm, XN + (size_t)m2 * DM, F.lane); }
        else rms_row<false>(s0, m < MT ? gx : gm, XN + (size_t)m * DM, F.lane);
      } }
    bf16_t* WS = WSP(bf16_t, WS_WSP);
    for (int i = F.bx * 512 + F.tid; i < 4 * 128 * 128; i += F.G * 512) { const int t = (i >> 7) & 127, s = i & 127; const float w = (s <= t) ? IN(10)[i] : 0.f; WS[i] = (bf16_t)(cvt_pk_bf16(w, 0.f) & 0xffff); }
}

__device__ __forceinline__ void phase_mixprep(Frame& F) {
    const bf16_t* P1 = WSP(bf16_t, WS_P1);
    {
        bf16_t* YB = WSP(bf16_t, WS_YA);   const float* cw = IN(12); const float* st = IN(2);
        for (int it = F.bx * 512 + F.tid; it < MT * 128; it += F.G * 512) {
            const int row = it >> 7, c0 = (it & 127) * 8;
            const bf16_t* pr = P1 + (size_t)row * NIN;
            float cg[8], xi[8], p0[8], p1[8], p2[8], bg[8];
            unpack8(*(const u32x4*)(pr + C_CG + c0), cg); unpack8(*(const u32x4*)(pr + C_XIN + c0), xi); unpack8(*(const u32x4*)(pr + C_BG + c0), bg);
#pragma unroll
            for (int e = 0; e < 8; ++e) p0[e] = cg[e] * xi[e];
            int pos, b; const bool prompt = row < MP;
            if (prompt) { pos = row & 2047; b = row >> 11; } else { pos = (row - MP) & 7; b = (row - MP) >> 3; }
            if (pos >= 1) { unpack8(*(const u32x4*)(pr - NIN + C_CG + c0), cg); unpack8(*(const u32x4*)(pr - NIN + C_XIN + c0), xi);
#pragma unroll
                for (int e = 0; e < 8; ++e) p1[e] = cg[e] * xi[e]; }
            else if (prompt) {
#pragma unroll
                for (int e = 0; e < 8; ++e) p1[e] = 0.f; }
            else { const f32x4 a = *(const f32x4*)(st + ((size_t)b * 2 + 1) * 1024 + c0), c = *(const f32x4*)(st + ((size_t)b * 2 + 1) * 1024 + c0 + 4);
                p1[0] = a.x; p1[1] = a.y; p1[2] = a.z; p1[3] = a.w; p1[4] = c.x; p1[5] = c.y; p1[6] = c.z; p1[7] = c.w; }
            if (pos >= 2) { unpack8(*(const u32x4*)(pr - 2 * NIN + C_CG + c0), cg); unpack8(*(const u32x4*)(pr - 2 * NIN + C_XIN + c0), xi);
#pragma unroll
                for (int e = 0; e < 8; ++e) p2[e] = cg[e] * xi[e]; }
            else if (prompt) {
#pragma unroll
                for (int e = 0; e < 8; ++e) p2[e] = 0.f; }
            else { const int sr = (pos == 1) ? 1 : 0; const f32x4 a = *(const f32x4*)(st + ((size_t)b * 2 + sr) * 1024 + c0), c = *(const f32x4*)(st + ((size_t)b * 2 + sr) * 1024 + c0 + 4);
                p2[0] = a.x; p2[1] = a.y; p2[2] = a.z; p2[3] = a.w; p2[4] = c.x; p2[5] = c.y; p2[6] = c.z; p2[7] = c.w; }
            float y[8];
#pragma unroll
            for (int e = 0; e < 8; ++e) y[e] = bg[e] * (cw[c0 + e] * p2[e] + cw[1024 + c0 + e] * p1[e] + cw[2048 + c0 + e] * p0[e]);
            u32x4 w; w.x = cvt_pk_bf16(y[0], y[1]); w.y = cvt_pk_bf16(y[2], y[3]); w.z = cvt_pk_bf16(y[4], y[5]); w.w = cvt_pk_bf16(y[6], y[7]);
            *(u32x4*)(YB + (size_t)row * DM + 1024 + c0) = w;
            const int tail = prompt ? 2046 : 6;
            if (pos >= tail) { float* o = F.out + (prompt ? O_CP : O_CS) + ((size_t)b * 2 + (pos - tail)) * 1024 + c0;
                *(f32x4*)o = (f32x4){p0[0], p0[1], p0[2], p0[3]}; *(f32x4*)(o + 4) = (f32x4){p0[4], p0[5], p0[6], p0[7]}; }
        }
    }
    {
        const float* lg = IN(8); const float* lb = IN(9); const float* wsp = IN(10); const float* bsp = IN(11);
        bf16_t* YA = WSP(bf16_t, WS_YA);
        const int gw = F.bx * NWAVES + F.wave, NGW = F.G * NWAVES;
        for (int item = gw; item < 256; item += NGW) {
            const int sq = item >> 1, jsel = item & 1;
            const int row0 = MP + sq * 8;
            float mu[8], rs[8];
            { float m4[4], r4[4], vlo[4][8], vhi[4][8];
              ln_stats<4>(P1 + (size_t)row0 * NIN + C_V + 8 * F.lane, NIN, m4, r4, vlo, vhi);
#pragma unroll
              for (int t = 0; t < 4; ++t) { mu[t] = m4[t]; rs[t] = r4[t]; }
              ln_stats<4>(P1 + (size_t)(row0 + 4) * NIN + C_V + 8 * F.lane, NIN, m4, r4, vlo, vhi);
#pragma unroll
              for (int t = 0; t < 4; ++t) { mu[4 + t] = m4[t]; rs[4 + t] = r4[t]; } }
            {
                const int j = jsel; const int c0 = 8 * F.lane + 512 * j, g = c0 >> 8;
                float gg[8], bb[8];
                { const f32x4 a = *(const f32x4*)(lg + c0), b = *(const f32x4*)(lg + c0 + 4), c = *(const f32x4*)(lb + c0), d = *(const f32x4*)(lb + c0 + 4);
                  gg[0] = a.x; gg[1] = a.y; gg[2] = a.z; gg[3] = a.w; gg[4] = b.x; gg[5] = b.y; gg[6] = b.z; gg[7] = b.w;
                  bb[0] = c.x; bb[1] = c.y; bb[2] = c.z; bb[3] = c.w; bb[4] = d.x; bb[5] = d.y; bb[6] = d.z; bb[7] = d.w; }
                float vl[8][8];
#pragma unroll
                for (int t = 0; t < 8; ++t) {
                    float a[8]; unpack8(*(const u32x4*)(P1 + (size_t)(row0 + t) * NIN + C_V + c0), a);
#pragma unroll
                    for (int e = 0; e < 8; ++e) vl[t][e] = (a[e] - mu[t]) * rs[t] * gg[e] + bb[e];
                    float* o = F.out + O_CV + (size_t)(sq * 8 + t) * 1024 + c0;
                    *(f32x4*)o = (f32x4){vl[t][0], vl[t][1], vl[t][2], vl[t][3]}; *(f32x4*)(o + 4) = (f32x4){vl[t][4], vl[t][5], vl[t][6], vl[t][7]};
                }
#pragma unroll
                for (int t = 0; t < 8; ++t) {
                    float z[8]; const float bs = bsp[g * 128 + t];
#pragma unroll
                    for (int e = 0; e < 8; ++e) z[e] = bs;
#pragma unroll
                    for (int s = 0; s < 8; ++s) if (s <= t) { const float w = wsp[(size_t)g * 16384 + t * 128 + s];
#pragma unroll
                        for (int e = 0; e < 8; ++e) z[e] += w * vl[s][e]; }
                    float uf[8]; unpack8(*(const u32x4*)(P1 + (size_t)(row0 + t) * NIN + C_U + c0), uf);
                    u32x4 w; w.x = cvt_pk_bf16(uf[0] * z[0], uf[1] * z[1]); w.y = cvt_pk_bf16(uf[2] * z[2], uf[3] * z[3]); w.z = cvt_pk_bf16(uf[4] * z[4], uf[5] * z[5]); w.w = cvt_pk_bf16(uf[6] * z[6], uf[7] * z[7]);
                    *(u32x4*)(YA + (size_t)(row0 + t) * DM + c0) = w;
                }
            }
        }
    }
    {
        const float* lg = IN(8); const float* lb = IN(9);
        bf16_t* VT = WSP(bf16_t, WS_VT);
        LAS bf16_t* T = (LAS bf16_t*)F.lds;
        for (int un = F.bx; un < 256; un += F.G) {
            const int chunk = un >> 2, g = un & 3;
            const bool mine = ((F.lane >> 5) == (g & 1));
            const int cm = 256 * g + 8 * (F.lane & 31);
            float gg[8], bb[8];
            { const f32x4 a = *(const f32x4*)(lg + cm), b = *(const f32x4*)(lg + cm + 4), c = *(const f32x4*)(lb + cm), d = *(const f32x4*)(lb + cm + 4);
              gg[0] = a.x; gg[1] = a.y; gg[2] = a.z; gg[3] = a.w; gg[4] = b.x; gg[5] = b.y; gg[6] = b.z; gg[7] = b.w;
              bb[0] = c.x; bb[1] = c.y; bb[2] = c.z; bb[3] = c.w; bb[4] = d.x; bb[5] = d.y; bb[6] = d.z; bb[7] = d.w; }
            for (int rr = 0; rr < 16; rr += 4) {
                const int s0 = F.wave * 16 + rr;
                float mean[4], rstd[4], vlo[4][8], vhi[4][8];
                ln_stats<4>(P1 + (size_t)(chunk * 128 + s0) * NIN + C_V + 8 * F.lane, NIN, mean, rstd, vlo, vhi);
                if (mine) {
#pragma unroll
                    for (int r = 0; r < 4; ++r) {
                        float y[8];
#pragma unroll
                        for (int e = 0; e < 8; ++e) { const float xl = vlo[r][e], xh = vhi[r][e]; const float x = (g >> 1) ? xh : xl; y[e] = (x - mean[r]) * rstd[r] * gg[e] + bb[e]; }
                        u32x4 w; w.x = cvt_pk_bf16(y[0], y[1]); w.y = cvt_pk_bf16(y[2], y[3]); w.z = cvt_pk_bf16(y[4], y[5]); w.w = cvt_pk_bf16(y[6], y[7]);
                        *(LAS u32x4*)(T + (s0 + r) * 264 + 8 * (F.lane & 31)) = w;
                    }
                }
            }
            __syncthreads();
#pragma unroll 2
            for (int itn = 0; itn < 8; ++itn) {
                const int idx = itn * 512 + F.tid, c = idx >> 4, sb = idx & 15;
                unsigned short h[8];
#pragma unroll
                for (int i = 0; i < 8; ++i) h[i] = T[(8 * sb + i) * 264 + c];
                u32x4 w; w.x = (unsigned)h[0] | ((unsigned)h[1] << 16); w.y = (unsigned)h[2] | ((unsigned)h[3] << 16); w.z = (unsigned)h[4] | ((unsigned)h[5] << 16); w.w = (unsigned)h[6] | ((unsigned)h[7] << 16);
                *(u32x4*)(VT + ((size_t)chunk * 1024 + g * 256 + c) * 128 + 8 * sb) = w;
            }
            __syncthreads();
        }
    }
}

__device__ __forceinline__ void sample_attn_unit(Frame& F, int unit, bool tail) {
    const int b = unit >> 2, h = unit & 3, lane = F.lane, wave = F.wave, r16 = lane & 15, kq = lane >> 4;
    const float* Kb = IN(3) + ((size_t)b * NMEM * XH + h) * XD;
    const float* Vb = IN(4) + ((size_t)b * NMEM * XH + h) * XD;
    const bf16_t* Qb = WSP(bf16_t, WS_Q) + (size_t)(MP + b * 8) * DM + h * XD;
    LAS bf16_t* sP = (LAS bf16_t*)F.lds;
    LAS float* sSt = (LAS float*)(F.lds + 16 * 528);
    LAS bf16_t* sQ = (LAS bf16_t*)(F.lds + 9472);
    if (tail) {
        const int t = F.tid >> 6, d0 = (F.tid & 63) * 8;
        const bf16_t* pp = WSP(bf16_t, WS_PART) + (size_t)(b * 8 + t) * DM + h * XD + d0;
        f32x4 a0 = {0.f, 0.f, 0.f, 0.f}, a1 = {0.f, 0.f, 0.f, 0.f};
#pragma unroll
        for (int s = 0; s < 8; ++s) { float f[8]; unpack8(*(const u32x4*)(pp + (size_t)s * (MS * DM)), f); a0 = a0 + (f32x4){f[0], f[1], f[2], f[3]}; a1 = a1 + (f32x4){f[4], f[5], f[6], f[7]}; }
        a0 = a0 * QSCALE; a1 = a1 * QSCALE;
        *(LAS bf16x8*)(sQ + t * 520 + d0) = pack8(a0, a1);
        __syncthreads();
    }
    f32x4 s0 = {0.f, 0.f, 0.f, 0.f}, s1 = {0.f, 0.f, 0.f, 0.f};
    const float* k0p = Kb + (size_t)(32 * wave + r16) * (XH * XD) + kq * 8;
    const float* k1p = k0p + (size_t)16 * (XH * XD);
    const bf16_t* qp = Qb + (size_t)(r16 & 7) * DM + kq * 8;
#pragma unroll 4
    for (int ds = 0; ds < 16; ++ds) {
        const f32x4 a0 = *(const f32x4*)(k0p + ds * 32), a1 = *(const f32x4*)(k0p + ds * 32 + 4);
        const f32x4 c0 = *(const f32x4*)(k1p + ds * 32), c1 = *(const f32x4*)(k1p + ds * 32 + 4);
        u32x4 qw = tail ? *(const LAS u32x4*)(sQ + (r16 & 7) * 520 + kq * 8 + ds * 32) : *(const u32x4*)(qp + ds * 32); if (r16 >= 8) qw = (u32x4){0u, 0u, 0u, 0u};
        const bf16x8 qf = __builtin_bit_cast(bf16x8, qw);
        s0 = __builtin_amdgcn_mfma_f32_16x16x32_bf16(pack8(a0, a1), qf, s0, 0, 0, 0);
        s1 = __builtin_amdgcn_mfma_f32_16x16x32_bf16(pack8(c0, c1), qf, s1, 0, 0, 0);
    }
    float mx = fmaxf(fmaxf(fmaxf(s0[0], s0[1]), fmaxf(s0[2], s0[3])), fmaxf(fmaxf(s1[0], s1[1]), fmaxf(s1[2], s1[3])));
    mx = fmaxf(mx, __shfl_xor(mx, 16)); mx = fmaxf(mx, __shfl_xor(mx, 32));
    float sm = 0.f;
#pragma unroll
    for (int j = 0; j < 4; ++j) { s0[j] = __expf(s0[j] - mx); s1[j] = __expf(s1[j] - mx); sm += s0[j] + s1[j]; }
    sm += __shfl_xor(sm, 16); sm += __shfl_xor(sm, 32);
    if (kq == 0) { sSt[(wave * 16 + r16) * 2] = mx; sSt[(wave * 16 + r16) * 2 + 1] = sm; }
    __syncthreads();
    float M = -3.0e38f;
#pragma unroll
    for (int w2 = 0; w2 < 8; ++w2) M = fmaxf(M, sSt[(w2 * 16 + r16) * 2]);
    float L = 0.f;
#pragma unroll
    for (int w2 = 0; w2 < 8; ++w2) L += sSt[(w2 * 16 + r16) * 2 + 1] * __expf(sSt[(w2 * 16 + r16) * 2] - M);
    const float f = __expf(mx - M) / L;
    { u32x2 w; w.x = cvt_pk_bf16(s0[0] * f, s0[1] * f); w.y = cvt_pk_bf16(s0[2] * f, s0[3] * f); *(LAS u32x2*)(sP + r16 * 264 + 32 * wave + 4 * kq) = w;
      w.x = cvt_pk_bf16(s1[0] * f, s1[1] * f); w.y = cvt_pk_bf16(s1[2] * f, s1[3] * f); *(LAS u32x2*)(sP + r16 * 264 + 32 * wave + 16 + 4 * kq) = w; }
    __syncthreads();
    f32x4 o[4];
#pragma unroll
    for (int c = 0; c < 4; ++c) o[c] = (f32x4){0.f, 0.f, 0.f, 0.f};
    const float* vp = Vb + (size_t)(kq * 8) * (XH * XD) + 64 * wave + 4 * r16;
#pragma unroll 2
    for (int ms = 0; ms < 8; ++ms) {
        const bf16x8 pf = *(const LAS bf16x8*)(sP + r16 * 264 + ms * 32 + kq * 8);
        f32x4 x[8];
#pragma unroll
        for (int j = 0; j < 8; ++j) x[j] = *(const f32x4*)(vp + (size_t)(ms * 32 + j) * (XH * XD));
#pragma unroll
        for (int c = 0; c < 4; ++c) {
            const bf16x8 a = pack8((f32x4){x[0][c], x[1][c], x[2][c], x[3][c]}, (f32x4){x[4][c], x[5][c], x[6][c], x[7][c]});
            o[c] = __builtin_amdgcn_mfma_f32_16x16x32_bf16(a, pf, o[c], 0, 0, 0);
        }
    }
    if (r16 < 8) {
        bf16_t* op = WSP(bf16_t, WS_O) + (size_t)(MP + b * 8 + r16) * DM + h * XD + 64 * wave + 16 * kq;
        u32x4 w0, w1;
        w0.x = cvt_pk_bf16(o[0][0], o[1][0]); w0.y = cvt_pk_bf16(o[2][0], o[3][0]); w0.z = cvt_pk_bf16(o[0][1], o[1][1]); w0.w = cvt_pk_bf16(o[2][1], o[3][1]);
        w1.x = cvt_pk_bf16(o[0][2], o[1][2]); w1.y = cvt_pk_bf16(o[2][2], o[3][2]); w1.z = cvt_pk_bf16(o[0][3], o[1][3]); w1.w = cvt_pk_bf16(o[2][3], o[3][3]);
        *(u32x4*)op = w0; *(u32x4*)(op + 8) = w1;
    }
    __syncthreads();
}

template <bool OUT_F32> __device__ __forceinline__ void rms_store(const float (&v)[4][8], float r, const float* g, void* orow, int lane) {
#pragma unroll
    for (int j = 0; j < 4; ++j) { const int c = 8 * lane + 512 * j; const f32x4 g0 = *(const f32x4*)(g + c), g1 = *(const f32x4*)(g + c + 4);
        const f32x4 a = (f32x4){v[j][0], v[j][1], v[j][2], v[j][3]} * r * g0, b = (f32x4){v[j][4], v[j][5], v[j][6], v[j][7]} * r * g1;
        if (OUT_F32) { *(f32x4*)((float*)orow + c) = a; *(f32x4*)((float*)orow + c + 4) = b; }
        else { u32x4 w; w.x = cvt_pk_bf16(a.x, a.y); w.y = cvt_pk_bf16(a.z, a.w); w.z = cvt_pk_bf16(b.x, b.y); w.w = cvt_pk_bf16(b.z, b.w); *(u32x4*)((bf16_t*)orow + c) = w; } }
}
template <bool OUT_F32> __device__ __forceinline__ void phase_rms(Frame& F, const bf16_t* src, const float* g, void* dst, const bf16_t* part, const float* sbaseF, const bf16_t* sbaseH, bf16_t* hout) {
    const int gw = F.bx * NWAVES + F.wave, NGW = F.G * NWAVES, lane = F.lane;
    for (int mm = gw; mm < MT; mm += 2 * NGW) {
      const int m2 = mm + NGW; const bool reg0 = (mm < MP || part == nullptr), reg1 = (m2 < MT) && (m2 < MP || part == nullptr);
      if (reg0 && reg1) {
        float v0[4][8], v1[4][8]; float s0 = 0.f, s1 = 0.f;
#pragma unroll
        for (int j = 0; j < 4; ++j) { unpack8(*(const u32x4*)(src + (size_t)mm * DM + 8 * lane + 512 * j), v0[j]); unpack8(*(const u32x4*)(src + (size_t)m2 * DM + 8 * lane + 512 * j), v1[j]); }
#pragma unroll
        for (int j = 0; j < 4; ++j)
#pragma unroll
            for (int e = 0; e < 8; ++e) { s0 += v0[j][e] * v0[j][e]; s1 += v1[j][e] * v1[j][e]; }
#pragma unroll
        for (int o = 1; o < 64; o <<= 1) { s0 += __shfl_xor(s0, o); s1 += __shfl_xor(s1, o); }
        rms_store<OUT_F32>(v0, rsqrtf(s0 * (1.f / DM) + EPS), g, OUT_F32 ? (void*)((float*)dst + (size_t)mm * DM) : (void*)((bf16_t*)dst + (size_t)mm * DM), lane);
        rms_store<OUT_F32>(v1, rsqrtf(s1 * (1.f / DM) + EPS), g, OUT_F32 ? (void*)((float*)dst + (size_t)m2 * DM) : (void*)((bf16_t*)dst + (size_t)m2 * DM), lane);
        continue;
      }
      for (int m = mm; m <= m2 && m < MT; m += NGW) {
        void* orow = OUT_F32 ? (void*)((float*)dst + (size_t)m * DM) : (void*)((bf16_t*)dst + (size_t)m * DM);
        float v[4][8]; float ss = 0.f;
        if (m < MP || part == nullptr) {
#pragma unroll
            for (int j = 0; j < 4; ++j) unpack8(*(const u32x4*)(src + (size_t)m * DM + 8 * lane + 512 * j), v[j]);
        } else {
            const int ms = m - MP;
#pragma unroll
            for (int j = 0; j < 4; ++j) { const int c = 8 * lane + 512 * j;
                if (sbaseF) { const f32x4 a = *(const f32x4*)(sbaseF + (size_t)ms * DM + c), b = *(const f32x4*)(sbaseF + (size_t)ms * DM + c + 4);
                    v[j][0] = a.x; v[j][1] = a.y; v[j][2] = a.z; v[j][3] = a.w; v[j][4] = b.x; v[j][5] = b.y; v[j][6] = b.z; v[j][7] = b.w; }
                else unpack8(*(const u32x4*)(sbaseH + (size_t)ms * DM + c), v[j]); }
#pragma unroll
            for (int s = 0; s < 8; ++s)
#pragma unroll
                for (int j = 0; j < 4; ++j) { float f[8]; unpack8(*(const u32x4*)(part + (size_t)s * (MS * DM) + (size_t)ms * DM + 8 * lane + 512 * j), f);
#pragma unroll
                    for (int e = 0; e < 8; ++e) v[j][e] += f[e]; }
            if (hout) {
#pragma unroll
                for (int j = 0; j < 4; ++j) { u32x4 w; w.x = cvt_pk_bf16(v[j][0], v[j][1]); w.y = cvt_pk_bf16(v[j][2], v[j][3]); w.z = cvt_pk_bf16(v[j][4], v[j][5]); w.w = cvt_pk_bf16(v[j][6], v[j][7]);
                    *(u32x4*)(hout + (size_t)ms * DM + 8 * lane + 512 * j) = w;
                    unpack8(w, v[j]); }
            }
        }
#pragma unroll
        for (int j = 0; j < 4; ++j)
#pragma unroll
            for (int e = 0; e < 8; ++e) ss += v[j][e] * v[j][e];
        rms_store<OUT_F32>(v, rsqrtf(wave_sum(ss) * (1.f / DM) + EPS), g, orow, lane);
      }
    }
}

__global__ void __launch_bounds__(NWAVES * 64, 2) fwd_megakernel(Args args) {
    extern __shared__ __attribute__((aligned(16))) unsigned char lds_raw[];
    cg::grid_group grid = cg::this_grid();
    Frame F;
    F.lds = (LAS unsigned char*)lds_raw;
    F.tid = threadIdx.x; F.lane = F.tid & 63; F.wave = __builtin_amdgcn_readfirstlane(F.tid >> 6);
    F.G = gridDim.x; F.bx = blockIdx.x;
    F.out = args.out; F.ws = args.ws;
    volatile LAS unsigned* MISC = (volatile LAS unsigned*)(F.lds + 131072 + 320);
    if (F.tid < 32) MISC[F.tid] = 0u;
    __syncthreads();
    XcdBarrier xbar = xcd_barrier_post((unsigned*)(F.ws + WS_CTL) + 4096, MISC + 8);
#define SEAM0() do { grid.sync(); int t_ = threadIdx.x; asm volatile("" : "+v"(t_)); F.tid = t_; F.lane = t_ & 63; } while (0)
#define SEAM() do { xcd_barrier(xbar); int t_ = threadIdx.x; asm volatile("" : "+v"(t_)); F.tid = t_; F.lane = t_ & 63; { unsigned char* w_ = F.ws; float* o_ = F.out; asm volatile("" : "+s"(w_), "+s"(o_)); F.ws = w_; F.out = o_; } } while (0)
#ifndef PHASE_MASK
#define PHASE_MASK 0xffffffffu
#endif
#define PH(k) ((PHASE_MASK >> (k)) & 1u)
    using namespace pg8;
    const char* XN = (const char*)(F.ws + WS_XN);
    const bool tail = (F.G == 256);

    if (PH(0)) phase_prologue(F);
    SEAM0();
    if (PH(1)) {
        SchedIn S{XN, (const char*)(F.ws + WS_WIN), F.G, F.bx};
        EpiIn E{WSP(bf16_t, WS_P1), F.out + O_MK, F.out + O_MV, WSP(bf16_t, WS_KP), WSP(bf16_t, WS_VPT)};
        gemm_phase<EpiIn, SchedIn, true>(F.lds, DM, DM, S, E);
        convert_fill(F, CV_A1, CV_B1, 1296 + 64);
    }
    SEAM();
    if (PH(2)) phase_mixprep(F);
    asm volatile("s_waitcnt vmcnt(0)" ::: "memory"); __syncthreads();
    { int t_ = threadIdx.x; asm volatile("" : "+v"(t_)); F.tid = t_; F.lane = t_ & 63; }
    if (PH(3)) {
        SchedSp S{(const char*)(F.ws + WS_WSP), (const char*)(F.ws + WS_VT), F.G, F.bx};
        EpiSp E{WSP(bf16_t, WS_P1), IN(11), WSP(bf16_t, WS_YA)};
        gemm_phase<EpiSp, SchedSp, true>(F.lds, 128, 128, S, E);
    }
    SEAM();
    if (PH(4)) {
        SchedRect S{(const char*)(F.ws + WS_YA), (const char*)(F.ws + WS_WA), (size_t)BM * DM * 2, (size_t)BM * DM * 2, 36, 8, F.G, F.bx, 32};
        EpiMerged E{WSP(bf16_t, WS_P1), WSP(bf16_t, WS_MRG)};
        gemm_phase<EpiMerged, SchedRect, true>(F.lds, DM, DM, S, E);
        convert_fill(F, CV_B1, CV_C1, 288);
    }
    SEAM();
    if (PH(6)) {
        SchedTail S{(const char*)(F.ws + WS_MRG), (const char*)(F.ws + WS_WMIX), (size_t)BM * DM * 2, (size_t)BM * DM * 2, 32, F.G, F.bx, tail};
        EpiTail<EpiRes<true>> E{{IN(0), IN(1), MP, nullptr, WSP(bf16_t, WS_H1)}, WSP(bf16_t, WS_PART)};
        gemm_phase<EpiTail<EpiRes<true>>, SchedTail, true>(F.lds, DM, DM, S, E);
    }
    SEAM();
    phase_rms<false>(F, WSP(bf16_t, WS_H1), IN(16), WSP(bf16_t, WS_XN), tail ? WSP(bf16_t, WS_PART) : nullptr, IN(1), nullptr, WSP(bf16_t, WS_H1) + (size_t)MP * DM);
    SEAM();
    if (PH(7)) {
        SchedTail S{XN, (const char*)(F.ws + WS_WQ), (size_t)BM * DM * 2, (size_t)BM * DM * 2, 32, F.G, F.bx, tail};
        EpiTail<EpiBf<0>> E{{WSP(bf16_t, WS_Q), DM, QSCALE}, WSP(bf16_t, WS_PART)};
        gemm_phase<EpiTail<EpiBf<0>>, SchedTail, true>(F.lds, DM, DM, S, E);
    }
    SEAM();
    if (PH(8)) {
        {
            SchedS S{(const char*)(F.ws + WS_Q), (const char*)(F.ws + WS_KP), F.G, F.bx};
            EpiSoftmax E{WSP(bf16_t, WS_PS)};
            gemm_phase<EpiSoftmax, SchedS, false>(F.lds, DM, DM, S, E);
        }
        asm volatile("s_waitcnt vmcnt(0)" ::: "memory"); __syncthreads();
        {
            SchedO S{(const char*)(F.ws + WS_PS), (const char*)(F.ws + WS_VPT), F.G, F.bx};
            EpiBf<0> E{WSP(bf16_t, WS_O), DM, 1.0f};
            gemm_phase<EpiBf<0>, SchedO, true>(F.lds, 256, 256, S, E);
        }
        __syncthreads();
        unsigned* qhead = (unsigned*)(F.ws + WS_CTL) + 2048;
        for (;;) {
            if (F.tid == 0) MISC[16] = __hip_atomic_fetch_add(qhead, 1u, __ATOMIC_RELAXED, __HIP_MEMORY_SCOPE_AGENT);
            __syncthreads();
            const int un = (int)MISC[16];
            if (un >= 512) break;
            sample_attn_unit(F, un, tail);
        }
    }
    SEAM();
    if (PH(10)) {
        SchedTail S{(const char*)(F.ws + WS_O), (const char*)(F.ws + WS_WXO), (size_t)BM * DM * 2, (size_t)BM * DM * 2, 32, F.G, F.bx, tail};
        EpiTail<EpiRes<false>> E{{nullptr, nullptr, 1 << 30, WSP(bf16_t, WS_H1), WSP(bf16_t, WS_H2)}, WSP(bf16_t, WS_PART)};
        gemm_phase<EpiTail<EpiRes<false>>, SchedTail, true>(F.lds, DM, DM, S, E);
    }
    SEAM();
    phase_rms<false>(F, WSP(bf16_t, WS_H2), IN(22), WSP(bf16_t, WS_XN), tail ? WSP(bf16_t, WS_PART) : nullptr, nullptr, WSP(bf16_t, WS_H1) + (size_t)MP * DM, WSP(bf16_t, WS_H2) + (size_t)MP * DM);
    SEAM();
    if (PH(11)) {
        SchedRect S{XN, (const char*)(F.ws + WS_WUP), (size_t)BM * DM * 2, (size_t)BM * DM * 2, 36, 32, F.G, F.bx, 32};
        EpiBf<1> E{WSP(bf16_t, WS_UP), FF, 1.0f};
        gemm_phase<EpiBf<1>, SchedRect, true>(F.lds, DM, DM, S, E);
        convert_fill(F, CV_C1, CV_D1, 36 * 32);
    }
    SEAM();
    if (PH(12)) {
        SchedTail S{(const char*)(F.ws + WS_UP), (const char*)(F.ws + WS_WDN), (size_t)BM * FF * 2, (size_t)BM * FF * 2, 128, F.G, F.bx, tail};
        EpiTail<EpiRes<false>> E{{nullptr, nullptr, 1 << 30, WSP(bf16_t, WS_H2), WSP(bf16_t, WS_H2)}, WSP(bf16_t, WS_PART)};
        gemm_phase<EpiTail<EpiRes<false>>, SchedTail, true>(F.lds, FF, FF, S, E);
    }
    SEAM();
    phase_rms<true>(F, WSP(bf16_t, WS_H2), IN(25), F.out + O_Y, tail ? WSP(bf16_t, WS_PART) : nullptr, nullptr, WSP(bf16_t, WS_H2) + (size_t)MP * DM, nullptr);
}

extern "C" void kernel_launch(void* const* d_in, const int* in_sizes, int n_in, void* d_out, int out_size, void* d_ws, size_t ws_size, hipStream_t stream) {
    static int grid = 0;
    if (grid == 0) {
        if (n_in != 26 || ws_size < WS_END) { fprintf(stderr, "kernel_launch: unexpected n_in %d / ws_size %zu\n", n_in, ws_size); grid = -1; return; }
        int dev = 0, cus = 0, per_cu = 0;
        hipGetDevice(&dev);
        hipDeviceGetAttribute(&cus, hipDeviceAttributeMultiprocessorCount, dev);
        if (hipFuncSetAttribute((const void*)fwd_megakernel, hipFuncAttributeMaxDynamicSharedMemorySize, LDS_BYTES) != hipSuccess) { fprintf(stderr, "kernel_launch: hipFuncSetAttribute failed\n"); grid = -1; return; }
        if (hipOccupancyMaxActiveBlocksPerMultiprocessor(&per_cu, (const void*)fwd_megakernel, NWAVES * 64, LDS_BYTES) != hipSuccess || per_cu < 1) { fprintf(stderr, "kernel_launch: occupancy query says %d\n", per_cu); per_cu = 1; }
        (void)hipGetLastError();
        grid = cus;
        if (grid < 128) { fprintf(stderr, "kernel_launch: needs >= 128 CUs\n"); grid = -1; return; }
    }
    if (grid < 0) return;
    if (hipMemsetAsync((char*)d_ws + WS_CTL, 0, 65536, stream) != hipSuccess) { fprintf(stderr, "kernel_launch: memset failed\n"); return; }
    Args a{};
    for (int i = 0; i < 26; ++i) a.in[i] = (const float*)d_in[i];
    a.out = (float*)d_out; a.ws = (unsigned char*)d_ws;
    void* kargs[] = {&a};
    hipError_t e = hipLaunchCooperativeKernel((const void*)fwd_megakernel, dim3(grid), dim3(NWAVES * 64), kargs, LDS_BYTES, stream);
    if (e != hipSuccess) fprintf(stderr, "kernel_launch: cooperative launch failed: %s (grid %d)\n", hipGetErrorString(e), grid);
}
```

```cpp
#include <hip/hip_runtime.h>
#include <hip/hip_cooperative_groups.h>
#include <cstdio>
#include <cstdint>
namespace cg = cooperative_groups;

#define LAS __attribute__((address_space(3)))
typedef unsigned short bf16_t;
typedef short bf16x8 __attribute__((ext_vector_type(8)));
typedef float f32x4 __attribute__((ext_vector_type(4)));
typedef float f32x2 __attribute__((ext_vector_type(2)));
typedef unsigned u32x4 __attribute__((ext_vector_type(4)));
typedef unsigned u32x2 __attribute__((ext_vector_type(2)));

constexpr int DM = 2048, MP = 8192, MS = 1024, MT = MP + MS  ;
constexpr int NIN = 9216, FF = 8192, NMEM = 256, XH = 4, XD = 512;
constexpr int C_U = 0, C_V = 1024, C_BG = 2048, C_CG = 3072, C_XIN = 4096, C_GA = 5120, C_GB = 7168;
constexpr float EPS = 1e-6f, QSCALE = 0.04419417382415922f  ;
constexpr size_t O_Y = 0, O_MK = 18874368, O_MV = 20971520, O_CP = 23068672, O_CS = 23076864, O_CV = 23339008;
constexpr size_t MiB = 1u << 20;
constexpr size_t WS_CTL = 0, CTL_BYTES = 1 * MiB;
constexpr size_t WS_WIN = 2 * MiB;
constexpr size_t WS_WA = 54 * MiB, WS_WB = 58 * MiB;
constexpr size_t WS_WMIX = 62 * MiB, WS_WQ = 70 * MiB, WS_WXO = 78 * MiB;
constexpr size_t WS_WUP = 86 * MiB;
constexpr size_t WS_WDN = 118 * MiB;
constexpr size_t WS_WSP = 150 * MiB;
constexpr size_t WS_XN = 152 * MiB;
constexpr size_t WS_P1 = 192 * MiB;
constexpr size_t WS_UP = 192 * MiB;
constexpr size_t WS_VT = 354 * MiB;
constexpr size_t WS_YA = 370 * MiB, WS_YB = 388 * MiB;
constexpr size_t WS_TMP = 406 * MiB;
constexpr size_t WS_PART = 406 * MiB;
constexpr size_t WS_MRG = 478 * MiB;
constexpr size_t WS_H1 = 514 * MiB;
constexpr size_t WS_Q = 586 * MiB;
constexpr size_t WS_KP = 622 * MiB;
constexpr size_t WS_VPT = 626 * MiB;
constexpr size_t WS_PS = 630 * MiB;
constexpr size_t WS_O = 646 * MiB;
constexpr size_t WS_H2 = 682 * MiB;
constexpr size_t WS_END = 754 * MiB;

constexpr int LDS_BYTES = 147456;
constexpr int NWAVES = 8;

__device__ __forceinline__ unsigned cvt_pk_bf16(float lo, float hi) { unsigned r; asm volatile("v_cvt_pk_bf16_f32 %0, %1, %2" : "=v"(r) : "v"(lo), "v"(hi)); return r; }
__device__ __forceinline__ float bf_lo(unsigned u) { return __uint_as_float(u << 16); }
__device__ __forceinline__ float bf_hi(unsigned u) { return __uint_as_float(u & 0xffff0000u); }
__device__ __forceinline__ float bf1(bf16_t h) { return __uint_as_float(((unsigned)h) << 16); }
__device__ __forceinline__ bf16x8 pack8(f32x4 a, f32x4 b) {
    u32x4 w; w.x = cvt_pk_bf16(a.x, a.y); w.y = cvt_pk_bf16(a.z, a.w); w.z = cvt_pk_bf16(b.x, b.y); w.w = cvt_pk_bf16(b.z, b.w);
    return __builtin_bit_cast(bf16x8, w);
}
__device__ __forceinline__ void unpack8(u32x4 w, float (&f)[8]) {
    f[0] = bf_lo(w.x); f[1] = bf_hi(w.x); f[2] = bf_lo(w.y); f[3] = bf_hi(w.y); f[4] = bf_lo(w.z); f[5] = bf_hi(w.z); f[6] = bf_lo(w.w); f[7] = bf_hi(w.w);
}
__device__ __forceinline__ float wave_sum(float v) {
#pragma unroll
    for (int o = 1; o < 64; o <<= 1) v += __shfl_xor(v, o);
    return v;
}
__device__ __forceinline__ float sigmoidf_(float x) { return __builtin_amdgcn_rcpf(1.0f + __expf(-x)); }
#define LDS_WAIT() asm volatile("s_waitcnt lgkmcnt(0)" ::: "memory")

namespace pg8 {
constexpr int BM = 256, BK = 64, HALF = 128, HTB = HALF * BK * 2, STAGE_BYTES = 8 * HTB, NXCD = 8, WGM = 8;
__host__ __device__ __forceinline__ int lds_byte(int r, int c) { const int st = (r >> 4) * 2 + (c >> 5), rr = r & 15, cc = c & 31, ob = rr * 64 + cc * 2; return st * 1024 + (ob ^ (((ob >> 9) & 1) << 5)); }
__host__ __device__ __forceinline__ void stage_rc(int b, int& R, int& C) { const int st = b / 1024, sb = b % 1024, swz = sb ^ (((sb >> 9) & 1) << 5); R = (st >> 1) * 16 + swz / 64; C = (st & 1) * 32 + (swz % 64) / 2; }
__host__ __device__ __forceinline__ int perm32(int rho) { const int n = rho >> 4, i = rho & 15; return 8 * (i >> 2) + 4 * n + (i & 3); }

struct Unit { const char* A; const char* B; int orow, ocol, aux, nkt; };

__device__ __forceinline__ void rect_order(int L, int nM, int nN, int& pm, int& pn) {
    const int nwg = nM * nN; int wgid = L;
    { const int q = nwg / NXCD, r = nwg % NXCD, xcd = wgid % NXCD, off = wgid / NXCD; wgid = (xcd < r ? xcd * (q + 1) : r * (q + 1) + (xcd - r) * q) + off; }
    const int nig = WGM * nN, gid = wgid / nig, fm = gid * WGM, gsz = (nM - fm) < WGM ? (nM - fm) : WGM;
    pm = fm + ((wgid % nig) % gsz); pn = (wgid % nig) / gsz;
}

template <class Epi, class Sched, bool ALIGN_EPI>
__device__ __forceinline__ void gemm_phase(LAS unsigned char* lds, const int lda, const int ldb, const Sched& S, const Epi& E) {
    int tid_ = threadIdx.x; asm volatile("" : "+v"(tid_));
    const int tid = tid_, wid = __builtin_amdgcn_readfirstlane(tid >> 6), lane = tid & 63, wr = wid >> 2, wc = wid & 3, fr = lane & 15, fq = lane >> 4;
    unsigned voffA[2], voffB[2];
#pragma unroll
    for (int i = 0; i < 2; ++i) { int R, C; stage_rc(tid * 16 + i * 8192, R, C); const int Rb = Epi::PERM ? ((R & ~31) + perm32(R & 31)) : R;
        voffA[i] = (unsigned)(R * lda + C) * 2u; voffB[i] = (unsigned)(Rb * ldb + C) * 2u; }
    const size_t kstep = (size_t)(BK * 2);
    const size_t hstepA = (size_t)HALF * lda * 2, hstepB = (size_t)HALF * ldb * 2;
    const unsigned ldsw = (unsigned)wid * 1024u;
    const int aoff = lds_byte(wr * 64 + fr, fq * 8), boff = lds_byte(wc * 32 + fr, fq * 8);
#define PG8_SA(b, h) (((b) * 2 + (h)) * HTB)
#define PG8_SB(b, h) ((4 + (b) * 2 + (h)) * HTB)
#define PG8_STAGE(bufoff, gbase, voff) do { _Pragma("unroll") for (int _i = 0; _i < 2; ++_i) \
        __builtin_amdgcn_global_load_lds((const unsigned*)((const char*)(gbase) + (voff)[_i]), (LAS unsigned*)(lds + (bufoff) + ldsw + _i * 8192), 16, 0, 0); } while (0)
#define PG8_LDA(dst, b, h) do { _Pragma("unroll") for (int m = 0; m < 4; ++m) _Pragma("unroll") for (int k = 0; k < 2; ++k) dst[m][k] = *(const LAS bf16x8*)(lds + PG8_SA(b, h) + aoff + m * 2048 + k * 1024); } while (0)
#define PG8_LDB(dst, b, h) do { _Pragma("unroll") for (int n = 0; n < 2; ++n) _Pragma("unroll") for (int k = 0; k < 2; ++k) dst[n][k] = *(const LAS bf16x8*)(lds + PG8_SB(b, h) + boff + n * 2048 + k * 1024); } while (0)
#define PG8_MMA(ai, bj, At, Bt) do { __builtin_amdgcn_s_setprio(1); _Pragma("unroll") for (int m = 0; m < 4; ++m) _Pragma("unroll") for (int n = 0; n < 2; ++n) _Pragma("unroll") for (int k = 0; k < 2; ++k) \
        acc[ai][bj][m][n] = __builtin_amdgcn_mfma_f32_16x16x32_bf16(Bt[n][k], At[m][k], acc[ai][bj][m][n], 0, 0, 0); __builtin_amdgcn_s_setprio(0); } while (0)
#define PG8_WAIT_V(n) asm volatile("s_waitcnt vmcnt(" #n ")" ::: "memory")
#define PG8_WAIT_L(n) asm volatile("s_waitcnt lgkmcnt(" #n ")" ::: "memory")
#define PG8_BAR __builtin_amdgcn_s_barrier()
#define PG8_SCHED __builtin_amdgcn_sched_barrier(0)
    Unit cur, nxt; int ui = 0;
    if (!S.next(0, cur)) return;
    f32x4 acc[2][2][4][2];
#pragma unroll
    for (int a = 0; a < 2; ++a)
#pragma unroll
        for (int b = 0; b < 2; ++b)
#pragma unroll
            for (int m = 0; m < 4; ++m)
#pragma unroll
                for (int n = 0; n < 2; ++n) acc[a][b][m][n] = (f32x4){0.f, 0.f, 0.f, 0.f};
    bf16x8 At[4][2], B0[2][2], B1[2][2];
    const char* cA = cur.A; const char* cB = cur.B;
    PG8_STAGE(PG8_SB(0, 0), cB, voffB); PG8_STAGE(PG8_SB(0, 1), cB + hstepB, voffB); PG8_STAGE(PG8_SA(0, 0), cA, voffA); PG8_STAGE(PG8_SA(0, 1), cA + hstepA, voffA);
    if (wr == 1) PG8_BAR;
    PG8_WAIT_V(2); PG8_BAR;
    PG8_STAGE(PG8_SB(1, 0), cB + kstep, voffB); PG8_STAGE(PG8_SA(1, 0), cA + kstep, voffA); PG8_STAGE(PG8_SB(1, 1), cB + hstepB + kstep, voffB);
    PG8_WAIT_V(6); PG8_BAR;
    for (;;) {
        const bool has_next = S.next(ui + 1, nxt);
        int nt = cur.nkt; asm volatile("" : "+s"(nt));
        const char* nA = has_next ? nxt.A : cA; const char* nB = has_next ? nxt.B : cB;
        for (int t = 0; t < nt; t += 2) {
            const bool last = (t == nt - 2);
            const char* a1 = cA + (size_t)(t + 1) * kstep;
            const char* a2 = last ? nA : cA + (size_t)(t + 2) * kstep; const char* b2 = last ? nB : cB + (size_t)(t + 2) * kstep;
            const char* a3 = a2 + kstep; const char* b3 = b2 + kstep;
            if constexpr (Epi::MIDK) { if (t == (nt >> 1)) E.mid(acc, cur, wr, wc, fr, fq); }
            PG8_LDB(B0, 0, 0); PG8_LDB(B1, 0, 1); PG8_SCHED; PG8_LDA(At, 0, 0); PG8_STAGE(PG8_SA(1, 1), a1 + hstepA, voffA);
            PG8_WAIT_V(8); PG8_WAIT_L(0); PG8_BAR; PG8_MMA(0, 0, At, B0); PG8_MMA(0, 1, At, B1); PG8_BAR; PG8_SCHED;
            PG8_LDA(At, 0, 1); PG8_STAGE(PG8_SB(0, 0), b2, voffB); PG8_STAGE(PG8_SB(0, 1), b2 + hstepB, voffB); PG8_STAGE(PG8_SA(0, 0), a2, voffA);
            PG8_WAIT_V(8); PG8_WAIT_L(0); PG8_BAR; PG8_MMA(1, 0, At, B0); PG8_MMA(1, 1, At, B1); PG8_BAR; PG8_SCHED;
            PG8_LDB(B0, 1, 0); PG8_LDB(B1, 1, 1); PG8_SCHED; PG8_LDA(At, 1, 0); PG8_STAGE(PG8_SA(0, 1), a2 + hstepA, voffA);
            PG8_WAIT_V(8); PG8_WAIT_L(0); PG8_BAR; PG8_MMA(0, 0, At, B0); PG8_MMA(0, 1, At, B1); PG8_BAR; PG8_SCHED;
            PG8_LDA(At, 1, 1); PG8_STAGE(PG8_SB(1, 0), b3, voffB); PG8_STAGE(PG8_SB(1, 1), b3 + hstepB, voffB); PG8_STAGE(PG8_SA(1, 0), a3, voffA);
            PG8_WAIT_V(8); PG8_WAIT_L(0); PG8_BAR; PG8_MMA(1, 0, At, B0); PG8_MMA(1, 1, At, B1); PG8_BAR; PG8_SCHED;
        }
        if constexpr (ALIGN_EPI) { if (wr == 0) PG8_BAR; }
        if constexpr (!Epi::AFTER_DRAIN) { int fr_ = fr, fq_ = fq; asm volatile("" : "+v"(fr_), "+v"(fq_)); E(acc, cur, wr, wc, fr_, fq_); }
        if (!has_next) break;
#pragma unroll
        for (int a = 0; a < 2; ++a)
#pragma unroll
            for (int b = 0; b < 2; ++b)
#pragma unroll
                for (int m = 0; m < 4; ++m)
#pragma unroll
                    for (int n = 0; n < 2; ++n) acc[a][b][m][n] = (f32x4){0.f, 0.f, 0.f, 0.f};
        cur = nxt; cA = nA; cB = nB; ++ui;
        if constexpr (ALIGN_EPI) { if (wr == 1) PG8_BAR; }
    }
    PG8_WAIT_V(0);
    if constexpr (!ALIGN_EPI) { if (wr == 0) PG8_BAR; }
    PG8_BAR;
    if constexpr (Epi::AFTER_DRAIN) { E.fused(acc, cur, wr, wc, fr, fq, lds, wid, lane); }
#undef PG8_SA
#undef PG8_SB
#undef PG8_STAGE
#undef PG8_LDA
#undef PG8_LDB
#undef PG8_MMA
#undef PG8_WAIT_V
#undef PG8_WAIT_L
#undef PG8_BAR
#undef PG8_SCHED
}

struct SchedRect {
    const char* A; const char* B; size_t atile, btile; int nM, nN, G, c, NT;
    __device__ __forceinline__ bool next(int i, Unit& u) const {
        const int L = i * G + c; if (L >= nM * nN) return false;
        int pm, pn; rect_order(L, nM, nN, pm, pn);
        u.A = A + (size_t)pm * atile; u.B = B + (size_t)pn * btile; u.orow = pm * BM; u.ocol = pn * BM; u.aux = 0; u.nkt = NT; return true;
    }
};
struct SchedIn {
    const char* A; const char* B; int G, c;
    __device__ __forceinline__ bool next(int i, Unit& u) const {
        const int L = i * G + c; if (L >= 1296 + 64) return false;
        int pm, pn;
        if (L < 1296) { rect_order(L, 36, 36, pm, pn); u.orow = pm * BM; u.ocol = pn * BM; u.aux = 0; }
        else { const int l = L - 1296; pm = 36 + (l & 3); pn = 36 + (l >> 2); u.orow = (pm - 36) * BM; u.ocol = (pn - 36) * BM; u.aux = 1; }
        u.A = A + (size_t)pm * (BM * DM * 2); u.B = B + (size_t)pn * (BM * DM * 2); u.nkt = DM / BK; return true;
    }
};
struct SchedSp {
    const char* WSP; const char* VT; int G, c;
    __device__ __forceinline__ bool next(int i, Unit& u) const {
        const int L = i * G + c; if (L >= 256) return false;
        const int chunk = L >> 2, p = (L >> 1) & 1, gi = L & 1, g = 2 * p + gi;
        u.A = WSP + (size_t)p * (256 * 128 * 2); u.B = VT + ((size_t)chunk * 1024 + g * 256) * 128 * 2; u.orow = chunk * 128; u.ocol = g * 256; u.aux = gi; u.nkt = 2; return true;
    }
};
struct SchedS {
    const char* Q; const char* KP; int G, c;
    __device__ __forceinline__ bool next(int i, Unit& u) const {
        const int L = i * G + c; if (L >= 128 || i > 0) return false;
        const int b = L >> 5, h = (L >> 3) & 3, p = L & 7;
        u.A = Q + ((size_t)(b * 2048 + p * 256) * DM + h * XD) * 2; u.B = KP + ((size_t)(b * 256) * DM + h * XD) * 2;
        u.orow = (b * 4 + h) * 2048 + p * 256; u.ocol = 0; u.aux = 0; u.nkt = XD / BK; return true;
    }
};
struct SchedO {
    const char* PS; const char* VPT; int G, c;
    __device__ __forceinline__ bool next(int i, Unit& u) const {
        if (c >= 128 || i >= 2) return false;
        const int b = c >> 5, h = (c >> 3) & 3, p = c & 7, pn = i;
        u.A = PS + ((size_t)((b * 4 + h) * 2048 + p * 256) * 256) * 2; u.B = VPT + ((size_t)(b * 2048 + h * XD + pn * 256) * 256) * 2;
        u.orow = b * 2048 + p * 256; u.ocol = h * XD + pn * 256; u.aux = 0; u.nkt = 4; return true;
    }
};

struct SchedTail {
    const char* A; const char* B; size_t atile, btile; int NT, G, c; bool tail;
    __device__ __forceinline__ bool next(int i, Unit& u) const {
        if (!tail) { const int L = i * G + c; if (L >= 288) return false; int pm, pn; rect_order(L, 36, 8, pm, pn);
            u.A = A + (size_t)pm * atile; u.B = B + (size_t)pn * btile; u.orow = pm * BM; u.ocol = pn * BM; u.aux = 0; u.nkt = NT; return true; }
        const int vcu = (c & 7) * 32 + (c >> 3);
        if (i == 0) { const int pm = vcu >> 3, pn = vcu & 7; u.A = A + (size_t)pm * atile; u.B = B + (size_t)pn * btile; u.orow = pm * BM; u.ocol = pn * BM; u.aux = 0; u.nkt = NT; return true; }
        if (i == 1) { const int t = vcu >> 3, s = vcu & 7, pm = 32 + (t >> 3), pn = t & 7, nk = NT >> 3;
            u.A = A + (size_t)pm * atile + (size_t)(s * nk) * (BK * 2); u.B = B + (size_t)pn * btile + (size_t)(s * nk) * (BK * 2);
            u.orow = (t >> 3) * BM; u.ocol = pn * BM; u.aux = 1 + s; u.nkt = nk; return true; }
        return false;
    }
};
#define EPI_ROWS_BEGIN _Pragma("unroll") for (int ai = 0; ai < 2; ++ai) _Pragma("unroll") for (int m = 0; m < 4; ++m) { const int rl = ai * HALF + wr * 64 + m * 16 + fr;
#define EPI_ROWS_END }

struct EpiIn {
    static constexpr bool PERM = true, AFTER_DRAIN = false, MIDK = false;
    bf16_t* P1; float* memk; float* memv; bf16_t* KP; bf16_t* VPT;
    __device__ __forceinline__ void operator()(const f32x4 (&acc)[2][2][4][2], const Unit& u, int wr, int wc, int fr, int fq) const {
        const int cl0 = wc * 32 + 8 * fq;
        if (u.aux == 0) {
            const bool gate = u.ocol >= C_GA;
            EPI_ROWS_BEGIN
                bf16_t* rowp = P1 + (size_t)(u.orow + rl) * NIN + u.ocol + cl0;
#pragma unroll
                for (int bj = 0; bj < 2; ++bj) { f32x4 v0 = acc[ai][bj][m][0], v1 = acc[ai][bj][m][1];
                    if (gate) {
                        const f32x4 g0 = acc[ai][1][m][0], g1 = acc[ai][1][m][1];
#pragma unroll
                        for (int e = 0; e < 4; ++e) { const float sb0 = sigmoidf_(g0[e]), sb1 = sigmoidf_(g1[e]);
                            if (bj == 0) { v0[e] = sigmoidf_(v0[e]) * __builtin_amdgcn_rcpf(fmaxf(sb0, 1e-30f)); v1[e] = sigmoidf_(v1[e]) * __builtin_amdgcn_rcpf(fmaxf(sb1, 1e-30f)); }
                            else { v0[e] = fmaxf(sb0, 1e-30f); v1[e] = fmaxf(sb1, 1e-30f); } } }
                    u32x4 w; w.x = cvt_pk_bf16(v0[0], v0[1]); w.y = cvt_pk_bf16(v0[2], v0[3]); w.z = cvt_pk_bf16(v1[0], v1[1]); w.w = cvt_pk_bf16(v1[2], v1[3]);
                    *(u32x4*)(rowp + bj * HALF) = w; }
            EPI_ROWS_END
        } else {
            const bool isV = u.ocol >= DM; const int cb = u.ocol - (isV ? DM : 0) + cl0;
            float* fo = isV ? memv : memk;
            EPI_ROWS_BEGIN
                const int row = u.orow + rl;
#pragma unroll
                for (int bj = 0; bj < 2; ++bj) { const f32x4 v0 = acc[ai][bj][m][0], v1 = acc[ai][bj][m][1]; const int col = cb + bj * HALF;
                    *(f32x4*)(fo + (size_t)row * DM + col) = v0; *(f32x4*)(fo + (size_t)row * DM + col + 4) = v1;
                    u32x4 w; w.x = cvt_pk_bf16(v0[0], v0[1]); w.y = cvt_pk_bf16(v0[2], v0[3]); w.z = cvt_pk_bf16(v1[0], v1[1]); w.w = cvt_pk_bf16(v1[2], v1[3]);
                    if (!isV) { *(u32x4*)(KP + (size_t)row * DM + col) = w; }
                    else { bf16_t* vp = VPT + ((size_t)(row >> 8) * DM + col) * 256 + (row & 255);
                        vp[0 * 256] = (bf16_t)(w.x & 0xffff); vp[1 * 256] = (bf16_t)(w.x >> 16); vp[2 * 256] = (bf16_t)(w.y & 0xffff); vp[3 * 256] = (bf16_t)(w.y >> 16);
                        vp[4 * 256] = (bf16_t)(w.z & 0xffff); vp[5 * 256] = (bf16_t)(w.z >> 16); vp[6 * 256] = (bf16_t)(w.w & 0xffff); vp[7 * 256] = (bf16_t)(w.w >> 16); } }
            EPI_ROWS_END
        }
    }
};
struct EpiSp {
    static constexpr bool PERM = true, AFTER_DRAIN = false, MIDK = false;
    const bf16_t* P1; const float* bsp; bf16_t* YA;
    __device__ __forceinline__ void operator()(const f32x4 (&acc)[2][2][4][2], const Unit& u, int wr, int wc, int fr, int fq) const {
        const int g = u.ocol >> 8, cl0 = wc * 32 + 8 * fq;
#pragma unroll
        for (int ai = 0; ai < 2; ++ai) if (ai == u.aux) {
#pragma unroll
            for (int m = 0; m < 4; ++m) { const int t = wr * 64 + m * 16 + fr; const int row = u.orow + t; const float bs = bsp[g * 128 + t];
#pragma unroll
                for (int bj = 0; bj < 2; ++bj) { const int col = u.ocol + bj * HALF + cl0;
                    const u32x4 uw = *(const u32x4*)(P1 + (size_t)row * NIN + C_U + col); float uf[8]; unpack8(uw, uf);
                    const f32x4 v0 = acc[ai][bj][m][0], v1 = acc[ai][bj][m][1];
                    u32x4 w; w.x = cvt_pk_bf16(uf[0] * (v0[0] + bs), uf[1] * (v0[1] + bs)); w.y = cvt_pk_bf16(uf[2] * (v0[2] + bs), uf[3] * (v0[3] + bs));
                    w.z = cvt_pk_bf16(uf[4] * (v1[0] + bs), uf[5] * (v1[1] + bs)); w.w = cvt_pk_bf16(uf[6] * (v1[2] + bs), uf[7] * (v1[3] + bs));
                    *(u32x4*)(YA + (size_t)row * DM + col) = w; } }
        }
    }
};
struct EpiMerged {
    static constexpr bool PERM = true, AFTER_DRAIN = false, MIDK = true;
    const bf16_t* P1; bf16_t* MRG;
    __device__ __forceinline__ void mid(f32x4 (&acc)[2][2][4][2], const Unit& u, int wr, int wc, int fr, int fq) const {
        asm volatile("" : "+v"(fr), "+v"(fq));
        const bf16_t* pb = P1 + (size_t)(u.orow + wr * 64 + fr) * NIN + C_GA + (u.ocol >> 7) * 256 + wc * 32 + 8 * fq;
#pragma unroll
        for (int ai = 0; ai < 2; ++ai) {
            u32x4 r[4][2];
#pragma unroll
            for (int m = 0; m < 4; ++m)
#pragma unroll
                for (int bj = 0; bj < 2; ++bj) r[m][bj] = *(const u32x4*)(pb + (size_t)(ai * HALF + m * 16) * NIN + bj * 256);
#pragma unroll
            for (int m = 0; m < 4; ++m)
#pragma unroll
                for (int bj = 0; bj < 2; ++bj) { float f[8]; unpack8(r[m][bj], f);
#pragma unroll
                    for (int e = 0; e < 4; ++e) { acc[ai][bj][m][0][e] *= f[e]; acc[ai][bj][m][1][e] *= f[4 + e]; } }
            asm volatile("" ::: "memory");
        }
    }
    __device__ __forceinline__ void operator()(const f32x4 (&acc)[2][2][4][2], const Unit& u, int wr, int wc, int fr, int fq) const {
        const int cl0 = wc * 32 + 8 * fq;
        const bf16_t* pb = P1 + (size_t)(u.orow + wr * 64 + fr) * NIN + C_GA + (u.ocol >> 7) * 256 + 128 + cl0;
        EPI_ROWS_BEGIN
            const int row = u.orow + rl;
#pragma unroll
            for (int bj = 0; bj < 2; ++bj) { const int col = u.ocol + bj * HALF + cl0;
                float sb[8]; unpack8(*(const u32x4*)(pb + (size_t)(ai * HALF + m * 16) * NIN + bj * 256), sb);
                const f32x4 v0 = acc[ai][bj][m][0], v1 = acc[ai][bj][m][1];
                u32x4 w; w.x = cvt_pk_bf16(v0[0] * sb[0], v0[1] * sb[1]); w.y = cvt_pk_bf16(v0[2] * sb[2], v0[3] * sb[3]); w.z = cvt_pk_bf16(v1[0] * sb[4], v1[1] * sb[5]); w.w = cvt_pk_bf16(v1[2] * sb[6], v1[3] * sb[7]);
                *(u32x4*)(MRG + (size_t)row * DM + col) = w; }
        EPI_ROWS_END
    }
};
template <bool RES_F32> struct EpiRes {
    static constexpr bool PERM = true, AFTER_DRAIN = false, MIDK = false;
    const float* resA; const float* resB; int split; const bf16_t* resH; bf16_t* out;
    __device__ __forceinline__ void operator()(const f32x4 (&acc)[2][2][4][2], const Unit& u, int wr, int wc, int fr, int fq) const {
        const float* rbase = (u.orow < split) ? resA + (size_t)u.orow * DM : resB + (size_t)(u.orow - split) * DM;
        const int cl0 = wc * 32 + 8 * fq;
        EPI_ROWS_BEGIN
#pragma unroll
            for (int bj = 0; bj < 2; ++bj) { const size_t off = (size_t)rl * DM + u.ocol + bj * HALF + cl0;
                f32x4 r0, r1;
                if (RES_F32) { r0 = *(const f32x4*)(rbase + off); r1 = *(const f32x4*)(rbase + off + 4); }
                else { float f[8]; unpack8(*(const u32x4*)(resH + (size_t)u.orow * DM + off), f); r0 = (f32x4){f[0], f[1], f[2], f[3]}; r1 = (f32x4){f[4], f[5], f[6], f[7]}; }
                const f32x4 v0 = r0 + acc[ai][bj][m][0], v1 = r1 + acc[ai][bj][m][1];
                u32x4 w; w.x = cvt_pk_bf16(v0[0], v0[1]); w.y = cvt_pk_bf16(v0[2], v0[3]); w.z = cvt_pk_bf16(v1[0], v1[1]); w.w = cvt_pk_bf16(v1[2], v1[3]);
                *(u32x4*)(out + (size_t)u.orow * DM + off) = w; }
        EPI_ROWS_END
    }
};
template <int MODE  > struct EpiBf {
    static constexpr bool PERM = true, AFTER_DRAIN = false, MIDK = false;
    bf16_t* O; int ldc; float scale;
    __device__ __forceinline__ void operator()(const f32x4 (&acc)[2][2][4][2], const Unit& u, int wr, int wc, int fr, int fq) const {
        const int cl0 = wc * 32 + 8 * fq;
        EPI_ROWS_BEGIN
            bf16_t* rowp = O + (size_t)(u.orow + rl) * ldc + u.ocol + cl0;
#pragma unroll
            for (int bj = 0; bj < 2; ++bj) { f32x4 v0 = acc[ai][bj][m][0], v1 = acc[ai][bj][m][1];
                if (MODE == 0) { v0 = v0 * scale; v1 = v1 * scale; }
                else {
#pragma unroll
                    for (int e = 0; e < 4; ++e) { const float a = fmaxf(v0[e], 0.f), b = fmaxf(v1[e], 0.f); v0[e] = a * a; v1[e] = b * b; } }
                u32x4 w; w.x = cvt_pk_bf16(v0[0], v0[1]); w.y = cvt_pk_bf16(v0[2], v0[3]); w.z = cvt_pk_bf16(v1[0], v1[1]); w.w = cvt_pk_bf16(v1[2], v1[3]);
                *(u32x4*)(rowp + bj * HALF) = w; }
        EPI_ROWS_END
    }
};
struct EpiSoftmax {
    static constexpr bool PERM = true, AFTER_DRAIN = true, MIDK = false;
    bf16_t* PS;
    __device__ __forceinline__ void fused(f32x4 (&acc)[2][2][4][2], const Unit& u, int wr, int wc, int fr, int fq, LAS unsigned char* lds, int wid, int lane) const {
        LAS f32x2* X = (LAS f32x2*)lds;
        float mxl[2][4];
        EPI_ROWS_BEGIN
            float mx = -3.0e38f;
#pragma unroll
            for (int bj = 0; bj < 2; ++bj)
#pragma unroll
                for (int n = 0; n < 2; ++n) { const f32x4 v = acc[ai][bj][m][n]; mx = fmaxf(mx, fmaxf(fmaxf(v[0], v[1]), fmaxf(v[2], v[3]))); }
            mx = fmaxf(mx, __shfl_xor(mx, 16)); mx = fmaxf(mx, __shfl_xor(mx, 32));
            float s = 0.f;
#pragma unroll
            for (int bj = 0; bj < 2; ++bj)
#pragma unroll
                for (int n = 0; n < 2; ++n) { f32x4 v = acc[ai][bj][m][n];
#pragma unroll
                    for (int e = 0; e < 4; ++e) { v[e] = __expf(v[e] - mx); s += v[e]; }
                    acc[ai][bj][m][n] = v; }
            s += __shfl_xor(s, 16); s += __shfl_xor(s, 32);
            mxl[ai][m] = mx;
            if (fq == 0) X[rl * 4 + wc] = (f32x2){mx, s};
        EPI_ROWS_END
        LDS_WAIT(); __builtin_amdgcn_s_barrier(); asm volatile("" ::: "memory");
        const int cl0 = wc * 32 + 8 * fq;
        EPI_ROWS_BEGIN
            const f32x2 a = X[rl * 4 + 0], b = X[rl * 4 + 1], c = X[rl * 4 + 2], d = X[rl * 4 + 3];
            const float M = fmaxf(fmaxf(a.x, b.x), fmaxf(c.x, d.x));
            const float L = a.y * __expf(a.x - M) + b.y * __expf(b.x - M) + c.y * __expf(c.x - M) + d.y * __expf(d.x - M);
            const float f = __expf(mxl[ai][m] - M) / L;
            bf16_t* rowp = PS + (size_t)(u.orow + rl) * 256 + cl0;
#pragma unroll
            for (int bj = 0; bj < 2; ++bj) { const f32x4 v0 = acc[ai][bj][m][0] * f, v1 = acc[ai][bj][m][1] * f;
                u32x4 w; w.x = cvt_pk_bf16(v0[0], v0[1]); w.y = cvt_pk_bf16(v0[2], v0[3]); w.z = cvt_pk_bf16(v1[0], v1[1]); w.w = cvt_pk_bf16(v1[2], v1[3]);
                *(u32x4*)(rowp + bj * HALF) = w; }
        EPI_ROWS_END
        LDS_WAIT(); __builtin_amdgcn_s_barrier(); asm volatile("" ::: "memory");
    }
};

template <class Base> struct EpiTail {
    static constexpr bool PERM = Base::PERM, AFTER_DRAIN = false, MIDK = false;
    Base base; bf16_t* part;
    __device__ __forceinline__ void operator()(const f32x4 (&acc)[2][2][4][2], const Unit& u, int wr, int wc, int fr, int fq) const {
        if (u.aux == 0) { base(acc, u, wr, wc, fr, fq); return; }
        bf16_t* pb = part + (size_t)(u.aux - 1) * (MS * DM) + (size_t)u.orow * DM + u.ocol;
        EPI_ROWS_BEGIN
#pragma unroll
            for (int bj = 0; bj < 2; ++bj) {
                if (PERM) { const f32x4 v0 = acc[ai][bj][m][0], v1 = acc[ai][bj][m][1];
                    u32x4 w; w.x = cvt_pk_bf16(v0[0], v0[1]); w.y = cvt_pk_bf16(v0[2], v0[3]); w.z = cvt_pk_bf16(v1[0], v1[1]); w.w = cvt_pk_bf16(v1[2], v1[3]);
                    *(u32x4*)(pb + (size_t)rl * DM + bj * HALF + wc * 32 + 8 * fq) = w; }
                else {
#pragma unroll
                    for (int n = 0; n < 2; ++n) { const f32x4 v = acc[ai][bj][m][n]; u32x2 w; w.x = cvt_pk_bf16(v[0], v[1]); w.y = cvt_pk_bf16(v[2], v[3]);
                        *(u32x2*)(pb + (size_t)rl * DM + bj * HALF + wc * 32 + 16 * n + 4 * fq) = w; } }
            }
        EPI_ROWS_END
    }
};
}


#define XB_TMO      128
#define XB_XCNT(j)  (256  + 64 * (j))
#define XB_XSUB(j)  (1280 + 64 * (j))
#define XB_XGEN(j)  (2304 + 64 * (j))
#define XB_TOP      3328
#define XB_TOPGEN   3392
#define XCD_BAR_WORDS 3456
#define XB_SPIN_CAP (1u << 18)
__device__ __forceinline__ unsigned xb_ld(unsigned* p)              { return __hip_atomic_load(p, __ATOMIC_RELAXED, __HIP_MEMORY_SCOPE_AGENT); }
__device__ __forceinline__ unsigned xb_add(unsigned* p, unsigned v) { return __hip_atomic_fetch_add(p, v, __ATOMIC_RELAXED, __HIP_MEMORY_SCOPE_AGENT); }
__device__ __forceinline__ unsigned xb_xcc_id() { return (unsigned)__builtin_amdgcn_s_getreg((3 << 11) | 20) & 0xFu; }
#define XB_SPIN(cond, bar) do { unsigned _sp = 0; while (cond) { __builtin_amdgcn_s_sleep(1); \
    if ((++_sp & 255u) == 0u) { if (xb_ld(&(bar)[XB_TMO])) break; if (_sp > XB_SPIN_CAP) { atomicAdd(&(bar)[XB_TMO], 1u); break; } } } } while (0)
struct XcdBarrier { unsigned* bar; unsigned x; volatile LAS unsigned* st; };
__device__ __forceinline__ XcdBarrier xcd_barrier_post(unsigned* bar, volatile LAS unsigned* st) {
    XcdBarrier b; b.bar = bar; b.x = xb_xcc_id(); b.st = st;
    if (threadIdx.x == 0) (void)xb_add(&bar[XB_XCNT(b.x)], 1u);
    return b;
}
__device__ __forceinline__ void xcd_barrier_complete(unsigned* bar, unsigned x, unsigned& nloc, unsigned& nx) {
    const unsigned G = gridDim.x * gridDim.y * gridDim.z;
    unsigned sum, cnt, mine, sp = 0u;
    for (;;) {
        sum = 0u; cnt = 0u; mine = 0u;
#pragma unroll
        for (unsigned j = 0; j < 16; ++j) { const unsigned c = xb_ld(&bar[XB_XCNT(j)]); sum += c; cnt += (c > 0u) ? 1u : 0u; mine = (j == x) ? c : mine; }
        if (sum == G) break;
        __builtin_amdgcn_s_sleep(1);
        if ((++sp & 255u) == 0u) { if (xb_ld(&bar[XB_TMO])) break; if (sp > XB_SPIN_CAP) { atomicAdd(&bar[XB_TMO], 1u); break; } }
    }
    nloc = mine > 0u ? mine : 1u; nx = cnt > 0u ? cnt : 1u;
}
__device__ __forceinline__ void xcd_barrier(const XcdBarrier& b) {
    asm volatile("s_waitcnt vmcnt(0)" ::: "memory");
    __syncthreads();
    if (threadIdx.x == 0) {
        unsigned* bar = b.bar;
        __builtin_amdgcn_s_waitcnt(0);
        unsigned nloc = b.st[0], nx = b.st[1];
        if (nloc == 0u) { xcd_barrier_complete(bar, b.x, nloc, nx); b.st[0] = nloc; b.st[1] = nx; }
        const unsigned old = xb_add(&bar[XB_XSUB(b.x)], 1u);
        const unsigned gen = old / nloc;
        if (old + 1u == (gen + 1u) * nloc) {
            __builtin_amdgcn_fence(__ATOMIC_RELEASE, "agent");
            asm volatile("s_waitcnt vmcnt(0)" ::: "memory");
            const unsigned og = xb_add(&bar[XB_TOP], 1u);
            const unsigned tg = og / nx;
            if (og + 1u == (tg + 1u) * nx) xb_add(&bar[XB_TOPGEN], 1u);
            else XB_SPIN(xb_ld(&bar[XB_TOPGEN]) == tg, bar);
            __builtin_amdgcn_fence(__ATOMIC_ACQUIRE, "agent");
            xb_add(&bar[XB_XGEN(b.x)], 1u);
            asm volatile("s_waitcnt vmcnt(0)" ::: "memory");
        } else {
            XB_SPIN(xb_ld(&bar[XB_XGEN(b.x)]) == gen, bar);
            __builtin_amdgcn_fence(__ATOMIC_ACQUIRE, "agent");
            asm volatile("s_waitcnt vmcnt(0)" ::: "memory");
        }
    }
    __syncthreads();
}

struct Args { const float* in[26]; float* out; unsigned char* ws; };

struct Frame {
    LAS unsigned char* lds;
    int tid, lane, wave, G, bx;
    float* out; unsigned char* ws;
};
typedef const float* cfp_t;
__device__ __forceinline__ const float* karg_in(int i) {
    asm volatile("" : "+s"(i));
    const __attribute__((address_space(4))) cfp_t* ka = (const __attribute__((address_space(4))) cfp_t*)__builtin_amdgcn_kernarg_segment_ptr();
    return ka[i];
}
#define IN(i) karg_in(i)
#define WSP(T, off) ((T*)(F.ws + (off)))

__device__ __forceinline__ void p0_transpose_item(const float* W, int K, int N, bf16_t* WT, int row_off, LAS float* scr, int item, int lane, int ldk, int koff) {
    const int nblk = N / 32, kb = item / nblk, nb = item % nblk, k0 = 64 * kb, n0 = 32 * nb;
#pragma unroll 8
    for (int i = 0; i < 32; ++i) { const int kk = 2 * i + (lane >> 5); scr[kk * 33 + (lane & 31)] = W[(size_t)(k0 + kk) * N + n0 + (lane & 31)]; }
    LDS_WAIT(); asm volatile("" ::: "memory");
    const int c = lane & 7;
#pragma unroll
    for (int j = 0; j < 4; ++j) { const int n = (lane >> 3) + 8 * j; const LAS float* s = scr + (8 * c) * 33 + n;
        u32x4 o; o.x = cvt_pk_bf16(s[0 * 33], s[1 * 33]); o.y = cvt_pk_bf16(s[2 * 33], s[3 * 33]); o.z = cvt_pk_bf16(s[4 * 33], s[5 * 33]); o.w = cvt_pk_bf16(s[6 * 33], s[7 * 33]);
        *(u32x4*)(WT + (size_t)(row_off + n0 + n) * ldk + koff + k0 + 8 * c) = o; }
    LDS_WAIT(); asm volatile("" ::: "memory");
}
template <bool OUT_F32> __device__ __forceinline__ void rms_row(const float* xrow, const float* g, void* orow, int lane) {
    const f32x4* xr = (const f32x4*)xrow + lane; f32x4 v[8]; float ss = 0.f;
#pragma unroll
    for (int j = 0; j < 8; ++j) { v[j] = xr[64 * j]; ss += (v[j].x * v[j].x + v[j].y * v[j].y) + (v[j].z * v[j].z + v[j].w * v[j].w); }
    const float r = rsqrtf(wave_sum(ss) * (1.f / DM) + EPS);
    const f32x4* gr = (const f32x4*)g + lane;
#pragma unroll
    for (int j = 0; j < 8; ++j) { const f32x4 gg = gr[64 * j]; const f32x4 o = v[j] * r * gg;
        if (OUT_F32) ((f32x4*)orow)[lane + 64 * j] = o;
        else { u32x2 w; w.x = cvt_pk_bf16(o.x, o.y); w.y = cvt_pk_bf16(o.z, o.w); ((u32x2*)orow)[lane + 64 * j] = w; } }
}

constexpr int I_IN = 32 * 288, I_SQ = 32 * 64, I_BR = 16 * 64, I_UP = 32 * 256, I_DN = 128 * 64;
constexpr int CV_A0 = 0, CV_A1 = I_IN + 2 * I_SQ;
constexpr int CV_B1 = CV_A1 + 3 * I_SQ + 2 * I_BR;
constexpr int CV_C1 = CV_B1 + I_UP;
constexpr int CV_D1 = CV_C1 + I_DN;
__device__ __forceinline__ void convert_one(Frame& F, int it, LAS float* scr) {
    int r = it, K = DM, N = DM, ro = 0, ldk = DM, koff = 0, src_i; size_t wso;
    if (r < I_IN) { src_i = 7; N = NIN; wso = WS_WIN; const int n0 = 32 * (r % 288);
        if (n0 >= C_GB) { const int j = n0 - C_GB; ro = C_GA + (j >> 7) * 256 + 128 + (j & 127) - n0; }
        else if (n0 >= C_GA) { const int j = n0 - C_GA; ro = C_GA + (j >> 7) * 256 + (j & 127) - n0; } }
    else if ((r -= I_IN) < I_SQ) { src_i = 19; wso = WS_WIN; ro = NIN; }
    else if ((r -= I_SQ) < I_SQ) { src_i = 20; wso = WS_WIN; ro = NIN + DM; }
    else if ((r -= I_SQ) < I_SQ) { src_i = 15; wso = WS_WMIX; }
    else if ((r -= I_SQ) < I_SQ) { src_i = 18; wso = WS_WQ; }
    else if ((r -= I_SQ) < I_SQ) { src_i = 21; wso = WS_WXO; }
    else if ((r -= I_SQ) < I_BR) { src_i = 13; wso = WS_WA; K = 1024; }
    else if ((r -= I_BR) < I_BR) { src_i = 14; wso = WS_WA; K = 1024; koff = 1024; }
    else if ((r -= I_BR) < I_UP) { src_i = 23; wso = WS_WUP; N = FF; }
    else { r -= I_UP; src_i = 24; wso = WS_WDN; K = FF; ldk = FF; }
    p0_transpose_item(IN(src_i), K, N, (bf16_t*)(F.ws + wso), ro, scr, r, F.lane, ldk, koff);
}
__device__ __forceinline__ void convert_fill(Frame& F, int i0, int i1, int n_units) {
    const int rounds = (n_units + F.G - 1) / F.G, nfull = n_units - (rounds - 1) * F.G;
    int slot = F.bx - nfull, nslots = F.G - nfull;
    if (nslots == 0) { slot = F.bx; nslots = F.G; }
    if (slot < 0) return;
    LAS float* scr = (LAS float*)(F.lds + F.wave * 16384);
    for (int it = i0 + slot * NWAVES + F.wave; it < i1; it += nslots * NWAVES) convert_one(F, it, scr);
}
template <int R> __device__ __forceinline__ void ln_stats(const bf16_t* p, size_t rstride, float (&mean)[R], float (&rstd)[R], float (&lo)[R][8], float (&hi)[R][8]) {
#pragma unroll
    for (int r = 0; r < R; ++r) { unpack8(*(const u32x4*)(p + r * rstride), lo[r]); unpack8(*(const u32x4*)(p + r * rstride + 512), hi[r]); }
    float s[R];
#pragma unroll
    for (int r = 0; r < R; ++r) { s[r] = 0.f;
#pragma unroll
        for (int e = 0; e < 8; ++e) s[r] += lo[r][e] + hi[r][e]; }
#pragma unroll
    for (int o = 1; o < 64; o <<= 1)
#pragma unroll
        for (int r = 0; r < R; ++r) s[r] += __shfl_xor(s[r], o);
#pragma unroll
    for (int r = 0; r < R; ++r) { mean[r] = s[r] * (1.f / 1024.f); s[r] = 0.f;
#pragma unroll
        for (int e = 0; e < 8; ++e) { const float d0 = lo[r][e] - mean[r], d1 = hi[r][e] - mean[r]; s[r] += d0 * d0 + d1 * d1; } }
#pragma unroll
    for (int o = 1; o < 64; o <<= 1)
#pragma unroll
        for (int r = 0; r < R; ++r) s[r] += __shfl_xor(s[r], o);
#pragma unroll
    for (int r = 0; r < R; ++r) rstd[r] = rsqrtf(s[r] * (1.f / 1024.f) + EPS);
}
template <bool OUT_F32> __device__ __forceinline__ void rms_rows2(const float* x0, const float* g0, void* o0, const float* x1, const float* g1, void* o1, int lane) {
    const f32x4* xr0 = (const f32x4*)x0 + lane; const f32x4* xr1 = (const f32x4*)x1 + lane; f32x4 v0[8], v1[8]; float s0 = 0.f, s1 = 0.f;
#pragma unroll
    for (int j = 0; j < 8; ++j) { v0[j] = xr0[64 * j]; v1[j] = xr1[64 * j]; }
#pragma unroll
    for (int j = 0; j < 8; ++j) { s0 += (v0[j].x * v0[j].x + v0[j].y * v0[j].y) + (v0[j].z * v0[j].z + v0[j].w * v0[j].w); s1 += (v1[j].x * v1[j].x + v1[j].y * v1[j].y) + (v1[j].z * v1[j].z + v1[j].w * v1[j].w); }
#pragma unroll
    for (int o = 1; o < 64; o <<= 1) { s0 += __shfl_xor(s0, o); s1 += __shfl_xor(s1, o); }
    const float r0 = rsqrtf(s0 * (1.f / DM) + EPS), r1 = rsqrtf(s1 * (1.f / DM) + EPS);
    const f32x4* gr0 = (const f32x4*)g0 + lane; const f32x4* gr1 = (const f32x4*)g1 + lane;
#pragma unroll
    for (int j = 0; j < 8; ++j) { const f32x4 a = v0[j] * r0 * gr0[64 * j], b = v1[j] * r1 * gr1[64 * j];
        if (OUT_F32) { ((f32x4*)o0)[lane + 64 * j] = a; ((f32x4*)o1)[lane + 64 * j] = b; }
        else { u32x2 w; w.x = cvt_pk_bf16(a.x, a.y); w.y = cvt_pk_bf16(a.z, a.w); ((u32x2*)o0)[lane + 64 * j] = w; w.x = cvt_pk_bf16(b.x, b.y); w.y = cvt_pk_bf16(b.z, b.w); ((u32x2*)o1)[lane + 64 * j] = w; } }
}
__device__ __forceinline__ void phase_prologue(Frame& F) {
    LAS float* scr = (LAS float*)(F.lds + F.wave * 16384);
    const int gw = F.bx * NWAVES + F.wave, NGW = F.G * NWAVES;
    for (int it = CV_A0 + gw; it < CV_A1; it += NGW) convert_one(F, it, scr);
    bf16_t* XN = WSP(bf16_t, WS_XN);
    { const float* xp = IN(0); const float* xs = IN(1); const float* xm = IN(5); const float* gx = IN(6); const float* gm = IN(17);
      for (int m = gw; m < MT + 1024; m += 2 * NGW) {
        const int m2 = m + NGW;
        const float* s0 = m < MP ? xp + (size_t)m * DM : (m < MT ? xs + (size_t)(m - MP) * DM : xm + (size_t)(m - MT) * DM);
        if (m2 < MT + 1024) { const float* s1 = m2 < MP ? xp + (size_t)m2 * DM : (m2 < MT ? xs + (size_t)(m2 - MP) * DM : xm + (size_t)(m2 - MT) * DM);
            rms_rows2<false>(s0, m < MT ? gx : gm, XN + (size_t)m * DM, s1, m2 < MT ? gx : gm, XN + (size_t)m2 * DM, F.lane); }
        else rms_row<false>(s0, m < MT ? gx : gm, XN + (size_t)m * DM, F.lane);
      } }
    bf16_t* WS = WSP(bf16_t, WS_WSP);
    for (int i = F.bx * 512 + F.tid; i < 4 * 128 * 128; i += F.G * 512) { const int t = (i >> 7) & 127, s = i & 127; const float w = (s <= t) ? IN(10)[i] : 0.f; WS[i] = (bf16_t)(cvt_pk_bf16(w, 0.f) & 0xffff); }
}

__device__ __forceinline__ void phase_mixprep(Frame& F) {
    const bf16_t* P1 = WSP(bf16_t, WS_P1);
    {
        bf16_t* YB = WSP(bf16_t, WS_YA);   const float* cw = IN(12); const float* st = IN(2);
        for (int it = F.bx * 512 + F.tid; it < MT * 128; it += F.G * 512) {
            const int row = it >> 7, c0 = (it & 127) * 8;
            const bf16_t* pr = P1 + (size_t)row * NIN;
            float cg[8], xi[8], p0[8], p1[8], p2[8], bg[8];
            unpack8(*(const u32x4*)(pr + C_CG + c0), cg); unpack8(*(const u32x4*)(pr + C_XIN + c0), xi); unpack8(*(const u32x4*)(pr + C_BG + c0), bg);
#pragma unroll
            for (int e = 0; e < 8; ++e) p0[e] = cg[e] * xi[e];
            int pos, b; const bool prompt = row < MP;
            if (prompt) { pos = row & 2047; b = row >> 11; } else { pos = (row - MP) & 7; b = (row - MP) >> 3; }
            if (pos >= 1) { unpack8(*(const u32x4*)(pr - NIN + C_CG + c0), cg); unpack8(*(const u32x4*)(pr - NIN + C_XIN + c0), xi);
#pragma unroll
                for (int e = 0; e < 8; ++e) p1[e] = cg[e] * xi[e]; }
            else if (prompt) {
#pragma unroll
                for (int e = 0; e < 8; ++e) p1[e] = 0.f; }
            else { const f32x4 a = *(const f32x4*)(st + ((size_t)b * 2 + 1) * 1024 + c0), c = *(const f32x4*)(st + ((size_t)b * 2 + 1) * 1024 + c0 + 4);
                p1[0] = a.x; p1[1] = a.y; p1[2] = a.z; p1[3] = a.w; p1[4] = c.x; p1[5] = c.y; p1[6] = c.z; p1[7] = c.w; }
            if (pos >= 2) { unpack8(*(const u32x4*)(pr - 2 * NIN + C_CG + c0), cg); unpack8(*(const u32x4*)(pr - 2 * NIN + C_XIN + c0), xi);
#pragma unroll
                for (int e = 0; e < 8; ++e) p2[e] = cg[e] * xi[e]; }
            else if (prompt) {
#pragma unroll
                for (int e = 0; e < 8; ++e) p2[e] = 0.f; }
            else { const int sr = (pos == 1) ? 1 : 0; const f32x4 a = *(const f32x4*)(st + ((size_t)b * 2 + sr) * 1024 + c0), c = *(const f32x4*)(st + ((size_t)b * 2 + sr) * 1024 + c0 + 4);
                p2[0] = a.x; p2[1] = a.y; p2[2] = a.z; p2[3] = a.w; p2[4] = c.x; p2[5] = c.y; p2[6] = c.z; p2[7] = c.w; }
            float y[8];
#pragma unroll
            for (int e = 0; e < 8; ++e) y[e] = bg[e] * (cw[c0 + e] * p2[e] + cw[1024 + c0 + e] * p1[e] + cw[2048 + c0 + e] * p0[e]);
            u32x4 w; w.x = cvt_pk_bf16(y[0], y[1]); w.y = cvt_pk_bf16(y[2], y[3]); w.z = cvt_pk_bf16(y[4], y[5]); w.w = cvt_pk_bf16(y[6], y[7]);
            *(u32x4*)(YB + (size_t)row * DM + 1024 + c0) = w;
            const int tail = prompt ? 2046 : 6;
            if (pos >= tail) { float* o = F.out + (prompt ? O_CP : O_CS) + ((size_t)b * 2 + (pos - tail)) * 1024 + c0;
                *(f32x4*)o = (f32x4){p0[0], p0[1], p0[2], p0[3]}; *(f32x4*)(o + 4) = (f32x4){p0[4], p0[5], p0[6], p0[7]}; }
        }
    }
    {
        const float* lg = IN(8); const float* lb = IN(9); const float* wsp = IN(10); const float* bsp = IN(11);
        bf16_t* YA = WSP(bf16_t, WS_YA);
        const int gw = F.bx * NWAVES + F.wave, NGW = F.G * NWAVES;
        for (int item = gw; item < 256; item += NGW) {
            const int sq = item >> 1, jsel = item & 1;
            const int row0 = MP + sq * 8;
            float mu[8], rs[8];
            { float m4[4], r4[4], vlo[4][8], vhi[4][8];
              ln_stats<4>(P1 + (size_t)row0 * NIN + C_V + 8 * F.lane, NIN, m4, r4, vlo, vhi);
#pragma unroll
              for (int t = 0; t < 4; ++t) { mu[t] = m4[t]; rs[t] = r4[t]; }
              ln_stats<4>(P1 + (size_t)(row0 + 4) * NIN + C_V + 8 * F.lane, NIN, m4, r4, vlo, vhi);
#pragma unroll
              for (int t = 0; t < 4; ++t) { mu[4 + t] = m4[t]; rs[4 + t] = r4[t]; } }
            {
                const int j = jsel; const int c0 = 8 * F.lane + 512 * j, g = c0 >> 8;
                float gg[8], bb[8];
                { const f32x4 a = *(const f32x4*)(lg + c0), b = *(const f32x4*)(lg + c0 + 4), c = *(const f32x4*)(lb + c0), d = *(const f32x4*)(lb + c0 + 4);
                  gg[0] = a.x; gg[1] = a.y; gg[2] = a.z; gg[3] = a.w; gg[4] = b.x; gg[5] = b.y; gg[6] = b.z; gg[7] = b.w;
                  bb[0] = c.x; bb[1] = c.y; bb[2] = c.z; bb[3] = c.w; bb[4] = d.x; bb[5] = d.y; bb[6] = d.z; bb[7] = d.w; }
                float vl[8][8];
#pragma unroll
                for (int t = 0; t < 8; ++t) {
                    float a[8]; unpack8(*(const u32x4*)(P1 + (size_t)(row0 + t) * NIN + C_V + c0), a);
#pragma unroll
                    for (int e = 0; e < 8; ++e) vl[t][e] = (a[e] - mu[t]) * rs[t] * gg[e] + bb[e];
                    float* o = F.out + O_CV + (size_t)(sq * 8 + t) * 1024 + c0;
                    *(f32x4*)o = (f32x4){vl[t][0], vl[t][1], vl[t][2], vl[t][3]}; *(f32x4*)(o + 4) = (f32x4){vl[t][4], vl[t][5], vl[t][6], vl[t][7]};
                }
#pragma unroll
                for (int t = 0; t < 8; ++t) {
                    float z[8]; const float bs = bsp[g * 128 + t];
#pragma unroll
                    for (int e = 0; e < 8; ++e) z[e] = bs;
#pragma unroll
                    for (int s = 0; s < 8; ++s) if (s <= t) { const float w = wsp[(size_t)g * 16384 + t * 128 + s];
#pragma unroll
                        for (int e = 0; e < 8; ++e) z[e] += w * vl[s][e]; }
                    float uf[8]; unpack8(*(const u32x4*)(P1 + (size_t)(row0 + t) * NIN + C_U + c0), uf);
                    u32x4 w; w.x = cvt_pk_bf16(uf[0] * z[0], uf[1] * z[1]); w.y = cvt_pk_bf16(uf[2] * z[2], uf[3] * z[3]); w.z = cvt_pk_bf16(uf[4] * z[4], uf[5] * z[5]); w.w = cvt_pk_bf16(uf[6] * z[6], uf[7] * z[7]);
                    *(u32x4*)(YA + (size_t)(row0 + t) * DM + c0) = w;
                }
            }
        }
    }
    {
        const float* lg = IN(8); const float* lb = IN(9);
        bf16_t* VT = WSP(bf16_t, WS_VT);
        LAS bf16_t* T = (LAS bf16_t*)F.lds;
        for (int un = F.bx; un < 256; un += F.G) {
            const int chunk = un >> 2, g = un & 3;
            const bool mine = ((F.lane >> 5) == (g & 1));
            const int cm = 256 * g + 8 * (F.lane & 31);
            float gg[8], bb[8];
            { const f32x4 a = *(const f32x4*)(lg + cm), b = *(const f32x4*)(lg + cm + 4), c = *(const f32x4*)(lb + cm), d = *(const f32x4*)(lb + cm + 4);
              gg[0] = a.x; gg[1] = a.y; gg[2] = a.z; gg[3] = a.w; gg[4] = b.x; gg[5] = b.y; gg[6] = b.z; gg[7] = b.w;
              bb[0] = c.x; bb[1] = c.y; bb[2] = c.z; bb[3] = c.w; bb[4] = d.x; bb[5] = d.y; bb[6] = d.z; bb[7] = d.w; }
            for (int rr = 0; rr < 16; rr += 4) {
                const int s0 = F.wave * 16 + rr;
                float mean[4], rstd[4], vlo[4][8], vhi[4][8];
                ln_stats<4>(P1 + (size_t)(chunk * 128 + s0) * NIN + C_V + 8 * F.lane, NIN, mean, rstd, vlo, vhi);
                if (mine) {
#pragma unroll
                    for (int r = 0; r < 4; ++r) {
                        float y[8];
#pragma unroll
                        for (int e = 0; e < 8; ++e) { const float xl = vlo[r][e], xh = vhi[r][e]; const float x = (g >> 1) ? xh : xl; y[e] = (x - mean[r]) * rstd[r] * gg[e] + bb[e]; }
                        u32x4 w; w.x = cvt_pk_bf16(y[0], y[1]); w.y = cvt_pk_bf16(y[2], y[3]); w.z = cvt_pk_bf16(y[4], y[5]); w.w = cvt_pk_bf16(y[6], y[7]);
                        *(LAS u32x4*)(T + (s0 + r) * 264 + 8 * (F.lane & 31)) = w;
                    }
                }
            }
            __syncthreads();
#pragma unroll 2
            for (int itn = 0; itn < 8; ++itn) {
                const int idx = itn * 512 + F.tid, c = idx >> 4, sb = idx & 15;
                unsigned short h[8];
#pragma unroll
                for (int i = 0; i < 8; ++i) h[i] = T[(8 * sb + i) * 264 + c];
                u32x4 w; w.x = (unsigned)h[0] | ((unsigned)h[1] << 16); w.y = (unsigned)h[2] | ((unsigned)h[3] << 16); w.z = (unsigned)h[4] | ((unsigned)h[5] << 16); w.w = (unsigned)h[6] | ((unsigned)h[7] << 16);
                *(u32x4*)(VT + ((size_t)chunk * 1024 + g * 256 + c) * 128 + 8 * sb) = w;
            }
            __syncthreads();
        }
    }
}

__device__ __forceinline__ void sample_attn_unit(Frame& F, int unit, bool tail) {
    const int b = unit >> 2, h = unit & 3, lane = F.lane, wave = F.wave, r16 = lane & 15, kq = lane >> 4;
    const float* Kb = IN(3) + ((size_t)b * NMEM * XH + h) * XD;
    const float* Vb = IN(4) + ((size_t)b * NMEM * XH + h) * XD;
    const bf16_t* Qb = WSP(bf16_t, WS_Q) + (size_t)(MP + b * 8) * DM + h * XD;
    LAS bf16_t* sP = (LAS bf16_t*)F.lds;
    LAS float* sSt = (LAS float*)(F.lds + 16 * 528);
    LAS bf16_t* sQ = (LAS bf16_t*)(F.lds + 9472);
    if (tail) {
        const int t = F.tid >> 6, d0 = (F.tid & 63) * 8;
        const bf16_t* pp = WSP(bf16_t, WS_PART) + (size_t)(b * 8 + t) * DM + h * XD + d0;
        f32x4 a0 = {0.f, 0.f, 0.f, 0.f}, a1 = {0.f, 0.f, 0.f, 0.f};
#pragma unroll
        for (int s = 0; s < 8; ++s) { float f[8]; unpack8(*(const u32x4*)(pp + (size_t)s * (MS * DM)), f); a0 = a0 + (f32x4){f[0], f[1], f[2], f[3]}; a1 = a1 + (f32x4){f[4], f[5], f[6], f[7]}; }
        a0 = a0 * QSCALE; a1 = a1 * QSCALE;
        *(LAS bf16x8*)(sQ + t * 520 + d0) = pack8(a0, a1);
        __syncthreads();
    }
    f32x4 s0 = {0.f, 0.f, 0.f, 0.f}, s1 = {0.f, 0.f, 0.f, 0.f};
    const float* k0p = Kb + (size_t)(32 * wave + r16) * (XH * XD) + kq * 8;
    const float* k1p = k0p + (size_t)16 * (XH * XD);
    const bf16_t* qp = Qb + (size_t)(r16 & 7) * DM + kq * 8;
#pragma unroll 4
    for (int ds = 0; ds < 16; ++ds) {
        const f32x4 a0 = *(const f32x4*)(k0p + ds * 32), a1 = *(const f32x4*)(k0p + ds * 32 + 4);
        const f32x4 c0 = *(const f32x4*)(k1p + ds * 32), c1 = *(const f32x4*)(k1p + ds * 32 + 4);
        u32x4 qw = tail ? *(const LAS u32x4*)(sQ + (r16 & 7) * 520 + kq * 8 + ds * 32) : *(const u32x4*)(qp + ds * 32); if (r16 >= 8) qw = (u32x4){0u, 0u, 0u, 0u};
        const bf16x8 qf = __builtin_bit_cast(bf16x8, qw);
        s0 = __builtin_amdgcn_mfma_f32_16x16x32_bf16(pack8(a0, a1), qf, s0, 0, 0, 0);
        s1 = __builtin_amdgcn_mfma_f32_16x16x32_bf16(pack8(c0, c1), qf, s1, 0, 0, 0);
    }
    float mx = fmaxf(fmaxf(fmaxf(s0[0], s0[1]), fmaxf(s0[2], s0[3])), fmaxf(fmaxf(s1[0], s1[1]), fmaxf(s1[2], s1[3])));
    mx = fmaxf(mx, __shfl_xor(mx, 16)); mx = fmaxf(mx, __shfl_xor(mx, 32));
    float sm = 0.f;
#pragma unroll
    for (int j = 0; j < 4; ++j) { s0[j] = __expf(s0[j] - mx); s1[j] = __expf(s1[j] - mx); sm += s0[j] + s1[j]; }
    sm += __shfl_xor(sm, 16); sm += __shfl_xor(sm, 32);
    if (kq == 0) { sSt[(wave * 16 + r16) * 2] = mx; sSt[(wave * 16 + r16) * 2 + 1] = sm; }
    __syncthreads();
    float M = -3.0e38f;
#pragma unroll
    for (int w2 = 0; w2 < 8; ++w2) M = fmaxf(M, sSt[(w2 * 16 + r16) * 2]);
    float L = 0.f;
#pragma unroll
    for (int w2 = 0; w2 < 8; ++w2) L += sSt[(w2 * 16 + r16) * 2 + 1] * __expf(sSt[(w2 * 16 + r16) * 2] - M);
    const float f = __expf(mx - M) / L;
    { u32x2 w; w.x = cvt_pk_bf16(s0[0] * f, s0[1] * f); w.y = cvt_pk_bf16(s0[2] * f, s0[3] * f); *(LAS u32x2*)(sP + r16 * 264 + 32 * wave + 4 * kq) = w;
      w.x = cvt_pk_bf16(s1[0] * f, s1[1] * f); w.y = cvt_pk_bf16(s1[2] * f, s1[3] * f); *(LAS u32x2*)(sP + r16 * 264 + 32 * wave + 16 + 4 * kq) = w; }
    __syncthreads();
    f32x4 o[4];
#pragma unroll
    for (int c = 0; c < 4; ++c) o[c] = (f32x4){0.f, 0.f, 0.f, 0.f};
    const float* vp = Vb + (size_t)(kq * 8) * (XH * XD) + 64 * wave + 4 * r16;
#pragma unroll 2
    for (int ms = 0; ms < 8; ++ms) {
        const bf16x8 pf = *(const LAS bf16x8*)(sP + r16 * 264 + ms * 32 + kq * 8);
        f32x4 x[8];
#pragma unroll
        for (int j = 0; j < 8; ++j) x[j] = *(const f32x4*)(vp + (size_t)(ms * 32 + j) * (XH * XD));
#pragma unroll
        for (int c = 0; c < 4; ++c) {
            const bf16x8 a = pack8((f32x4){x[0][c], x[1][c], x[2][c], x[3][c]}, (f32x4){x[4][c], x[5][c], x[6][c], x[7][c]});
            o[c] = __builtin_amdgcn_mfma_f32_16x16x32_bf16(a, pf, o[c], 0, 0, 0);
        }
    }
    if (r16 < 8) {
        bf16_t* op = WSP(bf16_t, WS_O) + (size_t)(MP + b * 8 + r16) * DM + h * XD + 64 * wave + 16 * kq;
        u32x4 w0, w1;
        w0.x = cvt_pk_bf16(o[0][0], o[1][0]); w0.y = cvt_pk_bf16(o[2][0], o[3][0]); w0.z = cvt_pk_bf16(o[0][1], o[1][1]); w0.w = cvt_pk_bf16(o[2][1], o[3][1]);
        w1.x = cvt_pk_bf16(o[0][2], o[1][2]); w1.y = cvt_pk_bf16(o[2][2], o[3][2]); w1.z = cvt_pk_bf16(o[0][3], o[1][3]); w1.w = cvt_pk_bf16(o[2][3], o[3][3]);
        *(u32x4*)op = w0; *(u32x4*)(op + 8) = w1;
    }
    __syncthreads();
}

template <bool OUT_F32> __device__ __forceinline__ void rms_store(const float (&v)[4][8], float r, const float* g, void* orow, int lane) {
#pragma unroll
    for (int j = 0; j < 4; ++j) { const int c = 8 * lane + 512 * j; const f32x4 g0 = *(const f32x4*)(g + c), g1 = *(const f32x4*)(g + c + 4);
        const f32x4 a = (f32x4){v[j][0], v[j][1], v[j][2], v[j][3]} * r * g0, b = (f32x4){v[j][4], v[j][5], v[j][6], v[j][7]} * r * g1;
        if (OUT_F32) { *(f32x4*)((float*)orow + c) = a; *(f32x4*)((float*)orow + c + 4) = b; }
        else { u32x4 w; w.x = cvt_pk_bf16(a.x, a.y); w.y = cvt_pk_bf16(a.z, a.w); w.z = cvt_pk_bf16(b.x, b.y); w.w = cvt_pk_bf16(b.z, b.w); *(u32x4*)((bf16_t*)orow + c) = w; } }
}
template <bool OUT_F32> __device__ __forceinline__ void phase_rms(Frame& F, const bf16_t* src, const float* g, void* dst, const bf16_t* part, const float* sbaseF, const bf16_t* sbaseH, bf16_t* hout) {
    const int gw = F.bx * NWAVES + F.wave, NGW = F.G * NWAVES, lane = F.lane;
    for (int mm = gw; mm < MT; mm += 2 * NGW) {
      const int m2 = mm + NGW; const bool reg0 = (mm < MP || part == nullptr), reg1 = (m2 < MT) && (m2 < MP || part == nullptr);
      if (reg0 && reg1) {
        float v0[4][8], v1[4][8]; float s0 = 0.f, s1 = 0.f;
#pragma unroll
        for (int j = 0; j < 4; ++j) { unpack8(*(const u32x4*)(src + (size_t)mm * DM + 8 * lane + 512 * j), v0[j]); unpack8(*(const u32x4*)(src + (size_t)m2 * DM + 8 * lane + 512 * j), v1[j]); }
#pragma unroll
        for (int j = 0; j < 4; ++j)
#pragma unroll
            for (int e = 0; e < 8; ++e) { s0 += v0[j][e] * v0[j][e]; s1 += v1[j][e] * v1[j][e]; }
#pragma unroll
        for (int o = 1; o < 64; o <<= 1) { s0 += __shfl_xor(s0, o); s1 += __shfl_xor(s1, o); }
        rms_store<OUT_F32>(v0, rsqrtf(s0 * (1.f / DM) + EPS), g, OUT_F32 ? (void*)((float*)dst + (size_t)mm * DM) : (void*)((bf16_t*)dst + (size_t)mm * DM), lane);
        rms_store<OUT_F32>(v1, rsqrtf(s1 * (1.f / DM) + EPS), g, OUT_F32 ? (void*)((float*)dst + (size_t)m2 * DM) : (void*)((bf16_t*)dst + (size_t)m2 * DM), lane);
        continue;
      }
      for (int m = mm; m <= m2 && m < MT; m += NGW) {
        void* orow = OUT_F32 ? (void*)((float*)dst + (size_t)m * DM) : (void*)((bf16_t*)dst + (size_t)m * DM);
        float v[4][8]; float ss = 0.f;
        if (m < MP || part == nullptr) {
#pragma unroll
            for (int j = 0; j < 4; ++j) unpack8(*(const u32x4*)(src + (size_t)m * DM + 8 * lane + 512 * j), v[j]);
        } else {
            const int ms = m - MP;
#pragma unroll
            for (int j = 0; j < 4; ++j) { const int c = 8 * lane + 512 * j;
                if (sbaseF) { const f32x4 a = *(const f32x4*)(sbaseF + (size_t)ms * DM + c), b = *(const f32x4*)(sbaseF + (size_t)ms * DM + c + 4);
                    v[j][0] = a.x; v[j][1] = a.y; v[j][2] = a.z; v[j][3] = a.w; v[j][4] = b.x; v[j][5] = b.y; v[j][6] = b.z; v[j][7] = b.w; }
                else unpack8(*(const u32x4*)(sbaseH + (size_t)ms * DM + c), v[j]); }
#pragma unroll
            for (int s = 0; s < 8; ++s)
#pragma unroll
                for (int j = 0; j < 4; ++j) { float f[8]; unpack8(*(const u32x4*)(part + (size_t)s * (MS * DM) + (size_t)ms * DM + 8 * lane + 512 * j), f);
#pragma unroll
                    for (int e = 0; e < 8; ++e) v[j][e] += f[e]; }
            if (hout) {
#pragma unroll
                for (int j = 0; j < 4; ++j) { u32x4 w; w.x = cvt_pk_bf16(v[j][0], v[j][1]); w.y = cvt_pk_bf16(v[j][2], v[j][3]); w.z = cvt_pk_bf16(v[j][4], v[j][5]); w.w = cvt_pk_bf16(v[j][6], v[j][7]);
                    *(u32x4*)(hout + (size_t)ms * DM + 8 * lane + 512 * j) = w;
                    unpack8(w, v[j]); }
            }
        }
#pragma unroll
        for (int j = 0; j < 4; ++j)
#pragma unroll
            for (int e = 0; e < 8; ++e) ss += v[j][e] * v[j][e];
        rms_store<OUT_F32>(v, rsqrtf(wave_sum(ss) * (1.f / DM) + EPS), g, orow, lane);
      }
    }
}

__global__ void __launch_bounds__(NWAVES * 64, 2) fwd_megakernel(Args args) {
    extern __shared__ __attribute__((aligned(16))) unsigned char lds_raw[];
    cg::grid_group grid = cg::this_grid();
    Frame F;
    F.lds = (LAS unsigned char*)lds_raw;
    F.tid = threadIdx.x; F.lane = F.tid & 63; F.wave = __builtin_amdgcn_readfirstlane(F.tid >> 6);
    F.G = gridDim.x; F.bx = blockIdx.x;
    F.out = args.out; F.ws = args.ws;
    volatile LAS unsigned* MISC = (volatile LAS unsigned*)(F.lds + 131072 + 320);
    if (F.tid < 32) MISC[F.tid] = 0u;
    __syncthreads();
    XcdBarrier xbar = xcd_barrier_post((unsigned*)(F.ws + WS_CTL) + 4096, MISC + 8);
#define SEAM0() do { grid.sync(); int t_ = threadIdx.x; asm volatile("" : "+v"(t_)); F.tid = t_; F.lane = t_ & 63; } while (0)
#define SEAM() do { xcd_barrier(xbar); int t_ = threadIdx.x; asm volatile("" : "+v"(t_)); F.tid = t_; F.lane = t_ & 63; { unsigned char* w_ = F.ws; float* o_ = F.out; asm volatile("" : "+s"(w_), "+s"(o_)); F.ws = w_; F.out = o_; } } while (0)
#ifndef PHASE_MASK
#define PHASE_MASK 0xffffffffu
#endif
#define PH(k) ((PHASE_MASK >> (k)) & 1u)
    using namespace pg8;
    const char* XN = (const char*)(F.ws + WS_XN);
    const bool tail = (F.G == 256);

    if (PH(0)) phase_prologue(F);
    if (F.G > (1 << 24)) SEAM0();
    SEAM();
    if (PH(1)) {
        SchedIn S{XN, (const char*)(F.ws + WS_WIN), F.G, F.bx};
        EpiIn E{WSP(bf16_t, WS_P1), F.out + O_MK, F.out + O_MV, WSP(bf16_t, WS_KP), WSP(bf16_t, WS_VPT)};
        gemm_phase<EpiIn, SchedIn, true>(F.lds, DM, DM, S, E);
        convert_fill(F, CV_A1, CV_B1, 1296 + 64);
    }
    SEAM();
    if (PH(2)) phase_mixprep(F);
    asm volatile("s_waitcnt vmcnt(0)" ::: "memory"); __syncthreads();
    { int t_ = threadIdx.x; asm volatile("" : "+v"(t_)); F.tid = t_; F.lane = t_ & 63; }
    if (PH(3)) {
        SchedSp S{(const char*)(F.ws + WS_WSP), (const char*)(F.ws + WS_VT), F.G, F.bx};
        EpiSp E{WSP(bf16_t, WS_P1), IN(11), WSP(bf16_t, WS_YA)};
        gemm_phase<EpiSp, SchedSp, true>(F.lds, 128, 128, S, E);
    }
    SEAM();
    if (PH(4)) {
        SchedRect S{(const char*)(F.ws + WS_YA), (const char*)(F.ws + WS_WA), (size_t)BM * DM * 2, (size_t)BM * DM * 2, 36, 8, F.G, F.bx, 32};
        EpiMerged E{WSP(bf16_t, WS_P1), WSP(bf16_t, WS_MRG)};
        gemm_phase<EpiMerged, SchedRect, true>(F.lds, DM, DM, S, E);
        convert_fill(F, CV_B1, CV_C1, 288);
    }
    SEAM();
    if (PH(6)) {
        SchedTail S{(const char*)(F.ws + WS_MRG), (const char*)(F.ws + WS_WMIX), (size_t)BM * DM * 2, (size_t)BM * DM * 2, 32, F.G, F.bx, tail};
        EpiTail<EpiRes<true>> E{{IN(0), IN(1), MP, nullptr, WSP(bf16_t, WS_H1)}, WSP(bf16_t, WS_PART)};
        gemm_phase<EpiTail<EpiRes<true>>, SchedTail, true>(F.lds, DM, DM, S, E);
    }
    SEAM();
    phase_rms<false>(F, WSP(bf16_t, WS_H1), IN(16), WSP(bf16_t, WS_XN), tail ? WSP(bf16_t, WS_PART) : nullptr, IN(1), nullptr, WSP(bf16_t, WS_H1) + (size_t)MP * DM);
    SEAM();
    if (PH(7)) {
        SchedTail S{XN, (const char*)(F.ws + WS_WQ), (size_t)BM * DM * 2, (size_t)BM * DM * 2, 32, F.G, F.bx, tail};
        EpiTail<EpiBf<0>> E{{WSP(bf16_t, WS_Q), DM, QSCALE}, WSP(bf16_t, WS_PART)};
        gemm_phase<EpiTail<EpiBf<0>>, SchedTail, true>(F.lds, DM, DM, S, E);
    }
    SEAM();
    if (PH(8)) {
        {
            SchedS S{(const char*)(F.ws + WS_Q), (const char*)(F.ws + WS_KP), F.G, F.bx};
            EpiSoftmax E{WSP(bf16_t, WS_PS)};
            gemm_phase<EpiSoftmax, SchedS, false>(F.lds, DM, DM, S, E);
        }
        asm volatile("s_waitcnt vmcnt(0)" ::: "memory"); __syncthreads();
        {
            SchedO S{(const char*)(F.ws + WS_PS), (const char*)(F.ws + WS_VPT), F.G, F.bx};
            EpiBf<0> E{WSP(bf16_t, WS_O), DM, 1.0f};
            gemm_phase<EpiBf<0>, SchedO, true>(F.lds, 256, 256, S, E);
        }
        __syncthreads();
        unsigned* qhead = (unsigned*)(F.ws + WS_CTL) + 2048;
        for (;;) {
            if (F.tid == 0) MISC[16] = __hip_atomic_fetch_add(qhead, 1u, __ATOMIC_RELAXED, __HIP_MEMORY_SCOPE_AGENT);
            __syncthreads();
            const int un = (int)MISC[16];
            if (un >= 512) break;
            sample_attn_unit(F, un, tail);
        }
    }
    SEAM();
    if (PH(10)) {
        SchedTail S{(const char*)(F.ws + WS_O), (const char*)(F.ws + WS_WXO), (size_t)BM * DM * 2, (size_t)BM * DM * 2, 32, F.G, F.bx, tail};
        EpiTail<EpiRes<false>> E{{nullptr, nullptr, 1 << 30, WSP(bf16_t, WS_H1), WSP(bf16_t, WS_H2)}, WSP(bf16_t, WS_PART)};
        gemm_phase<EpiTail<EpiRes<false>>, SchedTail, true>(F.lds, DM, DM, S, E);
    }
    SEAM();
    phase_rms<false>(F, WSP(bf16_t, WS_H2), IN(22), WSP(bf16_t, WS_XN), tail ? WSP(bf16_t, WS_PART) : nullptr, nullptr, WSP(bf16_t, WS_H1) + (size_t)MP * DM, WSP(bf16_t, WS_H2) + (size_t)MP * DM);
    SEAM();
    if (PH(11)) {
        SchedRect S{XN, (const char*)(F.ws + WS_WUP), (size_t)BM * DM * 2, (size_t)BM * DM * 2, 36, 32, F.G, F.bx, 32};
        EpiBf<1> E{WSP(bf16_t, WS_UP), FF, 1.0f};
        gemm_phase<EpiBf<1>, SchedRect, true>(F.lds, DM, DM, S, E);
        convert_fill(F, CV_C1, CV_D1, 36 * 32);
    }
    SEAM();
    if (PH(12)) {
        SchedTail S{(const char*)(F.ws + WS_UP), (const char*)(F.ws + WS_WDN), (size_t)BM * FF * 2, (size_t)BM * FF * 2, 128, F.G, F.bx, tail};
        EpiTail<EpiRes<false>> E{{nullptr, nullptr, 1 << 30, WSP(bf16_t, WS_H2), WSP(bf16_t, WS_H2)}, WSP(bf16_t, WS_PART)};
        gemm_phase<EpiTail<EpiRes<false>>, SchedTail, true>(F.lds, FF, FF, S, E);
    }
    SEAM();
    phase_rms<true>(F, WSP(bf16_t, WS_H2), IN(25), F.out + O_Y, tail ? WSP(bf16_t, WS_PART) : nullptr, nullptr, WSP(bf16_t, WS_H2) + (size_t)MP * DM, nullptr);
}

extern "C" void kernel_launch(void* const* d_in, const int* in_sizes, int n_in, void* d_out, int out_size, void* d_ws, size_t ws_size, hipStream_t stream) {
    static int grid = 0;
    if (grid == 0) {
        if (n_in != 26 || ws_size < WS_END) { fprintf(stderr, "kernel_launch: unexpected n_in %d / ws_size %zu\n", n_in, ws_size); grid = -1; return; }
        int dev = 0, cus = 0, per_cu = 0;
        hipGetDevice(&dev);
        hipDeviceGetAttribute(&cus, hipDeviceAttributeMultiprocessorCount, dev);
        if (hipFuncSetAttribute((const void*)fwd_megakernel, hipFuncAttributeMaxDynamicSharedMemorySize, LDS_BYTES) != hipSuccess) { fprintf(stderr, "kernel_launch: hipFuncSetAttribute failed\n"); grid = -1; return; }
        if (hipOccupancyMaxActiveBlocksPerMultiprocessor(&per_cu, (const void*)fwd_megakernel, NWAVES * 64, LDS_BYTES) != hipSuccess || per_cu < 1) { fprintf(stderr, "kernel_launch: occupancy query says %d\n", per_cu); per_cu = 1; }
        (void)hipGetLastError();
        grid = cus;
        if (grid < 128) { fprintf(stderr, "kernel_launch: needs >= 128 CUs\n"); grid = -1; return; }
    }
    if (grid < 0) return;
    if (hipMemsetAsync((char*)d_ws + WS_CTL, 0, 65536, stream) != hipSuccess) { fprintf(stderr, "kernel_launch: memset failed\n"); return; }
    Args a{};
    for (int i = 0; i < 26; ++i) a.in[i] = (const float*)d_in[i];
    a.out = (float*)d_out; a.ws = (unsigned char*)d_ws;
    void* kargs[] = {&a};
    hipError_t e = hipLaunchCooperativeKernel((const void*)fwd_megakernel, dim3(grid), dim3(NWAVES * 64), kargs, LDS_BYTES, stream);
    if (e != hipSuccess) fprintf(stderr, "kernel_launch: cooperative launch failed: %s (grid %d)\n", hipGetErrorString(e), grid);
}
```

```cpp
#include <hip/hip_runtime.h>
#include <hip/hip_cooperative_groups.h>
#include <cstdio>
#include <cstdint>
namespace cg = cooperative_groups;

#define LAS __attribute__((address_space(3)))
typedef unsigned short bf16_t;
typedef short bf16x8 __attribute__((ext_vector_type(8)));
typedef float f32x4 __attribute__((ext_vector_type(4)));
typedef float f32x2 __attribute__((ext_vector_type(2)));
typedef unsigned u32x4 __attribute__((ext_vector_type(4)));
typedef unsigned u32x2 __attribute__((ext_vector_type(2)));

constexpr int DM = 2048, MP = 8192, MS = 1024, MT = MP + MS  ;
constexpr int NIN = 9216, FF = 8192, NMEM = 256, XH = 4, XD = 512;
constexpr int C_U = 0, C_V = 1024, C_BG = 2048, C_CG = 3072, C_XIN = 4096, C_GA = 5120, C_GB = 7168;
constexpr float EPS = 1e-6f, QSCALE = 0.04419417382415922f  ;
constexpr size_t O_Y = 0, O_MK = 18874368, O_MV = 20971520, O_CP = 23068672, O_CS = 23076864, O_CV = 23339008;
constexpr size_t MiB = 1u << 20;
constexpr size_t WS_CTL = 0, CTL_BYTES = 1 * MiB;
constexpr size_t WS_WIN = 2 * MiB;
constexpr size_t WS_WA = 54 * MiB, WS_WB = 58 * MiB;
constexpr size_t WS_WMIX = 62 * MiB, WS_WQ = 70 * MiB, WS_WXO = 78 * MiB;
constexpr size_t WS_WUP = 86 * MiB;
constexpr size_t WS_WDN = 118 * MiB;
constexpr size_t WS_WSP = 150 * MiB;
constexpr size_t WS_XN = 152 * MiB;
constexpr size_t WS_P1 = 192 * MiB;
constexpr size_t WS_UP = 192 * MiB;
constexpr size_t WS_VT = 354 * MiB;
constexpr size_t WS_YA = 370 * MiB, WS_YB = 388 * MiB;
constexpr size_t WS_TMP = 406 * MiB;
constexpr size_t WS_PART = 406 * MiB;
constexpr size_t WS_MRG = 478 * MiB;
constexpr size_t WS_H1 = 514 * MiB;
constexpr size_t WS_Q = 586 * MiB;
constexpr size_t WS_KP = 622 * MiB;
constexpr size_t WS_VPT = 626 * MiB;
constexpr size_t WS_PS = 630 * MiB;
constexpr size_t WS_O = 646 * MiB;
constexpr size_t WS_H2 = 682 * MiB;
constexpr size_t WS_END = 754 * MiB;

constexpr int LDS_BYTES = 147456;
constexpr int NWAVES = 8;

__device__ __forceinline__ unsigned cvt_pk_bf16(float lo, float hi) { unsigned r; asm volatile("v_cvt_pk_bf16_f32 %0, %1, %2" : "=v"(r) : "v"(lo), "v"(hi)); return r; }
__device__ __forceinline__ float bf_lo(unsigned u) { return __uint_as_float(u << 16); }
__device__ __forceinline__ float bf_hi(unsigned u) { return __uint_as_float(u & 0xffff0000u); }
__device__ __forceinline__ float bf1(bf16_t h) { return __uint_as_float(((unsigned)h) << 16); }
__device__ __forceinline__ bf16x8 pack8(f32x4 a, f32x4 b) {
    u32x4 w; w.x = cvt_pk_bf16(a.x, a.y); w.y = cvt_pk_bf16(a.z, a.w); w.z = cvt_pk_bf16(b.x, b.y); w.w = cvt_pk_bf16(b.z, b.w);
    return __builtin_bit_cast(bf16x8, w);
}
__device__ __forceinline__ void unpack8(u32x4 w, float (&f)[8]) {
    f[0] = bf_lo(w.x); f[1] = bf_hi(w.x); f[2] = bf_lo(w.y); f[3] = bf_hi(w.y); f[4] = bf_lo(w.z); f[5] = bf_hi(w.z); f[6] = bf_lo(w.w); f[7] = bf_hi(w.w);
}
__device__ __forceinline__ float wave_sum(float v) {
#pragma unroll
    for (int o = 1; o < 64; o <<= 1) v += __shfl_xor(v, o);
    return v;
}
__device__ __forceinline__ float sigmoidf_(float x) { return __builtin_amdgcn_rcpf(1.0f + __expf(-x)); }
#define LDS_WAIT() asm volatile("s_waitcnt lgkmcnt(0)" ::: "memory")

namespace pg8 {
constexpr int BM = 256, BK = 64, HALF = 128, HTB = HALF * BK * 2, STAGE_BYTES = 8 * HTB, NXCD = 8, WGM = 8;
__host__ __device__ __forceinline__ int lds_byte(int r, int c) { const int st = (r >> 4) * 2 + (c >> 5), rr = r & 15, cc = c & 31, ob = rr * 64 + cc * 2; return st * 1024 + (ob ^ (((ob >> 9) & 1) << 5)); }
__host__ __device__ __forceinline__ void stage_rc(int b, int& R, int& C) { const int st = b / 1024, sb = b % 1024, swz = sb ^ (((sb >> 9) & 1) << 5); R = (st >> 1) * 16 + swz / 64; C = (st & 1) * 32 + (swz % 64) / 2; }
__host__ __device__ __forceinline__ int perm32(int rho) { const int n = rho >> 4, i = rho & 15; return 8 * (i >> 2) + 4 * n + (i & 3); }

struct Unit { const char* A; const char* B; int orow, ocol, aux, nkt; };

__device__ __forceinline__ void rect_order(int L, int nM, int nN, int& pm, int& pn) {
    const int nwg = nM * nN; int wgid = L;
    { const int q = nwg / NXCD, r = nwg % NXCD, xcd = wgid % NXCD, off = wgid / NXCD; wgid = (xcd < r ? xcd * (q + 1) : r * (q + 1) + (xcd - r) * q) + off; }
    const int nig = WGM * nN, gid = wgid / nig, fm = gid * WGM, gsz = (nM - fm) < WGM ? (nM - fm) : WGM;
    pm = fm + ((wgid % nig) % gsz); pn = (wgid % nig) / gsz;
}

template <class Epi, class Sched, bool ALIGN_EPI>
__device__ __forceinline__ void gemm_phase(LAS unsigned char* lds, const int lda, const int ldb, const Sched& S, const Epi& E) {
    int tid_ = threadIdx.x; asm volatile("" : "+v"(tid_));
    const int tid = tid_, wid = __builtin_amdgcn_readfirstlane(tid >> 6), lane = tid & 63, wr = wid >> 2, wc = wid & 3, fr = lane & 15, fq = lane >> 4;
    unsigned voffA[2], voffB[2];
#pragma unroll
    for (int i = 0; i < 2; ++i) { int R, C; stage_rc(tid * 16 + i * 8192, R, C); const int Rb = Epi::PERM ? ((R & ~31) + perm32(R & 31)) : R;
        voffA[i] = (unsigned)(R * lda + C) * 2u; voffB[i] = (unsigned)(Rb * ldb + C) * 2u; }
    const size_t kstep = (size_t)(BK * 2);
    const size_t hstepA = (size_t)HALF * lda * 2, hstepB = (size_t)HALF * ldb * 2;
    const unsigned ldsw = (unsigned)wid * 1024u;
    const int aoff = lds_byte(wr * 64 + fr, fq * 8), boff = lds_byte(wc * 32 + fr, fq * 8);
#define PG8_SA(b, h) (((b) * 2 + (h)) * HTB)
#define PG8_SB(b, h) ((4 + (b) * 2 + (h)) * HTB)
#define PG8_STAGE(bufoff, gbase, voff) do { _Pragma("unroll") for (int _i = 0; _i < 2; ++_i) \
        __builtin_amdgcn_global_load_lds((const unsigned*)((const char*)(gbase) + (voff)[_i]), (LAS unsigned*)(lds + (bufoff) + ldsw + _i * 8192), 16, 0, 0); } while (0)
#define PG8_LDA(dst, b, h) do { _Pragma("unroll") for (int m = 0; m < 4; ++m) _Pragma("unroll") for (int k = 0; k < 2; ++k) dst[m][k] = *(const LAS bf16x8*)(lds + PG8_SA(b, h) + aoff + m * 2048 + k * 1024); } while (0)
#define PG8_LDB(dst, b, h) do { _Pragma("unroll") for (int n = 0; n < 2; ++n) _Pragma("unroll") for (int k = 0; k < 2; ++k) dst[n][k] = *(const LAS bf16x8*)(lds + PG8_SB(b, h) + boff + n * 2048 + k * 1024); } while (0)
#define PG8_MMA(ai, bj, At, Bt) do { __builtin_amdgcn_s_setprio(1); _Pragma("unroll") for (int m = 0; m < 4; ++m) _Pragma("unroll") for (int n = 0; n < 2; ++n) _Pragma("unroll") for (int k = 0; k < 2; ++k) \
        acc[ai][bj][m][n] = __builtin_amdgcn_mfma_f32_16x16x32_bf16(Bt[n][k], At[m][k], acc[ai][bj][m][n], 0, 0, 0); __builtin_amdgcn_s_setprio(0); } while (0)
#define PG8_WAIT_V(n) asm volatile("s_waitcnt vmcnt(" #n ")" ::: "memory")
#define PG8_WAIT_L(n) asm volatile("s_waitcnt lgkmcnt(" #n ")" ::: "memory")
#define PG8_BAR __builtin_amdgcn_s_barrier()
#define PG8_SCHED __builtin_amdgcn_sched_barrier(0)
    Unit cur, nxt; int ui = 0;
    if (!S.next(0, cur)) return;
    f32x4 acc[2][2][4][2];
#pragma unroll
    for (int a = 0; a < 2; ++a)
#pragma unroll
        for (int b = 0; b < 2; ++b)
#pragma unroll
            for (int m = 0; m < 4; ++m)
#pragma unroll
                for (int n = 0; n < 2; ++n) acc[a][b][m][n] = (f32x4){0.f, 0.f, 0.f, 0.f};
    bf16x8 At[4][2], B0[2][2], B1[2][2];
    const char* cA = cur.A; const char* cB = cur.B;
    PG8_STAGE(PG8_SB(0, 0), cB, voffB); PG8_STAGE(PG8_SB(0, 1), cB + hstepB, voffB); PG8_STAGE(PG8_SA(0, 0), cA, voffA); PG8_STAGE(PG8_SA(0, 1), cA + hstepA, voffA);
    if (wr == 1) PG8_BAR;
    PG8_WAIT_V(2); PG8_BAR;
    PG8_STAGE(PG8_SB(1, 0), cB + kstep, voffB); PG8_STAGE(PG8_SA(1, 0), cA + kstep, voffA); PG8_STAGE(PG8_SB(1, 1), cB + hstepB + kstep, voffB);
    PG8_WAIT_V(6); PG8_BAR;
    for (;;) {
        const bool has_next = S.next(ui + 1, nxt);
        int nt = cur.nkt; asm volatile("" : "+s"(nt));
        const char* nA = has_next ? nxt.A : cA; const char* nB = has_next ? nxt.B : cB;
        for (int t = 0; t < nt; t += 2) {
            const bool last = (t == nt - 2);
            const char* a1 = cA + (size_t)(t + 1) * kstep;
            const char* a2 = last ? nA : cA + (size_t)(t + 2) * kstep; const char* b2 = last ? nB : cB + (size_t)(t + 2) * kstep;
            const char* a3 = a2 + kstep; const char* b3 = b2 + kstep;
            if constexpr (Epi::MIDK) { if (t == (nt >> 1)) E.mid(acc, cur, wr, wc, fr, fq); }
            PG8_LDB(B0, 0, 0); PG8_LDB(B1, 0, 1); PG8_SCHED; PG8_LDA(At, 0, 0); PG8_STAGE(PG8_SA(1, 1), a1 + hstepA, voffA);
            PG8_WAIT_V(8); PG8_WAIT_L(0); PG8_BAR; PG8_MMA(0, 0, At, B0); PG8_MMA(0, 1, At, B1); PG8_BAR; PG8_SCHED;
            PG8_LDA(At, 0, 1); PG8_STAGE(PG8_SB(0, 0), b2, voffB); PG8_STAGE(PG8_SB(0, 1), b2 + hstepB, voffB); PG8_STAGE(PG8_SA(0, 0), a2, voffA);
            PG8_WAIT_V(8); PG8_WAIT_L(0); PG8_BAR; PG8_MMA(1, 0, At, B0); PG8_MMA(1, 1, At, B1); PG8_BAR; PG8_SCHED;
            PG8_LDB(B0, 1, 0); PG8_LDB(B1, 1, 1); PG8_SCHED; PG8_LDA(At, 1, 0); PG8_STAGE(PG8_SA(0, 1), a2 + hstepA, voffA);
            PG8_WAIT_V(8); PG8_WAIT_L(0); PG8_BAR; PG8_MMA(0, 0, At, B0); PG8_MMA(0, 1, At, B1); PG8_BAR; PG8_SCHED;
            PG8_LDA(At, 1, 1); PG8_STAGE(PG8_SB(1, 0), b3, voffB); PG8_STAGE(PG8_SB(1, 1), b3 + hstepB, voffB); PG8_STAGE(PG8_SA(1, 0), a3, voffA);
            PG8_WAIT_V(8); PG8_WAIT_L(0); PG8_BAR; PG8_MMA(1, 0, At, B0); PG8_MMA(1, 1, At, B1); PG8_BAR; PG8_SCHED;
        }
        if constexpr (ALIGN_EPI) { if (wr == 0) PG8_BAR; }
        if constexpr (!Epi::AFTER_DRAIN) { int fr_ = fr, fq_ = fq; asm volatile("" : "+v"(fr_), "+v"(fq_)); E(acc, cur, wr, wc, fr_, fq_); }
        if (!has_next) break;
#pragma unroll
        for (int a = 0; a < 2; ++a)
#pragma unroll
            for (int b = 0; b < 2; ++b)
#pragma unroll
                for (int m = 0; m < 4; ++m)
#pragma unroll
                    for (int n = 0; n < 2; ++n) acc[a][b][m][n] = (f32x4){0.f, 0.f, 0.f, 0.f};
        cur = nxt; cA = nA; cB = nB; ++ui;
        if constexpr (ALIGN_EPI) { if (wr == 1) PG8_BAR; }
    }
    PG8_WAIT_V(0);
    if constexpr (!ALIGN_EPI) { if (wr == 0) PG8_BAR; }
    PG8_BAR;
    if constexpr (Epi::AFTER_DRAIN) { E.fused(acc, cur, wr, wc, fr, fq, lds, wid, lane); }
#undef PG8_SA
#undef PG8_SB
#undef PG8_STAGE
#undef PG8_LDA
#undef PG8_LDB
#undef PG8_MMA
#undef PG8_WAIT_V
#undef PG8_WAIT_L
#undef PG8_BAR
#undef PG8_SCHED
}

struct SchedRect {
    const char* A; const char* B; size_t atile, btile; int nM, nN, G, c, NT;
    __device__ __forceinline__ bool next(int i, Unit& u) const {
        const int L = i * G + c; if (L >= nM * nN) return false;
        int pm, pn; rect_order(L, nM, nN, pm, pn);
        u.A = A + (size_t)pm * atile; u.B = B + (size_t)pn * btile; u.orow = pm * BM; u.ocol = pn * BM; u.aux = 0; u.nkt = NT; return true;
    }
};
struct SchedIn {
    const char* A; const char* B; int G, c;
    __device__ __forceinline__ bool next(int i, Unit& u) const {
        const int L = i * G + c; if (L >= 1296 + 64) return false;
        int pm, pn;
        if (L < 1296) { rect_order(L, 36, 36, pm, pn); u.orow = pm * BM; u.ocol = pn * BM; u.aux = 0; }
        else { const int l = L - 1296; pm = 36 + (l & 3); pn = 36 + (l >> 2); u.orow = (pm - 36) * BM; u.ocol = (pn - 36) * BM; u.aux = 1; }
        u.A = A + (size_t)pm * (BM * DM * 2); u.B = B + (size_t)pn * (BM * DM * 2); u.nkt = DM / BK; return true;
    }
};
struct SchedSp {
    const char* WSP; const char* VT; int G, c;
    __device__ __forceinline__ bool next(int i, Unit& u) const {
        const int L = i * G + c; if (L >= 256) return false;
        const int chunk = L >> 2, p = (L >> 1) & 1, gi = L & 1, g = 2 * p + gi;
        u.A = WSP + (size_t)p * (256 * 128 * 2); u.B = VT + ((size_t)chunk * 1024 + g * 256) * 128 * 2; u.orow = chunk * 128; u.ocol = g * 256; u.aux = gi; u.nkt = 2; return true;
    }
};
struct SchedS {
    const char* Q; const char* KP; int G, c;
    __device__ __forceinline__ bool next(int i, Unit& u) const {
        const int L = i * G + c; if (L >= 128 || i > 0) return false;
        const int b = L >> 5, h = (L >> 3) & 3, p = L & 7;
        u.A = Q + ((size_t)(b * 2048 + p * 256) * DM + h * XD) * 2; u.B = KP + ((size_t)(b * 256) * DM + h * XD) * 2;
        u.orow = (b * 4 + h) * 2048 + p * 256; u.ocol = 0; u.aux = 0; u.nkt = XD / BK; return true;
    }
};
struct SchedO {
    const char* PS; const char* VPT; int G, c;
    __device__ __forceinline__ bool next(int i, Unit& u) const {
        if (c >= 128 || i >= 2) return false;
        const int b = c >> 5, h = (c >> 3) & 3, p = c & 7, pn = i;
        u.A = PS + ((size_t)((b * 4 + h) * 2048 + p * 256) * 256) * 2; u.B = VPT + ((size_t)(b * 2048 + h * XD + pn * 256) * 256) * 2;
        u.orow = b * 2048 + p * 256; u.ocol = h * XD + pn * 256; u.aux = 0; u.nkt = 4; return true;
    }
};

struct SchedTail {
    const char* A; const char* B; size_t atile, btile; int NT, G, c; bool tail;
    __device__ __forceinline__ bool next(int i, Unit& u) const {
        if (!tail) { const int L = i * G + c; if (L >= 288) return false; int pm, pn; rect_order(L, 36, 8, pm, pn);
            u.A = A + (size_t)pm * atile; u.B = B + (size_t)pn * btile; u.orow = pm * BM; u.ocol = pn * BM; u.aux = 0; u.nkt = NT; return true; }
        const int vcu = (c & 7) * 32 + (c >> 3);
        if (i == 0) { const int pm = vcu >> 3, pn = vcu & 7; u.A = A + (size_t)pm * atile; u.B = B + (size_t)pn * btile; u.orow = pm * BM; u.ocol = pn * BM; u.aux = 0; u.nkt = NT; return true; }
        if (i == 1) { const int t = vcu >> 3, s = vcu & 7, pm = 32 + (t >> 3), pn = t & 7, nk = NT >> 3;
            u.A = A + (size_t)pm * atile + (size_t)(s * nk) * (BK * 2); u.B = B + (size_t)pn * btile + (size_t)(s * nk) * (BK * 2);
            u.orow = (t >> 3) * BM; u.ocol = pn * BM; u.aux = 1 + s; u.nkt = nk; return true; }
        return false;
    }
};
#define EPI_ROWS_BEGIN _Pragma("unroll") for (int ai = 0; ai < 2; ++ai) _Pragma("unroll") for (int m = 0; m < 4; ++m) { const int rl = ai * HALF + wr * 64 + m * 16 + fr;
#define EPI_ROWS_END }

struct EpiIn {
    static constexpr bool PERM = true, AFTER_DRAIN = false, MIDK = false;
    bf16_t* P1; float* memk; float* memv; bf16_t* KP; bf16_t* VPT;
    __device__ __forceinline__ void operator()(const f32x4 (&acc)[2][2][4][2], const Unit& u, int wr, int wc, int fr, int fq) const {
        const int cl0 = wc * 32 + 8 * fq;
        if (u.aux == 0) {
            const bool gate = u.ocol >= C_GA;
            EPI_ROWS_BEGIN
                bf16_t* rowp = P1 + (size_t)(u.orow + rl) * NIN + u.ocol + cl0;
#pragma unroll
                for (int bj = 0; bj < 2; ++bj) { f32x4 v0 = acc[ai][bj][m][0], v1 = acc[ai][bj][m][1];
                    if (gate) {
                        const f32x4 g0 = acc[ai][1][m][0], g1 = acc[ai][1][m][1];
#pragma unroll
                        for (int e = 0; e < 4; ++e) { const float sb0 = sigmoidf_(g0[e]), sb1 = sigmoidf_(g1[e]);
                            if (bj == 0) { v0[e] = sigmoidf_(v0[e]) * __builtin_amdgcn_rcpf(fmaxf(sb0, 1e-30f)); v1[e] = sigmoidf_(v1[e]) * __builtin_amdgcn_rcpf(fmaxf(sb1, 1e-30f)); }
                            else { v0[e] = fmaxf(sb0, 1e-30f); v1[e] = fmaxf(sb1, 1e-30f); } } }
                    u32x4 w; w.x = cvt_pk_bf16(v0[0], v0[1]); w.y = cvt_pk_bf16(v0[2], v0[3]); w.z = cvt_pk_bf16(v1[0], v1[1]); w.w = cvt_pk_bf16(v1[2], v1[3]);
                    *(u32x4*)(rowp + bj * HALF) = w; }
            EPI_ROWS_END
        } else {
            const bool isV = u.ocol >= DM; const int cb = u.ocol - (isV ? DM : 0) + cl0;
            float* fo = isV ? memv : memk;
            EPI_ROWS_BEGIN
                const int row = u.orow + rl;
#pragma unroll
                for (int bj = 0; bj < 2; ++bj) { const f32x4 v0 = acc[ai][bj][m][0], v1 = acc[ai][bj][m][1]; const int col = cb + bj * HALF;
                    *(f32x4*)(fo + (size_t)row * DM + col) = v0; *(f32x4*)(fo + (size_t)row * DM + col + 4) = v1;
                    u32x4 w; w.x = cvt_pk_bf16(v0[0], v0[1]); w.y = cvt_pk_bf16(v0[2], v0[3]); w.z = cvt_pk_bf16(v1[0], v1[1]); w.w = cvt_pk_bf16(v1[2], v1[3]);
                    if (!isV) { *(u32x4*)(KP + (size_t)row * DM + col) = w; }
                    else { bf16_t* vp = VPT + ((size_t)(row >> 8) * DM + col) * 256 + (row & 255);
                        vp[0 * 256] = (bf16_t)(w.x & 0xffff); vp[1 * 256] = (bf16_t)(w.x >> 16); vp[2 * 256] = (bf16_t)(w.y & 0xffff); vp[3 * 256] = (bf16_t)(w.y >> 16);
                        vp[4 * 256] = (bf16_t)(w.z & 0xffff); vp[5 * 256] = (bf16_t)(w.z >> 16); vp[6 * 256] = (bf16_t)(w.w & 0xffff); vp[7 * 256] = (bf16_t)(w.w >> 16); } }
            EPI_ROWS_END
        }
    }
};
struct EpiSp {
    static constexpr bool PERM = true, AFTER_DRAIN = false, MIDK = false;
    const bf16_t* P1; const float* bsp; bf16_t* YA;
    __device__ __forceinline__ void operator()(const f32x4 (&acc)[2][2][4][2], const Unit& u, int wr, int wc, int fr, int fq) const {
        const int g = u.ocol >> 8, cl0 = wc * 32 + 8 * fq;
#pragma unroll
        for (int ai = 0; ai < 2; ++ai) if (ai == u.aux) {
#pragma unroll
            for (int m = 0; m < 4; ++m) { const int t = wr * 64 + m * 16 + fr; const int row = u.orow + t; const float bs = bsp[g * 128 + t];
#pragma unroll
                for (int bj = 0; bj < 2; ++bj) { const int col = u.ocol + bj * HALF + cl0;
                    const u32x4 uw = *(const u32x4*)(P1 + (size_t)row * NIN + C_U + col); float uf[8]; unpack8(uw, uf);
                    const f32x4 v0 = acc[ai][bj][m][0], v1 = acc[ai][bj][m][1];
                    u32x4 w; w.x = cvt_pk_bf16(uf[0] * (v0[0] + bs), uf[1] * (v0[1] + bs)); w.y = cvt_pk_bf16(uf[2] * (v0[2] + bs), uf[3] * (v0[3] + bs));
                    w.z = cvt_pk_bf16(uf[4] * (v1[0] + bs), uf[5] * (v1[1] + bs)); w.w = cvt_pk_bf16(uf[6] * (v1[2] + bs), uf[7] * (v1[3] + bs));
                    *(u32x4*)(YA + (size_t)row * DM + col) = w; } }
        }
    }
};
struct EpiMerged {
    static constexpr bool PERM = true, AFTER_DRAIN = false, MIDK = true;
    const bf16_t* P1; bf16_t* MRG;
    __device__ __forceinline__ void mid(f32x4 (&acc)[2][2][4][2], const Unit& u, int wr, int wc, int fr, int fq) const {
        asm volatile("" : "+v"(fr), "+v"(fq));
        const bf16_t* pb = P1 + (size_t)(u.orow + wr * 64 + fr) * NIN + C_GA + (u.ocol >> 7) * 256 + wc * 32 + 8 * fq;
#pragma unroll
        for (int ai = 0; ai < 2; ++ai) {
            u32x4 r[4][2];
#pragma unroll
            for (int m = 0; m < 4; ++m)
#pragma unroll
                for (int bj = 0; bj < 2; ++bj) r[m][bj] = *(const u32x4*)(pb + (size_t)(ai * HALF + m * 16) * NIN + bj * 256);
#pragma unroll
            for (int m = 0; m < 4; ++m)
#pragma unroll
                for (int bj = 0; bj < 2; ++bj) { float f[8]; unpack8(r[m][bj], f);
#pragma unroll
                    for (int e = 0; e < 4; ++e) { acc[ai][bj][m][0][e] *= f[e]; acc[ai][bj][m][1][e] *= f[4 + e]; } }
            asm volatile("" ::: "memory");
        }
    }
    __device__ __forceinline__ void operator()(const f32x4 (&acc)[2][2][4][2], const Unit& u, int wr, int wc, int fr, int fq) const {
        const int cl0 = wc * 32 + 8 * fq;
        const bf16_t* pb = P1 + (size_t)(u.orow + wr * 64 + fr) * NIN + C_GA + (u.ocol >> 7) * 256 + 128 + cl0;
        EPI_ROWS_BEGIN
            const int row = u.orow + rl;
#pragma unroll
            for (int bj = 0; bj < 2; ++bj) { const int col = u.ocol + bj * HALF + cl0;
                float sb[8]; unpack8(*(const u32x4*)(pb + (size_t)(ai * HALF + m * 16) * NIN + bj * 256), sb);
                const f32x4 v0 = acc[ai][bj][m][0], v1 = acc[ai][bj][m][1];
                u32x4 w; w.x = cvt_pk_bf16(v0[0] * sb[0], v0[1] * sb[1]); w.y = cvt_pk_bf16(v0[2] * sb[2], v0[3] * sb[3]); w.z = cvt_pk_bf16(v1[0] * sb[4], v1[1] * sb[5]); w.w = cvt_pk_bf16(v1[2] * sb[6], v1[3] * sb[7]);
                *(u32x4*)(MRG + (size_t)row * DM + col) = w; }
        EPI_ROWS_END
    }
};
template <bool RES_F32> struct EpiRes {
    static constexpr bool PERM = true, AFTER_DRAIN = false, MIDK = false;
    const float* resA; const float* resB; int split; const bf16_t* resH; bf16_t* out;
    __device__ __forceinline__ void operator()(const f32x4 (&acc)[2][2][4][2], const Unit& u, int wr, int wc, int fr, int fq) const {
        const float* rbase = (u.orow < split) ? resA + (size_t)u.orow * DM : resB + (size_t)(u.orow - split) * DM;
        const int cl0 = wc * 32 + 8 * fq;
        EPI_ROWS_BEGIN
#pragma unroll
            for (int bj = 0; bj < 2; ++bj) { const size_t off = (size_t)rl * DM + u.ocol + bj * HALF + cl0;
                f32x4 r0, r1;
                if (RES_F32) { r0 = *(const f32x4*)(rbase + off); r1 = *(const f32x4*)(rbase + off + 4); }
                else { float f[8]; unpack8(*(const u32x4*)(resH + (size_t)u.orow * DM + off), f); r0 = (f32x4){f[0], f[1], f[2], f[3]}; r1 = (f32x4){f[4], f[5], f[6], f[7]}; }
                const f32x4 v0 = r0 + acc[ai][bj][m][0], v1 = r1 + acc[ai][bj][m][1];
                u32x4 w; w.x = cvt_pk_bf16(v0[0], v0[1]); w.y = cvt_pk_bf16(v0[2], v0[3]); w.z = cvt_pk_bf16(v1[0], v1[1]); w.w = cvt_pk_bf16(v1[2], v1[3]);
                *(u32x4*)(out + (size_t)u.orow * DM + off) = w; }
        EPI_ROWS_END
    }
};
template <int MODE  > struct EpiBf {
    static constexpr bool PERM = true, AFTER_DRAIN = false, MIDK = false;
    bf16_t* O; int ldc; float scale;
    __device__ __forceinline__ void operator()(const f32x4 (&acc)[2][2][4][2], const Unit& u, int wr, int wc, int fr, int fq) const {
        const int cl0 = wc * 32 + 8 * fq;
        EPI_ROWS_BEGIN
            bf16_t* rowp = O + (size_t)(u.orow + rl) * ldc + u.ocol + cl0;
#pragma unroll
            for (int bj = 0; bj < 2; ++bj) { f32x4 v0 = acc[ai][bj][m][0], v1 = acc[ai][bj][m][1];
                if (MODE == 0) { v0 = v0 * scale; v1 = v1 * scale; }
                else {
#pragma unroll
                    for (int e = 0; e < 4; ++e) { const float a = fmaxf(v0[e], 0.f), b = fmaxf(v1[e], 0.f); v0[e] = a * a; v1[e] = b * b; } }
                u32x4 w; w.x = cvt_pk_bf16(v0[0], v0[1]); w.y = cvt_pk_bf16(v0[2], v0[3]); w.z = cvt_pk_bf16(v1[0], v1[1]); w.w = cvt_pk_bf16(v1[2], v1[3]);
                *(u32x4*)(rowp + bj * HALF) = w; }
        EPI_ROWS_END
    }
};
struct EpiSoftmax {
    static constexpr bool PERM = true, AFTER_DRAIN = true, MIDK = false;
    bf16_t* PS;
    __device__ __forceinline__ void fused(f32x4 (&acc)[2][2][4][2], const Unit& u, int wr, int wc, int fr, int fq, LAS unsigned char* lds, int wid, int lane) const {
        LAS f32x2* X = (LAS f32x2*)lds;
        float mxl[2][4];
        EPI_ROWS_BEGIN
            float mx = -3.0e38f;
#pragma unroll
            for (int bj = 0; bj < 2; ++bj)
#pragma unroll
                for (int n = 0; n < 2; ++n) { const f32x4 v = acc[ai][bj][m][n]; mx = fmaxf(mx, fmaxf(fmaxf(v[0], v[1]), fmaxf(v[2], v[3]))); }
            mx = fmaxf(mx, __shfl_xor(mx, 16)); mx = fmaxf(mx, __shfl_xor(mx, 32));
            float s = 0.f;
#pragma unroll
            for (int bj = 0; bj < 2; ++bj)
#pragma unroll
                for (int n = 0; n < 2; ++n) { f32x4 v = acc[ai][bj][m][n];
#pragma unroll
                    for (int e = 0; e < 4; ++e) { v[e] = __expf(v[e] - mx); s += v[e]; }
                    acc[ai][bj][m][n] = v; }
            s += __shfl_xor(s, 16); s += __shfl_xor(s, 32);
            mxl[ai][m] = mx;
            if (fq == 0) X[rl * 4 + wc] = (f32x2){mx, s};
        EPI_ROWS_END
        LDS_WAIT(); __builtin_amdgcn_s_barrier(); asm volatile("" ::: "memory");
        const int cl0 = wc * 32 + 8 * fq;
        EPI_ROWS_BEGIN
            const f32x2 a = X[rl * 4 + 0], b = X[rl * 4 + 1], c = X[rl * 4 + 2], d = X[rl * 4 + 3];
            const float M = fmaxf(fmaxf(a.x, b.x), fmaxf(c.x, d.x));
            const float L = a.y * __expf(a.x - M) + b.y * __expf(b.x - M) + c.y * __expf(c.x - M) + d.y * __expf(d.x - M);
            const float f = __expf(mxl[ai][m] - M) / L;
            bf16_t* rowp = PS + (size_t)(u.orow + rl) * 256 + cl0;
#pragma unroll
            for (int bj = 0; bj < 2; ++bj) { const f32x4 v0 = acc[ai][bj][m][0] * f, v1 = acc[ai][bj][m][1] * f;
                u32x4 w; w.x = cvt_pk_bf16(v0[0], v0[1]); w.y = cvt_pk_bf16(v0[2], v0[3]); w.z = cvt_pk_bf16(v1[0], v1[1]); w.w = cvt_pk_bf16(v1[2], v1[3]);
                *(u32x4*)(rowp + bj * HALF) = w; }
        EPI_ROWS_END
        LDS_WAIT(); __builtin_amdgcn_s_barrier(); asm volatile("" ::: "memory");
    }
};

template <class Base> struct EpiTail {
    static constexpr bool PERM = Base::PERM, AFTER_DRAIN = false, MIDK = false;
    Base base; bf16_t* part;
    __device__ __forceinline__ void operator()(const f32x4 (&acc)[2][2][4][2], const Unit& u, int wr, int wc, int fr, int fq) const {
        if (u.aux == 0) { base(acc, u, wr, wc, fr, fq); return; }
        bf16_t* pb = part + (size_t)(u.aux - 1) * (MS * DM) + (size_t)u.orow * DM + u.ocol;
        EPI_ROWS_BEGIN
#pragma unroll
            for (int bj = 0; bj < 2; ++bj) {
                if (PERM) { const f32x4 v0 = acc[ai][bj][m][0], v1 = acc[ai][bj][m][1];
                    u32x4 w; w.x = cvt_pk_bf16(v0[0], v0[1]); w.y = cvt_pk_bf16(v0[2], v0[3]); w.z = cvt_pk_bf16(v1[0], v1[1]); w.w = cvt_pk_bf16(v1[2], v1[3]);
                    *(u32x4*)(pb + (size_t)rl * DM + bj * HALF + wc * 32 + 8 * fq) = w; }
                else {
#pragma unroll
                    for (int n = 0; n < 2; ++n) { const f32x4 v = acc[ai][bj][m][n]; u32x2 w; w.x = cvt_pk_bf16(v[0], v[1]); w.y = cvt_pk_bf16(v[2], v[3]);
                        *(u32x2*)(pb + (size_t)rl * DM + bj * HALF + wc * 32 + 16 * n + 4 * fq) = w; } }
            }
        EPI_ROWS_END
    }
};
}


#define XB_TMO      128
#define XB_XCNT(j)  (256  + 64 * (j))
#define XB_XSUB(j)  (1280 + 64 * (j))
#define XB_XGEN(j)  (2304 + 64 * (j))
#define XB_TOP      3328
#define XB_TOPGEN   3392
#define XCD_BAR_WORDS 3456
#define XB_SPIN_CAP (1u << 18)
__device__ __forceinline__ unsigned xb_ld(unsigned* p)              { return __hip_atomic_load(p, __ATOMIC_RELAXED, __HIP_MEMORY_SCOPE_AGENT); }
__device__ __forceinline__ unsigned xb_add(unsigned* p, unsigned v) { return __hip_atomic_fetch_add(p, v, __ATOMIC_RELAXED, __HIP_MEMORY_SCOPE_AGENT); }
__device__ __forceinline__ unsigned xb_xcc_id() { return (unsigned)__builtin_amdgcn_s_getreg((3 << 11) | 20) & 0xFu; }
#define XB_SPIN(cond, bar) do { unsigned _sp = 0; while (cond) { __builtin_amdgcn_s_sleep(1); \
    if ((++_sp & 255u) == 0u) { if (xb_ld(&(bar)[XB_TMO])) break; if (_sp > XB_SPIN_CAP) { atomicAdd(&(bar)[XB_TMO], 1u); break; } } } } while (0)
struct XcdBarrier { unsigned* bar; unsigned x; volatile LAS unsigned* st; };
__device__ __forceinline__ XcdBarrier xcd_barrier_post(unsigned* bar, volatile LAS unsigned* st) {
    XcdBarrier b; b.bar = bar; b.x = xb_xcc_id(); b.st = st;
    if (threadIdx.x == 0) (void)xb_add(&bar[XB_XCNT(b.x)], 1u);
    return b;
}
__device__ __forceinline__ void xcd_barrier_complete(unsigned* bar, unsigned x, unsigned& nloc, unsigned& nx) {
    const unsigned G = gridDim.x * gridDim.y * gridDim.z;
    unsigned sum, cnt, mine, sp = 0u;
    for (;;) {
        sum = 0u; cnt = 0u; mine = 0u;
#pragma unroll
        for (unsigned j = 0; j < 16; ++j) { const unsigned c = xb_ld(&bar[XB_XCNT(j)]); sum += c; cnt += (c > 0u) ? 1u : 0u; mine = (j == x) ? c : mine; }
        if (sum == G) break;
        __builtin_amdgcn_s_sleep(1);
        if ((++sp & 255u) == 0u) { if (xb_ld(&bar[XB_TMO])) break; if (sp > XB_SPIN_CAP) { atomicAdd(&bar[XB_TMO], 1u); break; } }
    }
    nloc = mine > 0u ? mine : 1u; nx = cnt > 0u ? cnt : 1u;
}
__device__ __forceinline__ void xcd_barrier(const XcdBarrier& b) {
    asm volatile("s_waitcnt vmcnt(0)" ::: "memory");
    __syncthreads();
    if (threadIdx.x == 0) {
        unsigned* bar = b.bar;
        __builtin_amdgcn_s_waitcnt(0);
        unsigned nloc = b.st[0], nx = b.st[1];
        if (nloc == 0u) { xcd_barrier_complete(bar, b.x, nloc, nx); b.st[0] = nloc; b.st[1] = nx; }
        const unsigned old = xb_add(&bar[XB_XSUB(b.x)], 1u);
        const unsigned gen = old / nloc;
        if (old + 1u == (gen + 1u) * nloc) {
            __builtin_amdgcn_fence(__ATOMIC_RELEASE, "agent");
            asm volatile("s_waitcnt vmcnt(0)" ::: "memory");
            const unsigned og = xb_add(&bar[XB_TOP], 1u);
            const unsigned tg = og / nx;
            if (og + 1u == (tg + 1u) * nx) xb_add(&bar[XB_TOPGEN], 1u);
            else XB_SPIN(xb_ld(&bar[XB_TOPGEN]) == tg, bar);
            __builtin_amdgcn_fence(__ATOMIC_ACQUIRE, "agent");
            xb_add(&bar[XB_XGEN(b.x)], 1u);
            asm volatile("s_waitcnt vmcnt(0)" ::: "memory");
        } else {
            XB_SPIN(xb_ld(&bar[XB_XGEN(b.x)]) == gen, bar);
            __builtin_amdgcn_fence(__ATOMIC_ACQUIRE, "agent");
            asm volatile("s_waitcnt vmcnt(0)" ::: "memory");
        }
    }
    __syncthreads();
}

struct Args { const float* in[26]; float* out; unsigned char* ws; };

struct Frame {
    LAS unsigned char* lds;
    int tid, lane, wave, G, bx;
    float* out; unsigned char* ws;
};
typedef const float* cfp_t;
__device__ __forceinline__ const float* karg_in(int i) {
    asm volatile("" : "+s"(i));
    const __attribute__((address_space(4))) cfp_t* ka = (const __attribute__((address_space(4))) cfp_t*)__builtin_amdgcn_kernarg_segment_ptr();
    return ka[i];
}
#define IN(i) karg_in(i)
#define WSP(T, off) ((T*)(F.ws + (off)))

__device__ __forceinline__ void p0_transpose_item(const float* W, int K, int N, bf16_t* WT, int row_off, LAS float* scr, int item, int lane, int ldk, int koff) {
    const int nblk = N / 32, kb = item / nblk, nb = item % nblk, k0 = 64 * kb, n0 = 32 * nb;
#pragma unroll 4
    for (int i = 0; i < 32; ++i) { const int kk = 2 * i + (lane >> 5); scr[kk * 33 + (lane & 31)] = W[(size_t)(k0 + kk) * N + n0 + (lane & 31)]; }
    LDS_WAIT(); asm volatile("" ::: "memory");
    const int c = lane & 7;
#pragma unroll
    for (int j = 0; j < 4; ++j) { const int n = (lane >> 3) + 8 * j; const LAS float* s = scr + (8 * c) * 33 + n;
        u32x4 o; o.x = cvt_pk_bf16(s[0 * 33], s[1 * 33]); o.y = cvt_pk_bf16(s[2 * 33], s[3 * 33]); o.z = cvt_pk_bf16(s[4 * 33], s[5 * 33]); o.w = cvt_pk_bf16(s[6 * 33], s[7 * 33]);
        *(u32x4*)(WT + (size_t)(row_off + n0 + n) * ldk + koff + k0 + 8 * c) = o; }
    LDS_WAIT(); asm volatile("" ::: "memory");
}
template <bool OUT_F32> __device__ __forceinline__ void rms_row(const float* xrow, const float* g, void* orow, int lane) {
    const f32x4* xr = (const f32x4*)xrow + lane; f32x4 v[8]; float ss = 0.f;
#pragma unroll
    for (int j = 0; j < 8; ++j) { v[j] = xr[64 * j]; ss += (v[j].x * v[j].x + v[j].y * v[j].y) + (v[j].z * v[j].z + v[j].w * v[j].w); }
    const float r = rsqrtf(wave_sum(ss) * (1.f / DM) + EPS);
    const f32x4* gr = (const f32x4*)g + lane;
#pragma unroll
    for (int j = 0; j < 8; ++j) { const f32x4 gg = gr[64 * j]; const f32x4 o = v[j] * r * gg;
        if (OUT_F32) ((f32x4*)orow)[lane + 64 * j] = o;
        else { u32x2 w; w.x = cvt_pk_bf16(o.x, o.y); w.y = cvt_pk_bf16(o.z, o.w); ((u32x2*)orow)[lane + 64 * j] = w; } }
}

constexpr int I_IN = 32 * 288, I_SQ = 32 * 64, I_BR = 16 * 64, I_UP = 32 * 256, I_DN = 128 * 64;
constexpr int CV_A0 = 0, CV_A1 = I_IN + 2 * I_SQ;
constexpr int CV_B1 = CV_A1 + 3 * I_SQ + 2 * I_BR;
constexpr int CV_C1 = CV_B1 + I_UP;
constexpr int CV_D1 = CV_C1 + I_DN;
__device__ __forceinline__ void convert_one(Frame& F, int it, LAS float* scr) {
    int r = it, K = DM, N = DM, ro = 0, ldk = DM, koff = 0, src_i; size_t wso;
    if (r < I_IN) { src_i = 7; N = NIN; wso = WS_WIN; const int n0 = 32 * (r % 288);
        if (n0 >= C_GB) { const int j = n0 - C_GB; ro = C_GA + (j >> 7) * 256 + 128 + (j & 127) - n0; }
        else if (n0 >= C_GA) { const int j = n0 - C_GA; ro = C_GA + (j >> 7) * 256 + (j & 127) - n0; } }
    else if ((r -= I_IN) < I_SQ) { src_i = 19; wso = WS_WIN; ro = NIN; }
    else if ((r -= I_SQ) < I_SQ) { src_i = 20; wso = WS_WIN; ro = NIN + DM; }
    else if ((r -= I_SQ) < I_SQ) { src_i = 15; wso = WS_WMIX; }
    else if ((r -= I_SQ) < I_SQ) { src_i = 18; wso = WS_WQ; }
    else if ((r -= I_SQ) < I_SQ) { src_i = 21; wso = WS_WXO; }
    else if ((r -= I_SQ) < I_BR) { src_i = 13; wso = WS_WA; K = 1024; }
    else if ((r -= I_BR) < I_BR) { src_i = 14; wso = WS_WA; K = 1024; koff = 1024; }
    else if ((r -= I_BR) < I_UP) { src_i = 23; wso = WS_WUP; N = FF; }
    else { r -= I_UP; src_i = 24; wso = WS_WDN; K = FF; ldk = FF; }
    p0_transpose_item(IN(src_i), K, N, (bf16_t*)(F.ws + wso), ro, scr, r, F.lane, ldk, koff);
}
__device__ __forceinline__ void convert_fill(Frame& F, int i0, int i1, int n_units) {
    const int rounds = (n_units + F.G - 1) / F.G, nfull = n_units - (rounds - 1) * F.G;
    int slot = F.bx - nfull, nslots = F.G - nfull;
    if (nslots == 0) { slot = F.bx; nslots = F.G; }
    if (slot < 0) return;
    LAS float* scr = (LAS float*)(F.lds + F.wave * 16384);
    for (int it = i0 + slot * NWAVES + F.wave; it < i1; it += nslots * NWAVES) convert_one(F, it, scr);
}
template <int R> __device__ __forceinline__ void ln_stats(const bf16_t* p, size_t rstride, float (&mean)[R], float (&rstd)[R], float (&lo)[R][8], float (&hi)[R][8]) {
#pragma unroll
    for (int r = 0; r < R; ++r) { unpack8(*(const u32x4*)(p + r * rstride), lo[r]); unpack8(*(const u32x4*)(p + r * rstride + 512), hi[r]); }
    float s[R];
#pragma unroll
    for (int r = 0; r < R; ++r) { s[r] = 0.f;
#pragma unroll
        for (int e = 0; e < 8; ++e) s[r] += lo[r][e] + hi[r][e]; }
#pragma unroll
    for (int o = 1; o < 64; o <<= 1)
#pragma unroll
        for (int r = 0; r < R; ++r) s[r] += __shfl_xor(s[r], o);
#pragma unroll
    for (int r = 0; r < R; ++r) { mean[r] = s[r] * (1.f / 1024.f); s[r] = 0.f;
#pragma unroll
        for (int e = 0; e < 8; ++e) { const float d0 = lo[r][e] - mean[r], d1 = hi[r][e] - mean[r]; s[r] += d0 * d0 + d1 * d1; } }
#pragma unroll
    for (int o = 1; o < 64; o <<= 1)
#pragma unroll
        for (int r = 0; r < R; ++r) s[r] += __shfl_xor(s[r], o);
#pragma unroll
    for (int r = 0; r < R; ++r) rstd[r] = rsqrtf(s[r] * (1.f / 1024.f) + EPS);
}
template <bool OUT_F32> __device__ __forceinline__ void rms_rows2(const float* x0, const float* g0, void* o0, const float* x1, const float* g1, void* o1, int lane) {
    const f32x4* xr0 = (const f32x4*)x0 + lane; const f32x4* xr1 = (const f32x4*)x1 + lane; f32x4 v0[8], v1[8]; float s0 = 0.f, s1 = 0.f;
#pragma unroll
    for (int j = 0; j < 8; ++j) { v0[j] = xr0[64 * j]; v1[j] = xr1[64 * j]; }
#pragma unroll
    for (int j = 0; j < 8; ++j) { s0 += (v0[j].x * v0[j].x + v0[j].y * v0[j].y) + (v0[j].z * v0[j].z + v0[j].w * v0[j].w); s1 += (v1[j].x * v1[j].x + v1[j].y * v1[j].y) + (v1[j].z * v1[j].z + v1[j].w * v1[j].w); }
#pragma unroll
    for (int o = 1; o < 64; o <<= 1) { s0 += __shfl_xor(s0, o); s1 += __shfl_xor(s1, o); }
    const float r0 = rsqrtf(s0 * (1.f / DM) + EPS), r1 = rsqrtf(s1 * (1.f / DM) + EPS);
    const f32x4* gr0 = (const f32x4*)g0 + lane; const f32x4* gr1 = (const f32x4*)g1 + lane;
#pragma unroll
    for (int j = 0; j < 8; ++j) { const f32x4 a = v0[j] * r0 * gr0[64 * j], b = v1[j] * r1 * gr1[64 * j];
        if (OUT_F32) { ((f32x4*)o0)[lane + 64 * j] = a; ((f32x4*)o1)[lane + 64 * j] = b; }
        else { u32x2 w; w.x = cvt_pk_bf16(a.x, a.y); w.y = cvt_pk_bf16(a.z, a.w); ((u32x2*)o0)[lane + 64 * j] = w; w.x = cvt_pk_bf16(b.x, b.y); w.y = cvt_pk_bf16(b.z, b.w); ((u32x2*)o1)[lane + 64 * j] = w; } }
}
__device__ __forceinline__ void phase_prologue(Frame& F) {
    LAS float* scr = (LAS float*)(F.lds + F.wave * 16384);
    const int gw = F.bx * NWAVES + F.wave, NGW = F.G * NWAVES;
    for (int it = CV_A0 + gw; it < CV_A1; it += NGW) convert_one(F, it, scr);
    bf16_t* XN = WSP(bf16_t, WS_XN);
    { const float* xp = IN(0); const float* xs = IN(1); const float* xm = IN(5); const float* gx = IN(6); const float* gm = IN(17);
      for (int m = gw; m < MT + 1024; m += 2 * NGW) {
        const int m2 = m + NGW;
        const float* s0 = m < MP ? xp + (size_t)m * DM : (m < MT ? xs + (size_t)(m - MP) * DM : xm + (size_t)(m - MT) * DM);
        if (m2 < MT + 1024) { const float* s1 = m2 < MP ? xp + (size_t)m2 * DM : (m2 < MT ? xs + (size_t)(m2 - MP) * DM : xm + (size_t)(m2 - MT) * DM);
            rms_rows2<false>(s0, m < MT ? gx : gm, XN + (size_t)m * DM, s1, m2 < MT ? gx : gm, XN + (size_t)m2 * DM, F.lane); }
        else rms_row<false>(s0, m < MT ? gx : gm, XN + (size_t)m * DM, F.lane);
      } }
    bf16_t* WS = WSP(bf16_t, WS_WSP);
    for (int i = F.bx * 512 + F.tid; i < 4 * 128 * 128; i += F.G * 512) { const int t = (i >> 7) & 127, s = i & 127; const float w = (s <= t) ? IN(10)[i] : 0.f; WS[i] = (bf16_t)(cvt_pk_bf16(w, 0.f) & 0xffff); }
}

__device__ __forceinline__ void phase_mixprep(Frame& F) {
    const bf16_t* P1 = WSP(bf16_t, WS_P1);
    {
        bf16_t* YB = WSP(bf16_t, WS_YA);   const float* cw = IN(12); const float* st = IN(2);
        for (int it = F.bx * 512 + F.tid; it < (MT / 4) * 128; it += F.G * 512) {
            const int r0 = (it >> 7) * 4, c0 = (it & 127) * 8;
            const bool prompt = r0 < MP;
            const int pos0 = prompt ? (r0 & 2047) : ((r0 - MP) & 7), b = prompt ? (r0 >> 11) : ((r0 - MP) >> 3);
            float p[6][8], bg[4][8];
            if (pos0 >= 2) {
#pragma unroll
                for (int k = 0; k < 2; ++k) { float cg[8], xi[8]; unpack8(*(const u32x4*)(P1 + (size_t)(r0 - 2 + k) * NIN + C_CG + c0), cg); unpack8(*(const u32x4*)(P1 + (size_t)(r0 - 2 + k) * NIN + C_XIN + c0), xi);
#pragma unroll
                    for (int e = 0; e < 8; ++e) p[k][e] = cg[e] * xi[e]; }
            } else if (prompt) {
#pragma unroll
                for (int k = 0; k < 2; ++k)
#pragma unroll
                    for (int e = 0; e < 8; ++e) p[k][e] = 0.f;
            } else {
#pragma unroll
                for (int k = 0; k < 2; ++k) { const f32x4 a = *(const f32x4*)(st + ((size_t)b * 2 + k) * 1024 + c0), c = *(const f32x4*)(st + ((size_t)b * 2 + k) * 1024 + c0 + 4);
                    p[k][0] = a.x; p[k][1] = a.y; p[k][2] = a.z; p[k][3] = a.w; p[k][4] = c.x; p[k][5] = c.y; p[k][6] = c.z; p[k][7] = c.w; }
            }
#pragma unroll
            for (int i = 0; i < 4; ++i) { float cg[8], xi[8]; const bf16_t* pr = P1 + (size_t)(r0 + i) * NIN;
                unpack8(*(const u32x4*)(pr + C_CG + c0), cg); unpack8(*(const u32x4*)(pr + C_XIN + c0), xi); unpack8(*(const u32x4*)(pr + C_BG + c0), bg[i]);
#pragma unroll
                for (int e = 0; e < 8; ++e) p[2 + i][e] = cg[e] * xi[e]; }
            float w0[8], w1[8], w2[8];
#pragma unroll
            for (int e = 0; e < 8; ++e) { w0[e] = cw[c0 + e]; w1[e] = cw[1024 + c0 + e]; w2[e] = cw[2048 + c0 + e]; }
#pragma unroll
            for (int i = 0; i < 4; ++i) { float y[8];
#pragma unroll
                for (int e = 0; e < 8; ++e) y[e] = bg[i][e] * (w0[e] * p[i][e] + w1[e] * p[i + 1][e] + w2[e] * p[i + 2][e]);
                u32x4 w; w.x = cvt_pk_bf16(y[0], y[1]); w.y = cvt_pk_bf16(y[2], y[3]); w.z = cvt_pk_bf16(y[4], y[5]); w.w = cvt_pk_bf16(y[6], y[7]);
                *(u32x4*)(YB + (size_t)(r0 + i) * DM + 1024 + c0) = w; }
            if (pos0 == (prompt ? 2044 : 4)) {
                float* o = F.out + (prompt ? O_CP : O_CS) + ((size_t)b * 2) * 1024 + c0;
                *(f32x4*)o = (f32x4){p[4][0], p[4][1], p[4][2], p[4][3]}; *(f32x4*)(o + 4) = (f32x4){p[4][4], p[4][5], p[4][6], p[4][7]};
                *(f32x4*)(o + 1024) = (f32x4){p[5][0], p[5][1], p[5][2], p[5][3]}; *(f32x4*)(o + 1028) = (f32x4){p[5][4], p[5][5], p[5][6], p[5][7]};
            }
        }
    }
    {
        const float* lg = IN(8); const float* lb = IN(9); const float* wsp = IN(10); const float* bsp = IN(11);
        bf16_t* YA = WSP(bf16_t, WS_YA);
        const int gw = F.bx * NWAVES + F.wave, NGW = F.G * NWAVES;
        for (int item = gw; item < 256; item += NGW) {
            const int sq = item >> 1, jsel = item & 1;
            const int row0 = MP + sq * 8;
            float mu[8], rs[8];
            { float m4[4], r4[4], vlo[4][8], vhi[4][8];
              ln_stats<4>(P1 + (size_t)row0 * NIN + C_V + 8 * F.lane, NIN, m4, r4, vlo, vhi);
#pragma unroll
              for (int t = 0; t < 4; ++t) { mu[t] = m4[t]; rs[t] = r4[t]; }
              ln_stats<4>(P1 + (size_t)(row0 + 4) * NIN + C_V + 8 * F.lane, NIN, m4, r4, vlo, vhi);
#pragma unroll
              for (int t = 0; t < 4; ++t) { mu[4 + t] = m4[t]; rs[4 + t] = r4[t]; } }
            {
                const int j = jsel; const int c0 = 8 * F.lane + 512 * j, g = c0 >> 8;
                float gg[8], bb[8];
                { const f32x4 a = *(const f32x4*)(lg + c0), b = *(const f32x4*)(lg + c0 + 4), c = *(const f32x4*)(lb + c0), d = *(const f32x4*)(lb + c0 + 4);
                  gg[0] = a.x; gg[1] = a.y; gg[2] = a.z; gg[3] = a.w; gg[4] = b.x; gg[5] = b.y; gg[6] = b.z; gg[7] = b.w;
                  bb[0] = c.x; bb[1] = c.y; bb[2] = c.z; bb[3] = c.w; bb[4] = d.x; bb[5] = d.y; bb[6] = d.z; bb[7] = d.w; }
                float vl[8][8];
#pragma unroll
                for (int t = 0; t < 8; ++t) {
                    float a[8]; unpack8(*(const u32x4*)(P1 + (size_t)(row0 + t) * NIN + C_V + c0), a);
#pragma unroll
                    for (int e = 0; e < 8; ++e) vl[t][e] = (a[e] - mu[t]) * rs[t] * gg[e] + bb[e];
                    float* o = F.out + O_CV + (size_t)(sq * 8 + t) * 1024 + c0;
                    *(f32x4*)o = (f32x4){vl[t][0], vl[t][1], vl[t][2], vl[t][3]}; *(f32x4*)(o + 4) = (f32x4){vl[t][4], vl[t][5], vl[t][6], vl[t][7]};
                }
#pragma unroll
                for (int t = 0; t < 8; ++t) {
                    float z[8]; const float bs = bsp[g * 128 + t];
#pragma unroll
                    for (int e = 0; e < 8; ++e) z[e] = bs;
#pragma unroll
                    for (int s = 0; s < 8; ++s) if (s <= t) { const float w = wsp[(size_t)g * 16384 + t * 128 + s];
#pragma unroll
                        for (int e = 0; e < 8; ++e) z[e] += w * vl[s][e]; }
                    float uf[8]; unpack8(*(const u32x4*)(P1 + (size_t)(row0 + t) * NIN + C_U + c0), uf);
                    u32x4 w; w.x = cvt_pk_bf16(uf[0] * z[0], uf[1] * z[1]); w.y = cvt_pk_bf16(uf[2] * z[2], uf[3] * z[3]); w.z = cvt_pk_bf16(uf[4] * z[4], uf[5] * z[5]); w.w = cvt_pk_bf16(uf[6] * z[6], uf[7] * z[7]);
                    *(u32x4*)(YA + (size_t)(row0 + t) * DM + c0) = w;
                }
            }
        }
    }
    {
        const float* lg = IN(8); const float* lb = IN(9);
        bf16_t* VT = WSP(bf16_t, WS_VT);
        LAS bf16_t* T = (LAS bf16_t*)F.lds;
        for (int un = F.bx; un < 256; un += F.G) {
            const int chunk = un >> 2, g = un & 3;
            const bool mine = ((F.lane >> 5) == (g & 1));
            const int cm = 256 * g + 8 * (F.lane & 31);
            float gg[8], bb[8];
            { const f32x4 a = *(const f32x4*)(lg + cm), b = *(const f32x4*)(lg + cm + 4), c = *(const f32x4*)(lb + cm), d = *(const f32x4*)(lb + cm + 4);
              gg[0] = a.x; gg[1] = a.y; gg[2] = a.z; gg[3] = a.w; gg[4] = b.x; gg[5] = b.y; gg[6] = b.z; gg[7] = b.w;
              bb[0] = c.x; bb[1] = c.y; bb[2] = c.z; bb[3] = c.w; bb[4] = d.x; bb[5] = d.y; bb[6] = d.z; bb[7] = d.w; }
            for (int rr = 0; rr < 16; rr += 4) {
                const int s0 = F.wave * 16 + rr;
                float mean[4], rstd[4], vlo[4][8], vhi[4][8];
                ln_stats<4>(P1 + (size_t)(chunk * 128 + s0) * NIN + C_V + 8 * F.lane, NIN, mean, rstd, vlo, vhi);
                if (mine) {
#pragma unroll
                    for (int r = 0; r < 4; ++r) {
                        float y[8];
#pragma unroll
                        for (int e = 0; e < 8; ++e) { const float xl = vlo[r][e], xh = vhi[r][e]; const float x = (g >> 1) ? xh : xl; y[e] = (x - mean[r]) * rstd[r] * gg[e] + bb[e]; }
                        u32x4 w; w.x = cvt_pk_bf16(y[0], y[1]); w.y = cvt_pk_bf16(y[2], y[3]); w.z = cvt_pk_bf16(y[4], y[5]); w.w = cvt_pk_bf16(y[6], y[7]);
                        *(LAS u32x4*)(T + (s0 + r) * 264 + 8 * (F.lane & 31)) = w;
                    }
                }
            }
            __syncthreads();
#pragma unroll 2
            for (int itn = 0; itn < 8; ++itn) {
                const int idx = itn * 512 + F.tid, c = idx >> 4, sb = idx & 15;
                unsigned short h[8];
#pragma unroll
                for (int i = 0; i < 8; ++i) h[i] = T[(8 * sb + i) * 264 + c];
                u32x4 w; w.x = (unsigned)h[0] | ((unsigned)h[1] << 16); w.y = (unsigned)h[2] | ((unsigned)h[3] << 16); w.z = (unsigned)h[4] | ((unsigned)h[5] << 16); w.w = (unsigned)h[6] | ((unsigned)h[7] << 16);
                *(u32x4*)(VT + ((size_t)chunk * 1024 + g * 256 + c) * 128 + 8 * sb) = w;
            }
            __syncthreads();
        }
    }
}

__device__ __forceinline__ void sample_attn_unit(Frame& F, int unit, bool tail) {
    const int b = unit >> 2, h = unit & 3, lane = F.lane, wave = F.wave, r16 = lane & 15, kq = lane >> 4;
    const float* Kb = IN(3) + ((size_t)b * NMEM * XH + h) * XD;
    const float* Vb = IN(4) + ((size_t)b * NMEM * XH + h) * XD;
    const bf16_t* Qb = WSP(bf16_t, WS_Q) + (size_t)(MP + b * 8) * DM + h * XD;
    LAS bf16_t* sP = (LAS bf16_t*)F.lds;
    LAS float* sSt = (LAS float*)(F.lds + 16 * 528);
    LAS bf16_t* sQ = (LAS bf16_t*)(F.lds + 9472);
    if (tail) {
        const int t = F.tid >> 6, d0 = (F.tid & 63) * 8;
        const bf16_t* pp = WSP(bf16_t, WS_PART) + (size_t)(b * 8 + t) * DM + h * XD + d0;
        f32x4 a0 = {0.f, 0.f, 0.f, 0.f}, a1 = {0.f, 0.f, 0.f, 0.f};
#pragma unroll
        for (int s = 0; s < 8; ++s) { float f[8]; unpack8(*(const u32x4*)(pp + (size_t)s * (MS * DM)), f); a0 = a0 + (f32x4){f[0], f[1], f[2], f[3]}; a1 = a1 + (f32x4){f[4], f[5], f[6], f[7]}; }
        a0 = a0 * QSCALE; a1 = a1 * QSCALE;
        *(LAS bf16x8*)(sQ + t * 520 + d0) = pack8(a0, a1);
        __syncthreads();
    }
    f32x4 s0 = {0.f, 0.f, 0.f, 0.f}, s1 = {0.f, 0.f, 0.f, 0.f};
    const float* k0p = Kb + (size_t)(32 * wave + r16) * (XH * XD) + kq * 8;
    const float* k1p = k0p + (size_t)16 * (XH * XD);
    const bf16_t* qp = Qb + (size_t)(r16 & 7) * DM + kq * 8;
#pragma unroll 8
    for (int ds = 0; ds < 16; ++ds) {
        const f32x4 a0 = *(const f32x4*)(k0p + ds * 32), a1 = *(const f32x4*)(k0p + ds * 32 + 4);
        const f32x4 c0 = *(const f32x4*)(k1p + ds * 32), c1 = *(const f32x4*)(k1p + ds * 32 + 4);
        u32x4 qw = tail ? *(const LAS u32x4*)(sQ + (r16 & 7) * 520 + kq * 8 + ds * 32) : *(const u32x4*)(qp + ds * 32); if (r16 >= 8) qw = (u32x4){0u, 0u, 0u, 0u};
        const bf16x8 qf = __builtin_bit_cast(bf16x8, qw);
        s0 = __builtin_amdgcn_mfma_f32_16x16x32_bf16(pack8(a0, a1), qf, s0, 0, 0, 0);
        s1 = __builtin_amdgcn_mfma_f32_16x16x32_bf16(pack8(c0, c1), qf, s1, 0, 0, 0);
    }
    float mx = fmaxf(fmaxf(fmaxf(s0[0], s0[1]), fmaxf(s0[2], s0[3])), fmaxf(fmaxf(s1[0], s1[1]), fmaxf(s1[2], s1[3])));
    mx = fmaxf(mx, __shfl_xor(mx, 16)); mx = fmaxf(mx, __shfl_xor(mx, 32));
    float sm = 0.f;
#pragma unroll
    for (int j = 0; j < 4; ++j) { s0[j] = __expf(s0[j] - mx); s1[j] = __expf(s1[j] - mx); sm += s0[j] + s1[j]; }
    sm += __shfl_xor(sm, 16); sm += __shfl_xor(sm, 32);
    if (kq == 0) { sSt[(wave * 16 + r16) * 2] = mx; sSt[(wave * 16 + r16) * 2 + 1] = sm; }
    __syncthreads();
    float M = -3.0e38f;
#pragma unroll
    for (int w2 = 0; w2 < 8; ++w2) M = fmaxf(M, sSt[(w2 * 16 + r16) * 2]);
    float L = 0.f;
#pragma unroll
    for (int w2 = 0; w2 < 8; ++w2) L += sSt[(w2 * 16 + r16) * 2 + 1] * __expf(sSt[(w2 * 16 + r16) * 2] - M);
    const float f = __expf(mx - M) / L;
    { u32x2 w; w.x = cvt_pk_bf16(s0[0] * f, s0[1] * f); w.y = cvt_pk_bf16(s0[2] * f, s0[3] * f); *(LAS u32x2*)(sP + r16 * 264 + 32 * wave + 4 * kq) = w;
      w.x = cvt_pk_bf16(s1[0] * f, s1[1] * f); w.y = cvt_pk_bf16(s1[2] * f, s1[3] * f); *(LAS u32x2*)(sP + r16 * 264 + 32 * wave + 16 + 4 * kq) = w; }
    __syncthreads();
    f32x4 o[4];
#pragma unroll
    for (int c = 0; c < 4; ++c) o[c] = (f32x4){0.f, 0.f, 0.f, 0.f};
    const float* vp = Vb + (size_t)(kq * 8) * (XH * XD) + 64 * wave + 4 * r16;
#pragma unroll 4
    for (int ms = 0; ms < 8; ++ms) {
        const bf16x8 pf = *(const LAS bf16x8*)(sP + r16 * 264 + ms * 32 + kq * 8);
        f32x4 x[8];
#pragma unroll
        for (int j = 0; j < 8; ++j) x[j] = *(const f32x4*)(vp + (size_t)(ms * 32 + j) * (XH * XD));
#pragma unroll
        for (int c = 0; c < 4; ++c) {
            const bf16x8 a = pack8((f32x4){x[0][c], x[1][c], x[2][c], x[3][c]}, (f32x4){x[4][c], x[5][c], x[6][c], x[7][c]});
            o[c] = __builtin_amdgcn_mfma_f32_16x16x32_bf16(a, pf, o[c], 0, 0, 0);
        }
    }
    if (r16 < 8) {
        bf16_t* op = WSP(bf16_t, WS_O) + (size_t)(MP + b * 8 + r16) * DM + h * XD + 64 * wave + 16 * kq;
        u32x4 w0, w1;
        w0.x = cvt_pk_bf16(o[0][0], o[1][0]); w0.y = cvt_pk_bf16(o[2][0], o[3][0]); w0.z = cvt_pk_bf16(o[0][1], o[1][1]); w0.w = cvt_pk_bf16(o[2][1], o[3][1]);
        w1.x = cvt_pk_bf16(o[0][2], o[1][2]); w1.y = cvt_pk_bf16(o[2][2], o[3][2]); w1.z = cvt_pk_bf16(o[0][3], o[1][3]); w1.w = cvt_pk_bf16(o[2][3], o[3][3]);
        *(u32x4*)op = w0; *(u32x4*)(op + 8) = w1;
    }
    __syncthreads();
}

template <bool OUT_F32> __device__ __forceinline__ void rms_store(const float (&v)[4][8], float r, const float* g, void* orow, int lane) {
#pragma unroll
    for (int j = 0; j < 4; ++j) { const int c = 8 * lane + 512 * j; const f32x4 g0 = *(const f32x4*)(g + c), g1 = *(const f32x4*)(g + c + 4);
        const f32x4 a = (f32x4){v[j][0], v[j][1], v[j][2], v[j][3]} * r * g0, b = (f32x4){v[j][4], v[j][5], v[j][6], v[j][7]} * r * g1;
        if (OUT_F32) { *(f32x4*)((float*)orow + c) = a; *(f32x4*)((float*)orow + c + 4) = b; }
        else { u32x4 w; w.x = cvt_pk_bf16(a.x, a.y); w.y = cvt_pk_bf16(a.z, a.w); w.z = cvt_pk_bf16(b.x, b.y); w.w = cvt_pk_bf16(b.z, b.w); *(u32x4*)((bf16_t*)orow + c) = w; } }
}
template <bool OUT_F32> __device__ __forceinline__ void phase_rms(Frame& F, const bf16_t* src, const float* g, void* dst, const bf16_t* part, const float* sbaseF, const bf16_t* sbaseH, bf16_t* hout) {
    const int gw = F.bx * NWAVES + F.wave, NGW = F.G * NWAVES, lane = F.lane;
    for (int mm = gw; mm < MT; mm += 2 * NGW) {
      const int m2 = mm + NGW; const bool reg0 = (mm < MP || part == nullptr), reg1 = (m2 < MT) && (m2 < MP || part == nullptr);
      if (reg0 && reg1) {
        float v0[4][8], v1[4][8]; float s0 = 0.f, s1 = 0.f;
#pragma unroll
        for (int j = 0; j < 4; ++j) { unpack8(*(const u32x4*)(src + (size_t)mm * DM + 8 * lane + 512 * j), v0[j]); unpack8(*(const u32x4*)(src + (size_t)m2 * DM + 8 * lane + 512 * j), v1[j]); }
#pragma unroll
        for (int j = 0; j < 4; ++j)
#pragma unroll
            for (int e = 0; e < 8; ++e) { s0 += v0[j][e] * v0[j][e]; s1 += v1[j][e] * v1[j][e]; }
#pragma unroll
        for (int o = 1; o < 64; o <<= 1) { s0 += __shfl_xor(s0, o); s1 += __shfl_xor(s1, o); }
        rms_store<OUT_F32>(v0, rsqrtf(s0 * (1.f / DM) + EPS), g, OUT_F32 ? (void*)((float*)dst + (size_t)mm * DM) : (void*)((bf16_t*)dst + (size_t)mm * DM), lane);
        rms_store<OUT_F32>(v1, rsqrtf(s1 * (1.f / DM) + EPS), g, OUT_F32 ? (void*)((float*)dst + (size_t)m2 * DM) : (void*)((bf16_t*)dst + (size_t)m2 * DM), lane);
        continue;
      }
      for (int m = mm; m <= m2 && m < MT; m += NGW) {
        void* orow = OUT_F32 ? (void*)((float*)dst + (size_t)m * DM) : (void*)((bf16_t*)dst + (size_t)m * DM);
        float v[4][8]; float ss = 0.f;
        if (m < MP || part == nullptr) {
#pragma unroll
            for (int j = 0; j < 4; ++j) unpack8(*(const u32x4*)(src + (size_t)m * DM + 8 * lane + 512 * j), v[j]);
        } else {
            const int ms = m - MP;
#pragma unroll
            for (int j = 0; j < 4; ++j) { const int c = 8 * lane + 512 * j;
                if (sbaseF) { const f32x4 a = *(const f32x4*)(sbaseF + (size_t)ms * DM + c), b = *(const f32x4*)(sbaseF + (size_t)ms * DM + c + 4);
                    v[j][0] = a.x; v[j][1] = a.y; v[j][2] = a.z; v[j][3] = a.w; v[j][4] = b.x; v[j][5] = b.y; v[j][6] = b.z; v[j][7] = b.w; }
                else unpack8(*(const u32x4*)(sbaseH + (size_t)ms * DM + c), v[j]); }
#pragma unroll
            for (int s = 0; s < 8; ++s)
#pragma unroll
                for (int j = 0; j < 4; ++j) { float f[8]; unpack8(*(const u32x4*)(part + (size_t)s * (MS * DM) + (size_t)ms * DM + 8 * lane + 512 * j), f);
#pragma unroll
                    for (int e = 0; e < 8; ++e) v[j][e] += f[e]; }
            if (hout) {
#pragma unroll
                for (int j = 0; j < 4; ++j) { u32x4 w; w.x = cvt_pk_bf16(v[j][0], v[j][1]); w.y = cvt_pk_bf16(v[j][2], v[j][3]); w.z = cvt_pk_bf16(v[j][4], v[j][5]); w.w = cvt_pk_bf16(v[j][6], v[j][7]);
                    *(u32x4*)(hout + (size_t)ms * DM + 8 * lane + 512 * j) = w;
                    unpack8(w, v[j]); }
            }
        }
#pragma unroll
        for (int j = 0; j < 4; ++j)
#pragma unroll
            for (int e = 0; e < 8; ++e) ss += v[j][e] * v[j][e];
        rms_store<OUT_F32>(v, rsqrtf(wave_sum(ss) * (1.f / DM) + EPS), g, orow, lane);
      }
    }
}

__global__ void __launch_bounds__(NWAVES * 64, 2) fwd_megakernel(Args args) {
    extern __shared__ __attribute__((aligned(16))) unsigned char lds_raw[];
    cg::grid_group grid = cg::this_grid();
    Frame F;
    F.lds = (LAS unsigned char*)lds_raw;
    F.tid = threadIdx.x; F.lane = F.tid & 63; F.wave = __builtin_amdgcn_readfirstlane(F.tid >> 6);
    F.G = gridDim.x; F.bx = blockIdx.x;
    F.out = args.out; F.ws = args.ws;
    volatile LAS unsigned* MISC = (volatile LAS unsigned*)(F.lds + 131072 + 320);
    if (F.tid < 32) MISC[F.tid] = 0u;
    __syncthreads();
    XcdBarrier xbar = xcd_barrier_post((unsigned*)(F.ws + WS_CTL) + 4096, MISC + 8);
#define SEAM0() do { grid.sync(); int t_ = threadIdx.x; asm volatile("" : "+v"(t_)); F.tid = t_; F.lane = t_ & 63; } while (0)
#define SEAM() do { xcd_barrier(xbar); int t_ = threadIdx.x; asm volatile("" : "+v"(t_)); F.tid = t_; F.lane = t_ & 63; { unsigned char* w_ = F.ws; float* o_ = F.out; asm volatile("" : "+s"(w_), "+s"(o_)); F.ws = w_; F.out = o_; } } while (0)
#ifndef PHASE_MASK
#define PHASE_MASK 0xffffffffu
#endif
#define PH(k) ((PHASE_MASK >> (k)) & 1u)
    using namespace pg8;
    const char* XN = (const char*)(F.ws + WS_XN);
    const bool tail = (F.G == 256);

    if (PH(0)) phase_prologue(F);
    if (F.G > (1 << 24)) SEAM0();
    SEAM();
    if (PH(1)) {
        SchedIn S{XN, (const char*)(F.ws + WS_WIN), F.G, F.bx};
        EpiIn E{WSP(bf16_t, WS_P1), F.out + O_MK, F.out + O_MV, WSP(bf16_t, WS_KP), WSP(bf16_t, WS_VPT)};
        gemm_phase<EpiIn, SchedIn, true>(F.lds, DM, DM, S, E);
        convert_fill(F, CV_A1, CV_B1, 1296 + 64);
    }
    SEAM();
    if (PH(2)) phase_mixprep(F);
    asm volatile("s_waitcnt vmcnt(0)" ::: "memory"); __syncthreads();
    { int t_ = threadIdx.x; asm volatile("" : "+v"(t_)); F.tid = t_; F.lane = t_ & 63; }
    if (PH(3)) {
        SchedSp S{(const char*)(F.ws + WS_WSP), (const char*)(F.ws + WS_VT), F.G, F.bx};
        EpiSp E{WSP(bf16_t, WS_P1), IN(11), WSP(bf16_t, WS_YA)};
        gemm_phase<EpiSp, SchedSp, true>(F.lds, 128, 128, S, E);
    }
    SEAM();
    if (PH(4)) {
        SchedRect S{(const char*)(F.ws + WS_YA), (const char*)(F.ws + WS_WA), (size_t)BM * DM * 2, (size_t)BM * DM * 2, 36, 8, F.G, F.bx, 32};
        EpiMerged E{WSP(bf16_t, WS_P1), WSP(bf16_t, WS_MRG)};
        gemm_phase<EpiMerged, SchedRect, true>(F.lds, DM, DM, S, E);
        convert_fill(F, CV_B1, CV_C1, 288);
    }
    SEAM();
    if (PH(6)) {
        SchedTail S{(const char*)(F.ws + WS_MRG), (const char*)(F.ws + WS_WMIX), (size_t)BM * DM * 2, (size_t)BM * DM * 2, 32, F.G, F.bx, tail};
        EpiTail<EpiRes<true>> E{{IN(0), IN(1), MP, nullptr, WSP(bf16_t, WS_H1)}, WSP(bf16_t, WS_PART)};
        gemm_phase<EpiTail<EpiRes<true>>, SchedTail, true>(F.lds, DM, DM, S, E);
    }
    SEAM();
    phase_rms<false>(F, WSP(bf16_t, WS_H1), IN(16), WSP(bf16_t, WS_XN), tail ? WSP(bf16_t, WS_PART) : nullptr, IN(1), nullptr, WSP(bf16_t, WS_H1) + (size_t)MP * DM);
    SEAM();
    if (PH(7)) {
        SchedTail S{XN, (const char*)(F.ws + WS_WQ), (size_t)BM * DM * 2, (size_t)BM * DM * 2, 32, F.G, F.bx, tail};
        EpiTail<EpiBf<0>> E{{WSP(bf16_t, WS_Q), DM, QSCALE}, WSP(bf16_t, WS_PART)};
        gemm_phase<EpiTail<EpiBf<0>>, SchedTail, true>(F.lds, DM, DM, S, E);
    }
    SEAM();
    if (PH(8)) {
        {
            SchedS S{(const char*)(F.ws + WS_Q), (const char*)(F.ws + WS_KP), F.G, F.bx};
            EpiSoftmax E{WSP(bf16_t, WS_PS)};
            gemm_phase<EpiSoftmax, SchedS, false>(F.lds, DM, DM, S, E);
        }
        asm volatile("s_waitcnt vmcnt(0)" ::: "memory"); __syncthreads();
        {
            SchedO S{(const char*)(F.ws + WS_PS), (const char*)(F.ws + WS_VPT), F.G, F.bx};
            EpiBf<0> E{WSP(bf16_t, WS_O), DM, 1.0f};
            gemm_phase<EpiBf<0>, SchedO, true>(F.lds, 256, 256, S, E);
        }
        __syncthreads();
        unsigned* qhead = (unsigned*)(F.ws + WS_CTL) + 2048;
        for (;;) {
            if (F.tid == 0) MISC[16] = __hip_atomic_fetch_add(qhead, 1u, __ATOMIC_RELAXED, __HIP_MEMORY_SCOPE_AGENT);
            __syncthreads();
            const int un = (int)MISC[16];
            if (un >= 512) break;
            sample_attn_unit(F, un, tail);
        }
    }
    SEAM();
    if (PH(10)) {
        SchedTail S{(const char*)(F.ws + WS_O), (const char*)(F.ws + WS_WXO), (size_t)BM * DM * 2, (size_t)BM * DM * 2, 32, F.G, F.bx, tail};
        EpiTail<EpiRes<false>> E{{nullptr, nullptr, 1 << 30, WSP(bf16_t, WS_H1), WSP(bf16_t, WS_H2)}, WSP(bf16_t, WS_PART)};
        gemm_phase<EpiTail<EpiRes<false>>, SchedTail, true>(F.lds, DM, DM, S, E);
    }
    SEAM();
    phase_rms<false>(F, WSP(bf16_t, WS_H2), IN(22), WSP(bf16_t, WS_XN), tail ? WSP(bf16_t, WS_PART) : nullptr, nullptr, WSP(bf16_t, WS_H1) + (size_t)MP * DM, WSP(bf16_t, WS_H2) + (size_t)MP * DM);
    SEAM();
    if (PH(11)) {
        SchedRect S{XN, (const char*)(F.ws + WS_WUP), (size_t)BM * DM * 2, (size_t)BM * DM * 2, 36, 32, F.G, F.bx, 32};
        EpiBf<1> E{WSP(bf16_t, WS_UP), FF, 1.0f};
        gemm_phase<EpiBf<1>, SchedRect, true>(F.lds, DM, DM, S, E);
        convert_fill(F, CV_C1, CV_D1, 36 * 32);
    }
    SEAM();
    if (PH(12)) {
        SchedTail S{(const char*)(F.ws + WS_UP), (const char*)(F.ws + WS_WDN), (size_t)BM * FF * 2, (size_t)BM * FF * 2, 128, F.G, F.bx, tail};
        EpiTail<EpiRes<false>> E{{nullptr, nullptr, 1 << 30, WSP(bf16_t, WS_H2), WSP(bf16_t, WS_H2)}, WSP(bf16_t, WS_PART)};
        gemm_phase<EpiTail<EpiRes<false>>, SchedTail, true>(F.lds, FF, FF, S, E);
    }
    SEAM();
    phase_rms<true>(F, WSP(bf16_t, WS_H2), IN(25), F.out + O_Y, tail ? WSP(bf16_t, WS_PART) : nullptr, nullptr, WSP(bf16_t, WS_H2) + (size_t)MP * DM, nullptr);
}

extern "C" void kernel_launch(void* const* d_in, const int* in_sizes, int n_in, void* d_out, int out_size, void* d_ws, size_t ws_size, hipStream_t stream) {
    static int grid = 0;
    if (grid == 0) {
        if (n_in != 26 || ws_size < WS_END) { fprintf(stderr, "kernel_launch: unexpected n_in %d / ws_size %zu\n", n_in, ws_size); grid = -1; return; }
        int dev = 0, cus = 0, per_cu = 0;
        hipGetDevice(&dev);
        hipDeviceGetAttribute(&cus, hipDeviceAttributeMultiprocessorCount, dev);
        if (hipFuncSetAttribute((const void*)fwd_megakernel, hipFuncAttributeMaxDynamicSharedMemorySize, LDS_BYTES) != hipSuccess) { fprintf(stderr, "kernel_launch: hipFuncSetAttribute failed\n"); grid = -1; return; }
        if (hipOccupancyMaxActiveBlocksPerMultiprocessor(&per_cu, (const void*)fwd_megakernel, NWAVES * 64, LDS_BYTES) != hipSuccess || per_cu < 1) { fprintf(stderr, "kernel_launch: occupancy query says %d\n", per_cu); per_cu = 1; }
        (void)hipGetLastError();
        grid = cus;
        if (grid < 128) { fprintf(stderr, "kernel_launch: needs >= 128 CUs\n"); grid = -1; return; }
    }
    if (grid < 0) return;
    if (hipMemsetAsync((char*)d_ws + WS_CTL, 0, 65536, stream) != hipSuccess) { fprintf(stderr, "kernel_launch: memset failed\n"); return; }
    Args a{};
    for (int i = 0; i < 26; ++i) a.in[i] = (const float*)d_in[i];
    a.out = (float*)d_out; a.ws = (unsigned char*)d_ws;
    void* kargs[] = {&a};
    hipError_t e = hipLaunchCooperativeKernel((const void*)fwd_megakernel, dim3(grid), dim3(NWAVES * 64), kargs, LDS_BYTES, stream);
    if (e != hipSuccess) fprintf(stderr, "kernel_launch: cooperative launch failed: %s (grid %d)\n", hipGetErrorString(e), grid);
}
```

```cpp
#include <hip/hip_runtime.h>
#include <hip/hip_cooperative_groups.h>
#include <cstdio>
#include <cstdint>
namespace cg = cooperative_groups;

#define LAS __attribute__((address_space(3)))
typedef unsigned short bf16_t;
typedef short bf16x8 __attribute__((ext_vector_type(8)));
typedef float f32x4 __attribute__((ext_vector_type(4)));
typedef float f32x2 __attribute__((ext_vector_type(2)));
typedef unsigned u32x4 __attribute__((ext_vector_type(4)));
typedef unsigned u32x2 __attribute__((ext_vector_type(2)));

constexpr int DM = 2048, MP = 8192, MS = 1024, MT = MP + MS  ;
constexpr int NIN = 9216, FF = 8192, NMEM = 256, XH = 4, XD = 512;
constexpr int C_U = 0, C_V = 1024, C_BG = 2048, C_CG = 3072, C_XIN = 4096, C_GA = 5120, C_GB = 7168;
constexpr float EPS = 1e-6f, QSCALE = 0.04419417382415922f  ;
constexpr size_t O_Y = 0, O_MK = 18874368, O_MV = 20971520, O_CP = 23068672, O_CS = 23076864, O_CV = 23339008;
constexpr size_t MiB = 1u << 20;
constexpr size_t WS_CTL = 0, CTL_BYTES = 1 * MiB;
constexpr size_t WS_WIN = 2 * MiB;
constexpr size_t WS_WA = 54 * MiB, WS_WB = 58 * MiB;
constexpr size_t WS_WMIX = 62 * MiB, WS_WQ = 70 * MiB, WS_WXO = 78 * MiB;
constexpr size_t WS_WUP = 86 * MiB;
constexpr size_t WS_WDN = 118 * MiB;
constexpr size_t WS_WSP = 150 * MiB;
constexpr size_t WS_XN = 152 * MiB;
constexpr size_t WS_P1 = 192 * MiB;
constexpr size_t WS_UP = 192 * MiB;
constexpr size_t WS_VT = 354 * MiB;
constexpr size_t WS_YA = 370 * MiB, WS_YB = 388 * MiB;
constexpr size_t WS_TMP = 406 * MiB;
constexpr size_t WS_PART = 406 * MiB;
constexpr size_t WS_MRG = 478 * MiB;
constexpr size_t WS_H1 = 514 * MiB;
constexpr size_t WS_Q = 586 * MiB;
constexpr size_t WS_KP = 622 * MiB;
constexpr size_t WS_VPT = 626 * MiB;
constexpr size_t WS_PS = 630 * MiB;
constexpr size_t WS_O = 646 * MiB;
constexpr size_t WS_H2 = 682 * MiB;
constexpr size_t WS_END = 754 * MiB;

constexpr int LDS_BYTES = 147456;
constexpr int NWAVES = 8;

__device__ __forceinline__ unsigned cvt_pk_bf16(float lo, float hi) { unsigned r; asm volatile("v_cvt_pk_bf16_f32 %0, %1, %2" : "=v"(r) : "v"(lo), "v"(hi)); return r; }
__device__ __forceinline__ float bf_lo(unsigned u) { return __uint_as_float(u << 16); }
__device__ __forceinline__ float bf_hi(unsigned u) { return __uint_as_float(u & 0xffff0000u); }
__device__ __forceinline__ float bf1(bf16_t h) { return __uint_as_float(((unsigned)h) << 16); }
__device__ __forceinline__ bf16x8 pack8(f32x4 a, f32x4 b) {
    u32x4 w; w.x = cvt_pk_bf16(a.x, a.y); w.y = cvt_pk_bf16(a.z, a.w); w.z = cvt_pk_bf16(b.x, b.y); w.w = cvt_pk_bf16(b.z, b.w);
    return __builtin_bit_cast(bf16x8, w);
}
__device__ __forceinline__ void unpack8(u32x4 w, float (&f)[8]) {
    f[0] = bf_lo(w.x); f[1] = bf_hi(w.x); f[2] = bf_lo(w.y); f[3] = bf_hi(w.y); f[4] = bf_lo(w.z); f[5] = bf_hi(w.z); f[6] = bf_lo(w.w); f[7] = bf_hi(w.w);
}
__device__ __forceinline__ float wave_sum(float v) {
#pragma unroll
    for (int o = 1; o < 64; o <<= 1) v += __shfl_xor(v, o);
    return v;
}
__device__ __forceinline__ float sigmoidf_(float x) { return __builtin_amdgcn_rcpf(1.0f + __expf(-x)); }
#define LDS_WAIT() asm volatile("s_waitcnt lgkmcnt(0)" ::: "memory")

namespace pg8 {
constexpr int BM = 256, BK = 64, HALF = 128, HTB = HALF * BK * 2, STAGE_BYTES = 8 * HTB, NXCD = 8, WGM = 8;
__host__ __device__ __forceinline__ int lds_byte(int r, int c) { const int st = (r >> 4) * 2 + (c >> 5), rr = r & 15, cc = c & 31, ob = rr * 64 + cc * 2; return st * 1024 + (ob ^ (((ob >> 9) & 1) << 5)); }
__host__ __device__ __forceinline__ void stage_rc(int b, int& R, int& C) { const int st = b / 1024, sb = b % 1024, swz = sb ^ (((sb >> 9) & 1) << 5); R = (st >> 1) * 16 + swz / 64; C = (st & 1) * 32 + (swz % 64) / 2; }
__host__ __device__ __forceinline__ int perm32(int rho) { const int n = rho >> 4, i = rho & 15; return 8 * (i >> 2) + 4 * n + (i & 3); }

struct Unit { const char* A; const char* B; int orow, ocol, aux, nkt; };

__device__ __forceinline__ void rect_order(int L, int nM, int nN, int& pm, int& pn) {
    const int nwg = nM * nN; int wgid = L;
    { const int q = nwg / NXCD, r = nwg % NXCD, xcd = wgid % NXCD, off = wgid / NXCD; wgid = (xcd < r ? xcd * (q + 1) : r * (q + 1) + (xcd - r) * q) + off; }
    const int nig = WGM * nN, gid = wgid / nig, fm = gid * WGM, gsz = (nM - fm) < WGM ? (nM - fm) : WGM;
    pm = fm + ((wgid % nig) % gsz); pn = (wgid % nig) / gsz;
}

template <class Epi, class Sched, bool ALIGN_EPI>
__device__ __forceinline__ void gemm_phase(LAS unsigned char* lds, const int lda, const int ldb, const Sched& S, const Epi& E) {
    int tid_ = threadIdx.x; asm volatile("" : "+v"(tid_));
    const int tid = tid_, wid = __builtin_amdgcn_readfirstlane(tid >> 6), lane = tid & 63, wr = wid >> 2, wc = wid & 3, fr = lane & 15, fq = lane >> 4;
    unsigned voffA[2], voffB[2];
#pragma unroll
    for (int i = 0; i < 2; ++i) { int R, C; stage_rc(tid * 16 + i * 8192, R, C); const int Rb = Epi::PERM ? ((R & ~31) + perm32(R & 31)) : R;
        voffA[i] = (unsigned)(R * lda + C) * 2u; voffB[i] = (unsigned)(Rb * ldb + C) * 2u; }
    const size_t kstep = (size_t)(BK * 2);
    const size_t hstepA = (size_t)HALF * lda * 2, hstepB = (size_t)HALF * ldb * 2;
    const unsigned ldsw = (unsigned)wid * 1024u;
    const int aoff = lds_byte(wr * 64 + fr, fq * 8), boff = lds_byte(wc * 32 + fr, fq * 8);
#define PG8_SA(b, h) (((b) * 2 + (h)) * HTB)
#define PG8_SB(b, h) ((4 + (b) * 2 + (h)) * HTB)
#define PG8_STAGE(bufoff, gbase, voff) do { _Pragma("unroll") for (int _i = 0; _i < 2; ++_i) \
        __builtin_amdgcn_global_load_lds((const unsigned*)((const char*)(gbase) + (voff)[_i]), (LAS unsigned*)(lds + (bufoff) + ldsw + _i * 8192), 16, 0, 0); } while (0)
#define PG8_LDA(dst, b, h) do { _Pragma("unroll") for (int m = 0; m < 4; ++m) _Pragma("unroll") for (int k = 0; k < 2; ++k) dst[m][k] = *(const LAS bf16x8*)(lds + PG8_SA(b, h) + aoff + m * 2048 + k * 1024); } while (0)
#define PG8_LDB(dst, b, h) do { _Pragma("unroll") for (int n = 0; n < 2; ++n) _Pragma("unroll") for (int k = 0; k < 2; ++k) dst[n][k] = *(const LAS bf16x8*)(lds + PG8_SB(b, h) + boff + n * 2048 + k * 1024); } while (0)
#define PG8_MMA(ai, bj, At, Bt) do { __builtin_amdgcn_s_setprio(1); _Pragma("unroll") for (int m = 0; m < 4; ++m) _Pragma("unroll") for (int n = 0; n < 2; ++n) _Pragma("unroll") for (int k = 0; k < 2; ++k) \
        acc[ai][bj][m][n] = __builtin_amdgcn_mfma_f32_16x16x32_bf16(Bt[n][k], At[m][k], acc[ai][bj][m][n], 0, 0, 0); __builtin_amdgcn_s_setprio(0); } while (0)
#define PG8_WAIT_V(n) asm volatile("s_waitcnt vmcnt(" #n ")" ::: "memory")
#define PG8_WAIT_L(n) asm volatile("s_waitcnt lgkmcnt(" #n ")" ::: "memory")
#define PG8_BAR __builtin_amdgcn_s_barrier()
#define PG8_SCHED __builtin_amdgcn_sched_barrier(0)
    Unit cur, nxt; int ui = 0;
    if (!S.next(0, cur)) return;
    f32x4 acc[2][2][4][2];
#pragma unroll
    for (int a = 0; a < 2; ++a)
#pragma unroll
        for (int b = 0; b < 2; ++b)
#pragma unroll
            for (int m = 0; m < 4; ++m)
#pragma unroll
                for (int n = 0; n < 2; ++n) acc[a][b][m][n] = (f32x4){0.f, 0.f, 0.f, 0.f};
    bf16x8 At[4][2], B0[2][2], B1[2][2];
    const char* cA = cur.A; const char* cB = cur.B;
    PG8_STAGE(PG8_SB(0, 0), cB, voffB); PG8_STAGE(PG8_SB(0, 1), cB + hstepB, voffB); PG8_STAGE(PG8_SA(0, 0), cA, voffA); PG8_STAGE(PG8_SA(0, 1), cA + hstepA, voffA);
    if (wr == 1) PG8_BAR;
    PG8_WAIT_V(2); PG8_BAR;
    PG8_STAGE(PG8_SB(1, 0), cB + kstep, voffB); PG8_STAGE(PG8_SA(1, 0), cA + kstep, voffA); PG8_STAGE(PG8_SB(1, 1), cB + hstepB + kstep, voffB);
    PG8_WAIT_V(6); PG8_BAR;
    for (;;) {
        const bool has_next = S.next(ui + 1, nxt);
        int nt = cur.nkt; asm volatile("" : "+s"(nt));
        const char* nA = has_next ? nxt.A : cA; const char* nB = has_next ? nxt.B : cB;
        for (int t = 0; t < nt; t += 2) {
            const bool last = (t == nt - 2);
            const char* a1 = cA + (size_t)(t + 1) * kstep;
            const char* a2 = last ? nA : cA + (size_t)(t + 2) * kstep; const char* b2 = last ? nB : cB + (size_t)(t + 2) * kstep;
            const char* a3 = a2 + kstep; const char* b3 = b2 + kstep;
            if constexpr (Epi::MIDK) { if (t == (nt >> 1)) E.mid(acc, cur, wr, wc, fr, fq); }
            PG8_LDB(B0, 0, 0); PG8_LDB(B1, 0, 1); PG8_SCHED; PG8_LDA(At, 0, 0); PG8_STAGE(PG8_SA(1, 1), a1 + hstepA, voffA);
            PG8_WAIT_V(8); PG8_WAIT_L(0); PG8_BAR; PG8_MMA(0, 0, At, B0); PG8_MMA(0, 1, At, B1); PG8_BAR; PG8_SCHED;
            PG8_LDA(At, 0, 1); PG8_STAGE(PG8_SB(0, 0), b2, voffB); PG8_STAGE(PG8_SB(0, 1), b2 + hstepB, voffB); PG8_STAGE(PG8_SA(0, 0), a2, voffA);
            PG8_WAIT_V(8); PG8_WAIT_L(0); PG8_BAR; PG8_MMA(1, 0, At, B0); PG8_MMA(1, 1, At, B1); PG8_BAR; PG8_SCHED;
            PG8_LDB(B0, 1, 0); PG8_LDB(B1, 1, 1); PG8_SCHED; PG8_LDA(At, 1, 0); PG8_STAGE(PG8_SA(0, 1), a2 + hstepA, voffA);
            PG8_WAIT_V(8); PG8_WAIT_L(0); PG8_BAR; PG8_MMA(0, 0, At, B0); PG8_MMA(0, 1, At, B1); PG8_BAR; PG8_SCHED;
            PG8_LDA(At, 1, 1); PG8_STAGE(PG8_SB(1, 0), b3, voffB); PG8_STAGE(PG8_SB(1, 1), b3 + hstepB, voffB); PG8_STAGE(PG8_SA(1, 0), a3, voffA);
            PG8_WAIT_V(8); PG8_WAIT_L(0); PG8_BAR; PG8_MMA(1, 0, At, B0); PG8_MMA(1, 1, At, B1); PG8_BAR; PG8_SCHED;
        }
        if constexpr (ALIGN_EPI) { if (wr == 0) PG8_BAR; }
        if constexpr (!Epi::AFTER_DRAIN) { int fr_ = fr, fq_ = fq; asm volatile("" : "+v"(fr_), "+v"(fq_)); E(acc, cur, wr, wc, fr_, fq_); }
        if (!has_next) break;
#pragma unroll
        for (int a = 0; a < 2; ++a)
#pragma unroll
            for (int b = 0; b < 2; ++b)
#pragma unroll
                for (int m = 0; m < 4; ++m)
#pragma unroll
                    for (int n = 0; n < 2; ++n) acc[a][b][m][n] = (f32x4){0.f, 0.f, 0.f, 0.f};
        cur = nxt; cA = nA; cB = nB; ++ui;
        if constexpr (ALIGN_EPI) { if (wr == 1) PG8_BAR; }
    }
    PG8_WAIT_V(0);
    if constexpr (!ALIGN_EPI) { if (wr == 0) PG8_BAR; }
    PG8_BAR;
    if constexpr (Epi::AFTER_DRAIN) { E.fused(acc, cur, wr, wc, fr, fq, lds, wid, lane); }
#undef PG8_SA
#undef PG8_SB
#undef PG8_STAGE
#undef PG8_LDA
#undef PG8_LDB
#undef PG8_MMA
#undef PG8_WAIT_V
#undef PG8_WAIT_L
#undef PG8_BAR
#undef PG8_SCHED
}

struct SchedRect {
    const char* A; const char* B; size_t atile, btile; int nM, nN, G, c, NT;
    __device__ __forceinline__ bool next(int i, Unit& u) const {
        const int L = i * G + c; if (L >= nM * nN) return false;
        int pm, pn; rect_order(L, nM, nN, pm, pn);
        u.A = A + (size_t)pm * atile; u.B = B + (size_t)pn * btile; u.orow = pm * BM; u.ocol = pn * BM; u.aux = 0; u.nkt = NT; return true;
    }
};
struct SchedIn {
    const char* A; const char* B; int G, c;
    __device__ __forceinline__ bool next(int i, Unit& u) const {
        const int L = i * G + c; if (L >= 1296 + 64) return false;
        int pm, pn;
        if (L < 1296) { rect_order(L, 36, 36, pm, pn); u.orow = pm * BM; u.ocol = pn * BM; u.aux = 0; }
        else { const int l = L - 1296; pm = 36 + (l & 3); pn = 36 + (l >> 2); u.orow = (pm - 36) * BM; u.ocol = (pn - 36) * BM; u.aux = 1; }
        u.A = A + (size_t)pm * (BM * DM * 2); u.B = B + (size_t)pn * (BM * DM * 2); u.nkt = DM / BK; return true;
    }
};
struct SchedSp {
    const char* WSP; const char* VT; int G, c;
    __device__ __forceinline__ bool next(int i, Unit& u) const {
        const int L = i * G + c; if (L >= 256) return false;
        const int chunk = L >> 2, p = (L >> 1) & 1, gi = L & 1, g = 2 * p + gi;
        u.A = WSP + (size_t)p * (256 * 128 * 2); u.B = VT + ((size_t)chunk * 1024 + g * 256) * 128 * 2; u.orow = chunk * 128; u.ocol = g * 256; u.aux = gi; u.nkt = 2; return true;
    }
};
struct SchedS {
    const char* Q; const char* KP; int G, c;
    __device__ __forceinline__ bool next(int i, Unit& u) const {
        const int L = i * G + c; if (L >= 128 || i > 0) return false;
        const int b = L >> 5, h = (L >> 3) & 3, p = L & 7;
        u.A = Q + ((size_t)(b * 2048 + p * 256) * DM + h * XD) * 2; u.B = KP + ((size_t)(b * 256) * DM + h * XD) * 2;
        u.orow = (b * 4 + h) * 2048 + p * 256; u.ocol = 0; u.aux = 0; u.nkt = XD / BK; return true;
    }
};
struct SchedO {
    const char* PS; const char* VPT; int G, c;
    __device__ __forceinline__ bool next(int i, Unit& u) const {
        if (c >= 128 || i >= 2) return false;
        const int b = c >> 5, h = (c >> 3) & 3, p = c & 7, pn = i;
        u.A = PS + ((size_t)((b * 4 + h) * 2048 + p * 256) * 256) * 2; u.B = VPT + ((size_t)(b * 2048 + h * XD + pn * 256) * 256) * 2;
        u.orow = b * 2048 + p * 256; u.ocol = h * XD + pn * 256; u.aux = 0; u.nkt = 4; return true;
    }
};

struct SchedTail {
    const char* A; const char* B; size_t atile, btile; int NT, G, c; bool tail;
    __device__ __forceinline__ bool next(int i, Unit& u) const {
        if (!tail) { const int L = i * G + c; if (L >= 288) return false; int pm, pn; rect_order(L, 36, 8, pm, pn);
            u.A = A + (size_t)pm * atile; u.B = B + (size_t)pn * btile; u.orow = pm * BM; u.ocol = pn * BM; u.aux = 0; u.nkt = NT; return true; }
        const int vcu = (c & 7) * 32 + (c >> 3);
        if (i == 0) { const int pm = vcu >> 3, pn = vcu & 7; u.A = A + (size_t)pm * atile; u.B = B + (size_t)pn * btile; u.orow = pm * BM; u.ocol = pn * BM; u.aux = 0; u.nkt = NT; return true; }
        if (i == 1) { const int t = vcu >> 3, s = vcu & 7, pm = 32 + (t >> 3), pn = t & 7, nk = NT >> 3;
            u.A = A + (size_t)pm * atile + (size_t)(s * nk) * (BK * 2); u.B = B + (size_t)pn * btile + (size_t)(s * nk) * (BK * 2);
            u.orow = (t >> 3) * BM; u.ocol = pn * BM; u.aux = 1 + s; u.nkt = nk; return true; }
        return false;
    }
};
#define EPI_ROWS_BEGIN _Pragma("unroll") for (int ai = 0; ai < 2; ++ai) _Pragma("unroll") for (int m = 0; m < 4; ++m) { const int rl = ai * HALF + wr * 64 + m * 16 + fr;
#define EPI_ROWS_END }

struct EpiIn {
    static constexpr bool PERM = true, AFTER_DRAIN = false, MIDK = false;
    bf16_t* P1; float* memk; float* memv; bf16_t* KP; bf16_t* VPT;
    __device__ __forceinline__ void operator()(const f32x4 (&acc)[2][2][4][2], const Unit& u, int wr, int wc, int fr, int fq) const {
        const int cl0 = wc * 32 + 8 * fq;
        if (u.aux == 0) {
            const bool gate = u.ocol >= C_GA;
            EPI_ROWS_BEGIN
                bf16_t* rowp = P1 + (size_t)(u.orow + rl) * NIN + u.ocol + cl0;
#pragma unroll
                for (int bj = 0; bj < 2; ++bj) { f32x4 v0 = acc[ai][bj][m][0], v1 = acc[ai][bj][m][1];
                    if (gate) {
                        const f32x4 g0 = acc[ai][1][m][0], g1 = acc[ai][1][m][1];
#pragma unroll
                        for (int e = 0; e < 4; ++e) { const float sb0 = sigmoidf_(g0[e]), sb1 = sigmoidf_(g1[e]);
                            if (bj == 0) { v0[e] = sigmoidf_(v0[e]) * __builtin_amdgcn_rcpf(fmaxf(sb0, 1e-30f)); v1[e] = sigmoidf_(v1[e]) * __builtin_amdgcn_rcpf(fmaxf(sb1, 1e-30f)); }
                            else { v0[e] = fmaxf(sb0, 1e-30f); v1[e] = fmaxf(sb1, 1e-30f); } } }
                    u32x4 w; w.x = cvt_pk_bf16(v0[0], v0[1]); w.y = cvt_pk_bf16(v0[2], v0[3]); w.z = cvt_pk_bf16(v1[0], v1[1]); w.w = cvt_pk_bf16(v1[2], v1[3]);
                    *(u32x4*)(rowp + bj * HALF) = w; }
            EPI_ROWS_END
        } else {
            const bool isV = u.ocol >= DM; const int cb = u.ocol - (isV ? DM : 0) + cl0;
            float* fo = isV ? memv : memk;
            EPI_ROWS_BEGIN
                const int row = u.orow + rl;
#pragma unroll
                for (int bj = 0; bj < 2; ++bj) { const f32x4 v0 = acc[ai][bj][m][0], v1 = acc[ai][bj][m][1]; const int col = cb + bj * HALF;
                    *(f32x4*)(fo + (size_t)row * DM + col) = v0; *(f32x4*)(fo + (size_t)row * DM + col + 4) = v1;
                    u32x4 w; w.x = cvt_pk_bf16(v0[0], v0[1]); w.y = cvt_pk_bf16(v0[2], v0[3]); w.z = cvt_pk_bf16(v1[0], v1[1]); w.w = cvt_pk_bf16(v1[2], v1[3]);
                    if (!isV) { *(u32x4*)(KP + (size_t)row * DM + col) = w; }
                    else { bf16_t* vp = VPT + ((size_t)(row >> 8) * DM + col) * 256 + (row & 255);
                        vp[0 * 256] = (bf16_t)(w.x & 0xffff); vp[1 * 256] = (bf16_t)(w.x >> 16); vp[2 * 256] = (bf16_t)(w.y & 0xffff); vp[3 * 256] = (bf16_t)(w.y >> 16);
                        vp[4 * 256] = (bf16_t)(w.z & 0xffff); vp[5 * 256] = (bf16_t)(w.z >> 16); vp[6 * 256] = (bf16_t)(w.w & 0xffff); vp[7 * 256] = (bf16_t)(w.w >> 16); } }
            EPI_ROWS_END
        }
    }
};
struct EpiSp {
    static constexpr bool PERM = true, AFTER_DRAIN = false, MIDK = false;
    const bf16_t* P1; const float* bsp; bf16_t* YA;
    __device__ __forceinline__ void operator()(const f32x4 (&acc)[2][2][4][2], const Unit& u, int wr, int wc, int fr, int fq) const {
        const int g = u.ocol >> 8, cl0 = wc * 32 + 8 * fq;
#pragma unroll
        for (int ai = 0; ai < 2; ++ai) if (ai == u.aux) {
#pragma unroll
            for (int m = 0; m < 4; ++m) { const int t = wr * 64 + m * 16 + fr; const int row = u.orow + t; const float bs = bsp[g * 128 + t];
#pragma unroll
                for (int bj = 0; bj < 2; ++bj) { const int col = u.ocol + bj * HALF + cl0;
                    const u32x4 uw = *(const u32x4*)(P1 + (size_t)row * NIN + C_U + col); float uf[8]; unpack8(uw, uf);
                    const f32x4 v0 = acc[ai][bj][m][0], v1 = acc[ai][bj][m][1];
                    u32x4 w; w.x = cvt_pk_bf16(uf[0] * (v0[0] + bs), uf[1] * (v0[1] + bs)); w.y = cvt_pk_bf16(uf[2] * (v0[2] + bs), uf[3] * (v0[3] + bs));
                    w.z = cvt_pk_bf16(uf[4] * (v1[0] + bs), uf[5] * (v1[1] + bs)); w.w = cvt_pk_bf16(uf[6] * (v1[2] + bs), uf[7] * (v1[3] + bs));
                    *(u32x4*)(YA + (size_t)row * DM + col) = w; } }
        }
    }
};
struct EpiMerged {
    static constexpr bool PERM = true, AFTER_DRAIN = false, MIDK = true;
    const bf16_t* P1; bf16_t* MRG;
    __device__ __forceinline__ void mid(f32x4 (&acc)[2][2][4][2], const Unit& u, int wr, int wc, int fr, int fq) const {
        asm volatile("" : "+v"(fr), "+v"(fq));
        const bf16_t* pb = P1 + (size_t)(u.orow + wr * 64 + fr) * NIN + C_GA + (u.ocol >> 7) * 256 + wc * 32 + 8 * fq;
#pragma unroll
        for (int ai = 0; ai < 2; ++ai) {
            u32x4 r[4][2];
#pragma unroll
            for (int m = 0; m < 4; ++m)
#pragma unroll
                for (int bj = 0; bj < 2; ++bj) r[m][bj] = *(const u32x4*)(pb + (size_t)(ai * HALF + m * 16) * NIN + bj * 256);
#pragma unroll
            for (int m = 0; m < 4; ++m)
#pragma unroll
                for (int bj = 0; bj < 2; ++bj) { float f[8]; unpack8(r[m][bj], f);
#pragma unroll
                    for (int e = 0; e < 4; ++e) { acc[ai][bj][m][0][e] *= f[e]; acc[ai][bj][m][1][e] *= f[4 + e]; } }
            asm volatile("" ::: "memory");
        }
    }
    __device__ __forceinline__ void operator()(const f32x4 (&acc)[2][2][4][2], const Unit& u, int wr, int wc, int fr, int fq) const {
        const int cl0 = wc * 32 + 8 * fq;
        const bf16_t* pb = P1 + (size_t)(u.orow + wr * 64 + fr) * NIN + C_GA + (u.ocol >> 7) * 256 + 128 + cl0;
        EPI_ROWS_BEGIN
            const int row = u.orow + rl;
#pragma unroll
            for (int bj = 0; bj < 2; ++bj) { const int col = u.ocol + bj * HALF + cl0;
                float sb[8]; unpack8(*(const u32x4*)(pb + (size_t)(ai * HALF + m * 16) * NIN + bj * 256), sb);
                const f32x4 v0 = acc[ai][bj][m][0], v1 = acc[ai][bj][m][1];
                u32x4 w; w.x = cvt_pk_bf16(v0[0] * sb[0], v0[1] * sb[1]); w.y = cvt_pk_bf16(v0[2] * sb[2], v0[3] * sb[3]); w.z = cvt_pk_bf16(v1[0] * sb[4], v1[1] * sb[5]); w.w = cvt_pk_bf16(v1[2] * sb[6], v1[3] * sb[7]);
                *(u32x4*)(MRG + (size_t)row * DM + col) = w; }
        EPI_ROWS_END
    }
};
template <bool RES_F32> struct EpiRes {
    static constexpr bool PERM = true, AFTER_DRAIN = false, MIDK = false;
    const float* resA; const float* resB; int split; const bf16_t* resH; bf16_t* out;
    __device__ __forceinline__ void operator()(const f32x4 (&acc)[2][2][4][2], const Unit& u, int wr, int wc, int fr, int fq) const {
        const float* rbase = (u.orow < split) ? resA + (size_t)u.orow * DM : resB + (size_t)(u.orow - split) * DM;
        const int cl0 = wc * 32 + 8 * fq;
        EPI_ROWS_BEGIN
#pragma unroll
            for (int bj = 0; bj < 2; ++bj) { const size_t off = (size_t)rl * DM + u.ocol + bj * HALF + cl0;
                f32x4 r0, r1;
                if (RES_F32) { r0 = *(const f32x4*)(rbase + off); r1 = *(const f32x4*)(rbase + off + 4); }
                else { float f[8]; unpack8(*(const u32x4*)(resH + (size_t)u.orow * DM + off), f); r0 = (f32x4){f[0], f[1], f[2], f[3]}; r1 = (f32x4){f[4], f[5], f[6], f[7]}; }
                const f32x4 v0 = r0 + acc[ai][bj][m][0], v1 = r1 + acc[ai][bj][m][1];
                u32x4 w; w.x = cvt_pk_bf16(v0[0], v0[1]); w.y = cvt_pk_bf16(v0[2], v0[3]); w.z = cvt_pk_bf16(v1[0], v1[1]); w.w = cvt_pk_bf16(v1[2], v1[3]);
                *(u32x4*)(out + (size_t)u.orow * DM + off) = w; }
        EPI_ROWS_END
    }
};
template <int MODE  > struct EpiBf {
    static constexpr bool PERM = true, AFTER_DRAIN = false, MIDK = false;
    bf16_t* O; int ldc; float scale;
    __device__ __forceinline__ void operator()(const f32x4 (&acc)[2][2][4][2], const Unit& u, int wr, int wc, int fr, int fq) const {
        const int cl0 = wc * 32 + 8 * fq;
        EPI_ROWS_BEGIN
            bf16_t* rowp = O + (size_t)(u.orow + rl) * ldc + u.ocol + cl0;
#pragma unroll
            for (int bj = 0; bj < 2; ++bj) { f32x4 v0 = acc[ai][bj][m][0], v1 = acc[ai][bj][m][1];
                if (MODE == 0) { v0 = v0 * scale; v1 = v1 * scale; }
                else {
#pragma unroll
                    for (int e = 0; e < 4; ++e) { const float a = fmaxf(v0[e], 0.f), b = fmaxf(v1[e], 0.f); v0[e] = a * a; v1[e] = b * b; } }
                u32x4 w; w.x = cvt_pk_bf16(v0[0], v0[1]); w.y = cvt_pk_bf16(v0[2], v0[3]); w.z = cvt_pk_bf16(v1[0], v1[1]); w.w = cvt_pk_bf16(v1[2], v1[3]);
                *(u32x4*)(rowp + bj * HALF) = w; }
        EPI_ROWS_END
    }
};
struct EpiSoftmax {
    static constexpr bool PERM = true, AFTER_DRAIN = true, MIDK = false;
    bf16_t* PS;
    __device__ __forceinline__ void fused(f32x4 (&acc)[2][2][4][2], const Unit& u, int wr, int wc, int fr, int fq, LAS unsigned char* lds, int wid, int lane) const {
        LAS f32x2* X = (LAS f32x2*)lds;
        float mxl[2][4];
        EPI_ROWS_BEGIN
            float mx = -3.0e38f;
#pragma unroll
            for (int bj = 0; bj < 2; ++bj)
#pragma unroll
                for (int n = 0; n < 2; ++n) { const f32x4 v = acc[ai][bj][m][n]; mx = fmaxf(mx, fmaxf(fmaxf(v[0], v[1]), fmaxf(v[2], v[3]))); }
            mx = fmaxf(mx, __shfl_xor(mx, 16)); mx = fmaxf(mx, __shfl_xor(mx, 32));
            float s = 0.f;
#pragma unroll
            for (int bj = 0; bj < 2; ++bj)
#pragma unroll
                for (int n = 0; n < 2; ++n) { f32x4 v = acc[ai][bj][m][n];
#pragma unroll
                    for (int e = 0; e < 4; ++e) { v[e] = __expf(v[e] - mx); s += v[e]; }
                    acc[ai][bj][m][n] = v; }
            s += __shfl_xor(s, 16); s += __shfl_xor(s, 32);
            mxl[ai][m] = mx;
            if (fq == 0) X[rl * 4 + wc] = (f32x2){mx, s};
        EPI_ROWS_END
        LDS_WAIT(); __builtin_amdgcn_s_barrier(); asm volatile("" ::: "memory");
        const int cl0 = wc * 32 + 8 * fq;
        EPI_ROWS_BEGIN
            const f32x2 a = X[rl * 4 + 0], b = X[rl * 4 + 1], c = X[rl * 4 + 2], d = X[rl * 4 + 3];
            const float M = fmaxf(fmaxf(a.x, b.x), fmaxf(c.x, d.x));
            const float L = a.y * __expf(a.x - M) + b.y * __expf(b.x - M) + c.y * __expf(c.x - M) + d.y * __expf(d.x - M);
            const float f = __expf(mxl[ai][m] - M) / L;
            bf16_t* rowp = PS + (size_t)(u.orow + rl) * 256 + cl0;
#pragma unroll
            for (int bj = 0; bj < 2; ++bj) { const f32x4 v0 = acc[ai][bj][m][0] * f, v1 = acc[ai][bj][m][1] * f;
                u32x4 w; w.x = cvt_pk_bf16(v0[0], v0[1]); w.y = cvt_pk_bf16(v0[2], v0[3]); w.z = cvt_pk_bf16(v1[0], v1[1]); w.w = cvt_pk_bf16(v1[2], v1[3]);
                *(u32x4*)(rowp + bj * HALF) = w; }
        EPI_ROWS_END
        LDS_WAIT(); __builtin_amdgcn_s_barrier(); asm volatile("" ::: "memory");
    }
};

template <class Base> struct EpiTail {
    static constexpr bool PERM = Base::PERM, AFTER_DRAIN = false, MIDK = false;
    Base base; bf16_t* part;
    __device__ __forceinline__ void operator()(const f32x4 (&acc)[2][2][4][2], const Unit& u, int wr, int wc, int fr, int fq) const {
        if (u.aux == 0) { base(acc, u, wr, wc, fr, fq); return; }
        bf16_t* pb = part + (size_t)(u.aux - 1) * (MS * DM) + (size_t)u.orow * DM + u.ocol;
        EPI_ROWS_BEGIN
#pragma unroll
            for (int bj = 0; bj < 2; ++bj) {
                if (PERM) { const f32x4 v0 = acc[ai][bj][m][0], v1 = acc[ai][bj][m][1];
                    u32x4 w; w.x = cvt_pk_bf16(v0[0], v0[1]); w.y = cvt_pk_bf16(v0[2], v0[3]); w.z = cvt_pk_bf16(v1[0], v1[1]); w.w = cvt_pk_bf16(v1[2], v1[3]);
                    *(u32x4*)(pb + (size_t)rl * DM + bj * HALF + wc * 32 + 8 * fq) = w; }
                else {
#pragma unroll
                    for (int n = 0; n < 2; ++n) { const f32x4 v = acc[ai][bj][m][n]; u32x2 w; w.x = cvt_pk_bf16(v[0], v[1]); w.y = cvt_pk_bf16(v[2], v[3]);
                        *(u32x2*)(pb + (size_t)rl * DM + bj * HALF + wc * 32 + 16 * n + 4 * fq) = w; } }
            }
        EPI_ROWS_END
    }
};
}


#define XB_TMO      128
#define XB_XCNT(j)  (256  + 64 * (j))
#define XB_XSUB(j)  (1280 + 64 * (j))
#define XB_XGEN(j)  (2304 + 64 * (j))
#define XB_TOP      3328
#define XB_TOPGEN   3392
#define XCD_BAR_WORDS 3456
#define XB_SPIN_CAP (1u << 18)
__device__ __forceinline__ unsigned xb_ld(unsigned* p)              { return __hip_atomic_load(p, __ATOMIC_RELAXED, __HIP_MEMORY_SCOPE_AGENT); }
__device__ __forceinline__ unsigned xb_add(unsigned* p, unsigned v) { return __hip_atomic_fetch_add(p, v, __ATOMIC_RELAXED, __HIP_MEMORY_SCOPE_AGENT); }
__device__ __forceinline__ unsigned xb_xcc_id() { return (unsigned)__builtin_amdgcn_s_getreg((3 << 11) | 20) & 0xFu; }
#define XB_SPIN(cond, bar) do { unsigned _sp = 0; while (cond) { __builtin_amdgcn_s_sleep(1); \
    if ((++_sp & 255u) == 0u) { if (xb_ld(&(bar)[XB_TMO])) break; if (_sp > XB_SPIN_CAP) { atomicAdd(&(bar)[XB_TMO], 1u); break; } } } } while (0)
struct XcdBarrier { unsigned* bar; unsigned x; volatile LAS unsigned* st; };
__device__ __forceinline__ XcdBarrier xcd_barrier_post(unsigned* bar, volatile LAS unsigned* st) {
    XcdBarrier b; b.bar = bar; b.x = xb_xcc_id(); b.st = st;
    if (threadIdx.x == 0) (void)xb_add(&bar[XB_XCNT(b.x)], 1u);
    return b;
}
__device__ __forceinline__ void xcd_barrier_complete(unsigned* bar, unsigned x, unsigned& nloc, unsigned& nx) {
    const unsigned G = gridDim.x * gridDim.y * gridDim.z;
    unsigned sum, cnt, mine, sp = 0u;
    for (;;) {
        sum = 0u; cnt = 0u; mine = 0u;
#pragma unroll
        for (unsigned j = 0; j < 16; ++j) { const unsigned c = xb_ld(&bar[XB_XCNT(j)]); sum += c; cnt += (c > 0u) ? 1u : 0u; mine = (j == x) ? c : mine; }
        if (sum == G) break;
        __builtin_amdgcn_s_sleep(1);
        if ((++sp & 255u) == 0u) { if (xb_ld(&bar[XB_TMO])) break; if (sp > XB_SPIN_CAP) { atomicAdd(&bar[XB_TMO], 1u); break; } }
    }
    nloc = mine > 0u ? mine : 1u; nx = cnt > 0u ? cnt : 1u;
}
__device__ __forceinline__ void xcd_barrier(const XcdBarrier& b) {
    asm volatile("s_waitcnt vmcnt(0)" ::: "memory");
    __syncthreads();
    if (threadIdx.x == 0) {
        unsigned* bar = b.bar;
        __builtin_amdgcn_s_waitcnt(0);
        unsigned nloc = b.st[0], nx = b.st[1];
        if (nloc == 0u) { xcd_barrier_complete(bar, b.x, nloc, nx); b.st[0] = nloc; b.st[1] = nx; }
        const unsigned old = xb_add(&bar[XB_XSUB(b.x)], 1u);
        const unsigned gen = old / nloc;
        if (old + 1u == (gen + 1u) * nloc) {
            __builtin_amdgcn_fence(__ATOMIC_RELEASE, "agent");
            asm volatile("s_waitcnt vmcnt(0)" ::: "memory");
            const unsigned og = xb_add(&bar[XB_TOP], 1u);
            const unsigned tg = og / nx;
            if (og + 1u == (tg + 1u) * nx) xb_add(&bar[XB_TOPGEN], 1u);
            else XB_SPIN(xb_ld(&bar[XB_TOPGEN]) == tg, bar);
            __builtin_amdgcn_fence(__ATOMIC_ACQUIRE, "agent");
            xb_add(&bar[XB_XGEN(b.x)], 1u);
            asm volatile("s_waitcnt vmcnt(0)" ::: "memory");
        } else {
            XB_SPIN(xb_ld(&bar[XB_XGEN(b.x)]) == gen, bar);
            __builtin_amdgcn_fence(__ATOMIC_ACQUIRE, "agent");
            asm volatile("s_waitcnt vmcnt(0)" ::: "memory");
        }
    }
    __syncthreads();
}

struct Args { const float* in[26]; float* out; unsigned char* ws; };

struct Frame {
    LAS unsigned char* lds;
    int tid, lane, wave, G, bx;
    float* out; unsigned char* ws;
};
typedef const float* cfp_t;
__device__ __forceinline__ const float* karg_in(int i) {
    asm volatile("" : "+s"(i));
    const __attribute__((address_space(4))) cfp_t* ka = (const __attribute__((address_space(4))) cfp_t*)__builtin_amdgcn_kernarg_segment_ptr();
    return ka[i];
}
#define IN(i) karg_in(i)
#define WSP(T, off) ((T*)(F.ws + (off)))

__device__ __forceinline__ void p0_transpose_item(const float* W, int K, int N, bf16_t* WT, int row_off, LAS float* scr, int item, int lane, int ldk, int koff) {
    const int nblk = N / 32, kb = item / nblk, nb = item % nblk, k0 = 64 * kb, n0 = 32 * nb;
#pragma unroll 4
    for (int i = 0; i < 32; ++i) { const int kk = 2 * i + (lane >> 5); scr[kk * 33 + (lane & 31)] = W[(size_t)(k0 + kk) * N + n0 + (lane & 31)]; }
    LDS_WAIT(); asm volatile("" ::: "memory");
    const int c = lane & 7;
#pragma unroll
    for (int j = 0; j < 4; ++j) { const int n = (lane >> 3) + 8 * j; const LAS float* s = scr + (8 * c) * 33 + n;
        u32x4 o; o.x = cvt_pk_bf16(s[0 * 33], s[1 * 33]); o.y = cvt_pk_bf16(s[2 * 33], s[3 * 33]); o.z = cvt_pk_bf16(s[4 * 33], s[5 * 33]); o.w = cvt_pk_bf16(s[6 * 33], s[7 * 33]);
        *(u32x4*)(WT + (size_t)(row_off + n0 + n) * ldk + koff + k0 + 8 * c) = o; }
    LDS_WAIT(); asm volatile("" ::: "memory");
}
template <bool OUT_F32> __device__ __forceinline__ void rms_row(const float* xrow, const float* g, void* orow, int lane) {
    const f32x4* xr = (const f32x4*)xrow + lane; f32x4 v[8]; float ss = 0.f;
#pragma unroll
    for (int j = 0; j < 8; ++j) { v[j] = xr[64 * j]; ss += (v[j].x * v[j].x + v[j].y * v[j].y) + (v[j].z * v[j].z + v[j].w * v[j].w); }
    const float r = rsqrtf(wave_sum(ss) * (1.f / DM) + EPS);
    const f32x4* gr = (const f32x4*)g + lane;
#pragma unroll
    for (int j = 0; j < 8; ++j) { const f32x4 gg = gr[64 * j]; const f32x4 o = v[j] * r * gg;
        if (OUT_F32) ((f32x4*)orow)[lane + 64 * j] = o;
        else { u32x2 w; w.x = cvt_pk_bf16(o.x, o.y); w.y = cvt_pk_bf16(o.z, o.w); ((u32x2*)orow)[lane + 64 * j] = w; } }
}

constexpr int I_IN = 32 * 288, I_SQ = 32 * 64, I_BR = 16 * 64, I_UP = 32 * 256, I_DN = 128 * 64;
constexpr int CV_A0 = 0, CV_A1 = I_IN + 2 * I_SQ;
constexpr int CV_B1 = CV_A1 + 3 * I_SQ + 2 * I_BR;
constexpr int CV_C1 = CV_B1 + I_UP;
constexpr int CV_D1 = CV_C1 + I_DN;
__device__ __forceinline__ void convert_one(Frame& F, int it, LAS float* scr) {
    int r = it, K = DM, N = DM, ro = 0, ldk = DM, koff = 0, src_i; size_t wso;
    if (r < I_IN) { src_i = 7; N = NIN; wso = WS_WIN; const int n0 = 32 * (r % 288);
        if (n0 >= C_GB) { const int j = n0 - C_GB; ro = C_GA + (j >> 7) * 256 + 128 + (j & 127) - n0; }
        else if (n0 >= C_GA) { const int j = n0 - C_GA; ro = C_GA + (j >> 7) * 256 + (j & 127) - n0; } }
    else if ((r -= I_IN) < I_SQ) { src_i = 19; wso = WS_WIN; ro = NIN; }
    else if ((r -= I_SQ) < I_SQ) { src_i = 20; wso = WS_WIN; ro = NIN + DM; }
    else if ((r -= I_SQ) < I_SQ) { src_i = 15; wso = WS_WMIX; }
    else if ((r -= I_SQ) < I_SQ) { src_i = 18; wso = WS_WQ; }
    else if ((r -= I_SQ) < I_SQ) { src_i = 21; wso = WS_WXO; }
    else if ((r -= I_SQ) < I_BR) { src_i = 13; wso = WS_WA; K = 1024; }
    else if ((r -= I_BR) < I_BR) { src_i = 14; wso = WS_WA; K = 1024; koff = 1024; }
    else if ((r -= I_BR) < I_UP) { src_i = 23; wso = WS_WUP; N = FF; }
    else { r -= I_UP; src_i = 24; wso = WS_WDN; K = FF; ldk = FF; }
    p0_transpose_item(IN(src_i), K, N, (bf16_t*)(F.ws + wso), ro, scr, r, F.lane, ldk, koff);
}
__device__ __forceinline__ void convert_fill(Frame& F, int i0, int i1, int n_units) {
    const int rounds = (n_units + F.G - 1) / F.G, nfull = n_units - (rounds - 1) * F.G;
    int slot = F.bx - nfull, nslots = F.G - nfull;
    if (nslots == 0) { slot = F.bx; nslots = F.G; }
    if (slot < 0) return;
    LAS float* scr = (LAS float*)(F.lds + F.wave * 16384);
    for (int it = i0 + slot * NWAVES + F.wave; it < i1; it += nslots * NWAVES) convert_one(F, it, scr);
}
template <int R> __device__ __forceinline__ void ln_stats(const bf16_t* p, size_t rstride, float (&mean)[R], float (&rstd)[R], float (&lo)[R][8], float (&hi)[R][8]) {
#pragma unroll
    for (int r = 0; r < R; ++r) { unpack8(*(const u32x4*)(p + r * rstride), lo[r]); unpack8(*(const u32x4*)(p + r * rstride + 512), hi[r]); }
    float s[R];
#pragma unroll
    for (int r = 0; r < R; ++r) { s[r] = 0.f;
#pragma unroll
        for (int e = 0; e < 8; ++e) s[r] += lo[r][e] + hi[r][e]; }
#pragma unroll
    for (int o = 1; o < 64; o <<= 1)
#pragma unroll
        for (int r = 0; r < R; ++r) s[r] += __shfl_xor(s[r], o);
#pragma unroll
    for (int r = 0; r < R; ++r) { mean[r] = s[r] * (1.f / 1024.f); s[r] = 0.f;
#pragma unroll
        for (int e = 0; e < 8; ++e) { const float d0 = lo[r][e] - mean[r], d1 = hi[r][e] - mean[r]; s[r] += d0 * d0 + d1 * d1; } }
#pragma unroll
    for (int o = 1; o < 64; o <<= 1)
#pragma unroll
        for (int r = 0; r < R; ++r) s[r] += __shfl_xor(s[r], o);
#pragma unroll
    for (int r = 0; r < R; ++r) rstd[r] = rsqrtf(s[r] * (1.f / 1024.f) + EPS);
}
template <bool OUT_F32> __device__ __forceinline__ void rms_rows2(const float* x0, const float* g0, void* o0, const float* x1, const float* g1, void* o1, int lane) {
    const f32x4* xr0 = (const f32x4*)x0 + lane; const f32x4* xr1 = (const f32x4*)x1 + lane; f32x4 v0[8], v1[8]; float s0 = 0.f, s1 = 0.f;
#pragma unroll
    for (int j = 0; j < 8; ++j) { v0[j] = xr0[64 * j]; v1[j] = xr1[64 * j]; }
#pragma unroll
    for (int j = 0; j < 8; ++j) { s0 += (v0[j].x * v0[j].x + v0[j].y * v0[j].y) + (v0[j].z * v0[j].z + v0[j].w * v0[j].w); s1 += (v1[j].x * v1[j].x + v1[j].y * v1[j].y) + (v1[j].z * v1[j].z + v1[j].w * v1[j].w); }
#pragma unroll
    for (int o = 1; o < 64; o <<= 1) { s0 += __shfl_xor(s0, o); s1 += __shfl_xor(s1, o); }
    const float r0 = rsqrtf(s0 * (1.f / DM) + EPS), r1 = rsqrtf(s1 * (1.f / DM) + EPS);
    const f32x4* gr0 = (const f32x4*)g0 + lane; const f32x4* gr1 = (const f32x4*)g1 + lane;
#pragma unroll
    for (int j = 0; j < 8; ++j) { const f32x4 a = v0[j] * r0 * gr0[64 * j], b = v1[j] * r1 * gr1[64 * j];
        if (OUT_F32) { ((f32x4*)o0)[lane + 64 * j] = a; ((f32x4*)o1)[lane + 64 * j] = b; }
        else { u32x2 w; w.x = cvt_pk_bf16(a.x, a.y); w.y = cvt_pk_bf16(a.z, a.w); ((u32x2*)o0)[lane + 64 * j] = w; w.x = cvt_pk_bf16(b.x, b.y); w.y = cvt_pk_bf16(b.z, b.w); ((u32x2*)o1)[lane + 64 * j] = w; } }
}
__device__ __forceinline__ void phase_prologue(Frame& F) {
    LAS float* scr = (LAS float*)(F.lds + F.wave * 16384);
    const int gw = F.bx * NWAVES + F.wave, NGW = F.G * NWAVES;
    for (int it = CV_A0 + gw; it < CV_A1; it += NGW) convert_one(F, it, scr);
    bf16_t* XN = WSP(bf16_t, WS_XN);
    { const float* xp = IN(0); const float* xs = IN(1); const float* xm = IN(5); const float* gx = IN(6); const float* gm = IN(17);
      for (int m = gw; m < MT + 1024; m += 2 * NGW) {
        const int m2 = m + NGW;
        const float* s0 = m < MP ? xp + (size_t)m * DM : (m < MT ? xs + (size_t)(m - MP) * DM : xm + (size_t)(m - MT) * DM);
        if (m2 < MT + 1024) { const float* s1 = m2 < MP ? xp + (size_t)m2 * DM : (m2 < MT ? xs + (size_t)(m2 - MP) * DM : xm + (size_t)(m2 - MT) * DM);
            rms_rows2<false>(s0, m < MT ? gx : gm, XN + (size_t)m * DM, s1, m2 < MT ? gx : gm, XN + (size_t)m2 * DM, F.lane); }
        else rms_row<false>(s0, m < MT ? gx : gm, XN + (size_t)m * DM, F.lane);
      } }
    bf16_t* WS = WSP(bf16_t, WS_WSP);
    for (int i = F.bx * 512 + F.tid; i < 4 * 128 * 128; i += F.G * 512) { const int t = (i >> 7) & 127, s = i & 127; const float w = (s <= t) ? IN(10)[i] : 0.f; WS[i] = (bf16_t)(cvt_pk_bf16(w, 0.f) & 0xffff); }
}

__device__ __forceinline__ void phase_mixprep(Frame& F) {
    const bf16_t* P1 = WSP(bf16_t, WS_P1);
    {
        bf16_t* YB = WSP(bf16_t, WS_YA);   const float* cw = IN(12); const float* st = IN(2);
        for (int it = F.bx * 512 + F.tid; it < (MT / 4) * 128; it += F.G * 512) {
            const int r0 = (it >> 7) * 4, c0 = (it & 127) * 8;
            const bool prompt = r0 < MP;
            const int pos0 = prompt ? (r0 & 2047) : ((r0 - MP) & 7), b = prompt ? (r0 >> 11) : ((r0 - MP) >> 3);
            float p[6][8], bg[4][8];
            if (pos0 >= 2) {
#pragma unroll
                for (int k = 0; k < 2; ++k) { float cg[8], xi[8]; unpack8(*(const u32x4*)(P1 + (size_t)(r0 - 2 + k) * NIN + C_CG + c0), cg); unpack8(*(const u32x4*)(P1 + (size_t)(r0 - 2 + k) * NIN + C_XIN + c0), xi);
#pragma unroll
                    for (int e = 0; e < 8; ++e) p[k][e] = cg[e] * xi[e]; }
            } else if (prompt) {
#pragma unroll
                for (int k = 0; k < 2; ++k)
#pragma unroll
                    for (int e = 0; e < 8; ++e) p[k][e] = 0.f;
            } else {
#pragma unroll
                for (int k = 0; k < 2; ++k) { const f32x4 a = *(const f32x4*)(st + ((size_t)b * 2 + k) * 1024 + c0), c = *(const f32x4*)(st + ((size_t)b * 2 + k) * 1024 + c0 + 4);
                    p[k][0] = a.x; p[k][1] = a.y; p[k][2] = a.z; p[k][3] = a.w; p[k][4] = c.x; p[k][5] = c.y; p[k][6] = c.z; p[k][7] = c.w; }
            }
#pragma unroll
            for (int i = 0; i < 4; ++i) { float cg[8], xi[8]; const bf16_t* pr = P1 + (size_t)(r0 + i) * NIN;
                unpack8(*(const u32x4*)(pr + C_CG + c0), cg); unpack8(*(const u32x4*)(pr + C_XIN + c0), xi); unpack8(*(const u32x4*)(pr + C_BG + c0), bg[i]);
#pragma unroll
                for (int e = 0; e < 8; ++e) p[2 + i][e] = cg[e] * xi[e]; }
            float w0[8], w1[8], w2[8];
#pragma unroll
            for (int e = 0; e < 8; ++e) { w0[e] = cw[c0 + e]; w1[e] = cw[1024 + c0 + e]; w2[e] = cw[2048 + c0 + e]; }
#pragma unroll
            for (int i = 0; i < 4; ++i) { float y[8];
#pragma unroll
                for (int e = 0; e < 8; ++e) y[e] = bg[i][e] * (w0[e] * p[i][e] + w1[e] * p[i + 1][e] + w2[e] * p[i + 2][e]);
                u32x4 w; w.x = cvt_pk_bf16(y[0], y[1]); w.y = cvt_pk_bf16(y[2], y[3]); w.z = cvt_pk_bf16(y[4], y[5]); w.w = cvt_pk_bf16(y[6], y[7]);
                *(u32x4*)(YB + (size_t)(r0 + i) * DM + 1024 + c0) = w; }
            if (pos0 == (prompt ? 2044 : 4)) {
                float* o = F.out + (prompt ? O_CP : O_CS) + ((size_t)b * 2) * 1024 + c0;
                *(f32x4*)o = (f32x4){p[4][0], p[4][1], p[4][2], p[4][3]}; *(f32x4*)(o + 4) = (f32x4){p[4][4], p[4][5], p[4][6], p[4][7]};
                *(f32x4*)(o + 1024) = (f32x4){p[5][0], p[5][1], p[5][2], p[5][3]}; *(f32x4*)(o + 1028) = (f32x4){p[5][4], p[5][5], p[5][6], p[5][7]};
            }
        }
    }
    {
        const float* lg = IN(8); const float* lb = IN(9); const float* wsp = IN(10); const float* bsp = IN(11);
        bf16_t* YA = WSP(bf16_t, WS_YA);
        const int gw = F.bx * NWAVES + F.wave, NGW = F.G * NWAVES;
        for (int item = gw; item < 256; item += NGW) {
            const int sq = item >> 1, jsel = item & 1;
            const int row0 = MP + sq * 8;
            float mu[8], rs[8];
            { float m4[4], r4[4], vlo[4][8], vhi[4][8];
              ln_stats<4>(P1 + (size_t)row0 * NIN + C_V + 8 * F.lane, NIN, m4, r4, vlo, vhi);
#pragma unroll
              for (int t = 0; t < 4; ++t) { mu[t] = m4[t]; rs[t] = r4[t]; }
              ln_stats<4>(P1 + (size_t)(row0 + 4) * NIN + C_V + 8 * F.lane, NIN, m4, r4, vlo, vhi);
#pragma unroll
              for (int t = 0; t < 4; ++t) { mu[4 + t] = m4[t]; rs[4 + t] = r4[t]; } }
            {
                const int j = jsel; const int c0 = 8 * F.lane + 512 * j, g = c0 >> 8;
                float gg[8], bb[8];
                { const f32x4 a = *(const f32x4*)(lg + c0), b = *(const f32x4*)(lg + c0 + 4), c = *(const f32x4*)(lb + c0), d = *(const f32x4*)(lb + c0 + 4);
                  gg[0] = a.x; gg[1] = a.y; gg[2] = a.z; gg[3] = a.w; gg[4] = b.x; gg[5] = b.y; gg[6] = b.z; gg[7] = b.w;
                  bb[0] = c.x; bb[1] = c.y; bb[2] = c.z; bb[3] = c.w; bb[4] = d.x; bb[5] = d.y; bb[6] = d.z; bb[7] = d.w; }
                float vl[8][8];
#pragma unroll
                for (int t = 0; t < 8; ++t) {
                    float a[8]; unpack8(*(const u32x4*)(P1 + (size_t)(row0 + t) * NIN + C_V + c0), a);
#pragma unroll
                    for (int e = 0; e < 8; ++e) vl[t][e] = (a[e] - mu[t]) * rs[t] * gg[e] + bb[e];
                    float* o = F.out + O_CV + (size_t)(sq * 8 + t) * 1024 + c0;
                    *(f32x4*)o = (f32x4){vl[t][0], vl[t][1], vl[t][2], vl[t][3]}; *(f32x4*)(o + 4) = (f32x4){vl[t][4], vl[t][5], vl[t][6], vl[t][7]};
                }
#pragma unroll
                for (int t = 0; t < 8; ++t) {
                    float z[8]; const float bs = bsp[g * 128 + t];
#pragma unroll
                    for (int e = 0; e < 8; ++e) z[e] = bs;
#pragma unroll
                    for (int s = 0; s < 8; ++s) if (s <= t) { const float w = wsp[(size_t)g * 16384 + t * 128 + s];
#pragma unroll
                        for (int e = 0; e < 8; ++e) z[e] += w * vl[s][e]; }
                    float uf[8]; unpack8(*(const u32x4*)(P1 + (size_t)(row0 + t) * NIN + C_U + c0), uf);
                    u32x4 w; w.x = cvt_pk_bf16(uf[0] * z[0], uf[1] * z[1]); w.y = cvt_pk_bf16(uf[2] * z[2], uf[3] * z[3]); w.z = cvt_pk_bf16(uf[4] * z[4], uf[5] * z[5]); w.w = cvt_pk_bf16(uf[6] * z[6], uf[7] * z[7]);
                    *(u32x4*)(YA + (size_t)(row0 + t) * DM + c0) = w;
                }
            }
        }
    }
    {
        const float* lg = IN(8); const float* lb = IN(9);
        bf16_t* VT = WSP(bf16_t, WS_VT);
        LAS bf16_t* T = (LAS bf16_t*)F.lds;
        for (int un = F.bx; un < 256; un += F.G) {
            const int chunk = un >> 2, g = un & 3;
            const bool mine = ((F.lane >> 5) == (g & 1));
            const int cm = 256 * g + 8 * (F.lane & 31);
            float gg[8], bb[8];
            { const f32x4 a = *(const f32x4*)(lg + cm), b = *(const f32x4*)(lg + cm + 4), c = *(const f32x4*)(lb + cm), d = *(const f32x4*)(lb + cm + 4);
              gg[0] = a.x; gg[1] = a.y; gg[2] = a.z; gg[3] = a.w; gg[4] = b.x; gg[5] = b.y; gg[6] = b.z; gg[7] = b.w;
              bb[0] = c.x; bb[1] = c.y; bb[2] = c.z; bb[3] = c.w; bb[4] = d.x; bb[5] = d.y; bb[6] = d.z; bb[7] = d.w; }
            for (int rr = 0; rr < 16; rr += 4) {
                const int s0 = F.wave * 16 + rr;
                float mean[4], rstd[4], vlo[4][8], vhi[4][8];
                ln_stats<4>(P1 + (size_t)(chunk * 128 + s0) * NIN + C_V + 8 * F.lane, NIN, mean, rstd, vlo, vhi);
                if (mine) {
#pragma unroll
                    for (int r = 0; r < 4; ++r) {
                        float y[8];
#pragma unroll
                        for (int e = 0; e < 8; ++e) { const float xl = vlo[r][e], xh = vhi[r][e]; const float x = (g >> 1) ? xh : xl; y[e] = (x - mean[r]) * rstd[r] * gg[e] + bb[e]; }
                        u32x4 w; w.x = cvt_pk_bf16(y[0], y[1]); w.y = cvt_pk_bf16(y[2], y[3]); w.z = cvt_pk_bf16(y[4], y[5]); w.w = cvt_pk_bf16(y[6], y[7]);
                        *(LAS u32x4*)(T + (s0 + r) * 264 + 8 * (F.lane & 31)) = w;
                    }
                }
            }
            __syncthreads();
#pragma unroll 2
            for (int itn = 0; itn < 8; ++itn) {
                const int idx = itn * 512 + F.tid, c = idx >> 4, sb = idx & 15;
                unsigned short h[8];
#pragma unroll
                for (int i = 0; i < 8; ++i) h[i] = T[(8 * sb + i) * 264 + c];
                u32x4 w; w.x = (unsigned)h[0] | ((unsigned)h[1] << 16); w.y = (unsigned)h[2] | ((unsigned)h[3] << 16); w.z = (unsigned)h[4] | ((unsigned)h[5] << 16); w.w = (unsigned)h[6] | ((unsigned)h[7] << 16);
                *(u32x4*)(VT + ((size_t)chunk * 1024 + g * 256 + c) * 128 + 8 * sb) = w;
            }
            __syncthreads();
        }
    }
}

__device__ __forceinline__ void sample_attn_unit(Frame& F, int unit, bool tail) {
    const int b = unit >> 2, h = unit & 3, lane = F.lane, wave = F.wave, r16 = lane & 15, kq = lane >> 4;
    const float* Kb = IN(3) + ((size_t)b * NMEM * XH + h) * XD;
    const float* Vb = IN(4) + ((size_t)b * NMEM * XH + h) * XD;
    const bf16_t* Qb = WSP(bf16_t, WS_Q) + (size_t)(MP + b * 8) * DM + h * XD;
    LAS bf16_t* sP = (LAS bf16_t*)F.lds;
    LAS float* sSt = (LAS float*)(F.lds + 16 * 528);
    LAS bf16_t* sQ = (LAS bf16_t*)(F.lds + 9472);
    if (tail) {
        const int t = F.tid >> 6, d0 = (F.tid & 63) * 8;
        const bf16_t* pp = WSP(bf16_t, WS_PART) + (size_t)(b * 8 + t) * DM + h * XD + d0;
        f32x4 a0 = {0.f, 0.f, 0.f, 0.f}, a1 = {0.f, 0.f, 0.f, 0.f};
#pragma unroll
        for (int s = 0; s < 8; ++s) { float f[8]; unpack8(*(const u32x4*)(pp + (size_t)s * (MS * DM)), f); a0 = a0 + (f32x4){f[0], f[1], f[2], f[3]}; a1 = a1 + (f32x4){f[4], f[5], f[6], f[7]}; }
        a0 = a0 * QSCALE; a1 = a1 * QSCALE;
        *(LAS bf16x8*)(sQ + t * 520 + d0) = pack8(a0, a1);
        __syncthreads();
    }
    f32x4 s0 = {0.f, 0.f, 0.f, 0.f}, s1 = {0.f, 0.f, 0.f, 0.f};
    const float* k0p = Kb + (size_t)(32 * wave + r16) * (XH * XD) + kq * 8;
    const float* k1p = k0p + (size_t)16 * (XH * XD);
    const bf16_t* qp = Qb + (size_t)(r16 & 7) * DM + kq * 8;
#pragma unroll 8
    for (int ds = 0; ds < 16; ++ds) {
        const f32x4 a0 = *(const f32x4*)(k0p + ds * 32), a1 = *(const f32x4*)(k0p + ds * 32 + 4);
        const f32x4 c0 = *(const f32x4*)(k1p + ds * 32), c1 = *(const f32x4*)(k1p + ds * 32 + 4);
        u32x4 qw = tail ? *(const LAS u32x4*)(sQ + (r16 & 7) * 520 + kq * 8 + ds * 32) : *(const u32x4*)(qp + ds * 32); if (r16 >= 8) qw = (u32x4){0u, 0u, 0u, 0u};
        const bf16x8 qf = __builtin_bit_cast(bf16x8, qw);
        s0 = __builtin_amdgcn_mfma_f32_16x16x32_bf16(pack8(a0, a1), qf, s0, 0, 0, 0);
        s1 = __builtin_amdgcn_mfma_f32_16x16x32_bf16(pack8(c0, c1), qf, s1, 0, 0, 0);
    }
    float mx = fmaxf(fmaxf(fmaxf(s0[0], s0[1]), fmaxf(s0[2], s0[3])), fmaxf(fmaxf(s1[0], s1[1]), fmaxf(s1[2], s1[3])));
    mx = fmaxf(mx, __shfl_xor(mx, 16)); mx = fmaxf(mx, __shfl_xor(mx, 32));
    float sm = 0.f;
#pragma unroll
    for (int j = 0; j < 4; ++j) { s0[j] = __expf(s0[j] - mx); s1[j] = __expf(s1[j] - mx); sm += s0[j] + s1[j]; }
    sm += __shfl_xor(sm, 16); sm += __shfl_xor(sm, 32);
    if (kq == 0) { sSt[(wave * 16 + r16) * 2] = mx; sSt[(wave * 16 + r16) * 2 + 1] = sm; }
    __syncthreads();
    float M = -3.0e38f;
#pragma unroll
    for (int w2 = 0; w2 < 8; ++w2) M = fmaxf(M, sSt[(w2 * 16 + r16) * 2]);
    float L = 0.f;
#pragma unroll
    for (int w2 = 0; w2 < 8; ++w2) L += sSt[(w2 * 16 + r16) * 2 + 1] * __expf(sSt[(w2 * 16 + r16) * 2] - M);
    const float f = __expf(mx - M) / L;
    { u32x2 w; w.x = cvt_pk_bf16(s0[0] * f, s0[1] * f); w.y = cvt_pk_bf16(s0[2] * f, s0[3] * f); *(LAS u32x2*)(sP + r16 * 264 + 32 * wave + 4 * kq) = w;
      w.x = cvt_pk_bf16(s1[0] * f, s1[1] * f); w.y = cvt_pk_bf16(s1[2] * f, s1[3] * f); *(LAS u32x2*)(sP + r16 * 264 + 32 * wave + 16 + 4 * kq) = w; }
    __syncthreads();
    f32x4 o[4];
#pragma unroll
    for (int c = 0; c < 4; ++c) o[c] = (f32x4){0.f, 0.f, 0.f, 0.f};
    const float* vp = Vb + (size_t)(kq * 8) * (XH * XD) + 64 * wave + 4 * r16;
#pragma unroll 4
    for (int ms = 0; ms < 8; ++ms) {
        const bf16x8 pf = *(const LAS bf16x8*)(sP + r16 * 264 + ms * 32 + kq * 8);
        f32x4 x[8];
#pragma unroll
        for (int j = 0; j < 8; ++j) x[j] = *(const f32x4*)(vp + (size_t)(ms * 32 + j) * (XH * XD));
#pragma unroll
        for (int c = 0; c < 4; ++c) {
            const bf16x8 a = pack8((f32x4){x[0][c], x[1][c], x[2][c], x[3][c]}, (f32x4){x[4][c], x[5][c], x[6][c], x[7][c]});
            o[c] = __builtin_amdgcn_mfma_f32_16x16x32_bf16(a, pf, o[c], 0, 0, 0);
        }
    }
    if (r16 < 8) {
        bf16_t* op = WSP(bf16_t, WS_O) + (size_t)(MP + b * 8 + r16) * DM + h * XD + 64 * wave + 16 * kq;
        u32x4 w0, w1;
        w0.x = cvt_pk_bf16(o[0][0], o[1][0]); w0.y = cvt_pk_bf16(o[2][0], o[3][0]); w0.z = cvt_pk_bf16(o[0][1], o[1][1]); w0.w = cvt_pk_bf16(o[2][1], o[3][1]);
        w1.x = cvt_pk_bf16(o[0][2], o[1][2]); w1.y = cvt_pk_bf16(o[2][2], o[3][2]); w1.z = cvt_pk_bf16(o[0][3], o[1][3]); w1.w = cvt_pk_bf16(o[2][3], o[3][3]);
        *(u32x4*)op = w0; *(u32x4*)(op + 8) = w1;
    }
    __syncthreads();
}

template <bool OUT_F32> __device__ __forceinline__ void rms_store(const float (&v)[4][8], float r, const float* g, void* orow, int lane) {
#pragma unroll
    for (int j = 0; j < 4; ++j) { const int c = 8 * lane + 512 * j; const f32x4 g0 = *(const f32x4*)(g + c), g1 = *(const f32x4*)(g + c + 4);
        const f32x4 a = (f32x4){v[j][0], v[j][1], v[j][2], v[j][3]} * r * g0, b = (f32x4){v[j][4], v[j][5], v[j][6], v[j][7]} * r * g1;
        if (OUT_F32) { *(f32x4*)((float*)orow + c) = a; *(f32x4*)((float*)orow + c + 4) = b; }
        else { u32x4 w; w.x = cvt_pk_bf16(a.x, a.y); w.y = cvt_pk_bf16(a.z, a.w); w.z = cvt_pk_bf16(b.x, b.y); w.w = cvt_pk_bf16(b.z, b.w); *(u32x4*)((bf16_t*)orow + c) = w; } }
}
template <bool OUT_F32> __device__ __forceinline__ void phase_rms(Frame& F, const bf16_t* src, const float* g, void* dst, const bf16_t* part, const float* sbaseF, const bf16_t* sbaseH, bf16_t* hout) {
    const int gw = F.bx * NWAVES + F.wave, NGW = F.G * NWAVES, lane = F.lane;
    for (int mm = gw; mm < MT; mm += 2 * NGW) {
      const int m2 = mm + NGW; const bool reg0 = (mm < MP || part == nullptr), reg1 = (m2 < MT) && (m2 < MP || part == nullptr);
      if (reg0 && reg1) {
        float v0[4][8], v1[4][8]; float s0 = 0.f, s1 = 0.f;
#pragma unroll
        for (int j = 0; j < 4; ++j) { unpack8(*(const u32x4*)(src + (size_t)mm * DM + 8 * lane + 512 * j), v0[j]); unpack8(*(const u32x4*)(src + (size_t)m2 * DM + 8 * lane + 512 * j), v1[j]); }
#pragma unroll
        for (int j = 0; j < 4; ++j)
#pragma unroll
            for (int e = 0; e < 8; ++e) { s0 += v0[j][e] * v0[j][e]; s1 += v1[j][e] * v1[j][e]; }
#pragma unroll
        for (int o = 1; o < 64; o <<= 1) { s0 += __shfl_xor(s0, o); s1 += __shfl_xor(s1, o); }
        rms_store<OUT_F32>(v0, rsqrtf(s0 * (1.f / DM) + EPS), g, OUT_F32 ? (void*)((float*)dst + (size_t)mm * DM) : (void*)((bf16_t*)dst + (size_t)mm * DM), lane);
        rms_store<OUT_F32>(v1, rsqrtf(s1 * (1.f / DM) + EPS), g, OUT_F32 ? (void*)((float*)dst + (size_t)m2 * DM) : (void*)((bf16_t*)dst + (size_t)m2 * DM), lane);
        continue;
      }
      for (int m = mm; m <= m2 && m < MT; m += NGW) {
        void* orow = OUT_F32 ? (void*)((float*)dst + (size_t)m * DM) : (void*)((bf16_t*)dst + (size_t)m * DM);
        float v[4][8]; float ss = 0.f;
        if (m < MP || part == nullptr) {
#pragma unroll
            for (int j = 0; j < 4; ++j) unpack8(*(const u32x4*)(src + (size_t)m * DM + 8 * lane + 512 * j), v[j]);
        } else {
            const int ms = m - MP;
#pragma unroll
            for (int j = 0; j < 4; ++j) { const int c = 8 * lane + 512 * j;
                if (sbaseF) { const f32x4 a = *(const f32x4*)(sbaseF + (size_t)ms * DM + c), b = *(const f32x4*)(sbaseF + (size_t)ms * DM + c + 4);
                    v[j][0] = a.x; v[j][1] = a.y; v[j][2] = a.z; v[j][3] = a.w; v[j][4] = b.x; v[j][5] = b.y; v[j][6] = b.z; v[j][7] = b.w; }
                else unpack8(*(const u32x4*)(sbaseH + (size_t)ms * DM + c), v[j]); }
#pragma unroll
            for (int s = 0; s < 8; ++s)
#pragma unroll
                for (int j = 0; j < 4; ++j) { float f[8]; unpack8(*(const u32x4*)(part + (size_t)s * (MS * DM) + (size_t)ms * DM + 8 * lane + 512 * j), f);
#pragma unroll
                    for (int e = 0; e < 8; ++e) v[j][e] += f[e]; }
            if (hout) {
#pragma unroll
                for (int j = 0; j < 4; ++j) { u32x4 w; w.x = cvt_pk_bf16(v[j][0], v[j][1]); w.y = cvt_pk_bf16(v[j][2], v[j][3]); w.z = cvt_pk_bf16(v[j][4], v[j][5]); w.w = cvt_pk_bf16(v[j][6], v[j][7]);
                    *(u32x4*)(hout + (size_t)ms * DM + 8 * lane + 512 * j) = w;
                    unpack8(w, v[j]); }
            }
        }
#pragma unroll
        for (int j = 0; j < 4; ++j)
#pragma unroll
            for (int e = 0; e < 8; ++e) ss += v[j][e] * v[j][e];
        rms_store<OUT_F32>(v, rsqrtf(wave_sum(ss) * (1.f / DM) + EPS), g, orow, lane);
      }
    }
}

__global__ void __launch_bounds__(NWAVES * 64, 2) fwd_megakernel(Args args) {
    extern __shared__ __attribute__((aligned(16))) unsigned char lds_raw[];
    cg::grid_group grid = cg::this_grid();
    Frame F;
    F.lds = (LAS unsigned char*)lds_raw;
    F.tid = threadIdx.x; F.lane = F.tid & 63; F.wave = __builtin_amdgcn_readfirstlane(F.tid >> 6);
    F.G = gridDim.x; F.bx = blockIdx.x;
    F.out = args.out; F.ws = args.ws;
    volatile LAS unsigned* MISC = (volatile LAS unsigned*)(F.lds + 131072 + 320);
    if (F.tid < 32) MISC[F.tid] = 0u;
    __syncthreads();
    XcdBarrier xbar = xcd_barrier_post((unsigned*)(F.ws + WS_CTL) + 4096, MISC + 8);
#define SEAM0() do { grid.sync(); int t_ = threadIdx.x; asm volatile("" : "+v"(t_)); F.tid = t_; F.lane = t_ & 63; } while (0)
#define SEAM() do { xcd_barrier(xbar); int t_ = threadIdx.x; asm volatile("" : "+v"(t_)); F.tid = t_; F.lane = t_ & 63; { unsigned char* w_ = F.ws; float* o_ = F.out; asm volatile("" : "+s"(w_), "+s"(o_)); F.ws = w_; F.out = o_; } } while (0)
#ifndef PHASE_MASK
#define PHASE_MASK 0xffffffffu
#endif
#define PH(k) ((PHASE_MASK >> (k)) & 1u)
    using namespace pg8;
    const char* XN = (const char*)(F.ws + WS_XN);
    const bool tail = (F.G == 256);

    if (PH(0)) phase_prologue(F);
    if (F.G > (1 << 24)) SEAM0();
    SEAM();
    if (PH(1)) {
        SchedIn S{XN, (const char*)(F.ws + WS_WIN), F.G, F.bx};
        EpiIn E{WSP(bf16_t, WS_P1), F.out + O_MK, F.out + O_MV, WSP(bf16_t, WS_KP), WSP(bf16_t, WS_VPT)};
        gemm_phase<EpiIn, SchedIn, false>(F.lds, DM, DM, S, E);
        convert_fill(F, CV_A1, CV_B1, 1296 + 64);
    }
    SEAM();
    if (PH(2)) phase_mixprep(F);
    asm volatile("s_waitcnt vmcnt(0)" ::: "memory"); __syncthreads();
    { int t_ = threadIdx.x; asm volatile("" : "+v"(t_)); F.tid = t_; F.lane = t_ & 63; }
    if (PH(3)) {
        SchedSp S{(const char*)(F.ws + WS_WSP), (const char*)(F.ws + WS_VT), F.G, F.bx};
        EpiSp E{WSP(bf16_t, WS_P1), IN(11), WSP(bf16_t, WS_YA)};
        gemm_phase<EpiSp, SchedSp, true>(F.lds, 128, 128, S, E);
    }
    SEAM();
    if (PH(4)) {
        SchedRect S{(const char*)(F.ws + WS_YA), (const char*)(F.ws + WS_WA), (size_t)BM * DM * 2, (size_t)BM * DM * 2, 36, 8, F.G, F.bx, 32};
        EpiMerged E{WSP(bf16_t, WS_P1), WSP(bf16_t, WS_MRG)};
        gemm_phase<EpiMerged, SchedRect, true>(F.lds, DM, DM, S, E);
        convert_fill(F, CV_B1, CV_C1, 288);
    }
    SEAM();
    if (PH(6)) {
        SchedTail S{(const char*)(F.ws + WS_MRG), (const char*)(F.ws + WS_WMIX), (size_t)BM * DM * 2, (size_t)BM * DM * 2, 32, F.G, F.bx, tail};
        EpiTail<EpiRes<true>> E{{IN(0), IN(1), MP, nullptr, WSP(bf16_t, WS_H1)}, WSP(bf16_t, WS_PART)};
        gemm_phase<EpiTail<EpiRes<true>>, SchedTail, true>(F.lds, DM, DM, S, E);
    }
    SEAM();
    phase_rms<false>(F, WSP(bf16_t, WS_H1), IN(16), WSP(bf16_t, WS_XN), tail ? WSP(bf16_t, WS_PART) : nullptr, IN(1), nullptr, WSP(bf16_t, WS_H1) + (size_t)MP * DM);
    SEAM();
    if (PH(7)) {
        SchedTail S{XN, (const char*)(F.ws + WS_WQ), (size_t)BM * DM * 2, (size_t)BM * DM * 2, 32, F.G, F.bx, tail};
        EpiTail<EpiBf<0>> E{{WSP(bf16_t, WS_Q), DM, QSCALE}, WSP(bf16_t, WS_PART)};
        gemm_phase<EpiTail<EpiBf<0>>, SchedTail, true>(F.lds, DM, DM, S, E);
    }
    SEAM();
    if (PH(8)) {
        {
            SchedS S{(const char*)(F.ws + WS_Q), (const char*)(F.ws + WS_KP), F.G, F.bx};
            EpiSoftmax E{WSP(bf16_t, WS_PS)};
            gemm_phase<EpiSoftmax, SchedS, false>(F.lds, DM, DM, S, E);
        }
        asm volatile("s_waitcnt vmcnt(0)" ::: "memory"); __syncthreads();
        {
            SchedO S{(const char*)(F.ws + WS_PS), (const char*)(F.ws + WS_VPT), F.G, F.bx};
            EpiBf<0> E{WSP(bf16_t, WS_O), DM, 1.0f};
            gemm_phase<EpiBf<0>, SchedO, true>(F.lds, 256, 256, S, E);
        }
        __syncthreads();
        unsigned* qhead = (unsigned*)(F.ws + WS_CTL) + 2048;
        for (;;) {
            if (F.tid == 0) MISC[16] = __hip_atomic_fetch_add(qhead, 1u, __ATOMIC_RELAXED, __HIP_MEMORY_SCOPE_AGENT);
            __syncthreads();
            const int un = (int)MISC[16];
            if (un >= 512) break;
            sample_attn_unit(F, un, tail);
        }
    }
    SEAM();
    if (PH(10)) {
        SchedTail S{(const char*)(F.ws + WS_O), (const char*)(F.ws + WS_WXO), (size_t)BM * DM * 2, (size_t)BM * DM * 2, 32, F.G, F.bx, tail};
        EpiTail<EpiRes<false>> E{{nullptr, nullptr, 1 << 30, WSP(bf16_t, WS_H1), WSP(bf16_t, WS_H2)}, WSP(bf16_t, WS_PART)};
        gemm_phase<EpiTail<EpiRes<false>>, SchedTail, true>(F.lds, DM, DM, S, E);
    }
    SEAM();
    phase_rms<false>(F, WSP(bf16_t, WS_H2), IN(22), WSP(bf16_t, WS_XN), tail ? WSP(bf16_t, WS_PART) : nullptr, nullptr, WSP(bf16_t, WS_H1) + (size_t)MP * DM, WSP(bf16_t, WS_H2) + (size_t)MP * DM);
    SEAM();
    if (PH(11)) {
        SchedRect S{XN, (const char*)(F.ws + WS_WUP), (size_t)BM * DM * 2, (size_t)BM * DM * 2, 36, 32, F.G, F.bx, 32};
        EpiBf<1> E{WSP(bf16_t, WS_UP), FF, 1.0f};
        gemm_phase<EpiBf<1>, SchedRect, false>(F.lds, DM, DM, S, E);
        convert_fill(F, CV_C1, CV_D1, 36 * 32);
    }
    SEAM();
    if (PH(12)) {
        SchedTail S{(const char*)(F.ws + WS_UP), (const char*)(F.ws + WS_WDN), (size_t)BM * FF * 2, (size_t)BM * FF * 2, 128, F.G, F.bx, tail};
        EpiTail<EpiRes<false>> E{{nullptr, nullptr, 1 << 30, WSP(bf16_t, WS_H2), WSP(bf16_t, WS_H2)}, WSP(bf16_t, WS_PART)};
        gemm_phase<EpiTail<EpiRes<false>>, SchedTail, true>(F.lds, FF, FF, S, E);
    }
    SEAM();
    phase_rms<true>(F, WSP(bf16_t, WS_H2), IN(25), F.out + O_Y, tail ? WSP(bf16_t, WS_PART) : nullptr, nullptr, WSP(bf16_t, WS_H2) + (size_t)MP * DM, nullptr);
}

extern "C" void kernel_launch(void* const* d_in, const int* in_sizes, int n_in, void* d_out, int out_size, void* d_ws, size_t ws_size, hipStream_t stream) {
    static int grid = 0;
    if (grid == 0) {
        if (n_in != 26 || ws_size < WS_END) { fprintf(stderr, "kernel_launch: unexpected n_in %d / ws_size %zu\n", n_in, ws_size); grid = -1; return; }
        int dev = 0, cus = 0, per_cu = 0;
        hipGetDevice(&dev);
        hipDeviceGetAttribute(&cus, hipDeviceAttributeMultiprocessorCount, dev);
        if (hipFuncSetAttribute((const void*)fwd_megakernel, hipFuncAttributeMaxDynamicSharedMemorySize, LDS_BYTES) != hipSuccess) { fprintf(stderr, "kernel_launch: hipFuncSetAttribute failed\n"); grid = -1; return; }
        if (hipOccupancyMaxActiveBlocksPerMultiprocessor(&per_cu, (const void*)fwd_megakernel, NWAVES * 64, LDS_BYTES) != hipSuccess || per_cu < 1) { fprintf(stderr, "kernel_launch: occupancy query says %d\n", per_cu); per_cu = 1; }
        (void)hipGetLastError();
        grid = cus;
        if (grid < 128) { fprintf(stderr, "kernel_launch: needs >= 128 CUs\n"); grid = -1; return; }
    }
    if (grid < 0) return;
    if (hipMemsetAsync((char*)d_ws + WS_CTL, 0, 65536, stream) != hipSuccess) { fprintf(stderr, "kernel_launch: memset failed\n"); return; }
    Args a{};
    for (int i = 0; i < 26; ++i) a.in[i] = (const float*)d_in[i];
    a.out = (float*)d_out; a.ws = (unsigned char*)d_ws;
    void* kargs[] = {&a};
    hipError_t e = hipLaunchCooperativeKernel((const void*)fwd_megakernel, dim3(grid), dim3(NWAVES * 64), kargs, LDS_BYTES, stream);
    if (e != hipSuccess) fprintf(stderr, "kernel_launch: cooperative launch failed: %s (grid %d)\n", hipGetErrorString(e), grid);
}
```
